# Optimizing an MI355X kernel written in HIP

```python
import math
import jax, jax.numpy as jnp
from jax import lax
import numpy as np

D_MODEL = 2048
BATCH = 4
SEQ = 4096
DEPTH = 2

GRID_W = 64
CTX_LEN = 256
HEAD_DIM = 128
N_GROUP_HEADS = D_MODEL // (2 * HEAD_DIM)
MIX_WIDTH = 2 * N_GROUP_HEADS * HEAD_DIM
Q_BLOCK = 128
ROPE_BASE = 10000.0
EPS = 1e-6
NEG_INF = -1e30
A_HEADS = N_GROUP_HEADS
A_SUB = HEAD_DIM // 2
A_SCALE = A_SUB ** -0.5
LAMBDA_INIT_L0 = 0.8 - 0.6 * math.exp(-0.3 * 0)
B_HEADS = N_GROUP_HEADS
B_KV = B_HEADS // 4
B_GROUP = B_HEADS // B_KV
C_HEADS = N_GROUP_HEADS
C_KV = C_HEADS // 4
C_GROUP = C_HEADS // C_KV
C_WINDOW = 128
D_HEADS = N_GROUP_HEADS
NA_ROWS = 8
NA_COLS = 16
NA_QCOLS = 16
NA_KCOLS = NA_COLS + NA_QCOLS
ATT_SCALE = HEAD_DIM ** -0.5
D_FF = 5632
N_EXPERTS = 8
TOP_K = 2
D_EXPERT = 7168
MOE_BLOCK = 128

L0_SIZES = (A_HEADS * HEAD_DIM, B_HEADS * HEAD_DIM, A_HEADS * HEAD_DIM, A_HEADS * HEAD_DIM, B_KV * HEAD_DIM, B_KV * HEAD_DIM)
L1_SIZES = (C_HEADS * HEAD_DIM, D_HEADS * HEAD_DIM, C_KV * HEAD_DIM, C_KV * HEAD_DIM, D_HEADS * HEAD_DIM, D_HEADS * HEAD_DIM)
L0_Q = L0_SIZES[0] + L0_SIZES[1]
L1_Q = L1_SIZES[0] + L1_SIZES[1]
PROJ_COLS = sum(L0_SIZES)

kernel_name = 'hybrid_diffusion_prefix_block'


def _split(t, sizes):
    return jnp.split(t, [int(i) for i in np.cumsum(sizes)[:-1]], axis=-1)


def rmsnorm(x, g):
    xf = x.astype(jnp.float32)
    y = xf * lax.rsqrt(jnp.mean(xf * xf, axis=-1, keepdims=True) + EPS)
    return (y * g.astype(jnp.float32)).astype(x.dtype)


def modulate(x, g, shift, scale):
    return rmsnorm(x, g) * (1.0 + scale) + shift


def ada_mod(c_vec, w_ada, b_ada, n_chunks):
    m = jax.nn.silu(c_vec) @ w_ada[:, :n_chunks * D_MODEL] + b_ada[:n_chunks * D_MODEL]
    return jnp.split(m, n_chunks, axis=-1)


def axial_rope(n_tok, dim):
    t = jnp.arange(n_tok)
    pos = jnp.stack([t // GRID_W, t % GRID_W], axis=-1).astype(jnp.float32)
    n_pairs = dim // 4
    freq = ROPE_BASE ** (-jnp.arange(n_pairs, dtype=jnp.float32) / n_pairs)
    ang = (pos[:, :, None] * freq).reshape(n_tok, 2 * n_pairs)
    return jnp.cos(ang), jnp.sin(ang)


def apply_rope(x, cos, sin):
    xf = x.astype(jnp.float32).reshape(x.shape[:-1] + (-1, 2))
    x0, x1 = xf[..., 0], xf[..., 1]
    shape = (1, cos.shape[0]) + (1,) * (x.ndim - 3) + (cos.shape[1],)
    c, s = cos.reshape(shape), sin.reshape(shape)
    out = jnp.stack([x0 * c - x1 * s, x0 * s + x1 * c], axis=-1)
    return out.reshape(x.shape).astype(x.dtype)


def gqa_attend(q, k, v, sink=None):
    s = jnp.einsum('bqhgd,bkhd->bhgqk', q, k).astype(jnp.float32) * ATT_SCALE
    if sink is None:
        p = jax.nn.softmax(s, axis=-1)
    else:
        sk = jnp.broadcast_to(sink.astype(jnp.float32).reshape(1, k.shape[2], -1, 1, 1), s.shape[:-1] + (1,))
        p = jax.nn.softmax(jnp.concatenate([s, sk], axis=-1), axis=-1)[..., :-1]
    o = jnp.einsum('bhgqk,bkhd->bqhgd', p.astype(v.dtype), v)
    return o.reshape(q.shape[:2] + (-1,))


def diff_attend(q, k, v, lam, subln_g):
    s = jnp.einsum('bqhcd,bkhcd->bhcqk', q, k).astype(jnp.float32) * A_SCALE
    p = jax.nn.softmax(s, axis=-1)
    a = p[:, :, 0] - lam * p[:, :, 1]
    o = jnp.einsum('bhqk,bkhd->bqhd', a.astype(v.dtype), v)
    o = rmsnorm(o, subln_g) * (1.0 - LAMBDA_INIT_L0)
    return o.reshape(q.shape[:2] + (-1,))


def sweep_query_blocks(fn, *qs):
    b, s = qs[0].shape[:2]
    nb = s // Q_BLOCK
    blocks = tuple(jnp.moveaxis(q.reshape((b, nb, Q_BLOCK) + q.shape[2:]), 1, 0) for q in qs)
    out = lax.map(lambda a: fn(*a), blocks)
    return jnp.moveaxis(out, 0, 1).reshape((b, s) + out.shape[3:])


def window_attend(q, k, v, kc, vc, sinks):
    b, s, hkv, g, d = q.shape
    nb = s // Q_BLOCK
    ns = C_WINDOW // Q_BLOCK
    band = (2 * ns + 1) * Q_BLOCK
    pad = ((0, 0), (C_WINDOW, C_WINDOW), (0, 0), (0, 0))
    kb = jnp.pad(k, pad).reshape(b, nb + 2 * ns, Q_BLOCK, hkv, d)
    vb = jnp.pad(v, pad).reshape(b, nb + 2 * ns, Q_BLOCK, hkv, d)
    k_band = jnp.concatenate([kb[:, j:j + nb] for j in range(2 * ns + 1)], axis=2)
    v_band = jnp.concatenate([vb[:, j:j + nb] for j in range(2 * ns + 1)], axis=2)
    qb = q.reshape(b, nb, Q_BLOCK, hkv, g, d)
    qpos = jnp.arange(s).reshape(nb, Q_BLOCK)
    kpos = jnp.arange(nb)[:, None] * Q_BLOCK - C_WINDOW + jnp.arange(band)[None, :]
    ok = (jnp.abs(kpos[:, None, :] - qpos[:, :, None]) <= C_WINDOW) & (kpos[:, None, :] >= 0) & (kpos[:, None, :] < s)
    s_loc = jnp.einsum('bnqhgd,bnkhd->bhgnqk', qb, k_band).astype(jnp.float32) * ATT_SCALE
    s_loc = jnp.where(ok, s_loc, NEG_INF)
    s_ctx = jnp.einsum('bnqhgd,bkhd->bhgnqk', qb, kc).astype(jnp.float32) * ATT_SCALE
    sk = jnp.broadcast_to(sinks.astype(jnp.float32).reshape(1, hkv, g, 1, 1, 1), s_loc.shape[:-1] + (1,))
    p = jax.nn.softmax(jnp.concatenate([s_loc, s_ctx, sk], axis=-1), axis=-1).astype(v.dtype)
    o = (jnp.einsum('bhgnqk,bnkhd->bnqhgd', p[..., :band], v_band)
         + jnp.einsum('bhgnqk,bkhd->bnqhgd', p[..., band:-1], vc))
    return o.reshape(b, s, hkv * g * d)


def neighbourhood_attend(q, k, v, kc, vc, rpb):
    b, s, h, d = q.shape
    rows = s // GRID_W
    wr = min(NA_ROWS, rows)
    n_cb = GRID_W // NA_QCOLS
    cb = np.clip(np.arange(n_cb) * NA_QCOLS - NA_COLS // 2, 0, GRID_W - NA_KCOLS)
    kcol = cb[:, None] + np.arange(NA_KCOLS)[None, :]
    qcol = np.arange(GRID_W).reshape(n_cb, NA_QCOLS)
    cstart = np.clip(qcol - NA_COLS // 2, 0, GRID_W - NA_COLS)
    col_ok = (kcol[:, None, :] >= cstart[:, :, None]) & (kcol[:, None, :] < cstart[:, :, None] + NA_COLS)
    dcol = np.clip(kcol[:, None, :] - qcol[:, :, None] + NA_COLS - 1, 0, 2 * NA_COLS - 2)
    kg = k.reshape(b, rows, GRID_W, h, d)
    vg = v.reshape(b, rows, GRID_W, h, d)
    qg = jnp.moveaxis(q.reshape(b, rows, GRID_W, h, d), 1, 0)

    def row_block(args):
        r, q_row = args
        rs = jnp.clip(r - wr // 2, 0, rows - wr)
        k_nb = lax.dynamic_slice_in_dim(kg, rs, wr, axis=1)[:, :, kcol]
        v_nb = lax.dynamic_slice_in_dim(vg, rs, wr, axis=1)[:, :, kcol]
        qb = q_row.reshape(b, n_cb, NA_QCOLS, h, d)
        drow = rs + jnp.arange(wr) - r + NA_ROWS - 1
        bias = rpb[:, drow[None, None, :, None], dcol[:, :, None, :]].astype(jnp.float32)
        s_nb = jnp.einsum('bcqhd,bwckhd->bhcqwk', qb, k_nb).astype(jnp.float32) * ATT_SCALE + bias
        s_nb = jnp.where(col_ok[:, :, None, :], s_nb, NEG_INF).reshape(b, h, n_cb, NA_QCOLS, wr * NA_KCOLS)
        s_ctx = jnp.einsum('bcqhd,bkhd->bhcqk', qb, kc).astype(jnp.float32) * ATT_SCALE
        p = jax.nn.softmax(jnp.concatenate([s_nb, s_ctx], axis=-1), axis=-1).astype(v.dtype)
        p_nb = p[..., :wr * NA_KCOLS].reshape(b, h, n_cb, NA_QCOLS, wr, NA_KCOLS)
        o = (jnp.einsum('bhcqwk,bwckhd->bcqhd', p_nb, v_nb)
             + jnp.einsum('bhcqk,bkhd->bcqhd', p[..., wr * NA_KCOLS:], vc))
        return o.reshape(b, GRID_W, h * d)

    o = lax.map(row_block, (jnp.arange(rows), qg))
    return jnp.moveaxis(o, 0, 1).reshape(b, s, h * d)


def mixer_diff_gqa(h, hc, w_in, lam_q1, lam_k1, lam_q2, lam_k2, subln_g, q_norm_g, k_norm_g, rope, ctx_out):
    cos_a, sin_a, cos_b, sin_b = rope
    b, s, _ = h.shape
    n_ctx = hc.shape[1]
    aq, bq, ak, av, bk, bv = _split(h @ w_in, L0_SIZES)
    aq = apply_rope(aq.reshape(b, s, A_HEADS, 2, A_SUB), cos_a, sin_a)
    ak = apply_rope(ak.reshape(b, s, A_HEADS, 2, A_SUB), cos_a, sin_a)
    bq = apply_rope(rmsnorm(bq.reshape(b, s, B_KV, B_GROUP, HEAD_DIM), q_norm_g), cos_b, sin_b)
    bk = apply_rope(rmsnorm(bk.reshape(b, s, B_KV, HEAD_DIM), k_norm_g), cos_b, sin_b)
    if ctx_out:
        aqc, bqc, akc, avc, bkc, bvc = _split(hc @ w_in, L0_SIZES)
    else:
        akc, avc, bkc, bvc = _split(hc @ w_in[:, L0_Q:], L0_SIZES[2:])
    akc = akc.reshape(b, n_ctx, A_HEADS, 2, A_SUB)
    avc = avc.reshape(b, n_ctx, A_HEADS, HEAD_DIM)
    bkc = rmsnorm(bkc.reshape(b, n_ctx, B_KV, HEAD_DIM), k_norm_g)
    bvc = bvc.reshape(b, n_ctx, B_KV, HEAD_DIM)
    lam = (jnp.exp(jnp.sum((lam_q1 * lam_k1).astype(jnp.float32)))
           - jnp.exp(jnp.sum((lam_q2 * lam_k2).astype(jnp.float32))) + LAMBDA_INIT_L0)
    ak_all = jnp.concatenate([ak, akc], axis=1)
    av_all = jnp.concatenate([av.reshape(b, s, A_HEADS, HEAD_DIM), avc], axis=1)
    bk_all = jnp.concatenate([bk, bkc], axis=1)
    bv_all = jnp.concatenate([bv.reshape(b, s, B_KV, HEAD_DIM), bvc], axis=1)

    def block(aq_blk, bq_blk):
        return jnp.concatenate([diff_attend(aq_blk, ak_all, av_all, lam, subln_g),
                                gqa_attend(bq_blk, bk_all, bv_all)], axis=-1)

    o_lat = sweep_query_blocks(block, aq, bq)
    if not ctx_out:
        return o_lat, None
    aqc = aqc.reshape(b, n_ctx, A_HEADS, 2, A_SUB)
    bqc = rmsnorm(bqc.reshape(b, n_ctx, B_KV, B_GROUP, HEAD_DIM), q_norm_g)
    o_ctx = jnp.concatenate([diff_attend(aqc, akc, avc, lam, subln_g), gqa_attend(bqc, bkc, bvc)], axis=-1)
    return o_lat, o_ctx


def mixer_window_na(h, hc, w_in, sinks, rpb, rope, ctx_out):
    _, _, cos_b, sin_b = rope
    b, s, _ = h.shape
    n_ctx = hc.shape[1]
    cq, dq, ck, cv, dk, dv = _split(h @ w_in, L1_SIZES)
    cq = apply_rope(cq.reshape(b, s, C_KV, C_GROUP, HEAD_DIM), cos_b, sin_b)
    ck = apply_rope(ck.reshape(b, s, C_KV, HEAD_DIM), cos_b, sin_b)
    cv = cv.reshape(b, s, C_KV, HEAD_DIM)
    dq = dq.reshape(b, s, D_HEADS, HEAD_DIM)
    dk = dk.reshape(b, s, D_HEADS, HEAD_DIM)
    dv = dv.reshape(b, s, D_HEADS, HEAD_DIM)
    if ctx_out:
        cqc, dqc, ckc, cvc, dkc, dvc = _split(hc @ w_in, L1_SIZES)
    else:
        ckc, cvc, dkc, dvc = _split(hc @ w_in[:, L1_Q:], L1_SIZES[2:])
    ckc = ckc.reshape(b, n_ctx, C_KV, HEAD_DIM)
    cvc = cvc.reshape(b, n_ctx, C_KV, HEAD_DIM)
    dkc = dkc.reshape(b, n_ctx, D_HEADS, HEAD_DIM)
    dvc = dvc.reshape(b, n_ctx, D_HEADS, HEAD_DIM)
    o_lat = jnp.concatenate([window_attend(cq, ck, cv, ckc, cvc, sinks),
                             neighbourhood_attend(dq, dk, dv, dkc, dvc, rpb)], axis=-1)
    if not ctx_out:
        return o_lat, None
    o_ctx = jnp.concatenate([gqa_attend(cqc.reshape(b, n_ctx, C_KV, C_GROUP, HEAD_DIM), ckc, cvc, sinks),
                             gqa_attend(dqc.reshape(b, n_ctx, D_HEADS, 1, HEAD_DIM), dkc, dvc)], axis=-1)
    return o_lat, o_ctx


def dense_swiglu(h, w_gate, w_up, w_down):
    return (jax.nn.silu(h @ w_gate) * (h @ w_up)) @ w_down


def moe_swiglu(h, w_router, w_gate_e, w_up_e, w_down_e):
    b, s, d = h.shape
    xt = h.reshape(-1, d)
    n = xt.shape[0]
    logits = (xt @ w_router).astype(jnp.float32)
    top_logit, top_idx = lax.top_k(logits, TOP_K)
    gates = jax.nn.softmax(top_logit, axis=-1)
    e_flat = top_idx.reshape(-1)
    tok_flat = jnp.repeat(jnp.arange(n, dtype=jnp.int32), TOP_K)
    order = jnp.argsort(e_flat)
    e_sorted = e_flat[order]
    tok_sorted = tok_flat[order]
    g_sorted = gates.reshape(-1)[order]
    counts = jnp.bincount(e_flat, length=N_EXPERTS)
    padded = (counts + MOE_BLOCK - 1) // MOE_BLOCK * MOE_BLOCK
    pad_end = jnp.cumsum(padded)
    pad_start = pad_end - padded
    sort_start = jnp.cumsum(counts) - counts
    slot = pad_start[e_sorted] + (jnp.arange(n * TOP_K) - sort_start[e_sorted])
    n_blocks = (n * TOP_K + N_EXPERTS * (MOE_BLOCK - 1) + MOE_BLOCK - 1) // MOE_BLOCK
    cap = n_blocks * MOE_BLOCK
    slot_tok = jnp.full((cap,), n, dtype=jnp.int32).at[slot].set(tok_sorted)
    x_pad = jnp.concatenate([xt, jnp.zeros((1, d), xt.dtype)], axis=0)
    block_expert = jnp.minimum(jnp.searchsorted(pad_end, jnp.arange(n_blocks) * MOE_BLOCK, side='right'), N_EXPERTS - 1)

    def run_block(args):
        e, idx = args
        xb = x_pad[idx]
        return (jax.nn.silu(xb @ w_gate_e[e]) * (xb @ w_up_e[e])) @ w_down_e[e]

    y_pad = lax.map(run_block, (block_expert, slot_tok.reshape(n_blocks, MOE_BLOCK))).reshape(cap, d)
    y_sorted = y_pad[slot] * g_sorted[:, None].astype(y_pad.dtype)
    y = jax.ops.segment_sum(y_sorted, tok_sorted, num_segments=n)
    return y.reshape(b, s, d)


def hybrid_layer(x, xc, c, c_ctx, base, mixer_fn, mix_prm, ffn_fn, ffn_prm, rope, ctx_out):
    norm1_g, norm2_g, w_ada, b_ada, w_in, w_out = base
    sh1, sc1, gt1, sh2, sc2, gt2 = [m[:, None] for m in ada_mod(c, w_ada, b_ada, 6)]
    cm = ada_mod(c_ctx, w_ada, b_ada, 6 if ctx_out else 2)
    o_lat, o_ctx = mixer_fn(modulate(x, norm1_g, sh1, sc1), modulate(xc, norm1_g, cm[0], cm[1]), w_in,
                            *mix_prm, rope=rope, ctx_out=ctx_out)
    x = x + gt1 * (o_lat @ w_out)
    x = x + gt2 * ffn_fn(modulate(x, norm2_g, sh2, sc2), *ffn_prm)
    if not ctx_out:
        return x, None
    xc = xc + cm[2] * (o_ctx @ w_out)
    xc = xc + cm[5] * ffn_fn(modulate(xc, norm2_g, cm[3], cm[4]), *ffn_prm)
    return x, xc


def setup_inputs(seed: int = 0) -> dict:
    key = jax.random.key(seed)
    ks = iter(jax.random.split(key, 40))
    d = D_MODEL

    def nrm(shape, scale):
        return jax.random.normal(next(ks), shape, jnp.float32) * scale

    def gain(n):
        return 1.0 + nrm((n,), 0.1)

    inp = {}
    inp['x'] = nrm((BATCH, SEQ, d), 1.0)
    inp['c'] = nrm((BATCH, d), 1.0)
    inp['ctx'] = nrm((BATCH, CTX_LEN, d), 1.0)
    inp['c_ctx'] = nrm((d,), 1.0)
    inp['l0_norm1_g'] = gain(d)
    inp['l0_norm2_g'] = gain(d)
    inp['l0_w_ada'] = nrm((d, 6 * d), 0.5 * d ** -0.5)
    inp['l0_b_ada'] = nrm((6 * d,), 0.01)
    inp['l0_w_in'] = nrm((d, PROJ_COLS), d ** -0.5)
    inp['l0_w_out'] = nrm((MIX_WIDTH, d), MIX_WIDTH ** -0.5)
    inp['l0_lam_q1'] = nrm((A_SUB,), 0.1)
    inp['l0_lam_k1'] = nrm((A_SUB,), 0.1)
    inp['l0_lam_q2'] = nrm((A_SUB,), 0.1)
    inp['l0_lam_k2'] = nrm((A_SUB,), 0.1)
    inp['l0_subln_g'] = gain(HEAD_DIM)
    inp['l0_q_norm_g'] = gain(HEAD_DIM)
    inp['l0_k_norm_g'] = gain(HEAD_DIM)
    inp['l0_ffn_w_gate'] = nrm((d, D_FF), d ** -0.5)
    inp['l0_ffn_w_up'] = nrm((d, D_FF), d ** -0.5)
    inp['l0_ffn_w_down'] = nrm((D_FF, d), D_FF ** -0.5)
    inp['l1_norm1_g'] = gain(d)
    inp['l1_norm2_g'] = gain(d)
    inp['l1_w_ada'] = nrm((d, 6 * d), 0.5 * d ** -0.5)
    inp['l1_b_ada'] = nrm((6 * d,), 0.01)
    inp['l1_w_in'] = nrm((d, PROJ_COLS), d ** -0.5)
    inp['l1_w_out'] = nrm((MIX_WIDTH, d), MIX_WIDTH ** -0.5)
    inp['l1_sinks'] = nrm((C_HEADS,), 0.5)
    inp['l1_rpb'] = nrm((D_HEADS, 2 * NA_ROWS - 1, 2 * NA_COLS - 1), 0.1)
    inp['l1_router'] = nrm((d, N_EXPERTS), d ** -0.5)
    inp['l1_exp_w_gate'] = nrm((N_EXPERTS, d, D_EXPERT), d ** -0.5)
    inp['l1_exp_w_up'] = nrm((N_EXPERTS, d, D_EXPERT), d ** -0.5)
    inp['l1_exp_w_down'] = nrm((N_EXPERTS, D_EXPERT, d), D_EXPERT ** -0.5)
    inp['final_norm_g'] = gain(d)
    return inp


def reference(x, c, ctx, c_ctx,
              l0_norm1_g, l0_norm2_g, l0_w_ada, l0_b_ada, l0_w_in, l0_w_out,
              l0_lam_q1, l0_lam_k1, l0_lam_q2, l0_lam_k2, l0_subln_g, l0_q_norm_g, l0_k_norm_g,
              l0_ffn_w_gate, l0_ffn_w_up, l0_ffn_w_down,
              l1_norm1_g, l1_norm2_g, l1_w_ada, l1_b_ada, l1_w_in, l1_w_out,
              l1_sinks, l1_rpb, l1_router, l1_exp_w_gate, l1_exp_w_up, l1_exp_w_down,
              final_norm_g):
    s = x.shape[1]
    rope = axial_rope(s, A_SUB) + axial_rope(s, HEAD_DIM)
    layers = [
        ((l0_norm1_g, l0_norm2_g, l0_w_ada, l0_b_ada, l0_w_in, l0_w_out), mixer_diff_gqa,
         (l0_lam_q1, l0_lam_k1, l0_lam_q2, l0_lam_k2, l0_subln_g, l0_q_norm_g, l0_k_norm_g),
         dense_swiglu, (l0_ffn_w_gate, l0_ffn_w_up, l0_ffn_w_down)),
        ((l1_norm1_g, l1_norm2_g, l1_w_ada, l1_b_ada, l1_w_in, l1_w_out), mixer_window_na,
         (l1_sinks, l1_rpb),
         moe_swiglu, (l1_router, l1_exp_w_gate, l1_exp_w_up, l1_exp_w_down)),
    ]
    xc = ctx
    for i in range(DEPTH):
        base, mixer_fn, mix_prm, ffn_fn, ffn_prm = layers[i]
        x, xc = hybrid_layer(x, xc, c, c_ctx, base, mixer_fn, mix_prm, ffn_fn, ffn_prm, rope,
                             ctx_out=(i < DEPTH - 1))
    return rmsnorm(x, final_norm_g)
```

```cpp
#include <hip/hip_runtime.h>
#include <hip/hip_bf16.h>
#include <cstdio>
#include <cstdint>

#ifndef MK_PER_PHASE
#define MK_PER_PHASE 0
#endif

#ifndef PRESCALE
#define PRESCALE 1
#endif
#ifndef L1ATT_FP8
#define L1ATT_FP8 1
#endif
#ifndef FFN0_FP8
#define FFN0_FP8 0
#endif
#define GAS __attribute__((address_space(1)))
#define LAS __attribute__((address_space(3)))
typedef unsigned short bf16_t;
typedef short bf16x8 __attribute__((ext_vector_type(8)));
typedef short s16x4 __attribute__((ext_vector_type(4)));
typedef float f32x2 __attribute__((ext_vector_type(2)));
typedef float f32x4 __attribute__((ext_vector_type(4)));
typedef float f32x16 __attribute__((ext_vector_type(16)));
typedef unsigned u32x2 __attribute__((ext_vector_type(2)));
typedef unsigned u32x4 __attribute__((ext_vector_type(4)));
typedef GAS unsigned gu32;

constexpr int DM = 2048, NB = 4, SEQ = 4096, NCTX = 256, RPB = SEQ + NCTX, MROWS = NB * RPB;
constexpr int NTOK = NB * SEQ;
constexpr int PROJ = 4608, DFF = 5632, NE = 8, DEX = 7168;
constexpr int CAP_TILES = 136, CAP = CAP_TILES * 256;
constexpr float EPS = 1e-6f;
constexpr float LOG2E = 1.4426950408889634f;
constexpr float ATT_SCALE = 0.088388347648318440f;
constexpr float A_SCALE = 0.125f;
constexpr float LAMBDA_INIT = 0.2f;

constexpr size_t MiB = 1u << 20;
constexpr size_t WS_CTL = 0, CTL_ZERO_BYTES = 32 * 1024;
constexpr size_t WS_MODS = 1 * MiB;
constexpr size_t WS_ADAP = 2 * MiB;
constexpr size_t WS_ROPE = 18 * MiB;
constexpr size_t WS_ROUTE = 22 * MiB;
constexpr size_t WS_GATES = WS_ROUTE + 512 * 1024;
constexpr size_t WS_SLOT = WS_GATES + 256 * 1024;
constexpr size_t WS_CNT = WS_SLOT + 256 * 1024;
constexpr size_t WS_TILEE = WS_CNT + 64 * 1024;
constexpr size_t WS_WIN0 = 34 * MiB, WS_WOUT0 = 52 * MiB, WS_WGU0 = 60 * MiB, WS_WDN0 = 104 * MiB;
constexpr size_t WS_WIN1 = 126 * MiB, WS_WOUT1 = 144 * MiB, WS_WGU1 = 152 * MiB, WS_WDN1 = 600 * MiB;
constexpr size_t WS_XR = 824 * MiB;
constexpr size_t WS_H = 960 * MiB;
constexpr size_t WS_AO = 1028 * MiB;
constexpr size_t WS_Y = WS_H;
constexpr size_t WS_QKV = 1096 * MiB;
constexpr size_t WS_XG = WS_QKV;
constexpr size_t WS_MID = 1249 * MiB;
constexpr size_t WS_SLAB0 = 1500 * MiB;
constexpr size_t WS_SLAB1 = 1540 * MiB;
constexpr size_t WS_SLABW = 1600 * MiB;
constexpr size_t WS_END = 1725 * MiB;
constexpr int CW_TMO = 0, CW_BAR = 4096;
constexpr int NS0 = FFN0_FP8 ? 2 : 4;

constexpr int RING_BYTES = 131072;
constexpr int LDS_BYTES = 147456;
constexpr int MISC_OFF = LDS_BYTES - 256;

#define RLX_AGENT __ATOMIC_RELAXED, __HIP_MEMORY_SCOPE_AGENT
#define LDS_WAIT() asm volatile("s_waitcnt lgkmcnt(0)" ::: "memory")
#define VM_WAIT() asm volatile("s_waitcnt vmcnt(0)" ::: "memory")
__device__ __forceinline__ unsigned cvt_pk_bf16(float lo, float hi) { unsigned r; asm volatile("v_cvt_pk_bf16_f32 %0, %1, %2" : "=v"(r) : "v"(lo), "v"(hi)); return r; }
__device__ __forceinline__ float bf_lo(unsigned w) { return __uint_as_float(w << 16); }
__device__ __forceinline__ float bf_hi(unsigned w) { return __uint_as_float(w & 0xffff0000u); }
typedef int i32x8 __attribute__((ext_vector_type(8)));
constexpr float S_H8 = 16.0f, S_W8 = 1024.0f, S_M8 = 4.0f, S_A8 = 64.0f;
__device__ __forceinline__ float clamp8(float x) { return __builtin_amdgcn_fmed3f(x, -448.0f, 448.0f); }
__device__ __forceinline__ unsigned pk4_fp8(float a, float b, float c, float d) {
    int w = 0; w = __builtin_amdgcn_cvt_pk_fp8_f32(clamp8(a), clamp8(b), w, false); w = __builtin_amdgcn_cvt_pk_fp8_f32(clamp8(c), clamp8(d), w, true); return (unsigned)w; }
__device__ __forceinline__ float wave_sum(float v) {
#pragma unroll
    for (int o = 1; o < 64; o <<= 1) v += __shfl_xor(v, o);
    return v;
}
__device__ __forceinline__ int fresh_tid() { int t = threadIdx.x; asm volatile("" : "+v"(t)); return t; }
__device__ __forceinline__ float fast_silu(float x) { return x * __builtin_amdgcn_rcpf(1.0f + __builtin_amdgcn_exp2f(-x * LOG2E)); }

namespace pg8 {
constexpr int BM = 256, BK = 64, HALF = 128, HTB = HALF * BK * 2, STAGE_BYTES = 8 * HTB, NXCD = 8, WGM = 4;
__host__ __device__ __forceinline__ int lds_byte(int r, int c) { const int st = (r >> 4) * 2 + (c >> 5), rr = r & 15, cc = c & 31, ob = rr * 64 + cc * 2; return st * 1024 + (ob ^ (((ob >> 9) & 1) << 5)); }
__host__ __device__ __forceinline__ void stage_rc(int b, int& R, int& C) { const int st = b / 1024, sb = b % 1024, swz = sb ^ (((sb >> 9) & 1) << 5); R = (st >> 1) * 16 + swz / 64; C = (st & 1) * 32 + (swz % 64) / 2; }
__host__ __device__ __forceinline__ int perm32(int rho) { const int n = rho >> 4, i = rho & 15; return 8 * (i >> 2) + 4 * n + (i & 3); }

typedef int i32x4_t __attribute__((ext_vector_type(4)));
struct Unit { int pm, pn, kofs, nt, flag; };
struct Gemm { const bf16_t* A; const bf16_t* Bt; int K; };

struct MapId { __device__ __forceinline__ void operator()(int pm, int pn, Unit& u) const { u.pm = pm; u.pn = pn; } };
struct MapL0Split { __device__ __forceinline__ void operator()(int pm, int pn, Unit& u) const { u.pm = pm < 64 ? (pm >> 4) * 17 + (pm & 15) : (pm - 64) * 17 + 16; u.pn = pn; } };
struct MapLatent { __device__ __forceinline__ void operator()(int pm, int pn, Unit& u) const { u.pm = (pm >> 4) * 17 + (pm & 15); u.pn = pn; } };
struct MapMoe { const int* tile_e; int npe; __device__ __forceinline__ void operator()(int pm, int pn, Unit& u) const { u.pm = pm; u.pn = tile_e[pm] * npe + pn; } };
template <class Map> struct Order {
    int nM, nN, nwg, G, c, ntf, exn, S; Map map;
    __device__ __forceinline__ void init(int nM_, int nN_, int G_, int c_, Map m, int ntf_, int ex_nM = 0, int S_ = 1) { nM = nM_; nN = nN_; nwg = nM * nN; G = G_; c = c_; map = m; ntf = ntf_; S = S_; exn = ex_nM * nN_ * S_; }
    __device__ __forceinline__ bool next(int i, Unit& u) const {
        const long L = (long)i * G + c; u.kofs = 0; u.nt = ntf; u.flag = 0;
        if (L >= nwg) { const long sidx = L - nwg; if (sidx >= exn) return false; const int part = (int)(sidx % S), ux = (int)(sidx / S);
            map(nM + ux / nN, ux % nN, u); u.nt = ntf / S; u.kofs = part * u.nt * (BK * 2); u.flag = 1 + part; return true; }
        int wgid = (int)L; { const int q = nwg / NXCD, r = nwg % NXCD, xcd = wgid % NXCD, off = wgid / NXCD; wgid = (xcd < r ? xcd * (q + 1) : r * (q + 1) + (xcd - r) * q) + off; }
        const int nig = WGM * nN, gid = wgid / nig, fm = gid * WGM, gsz = (nM - fm) < WGM ? (nM - fm) : WGM;
        map(fm + ((wgid % nig) % gsz), (wgid % nig) / gsz, u); return true;
    }
    __device__ __forceinline__ void a_ready(const Unit&) const {}
    __device__ __forceinline__ void done(const Unit&) const {}
};

struct EpiBf16 {
    static constexpr bool PERM = true;
    bf16_t* O; int ldc; int npn; float sc; float* slab;
    __device__ __forceinline__ void operator()(const f32x4 (&acc)[2][2][4][2], const Unit& u, int wr, int wc, int fr, int fq) const {
        const int row0 = u.pm * BM + wr * 64 + fr, col0 = (u.pn % npn) * BM + wc * 32 + 8 * fq;
        if (u.flag) {
            float* sp = slab + ((size_t)(u.flag - 1) * (7 * 256) + (size_t)(u.pm - 128) * BM + wr * 64 + fr) * ldc + col0;
#pragma unroll
            for (int ai = 0; ai < 2; ++ai)
#pragma unroll
                for (int m = 0; m < 4; ++m)
#pragma unroll
                    for (int bj = 0; bj < 2; ++bj) { float* p = sp + (size_t)(ai * HALF + m * 16) * ldc + bj * HALF;
                        *(f32x4*)p = acc[ai][bj][m][0] * sc; *(f32x4*)(p + 4) = acc[ai][bj][m][1] * sc; }
            return;
        }
#pragma unroll
        for (int ai = 0; ai < 2; ++ai)
#pragma unroll
            for (int m = 0; m < 4; ++m) { bf16_t* rowp = O + (size_t)(row0 + ai * HALF + m * 16) * ldc + col0;
#pragma unroll
                for (int bj = 0; bj < 2; ++bj) { const f32x4 v0 = acc[ai][bj][m][0] * sc, v1 = acc[ai][bj][m][1] * sc;
                    u32x4 w; w.x = cvt_pk_bf16(v0[0], v0[1]); w.y = cvt_pk_bf16(v0[2], v0[3]); w.z = cvt_pk_bf16(v1[0], v1[1]); w.w = cvt_pk_bf16(v1[2], v1[3]);
                    *(u32x4*)(rowp + bj * HALF) = w; } }
    }
};
template <int LAYER> struct EpiQKV {
    static constexpr bool PERM = true;
    bf16_t* O; const float* cA; const float* sA; const float* cB; const float* sB; const float* qg; const float* kg; LAS float* scr; float asc;
    __device__ __forceinline__ void operator()(const f32x4 (&acc)[2][2][4][2], const Unit& u, int wr, int wc, int fr, int fq) const {
        const int tt = u.pm % 17, pn = u.pn; const bool latent = tt < 16;
        int kind0, kind1; bool norm = false;
        if constexpr (LAYER == 0) { const int k = (pn < 4 || (pn >= 8 && pn < 12)) ? 1 : ((pn >= 4 && pn < 8) || pn == 16) ? 2 : 0; kind0 = kind1 = k; norm = (k == 2); }
        else { kind0 = kind1 = (pn < 4 || pn == 8) ? 2 : 0; }
        const int row0 = u.pm * BM + wr * 64 + fr, col0 = pn * BM + wc * 32 + 8 * fq, ch = wc * 32 + 8 * fq;
        if (norm) {
#pragma unroll
            for (int ai = 0; ai < 2; ++ai)
#pragma unroll
                for (int m = 0; m < 4; ++m)
#pragma unroll
                    for (int bj = 0; bj < 2; ++bj) { const f32x4 a = acc[ai][bj][m][0], b = acc[ai][bj][m][1];
                        float q = (a[0] * a[0] + a[1] * a[1]) + (a[2] * a[2] + a[3] * a[3]) + (b[0] * b[0] + b[1] * b[1]) + (b[2] * b[2] + b[3] * b[3]);
                        q += __shfl_xor(q, 16); q += __shfl_xor(q, 32);
                        if (fq == 0) scr[((ai * HALF + wr * 64 + m * 16 + fr) * 2 + bj) * 4 + wc] = q; }
            asm volatile("s_waitcnt lgkmcnt(0)" ::: "memory"); __builtin_amdgcn_s_barrier(); asm volatile("" ::: "memory");
        }
        f32x4 g0 = {1.f, 1.f, 1.f, 1.f}, g1 = g0;
        if (norm) { const LAS float* gl = scr + 2048 + ((pn == 16) ? 128 : 0) + ch; g0 = *(const LAS f32x4*)gl; g1 = *(const LAS f32x4*)(gl + 4); }
        const int kmax = kind0 > kind1 ? kind0 : kind1;
        const int npair = (kmax == 1) ? 16 : 32, p0 = (kmax == 1) ? ((ch & 63) >> 1) : (ch >> 1), q0 = p0 & (npair - 1); const bool use_row = p0 < npair;
        f32x4 frq;
#pragma unroll
        for (int i = 0; i < 4; ++i) frq[i] = __builtin_amdgcn_exp2f(-(float)(q0 + i) * (13.287712379549449f / (float)npair)) * 0.15915494309189535f;
#pragma unroll
        for (int ai = 0; ai < 2; ++ai)
#pragma unroll
            for (int m = 0; m < 4; ++m) { const int r = ai * HALF + wr * 64 + m * 16 + fr, t = tt * 256 + r;
                bf16_t* rowp = O + (size_t)(row0 + ai * HALF + m * 16) * PROJ + col0;
                f32x4 cs = {1.f, 1.f, 1.f, 1.f}, sn = {0.f, 0.f, 0.f, 0.f};
                if (latent && kmax != 0) { const float pos = (float)(use_row ? (t >> 6) : (t & 63));
#pragma unroll
                    for (int i = 0; i < 4; ++i) { const float x = pos * frq[i]; cs[i] = __builtin_amdgcn_cosf(x); sn[i] = __builtin_amdgcn_sinf(x); } }
#pragma unroll
                for (int bj = 0; bj < 2; ++bj) { f32x4 v0 = acc[ai][bj][m][0] * asc, v1 = acc[ai][bj][m][1] * asc; const int kind = bj ? kind1 : kind0;
                    if (norm) { const f32x4 p = *(const LAS f32x4*)(scr + ((ai * HALF + wr * 64 + m * 16 + fr) * 2 + bj) * 4);
                        const float rsv = 1.0f / sqrtf(((p[0] + p[1]) + (p[2] + p[3])) * (1.0f / 128.0f) + EPS); v0 = v0 * rsv * g0; v1 = v1 * rsv * g1; }
                    if (latent && kind != 0) {
                        const f32x4 a = v0, b = v1;
                        v0[0] = a[0] * cs[0] - a[1] * sn[0]; v0[1] = a[0] * sn[0] + a[1] * cs[0]; v0[2] = a[2] * cs[1] - a[3] * sn[1]; v0[3] = a[2] * sn[1] + a[3] * cs[1];
                        v1[0] = b[0] * cs[2] - b[1] * sn[2]; v1[1] = b[0] * sn[2] + b[1] * cs[2]; v1[2] = b[2] * cs[3] - b[3] * sn[3]; v1[3] = b[2] * sn[3] + b[3] * cs[3]; }
                    if constexpr (LAYER == 0 && PRESCALE) { const float qs = pn < 4 ? A_SCALE * LOG2E : (pn < 8 ? ATT_SCALE * LOG2E : 1.0f); v0 = v0 * qs; v1 = v1 * qs; }
                    u32x4 w; w.x = cvt_pk_bf16(v0[0], v0[1]); w.y = cvt_pk_bf16(v0[2], v0[3]); w.z = cvt_pk_bf16(v1[0], v1[1]); w.w = cvt_pk_bf16(v1[2], v1[3]);
                    *(u32x4*)(rowp + bj * HALF) = w; } }
    }
};
struct EpiSwiGLU {
    static constexpr bool PERM = true;
    bf16_t* O; int ldc; int npn;
    __device__ __forceinline__ void operator()(const f32x4 (&acc)[2][2][4][2], const Unit& u, int wr, int wc, int fr, int fq) const {
        const int row0 = u.pm * BM + wr * 64 + fr, col0 = (u.pn % npn) * HALF + wc * 32 + 8 * fq;
#pragma unroll
        for (int ai = 0; ai < 2; ++ai)
#pragma unroll
            for (int m = 0; m < 4; ++m) { bf16_t* rowp = O + (size_t)(row0 + ai * HALF + m * 16) * ldc + col0;
                const f32x4 g0 = acc[ai][0][m][0], g1 = acc[ai][0][m][1], u0 = acc[ai][1][m][0], u1 = acc[ai][1][m][1];
                u32x4 w;
                w.x = cvt_pk_bf16(fast_silu(g0[0]) * u0[0], fast_silu(g0[1]) * u0[1]); w.y = cvt_pk_bf16(fast_silu(g0[2]) * u0[2], fast_silu(g0[3]) * u0[3]);
                w.z = cvt_pk_bf16(fast_silu(g1[0]) * u1[0], fast_silu(g1[1]) * u1[1]); w.w = cvt_pk_bf16(fast_silu(g1[2]) * u1[2], fast_silu(g1[3]) * u1[3]);
                *(u32x4*)rowp = w; }
    }
};
struct EpiSwiGLU8 {
    static constexpr bool PERM = true;
    unsigned char* O; int ldc; int npn; float si, so;
    __device__ __forceinline__ void operator()(const f32x4 (&acc)[2][2][4][2], const Unit& u, int wr, int wc, int fr, int fq) const {
        const int row0 = u.pm * BM + wr * 64 + fr, col0 = (u.pn % npn) * HALF + wc * 32 + 8 * fq;
#pragma unroll
        for (int ai = 0; ai < 2; ++ai)
#pragma unroll
            for (int m = 0; m < 4; ++m) { unsigned char* rowp = O + (size_t)(row0 + ai * HALF + m * 16) * ldc + col0;
                const f32x4 g0 = acc[ai][0][m][0] * si, g1 = acc[ai][0][m][1] * si, u0 = acc[ai][1][m][0] * so, u1 = acc[ai][1][m][1] * so;
                u32x2 w;
                w.x = pk4_fp8(fast_silu(g0[0]) * u0[0], fast_silu(g0[1]) * u0[1], fast_silu(g0[2]) * u0[2], fast_silu(g0[3]) * u0[3]);
                w.y = pk4_fp8(fast_silu(g1[0]) * u1[0], fast_silu(g1[1]) * u1[1], fast_silu(g1[2]) * u1[2], fast_silu(g1[3]) * u1[3]);
                *(u32x2*)rowp = w; }
    }
};
struct EpiResid {
    static constexpr bool PERM = false;
    const float* x_in; const float* ctx_in; float* XR; const float* mods; int gate_chunk; int from_input; float* slab; float asc;
    __device__ __forceinline__ void operator()(const f32x4 (&acc)[2][2][4][2], const Unit& u, int wr, int wc, int fr, int fq) const {
        const int b = u.pm / 17, tt = u.pm % 17;
        float* outp = XR + (size_t)u.pm * BM * DM;
        const float* basep = from_input ? (tt < 16 ? x_in + ((size_t)b * SEQ + (size_t)tt * 256) * DM : ctx_in + (size_t)b * NCTX * DM) : outp;
        const float* gate = mods + (size_t)(tt < 16 ? b : 4) * 12288 + gate_chunk * DM;
        const int col0 = u.pn * BM + wc * 32 + 4 * fq;
        f32x4 gv[2][2];
#pragma unroll
        for (int bj = 0; bj < 2; ++bj)
#pragma unroll
            for (int n = 0; n < 2; ++n) gv[bj][n] = *(const f32x4*)(gate + col0 + bj * HALF + n * 16) * asc;
        if (u.flag) {
            float* sp = slab + ((size_t)(u.flag - 1) * (NB * NCTX) + (size_t)b * NCTX) * DM;
#pragma unroll
            for (int ai = 0; ai < 2; ++ai)
#pragma unroll
                for (int m = 0; m < 4; ++m) { const size_t off = (size_t)(ai * HALF + wr * 64 + m * 16 + fr) * DM + col0;
#pragma unroll
                    for (int bj = 0; bj < 2; ++bj)
#pragma unroll
                        for (int n = 0; n < 2; ++n) *(f32x4*)(sp + off + bj * HALF + n * 16) = gv[bj][n] * acc[ai][bj][m][n]; }
            return;
        }
#pragma unroll
        for (int ai = 0; ai < 2; ++ai)
#pragma unroll
            for (int m = 0; m < 4; ++m) { const size_t off = (size_t)(ai * HALF + wr * 64 + m * 16 + fr) * DM + col0;
#pragma unroll
                for (int bj = 0; bj < 2; ++bj)
#pragma unroll
                    for (int n = 0; n < 2; ++n) { const f32x4 bs = *(const f32x4*)(basep + off + bj * HALF + n * 16);
                        *(f32x4*)(outp + off + bj * HALF + n * 16) = bs + gv[bj][n] * acc[ai][bj][m][n]; }
                if (m & 1) asm volatile("" ::: "memory"); }
    }
};

template <class Epi, class Sched, bool FP8 = false, bool ALIGN_EPI = true, bool SP2 = true>
__device__ __forceinline__ void gemm_phase(LAS unsigned char* lds, const Gemm g, const Sched& S, const Epi& E) {
    const int tid = fresh_tid(), wid = __builtin_amdgcn_readfirstlane(tid >> 6), lane = tid & 63, wr = wid >> 2, wc = wid & 3, fr = lane & 15, fq = lane >> 4;
    const int K = g.K;
    unsigned voffA[2], voffB[2];
#pragma unroll
    for (int i = 0; i < 2; ++i) { int R, C; stage_rc(tid * 16 + i * 8192, R, C); const int Rb = Epi::PERM ? ((R & ~31) + perm32(R & 31)) : R;
        voffA[i] = (unsigned)(R * K + C) * 2u; voffB[i] = (unsigned)(Rb * K + C) * 2u; }
    const size_t kstep = (size_t)(BK * 2);
    const size_t hstep = (size_t)HALF * K * 2;
    const size_t tstep = 2 * hstep;
    const unsigned ldsw = (unsigned)wid * 1024u;
    const int aoff = FP8 ? lds_byte(wr * 64 + fr, fq * 16) : lds_byte(wr * 64 + fr, fq * 8), boff = FP8 ? lds_byte(wc * 32 + fr, fq * 16) : lds_byte(wc * 32 + fr, fq * 8);
#define PG8_SA(b, h) (((b) * 2 + (h)) * HTB)
#define PG8_SB(b, h) ((4 + (b) * 2 + (h)) * HTB)
#define PG8_STAGE(bufoff, gbase, voff) do { _Pragma("unroll") for (int _i = 0; _i < 2; ++_i) \
        __builtin_amdgcn_global_load_lds((const unsigned*)((const char*)(gbase) + (voff)[_i]), (LAS unsigned*)(lds + (bufoff) + ldsw + _i * 8192), 16, 0, 0); } while (0)
#define PG8_LD16(p) (*(const LAS i32x4_t*)(p))
#define PG8_LDA(dst, b, h) do { if constexpr (FP8) { _Pragma("unroll") for (int m = 0; m < 4; ++m) { const LAS unsigned char* _p = lds + PG8_SA(b, h) + aoff + m * 2048; \
            dst##8[m] = __builtin_shufflevector(PG8_LD16(_p), PG8_LD16(_p + 16), 0, 1, 2, 3, 4, 5, 6, 7); } } else { \
        _Pragma("unroll") for (int m = 0; m < 4; ++m) _Pragma("unroll") for (int k = 0; k < 2; ++k) dst[m][k] = *(const LAS bf16x8*)(lds + PG8_SA(b, h) + aoff + m * 2048 + k * 1024); } } while (0)
#define PG8_LDB(dst, b, h) do { if constexpr (FP8) { _Pragma("unroll") for (int n = 0; n < 2; ++n) { const LAS unsigned char* _p = lds + PG8_SB(b, h) + boff + n * 2048; \
            dst##8[n] = __builtin_shufflevector(PG8_LD16(_p), PG8_LD16(_p + 16), 0, 1, 2, 3, 4, 5, 6, 7); } } else { \
        _Pragma("unroll") for (int n = 0; n < 2; ++n) _Pragma("unroll") for (int k = 0; k < 2; ++k) dst[n][k] = *(const LAS bf16x8*)(lds + PG8_SB(b, h) + boff + n * 2048 + k * 1024); } } while (0)
#define PG8_MMA(ai, bj, At, Bt) do { __builtin_amdgcn_s_setprio(1); _Pragma("unroll") for (int m = 0; m < 4; ++m) _Pragma("unroll") for (int n = 0; n < 2; ++n) { if constexpr (FP8) \
        asm volatile("v_mfma_f32_16x16x128_f8f6f4 %0, %1, %2, %0" : "+v"(acc[ai][bj][m][n]) : "v"(Bt##8[n]), "v"(At##8[m])); else { _Pragma("unroll") for (int k = 0; k < 2; ++k) \
        acc[ai][bj][m][n] = __builtin_amdgcn_mfma_f32_16x16x32_bf16(Bt[n][k], At[m][k], acc[ai][bj][m][n], 0, 0, 0); } } __builtin_amdgcn_s_setprio(0); } while (0)
#define PG8_WAIT_V(n) asm volatile("s_waitcnt vmcnt(" #n ")" ::: "memory")
#define PG8_WAIT_L(n) asm volatile("s_waitcnt lgkmcnt(" #n ")" ::: "memory")
#define PG8_BAR __builtin_amdgcn_s_barrier()
#define PG8_SCHED __builtin_amdgcn_sched_barrier(0)
    Unit cur, nxt; int ui = 0;
    if (!S.next(0, cur)) return;
    f32x4 acc[2][2][4][2];
#pragma unroll
    for (int a = 0; a < 2; ++a)
#pragma unroll
        for (int b = 0; b < 2; ++b)
#pragma unroll
            for (int m = 0; m < 4; ++m)
#pragma unroll
                for (int n = 0; n < 2; ++n) acc[a][b][m][n] = (f32x4){0.f, 0.f, 0.f, 0.f};
    bf16x8 At[4][2], B0[2][2], B1[2][2]; i32x8 At8[4], B08[2], B18[2];
    const char* cA = (const char*)g.A + (size_t)cur.pm * tstep + cur.kofs; const char* cB = (const char*)g.Bt + (size_t)cur.pn * tstep + cur.kofs;
    S.a_ready(cur);
    if constexpr (SP2) {
        PG8_STAGE(PG8_SB(0, 0), cB, voffB); PG8_STAGE(PG8_SB(0, 1), cB + hstep, voffB); PG8_STAGE(PG8_SA(0, 0), cA, voffA); PG8_STAGE(PG8_SA(0, 1), cA + hstep, voffA);
        if (wr == 1) PG8_BAR;
        PG8_WAIT_V(2); PG8_BAR;
        PG8_STAGE(PG8_SB(1, 0), cB + kstep, voffB); PG8_STAGE(PG8_SA(1, 0), cA + kstep, voffA); PG8_STAGE(PG8_SB(1, 1), cB + hstep + kstep, voffB);
        PG8_WAIT_V(6); PG8_BAR;
    } else {
        PG8_STAGE(PG8_SB(0, 0), cB, voffB); PG8_STAGE(PG8_SA(0, 0), cA, voffA); PG8_STAGE(PG8_SB(0, 1), cB + hstep, voffB); PG8_STAGE(PG8_SA(0, 1), cA + hstep, voffA);
        if (wr == 1) PG8_BAR;
        PG8_WAIT_V(4); PG8_BAR;
        PG8_STAGE(PG8_SB(1, 0), cB + kstep, voffB); PG8_STAGE(PG8_SA(1, 0), cA + kstep, voffA); PG8_STAGE(PG8_SB(1, 1), cB + hstep + kstep, voffB);
        PG8_WAIT_V(6); PG8_BAR;
    }
    for (;;) {
        const bool has_next = S.next(ui + 1, nxt);
        const char* nA = has_next ? (const char*)g.A + (size_t)nxt.pm * tstep + nxt.kofs : cA; const char* nB = has_next ? (const char*)g.Bt + (size_t)nxt.pn * tstep + nxt.kofs : cB;
        const int nt = cur.nt;
        for (int t = 0; t < nt; t += 2) {
            const bool last = (t == nt - 2);
            const char* a1 = cA + (size_t)(t + 1) * kstep;
            const char* a2 = last ? nA : cA + (size_t)(t + 2) * kstep; const char* b2 = last ? nB : cB + (size_t)(t + 2) * kstep;
            const char* a3 = a2 + kstep; const char* b3 = b2 + kstep;
            if (last && has_next) S.a_ready(nxt);
            if constexpr (SP2) {
            PG8_LDB(B0, 0, 0); PG8_LDB(B1, 0, 1); PG8_SCHED; PG8_LDA(At, 0, 0); PG8_STAGE(PG8_SA(1, 1), a1 + hstep, voffA);
            PG8_WAIT_V(8); PG8_WAIT_L(0); PG8_BAR; PG8_MMA(0, 0, At, B0); PG8_MMA(0, 1, At, B1); PG8_BAR; PG8_SCHED;
            PG8_LDA(At, 0, 1); PG8_STAGE(PG8_SB(0, 0), b2, voffB); PG8_STAGE(PG8_SB(0, 1), b2 + hstep, voffB); PG8_STAGE(PG8_SA(0, 0), a2, voffA);
            PG8_WAIT_V(8); PG8_WAIT_L(0); PG8_BAR; PG8_MMA(1, 0, At, B0); PG8_MMA(1, 1, At, B1); PG8_BAR; PG8_SCHED;
            PG8_LDB(B0, 1, 0); PG8_LDB(B1, 1, 1); PG8_SCHED; PG8_LDA(At, 1, 0); PG8_STAGE(PG8_SA(0, 1), a2 + hstep, voffA);
            PG8_WAIT_V(8); PG8_WAIT_L(0); PG8_BAR; PG8_MMA(0, 0, At, B0); PG8_MMA(0, 1, At, B1); PG8_BAR; PG8_SCHED;
            PG8_LDA(At, 1, 1); PG8_STAGE(PG8_SB(1, 0), b3, voffB); PG8_STAGE(PG8_SB(1, 1), b3 + hstep, voffB); PG8_STAGE(PG8_SA(1, 0), a3, voffA);
            PG8_WAIT_V(8); PG8_WAIT_L(0); PG8_BAR; PG8_MMA(1, 0, At, B0); PG8_MMA(1, 1, At, B1); PG8_BAR; PG8_SCHED;
            } else {
            PG8_LDB(B0, 0, 0); PG8_SCHED; PG8_LDA(At, 0, 0); PG8_STAGE(PG8_SA(1, 1), a1 + hstep, voffA);
            PG8_WAIT_L(8); PG8_BAR; PG8_WAIT_L(0); PG8_MMA(0, 0, At, B0); PG8_BAR; PG8_SCHED;
            PG8_LDB(B1, 0, 1); PG8_STAGE(PG8_SB(0, 0), b2, voffB);
            PG8_BAR; PG8_WAIT_L(0); PG8_MMA(0, 1, At, B1); PG8_BAR;
            PG8_LDA(At, 0, 1); PG8_STAGE(PG8_SA(0, 0), a2, voffA);
            PG8_BAR; PG8_WAIT_L(0); PG8_MMA(1, 0, At, B0); PG8_BAR; PG8_SCHED;
            PG8_STAGE(PG8_SB(0, 1), b2 + hstep, voffB);
            PG8_WAIT_V(6); PG8_BAR; PG8_MMA(1, 1, At, B1); PG8_BAR;
            PG8_LDB(B0, 1, 0); PG8_SCHED; PG8_LDA(At, 1, 0); PG8_STAGE(PG8_SA(0, 1), a2 + hstep, voffA);
            PG8_WAIT_L(8); PG8_BAR; PG8_WAIT_L(0); PG8_MMA(0, 0, At, B0); PG8_BAR; PG8_SCHED;
            PG8_LDB(B1, 1, 1); PG8_STAGE(PG8_SB(1, 0), b3, voffB);
            PG8_BAR; PG8_WAIT_L(0); PG8_MMA(0, 1, At, B1); PG8_BAR;
            PG8_LDA(At, 1, 1); PG8_STAGE(PG8_SA(1, 0), a3, voffA);
            PG8_BAR; PG8_WAIT_L(0); PG8_MMA(1, 0, At, B0); PG8_BAR; PG8_SCHED;
            PG8_STAGE(PG8_SB(1, 1), b3 + hstep, voffB);
            PG8_WAIT_V(6); PG8_BAR; PG8_MMA(1, 1, At, B1); PG8_BAR;
            }
        }
        if constexpr (ALIGN_EPI) { if (wr == 0) PG8_BAR; }
        if constexpr (FP8) asm volatile("s_nop 15\n\ts_nop 15" ::: "memory");
        E(acc, cur, wr, wc, fr, fq); S.done(cur);
        if (!has_next) break;
#pragma unroll
        for (int a = 0; a < 2; ++a)
#pragma unroll
            for (int b = 0; b < 2; ++b)
#pragma unroll
                for (int m = 0; m < 4; ++m)
#pragma unroll
                    for (int n = 0; n < 2; ++n) acc[a][b][m][n] = (f32x4){0.f, 0.f, 0.f, 0.f};
        cur = nxt; cA = nA; cB = nB; ++ui;
        if constexpr (ALIGN_EPI) { if (wr == 1) PG8_BAR; }
    }
    PG8_WAIT_V(0);
    if constexpr (!ALIGN_EPI) { if (wr == 0) PG8_BAR; }
    PG8_BAR;
#undef PG8_SA
#undef PG8_SB
#undef PG8_STAGE
#undef PG8_LDA
#undef PG8_LDB
#undef PG8_MMA
#undef PG8_LD16
#undef PG8_WAIT_V
#undef PG8_WAIT_L
#undef PG8_BAR
#undef PG8_SCHED
}
}

namespace att {
constexpr int D = 128, NW = 8, QBLK = 32, KVBLK = 64;
constexpr int LDQK = PROJ, LDO = DM;
constexpr float THR = 8.f;
#ifndef DIFF_SD
#define DIFF_SD 2
#endif
#ifndef STD_SD
#define STD_SD 1
#endif
constexpr int SHM_V = KVBLK * D * 2, SHM_K = KVBLK * D * 2;
constexpr int OFF_WS = 2 * SHM_V + 2 * SHM_K, OFF_STASH = OFF_WS + NW * 64 * 4, OFF_BIAS = OFF_STASH + 65536, ATT_LDS = OFF_BIAS + 2048;
static_assert(ATT_LDS <= MISC_OFF, "attention LDS");
#define KSWZ(row, colB) ((row) * 256 + ((colB) ^ (((row) & 7) << 4)))
#define SBAR() __builtin_amdgcn_sched_barrier(0)
__device__ __forceinline__ int crow(int r, int hi) { return (r & 3) + 8 * (r >> 2) + 4 * hi; }
struct TileMap { int NC, cbase, lbase, NT; __device__ __forceinline__ int krow(int j) const { return j < NC ? cbase + 64 * j : lbase + 64 * (j - NC); } };
struct MaskInfo { int q0, r0, lo; };

template <int MODE>
__device__ __forceinline__ void apply_mask(f32x16& p0, f32x16& p1, int j, const TileMap& tm, const MaskInfo& mi, int wid, int r32, int hi, const float* btab) {
    if constexpr (MODE == 1) {
        if (j >= tm.NC) {
            const int kp0 = tm.lbase + 64 * (j - tm.NC), qw = mi.q0 + wid * 32;
            if (kp0 - (qw + 31) < -128 || kp0 + 63 - qw > 128) {
                const int dq = kp0 - (qw + r32) + 4 * hi;
#pragma unroll
                for (int r = 0; r < 16; ++r) { const int d = dq + (r & 3) + 8 * (r >> 2);
                    if (d > 128 || d < -128) p0[r] = -1e30f;
                    if (d + 32 > 128 || d + 32 < -128) p1[r] = -1e30f; }
            }
        }
    } else if constexpr (MODE == 2) {
        if (j >= tm.NC) {
            const int kr = mi.lo + (j - tm.NC), rq = mi.r0 + (wid >> 1);
            int rs = rq - 4; rs = rs < 0 ? 0 : (rs > 56 ? 56 : rs);
            if (kr >= rs && kr < rs + 8) {
                const int cq = (wid & 1) * 32 + r32; int cs = cq - 8; cs = cs < 0 ? 0 : (cs > 48 ? 48 : cs);
                const float* bt = btab + (kr - rq + 7) * 31 + (4 * hi - cq + 15);
                const int cb = 4 * hi - cs;
#pragma unroll
                for (int r = 0; r < 16; ++r) { const int ko = (r & 3) + 8 * (r >> 2);
                    p0[r] = ((unsigned)(ko + cb) < 16u) ? p0[r] + bt[ko] : -1e30f;
                    if ((r & 7) == 7) SBAR(); }
#pragma unroll
                for (int r = 0; r < 16; ++r) { const int ko = (r & 3) + 8 * (r >> 2);
                    p1[r] = ((unsigned)(ko + 32 + cb) < 16u) ? p1[r] + bt[ko + 32] : -1e30f;
                    if ((r & 7) == 7) SBAR(); }
            } else {
#pragma unroll
                for (int r = 0; r < 16; ++r) { p0[r] = -1e30f; p1[r] = -1e30f; }
            }
        }
    }
}
__device__ __forceinline__ void partialSM(f32x16& p0, f32x16& p1, float& m_reg, float& mn, float& alpha, const float C, const float thr_raw) {
    float pmax = p0[0];
#pragma unroll
    for (int r = 1; r < 16; ++r) pmax = fmaxf(pmax, p0[r]);
#pragma unroll
    for (int r = 0; r < 16; ++r) pmax = fmaxf(pmax, p1[r]);
    { auto rr = __builtin_amdgcn_permlane32_swap(__float_as_uint(pmax), __float_as_uint(pmax), false, false);
      pmax = fmaxf(__uint_as_float(rr[0]), __uint_as_float(rr[1])); }
    if (__builtin_expect(__all(pmax - m_reg <= thr_raw), 1)) { mn = m_reg; alpha = 1.f; }
    else { mn = fmaxf(m_reg, pmax); alpha = __builtin_amdgcn_exp2f((m_reg - mn) * C); m_reg = mn; }
    const float mnC = -mn * C;
#pragma unroll
    for (int r = 0; r < 16; ++r) p0[r] = fmaf(p0[r], C, mnC);
#pragma unroll
    for (int r = 0; r < 16; ++r) p1[r] = fmaf(p1[r], C, mnC);
#pragma unroll
    for (int r = 0; r < 16; ++r) p0[r] = __builtin_amdgcn_exp2f(p0[r]);
}
__device__ __forceinline__ void finishSM(f32x16& p0, f32x16& p1, float alpha, float& l_reg, bf16x8& pa0, bf16x8& pa1, bf16x8& pa2, bf16x8& pa3) {
#pragma unroll
    for (int r = 0; r < 16; ++r) p1[r] = __builtin_amdgcn_exp2f(p1[r]);
    float ps = 0;
#pragma unroll
    for (int r = 0; r < 16; ++r) ps += p0[r];
#pragma unroll
    for (int r = 0; r < 16; ++r) ps += p1[r];
    { auto rr = __builtin_amdgcn_permlane32_swap(__float_as_uint(ps), __float_as_uint(ps), false, false);
      ps = __uint_as_float(rr[0]) + __uint_as_float(rr[1]); }
    l_reg = l_reg * alpha + ps;
#define PK4(P, BASE, OUT) do { unsigned a0 = cvt_pk_bf16(P[BASE + 0], P[BASE + 1]), a1 = cvt_pk_bf16(P[BASE + 2], P[BASE + 3]);   \
    unsigned b0 = cvt_pk_bf16(P[BASE + 4], P[BASE + 5]), b1 = cvt_pk_bf16(P[BASE + 6], P[BASE + 7]);                              \
    auto r0 = __builtin_amdgcn_permlane32_swap(a0, b0, false, false); auto r1 = __builtin_amdgcn_permlane32_swap(a1, b1, false, false); \
    u32x4 w = {r0[0], r1[0], r0[1], r1[1]}; OUT = *reinterpret_cast<bf16x8*>(&w); } while (0)
    PK4(p0, 0, pa0); PK4(p0, 8, pa1); PK4(p1, 0, pa2); PK4(p1, 8, pa3);
#undef PK4
}
template <int DLO, int DHI, bool QLDS>
__device__ __forceinline__ void qkt(f32x16& p0, f32x16& p1, const char* Ks, const bf16x8* qr, const char* qlds, int r32, int hi, const f32x16& cinit = f32x16{}) {
#pragma unroll
    for (int d0 = DLO; d0 < DHI; ++d0) { const int cb = (d0 * 16 + hi * 8) * 2;
        bf16x8 q; if constexpr (QLDS) q = *(const volatile LAS bf16x8*)((const LAS char*)qlds + d0 * 8192); else q = qr[d0];
        const bf16x8 b0 = *reinterpret_cast<const bf16x8*>(Ks + KSWZ(r32, cb));
        const bf16x8 b1 = *reinterpret_cast<const bf16x8*>(Ks + KSWZ(32 + r32, cb));
        if (d0 == DLO) {
            if constexpr (PRESCALE && !QLDS) {
                asm("v_mfma_f32_32x32x16_bf16 %0, %1, %2, %3" : "=&v"(p0) : "v"(b0), "v"(q), "v"(cinit));
                asm("v_mfma_f32_32x32x16_bf16 %0, %1, %2, %3" : "=&v"(p1) : "v"(b1), "v"(q), "v"(cinit)); }
            else { p0 = __builtin_amdgcn_mfma_f32_32x32x16_bf16(b0, q, cinit, 0, 0, 0); p1 = __builtin_amdgcn_mfma_f32_32x32x16_bf16(b1, q, cinit, 0, 0, 0); } }
        else { p0 = __builtin_amdgcn_mfma_f32_32x32x16_bf16(b0, q, p0, 0, 0, 0); p1 = __builtin_amdgcn_mfma_f32_32x32x16_bf16(b1, q, p1, 0, 0, 0); } }
}
constexpr float THR_L2 = THR * LOG2E;
__device__ __forceinline__ void presm_decide(f32x16& p0, f32x16& p1, float pmax, float& m_hat, float& alpha, f32x16& negm, bool first) {
    { auto rr = __builtin_amdgcn_permlane32_swap(__float_as_uint(pmax), __float_as_uint(pmax), false, false);
      pmax = fmaxf(__uint_as_float(rr[0]), __uint_as_float(rr[1])); }
    if (!first && __builtin_expect(__all(pmax <= THR_L2), 1)) { alpha = 1.f; }
    else { const float dl = first ? pmax : fmaxf(pmax, 0.f); m_hat += dl; alpha = first ? 1.f : __builtin_amdgcn_exp2f(-dl);
#pragma unroll
        for (int r = 0; r < 16; ++r) { p0[r] -= dl; p1[r] -= dl; }
#pragma unroll
        for (int r = 0; r < 16; ++r) negm[r] = -m_hat; }
}
__device__ __forceinline__ int v_st(int k, int c) { const int kk = (k & ~0xC) | ((k & 4) << 1) | ((k & 8) >> 1); return ((kk >> 3) * 4 + (c >> 5)) * 512 + ((kk & 7) * 32 + (c & 31)) * 2; }
__device__ __forceinline__ int v_rd_base(int lane) { return ((lane & 3) << 3) | (((lane >> 2) & 3) << 6) | (((lane >> 4) & 1) << 5) | (((lane >> 5) & 1) << 8); }
constexpr int v_rd_off(int d0, int ks, int half) { return d0 * 512 + ks * 4096 + half * 2048; }
template <int OFF> __device__ __forceinline__ s16x4 tr_read(int vb) {
    s16x4 r; asm volatile("ds_read_b64_tr_b16 %0, %1 offset:%2" : "=&v"(r) : "v"(vb), "i"(OFF) : "memory"); return r;
}
template <int D0> __device__ __forceinline__ void pv_one(f32x16& od, int vb, bf16x8 pa0, bf16x8 pa1, bf16x8 pa2, bf16x8 pa3) {
    const s16x4 l0 = tr_read<v_rd_off(D0, 0, 0)>(vb), h0 = tr_read<v_rd_off(D0, 0, 1)>(vb), l1 = tr_read<v_rd_off(D0, 1, 0)>(vb), h1 = tr_read<v_rd_off(D0, 1, 1)>(vb);
    const s16x4 l2 = tr_read<v_rd_off(D0, 2, 0)>(vb), h2 = tr_read<v_rd_off(D0, 2, 1)>(vb), l3 = tr_read<v_rd_off(D0, 3, 0)>(vb), h3 = tr_read<v_rd_off(D0, 3, 1)>(vb);
    asm volatile("s_waitcnt lgkmcnt(0)" ::: "memory"); SBAR();
#define PK(L, H) (bf16x8){L[0], L[1], L[2], L[3], H[0], H[1], H[2], H[3]}
    od = __builtin_amdgcn_mfma_f32_32x32x16_bf16(pa0, PK(l0, h0), od, 0, 0, 0);
    od = __builtin_amdgcn_mfma_f32_32x32x16_bf16(pa1, PK(l1, h1), od, 0, 0, 0);
    od = __builtin_amdgcn_mfma_f32_32x32x16_bf16(pa2, PK(l2, h2), od, 0, 0, 0);
    od = __builtin_amdgcn_mfma_f32_32x32x16_bf16(pa3, PK(l3, h3), od, 0, 0, 0);
#undef PK
}
__device__ __forceinline__ void pv_d0(f32x16* o, int vb, bf16x8 pa0, bf16x8 pa1, bf16x8 pa2, bf16x8 pa3) {
    pv_one<0>(o[0], vb, pa0, pa1, pa2, pa3); pv_one<1>(o[1], vb, pa0, pa1, pa2, pa3); pv_one<2>(o[2], vb, pa0, pa1, pa2, pa3); pv_one<3>(o[3], vb, pa0, pa1, pa2, pa3);
}
template <int MODE, bool PRE = false>
__device__ __forceinline__ void pv_sm(f32x16* o, int vb, bf16x8 pa0, bf16x8 pa1, bf16x8 pa2, bf16x8 pa3, f32x16& p0, f32x16& p1, float& m_reg, float& mn, float& alpha, const float C, const float thr_raw,
                                      int j, const TileMap& tm, const MaskInfo& mi, int wid, int r32, int hi, const float* btab, f32x16* negm = nullptr) {
    if constexpr (PRE) {
        pv_one<0>(o[0], vb, pa0, pa1, pa2, pa3);
        float pmax = p0[0];
#pragma unroll
        for (int r = 1; r < 16; ++r) pmax = fmaxf(pmax, p0[r]);
        pv_one<1>(o[1], vb, pa0, pa1, pa2, pa3);
#pragma unroll
        for (int r = 0; r < 16; ++r) pmax = fmaxf(pmax, p1[r]);
        pv_one<2>(o[2], vb, pa0, pa1, pa2, pa3);
        presm_decide(p0, p1, pmax, m_reg, alpha, *negm, false);
        pv_one<3>(o[3], vb, pa0, pa1, pa2, pa3);
#pragma unroll
        for (int r = 0; r < 16; ++r) p0[r] = __builtin_amdgcn_exp2f(p0[r]);
        return;
    }
    pv_one<0>(o[0], vb, pa0, pa1, pa2, pa3);
    apply_mask<MODE>(p0, p1, j, tm, mi, wid, r32, hi, btab);
    float pmax = p0[0];
#pragma unroll
    for (int r = 1; r < 16; ++r) pmax = fmaxf(pmax, p0[r]);
    pv_one<1>(o[1], vb, pa0, pa1, pa2, pa3);
#pragma unroll
    for (int r = 0; r < 16; ++r) pmax = fmaxf(pmax, p1[r]);
    { auto rr = __builtin_amdgcn_permlane32_swap(__float_as_uint(pmax), __float_as_uint(pmax), false, false);
      pmax = fmaxf(__uint_as_float(rr[0]), __uint_as_float(rr[1])); }
    if (__builtin_expect(__all(pmax - m_reg <= thr_raw), 1)) { mn = m_reg; alpha = 1.f; }
    else { mn = fmaxf(m_reg, pmax); alpha = __builtin_amdgcn_exp2f((m_reg - mn) * C); m_reg = mn; }
    const float mnC = -mn * C;
    pv_one<2>(o[2], vb, pa0, pa1, pa2, pa3);
#pragma unroll
    for (int r = 0; r < 16; ++r) p0[r] = fmaf(p0[r], C, mnC);
#pragma unroll
    for (int r = 0; r < 16; ++r) p1[r] = fmaf(p1[r], C, mnC);
    pv_one<3>(o[3], vb, pa0, pa1, pa2, pa3);
#pragma unroll
    for (int r = 0; r < 16; ++r) p0[r] = __builtin_amdgcn_exp2f(p0[r]);
}

template <int MODE, int DLO, int DHI, int SD = 2, bool QLDS = false>
__device__ __forceinline__ void attn_core(const bf16_t* __restrict__ Qb, const bf16_t* __restrict__ Kh, const bf16_t* __restrict__ Vh, const TileMap tm, const MaskInfo mi,
                                          const float C, const float thr_raw, char* lds, f32x16 (&o)[4], float& l_out, float& m_out) {
    const int tid = fresh_tid(), wid = tid >> 6, lane = tid & 63, r32 = lane & 31, hi = lane >> 5;
    char* V_lds = lds; char* K_lds = lds + 2 * SHM_V;
    float* ws = (float*)(lds + OFF_WS) + wid * 64; float* al_l = ws + 32;
    const float* btab = (const float*)(lds + OFF_BIAS);
    constexpr bool PRE = (MODE == 0) && (PRESCALE != 0);
    float m_reg = PRE ? 0.f : -1e30f, l_reg = 0; f32x16 negm = f32x16{};
#pragma unroll
    for (int d = 0; d < 4; ++d) o[d] = f32x16{};
    bf16x8 qr[8];
    const unsigned qoff = (unsigned)((wid * QBLK + r32) * LDQK + hi * 8);
#pragma unroll
    for (int d0 = 0; d0 < 8; ++d0) { if (d0 >= DLO && d0 < DHI) qr[d0] = *reinterpret_cast<const bf16x8*>(Qb + qoff + d0 * 16); else qr[d0] = bf16x8{}; }
    const char* qlds = lds + OFF_STASH + tid * 16;
    if constexpr (QLDS) {
#pragma unroll
        for (int d0 = DLO; d0 < DHI; ++d0) *(bf16x8*)(lds + OFF_STASH + tid * 16 + d0 * 8192) = qr[d0];
        asm volatile("s_waitcnt lgkmcnt(0)" ::: "memory");
    }
    const int sr = tid >> 4, sc = (tid & 15) * 8, vst0 = v_st(sr, sc), vst1 = v_st(32 + sr, sc);
    const unsigned loff = (unsigned)(sr * LDQK + sc);
    const int vb0 = (int)(uintptr_t)V_lds + v_rd_base(lane);
    struct { bf16x8 vs0, vs1, ks0, ks1; } sr_[SD];
#define SLOAD(i, k0) do { const size_t _k0 = (size_t)(k0) * LDQK; const bf16_t* _kt = Kh + _k0; const bf16_t* _vt = Vh + _k0; \
    sr_[i].vs0 = *reinterpret_cast<const bf16x8*>(_vt + loff); sr_[i].vs1 = *reinterpret_cast<const bf16x8*>(_vt + 32 * LDQK + loff); \
    sr_[i].ks0 = *reinterpret_cast<const bf16x8*>(_kt + loff); sr_[i].ks1 = *reinterpret_cast<const bf16x8*>(_kt + 32 * LDQK + loff); } while (0)
#define SWRITE(b, i) do { *(bf16x8*)(V_lds + (b) * SHM_V + vst0) = sr_[i].vs0; *(bf16x8*)(V_lds + (b) * SHM_V + vst1) = sr_[i].vs1; const int kc = sc * 2; \
    *(bf16x8*)(K_lds + (b) * SHM_K + KSWZ(sr, kc)) = sr_[i].ks0; *(bf16x8*)(K_lds + (b) * SHM_K + KSWZ(32 + sr, kc)) = sr_[i].ks1; } while (0)
#define SWAIT() do { if constexpr (SD == 2) asm volatile("s_waitcnt vmcnt(4)" ::: "memory"); else asm volatile("s_waitcnt vmcnt(0)" ::: "memory"); } while (0)
#define RESC(a) do { if (__any((a) < 1.f)) { if (hi == 0) al_l[r32] = (a); asm volatile("s_waitcnt lgkmcnt(0)" ::: "memory"); \
    _Pragma("unroll") for (int d = 0; d < 4; ++d) _Pragma("unroll") for (int r = 0; r < 16; ++r) o[d][r] *= al_l[crow(r, hi)]; } } while (0)
    f32x16 pA0, pA1, pB0, pB1; float mnA, mnB, alA, alB; bf16x8 pa0, pa1, pa2, pa3; const int NT = tm.NT;
    constexpr int SE = 0, SO = SD - 1;
    SLOAD(SE, tm.krow(0)); asm volatile("s_waitcnt vmcnt(0)" ::: "memory"); SWRITE(0, SE); __syncthreads();
    qkt<DLO, DHI, QLDS>(pA0, pA1, K_lds, qr, qlds, r32, hi, negm); apply_mask<MODE>(pA0, pA1, 0, tm, mi, wid, r32, hi, btab);
    if constexpr (PRE) { float pmax = pA0[0];
#pragma unroll
        for (int r = 1; r < 16; ++r) pmax = fmaxf(pmax, pA0[r]);
#pragma unroll
        for (int r = 0; r < 16; ++r) pmax = fmaxf(pmax, pA1[r]);
        presm_decide(pA0, pA1, pmax, m_reg, alA, negm, true);
#pragma unroll
        for (int r = 0; r < 16; ++r) pA0[r] = __builtin_amdgcn_exp2f(pA0[r]); }
    else partialSM(pA0, pA1, m_reg, mnA, alA, C, thr_raw);
    SLOAD(SO, tm.krow(1)); if constexpr (SD == 2) { if (2 < NT) SLOAD(SE, tm.krow(2)); }
    SWAIT(); SWRITE(1, SO); __syncthreads();
    for (int j = 1; j + 1 < NT; j += 2) {
        SBAR(); qkt<DLO, DHI, QLDS>(pB0, pB1, K_lds + SHM_K, qr, qlds, r32, hi, negm);
        finishSM(pA0, pA1, alA, l_reg, pa0, pa1, pa2, pa3); SBAR();
        SLOAD(SO, tm.krow(j + SD)); SBAR();
        pv_sm<MODE, PRE>(o, vb0, pa0, pa1, pa2, pa3, pB0, pB1, m_reg, mnB, alB, C, thr_raw, j, tm, mi, wid, r32, hi, btab, &negm);
        __syncthreads(); SWAIT(); SWRITE(0, SE);
        RESC(alB); __syncthreads();
        SBAR(); qkt<DLO, DHI, QLDS>(pA0, pA1, K_lds, qr, qlds, r32, hi, negm);
        finishSM(pB0, pB1, alB, l_reg, pa0, pa1, pa2, pa3); SBAR();
        if (SD == 1 || j + 3 < NT) SLOAD(SE, tm.krow(j + 1 + SD)); SBAR();
        pv_sm<MODE, PRE>(o, vb0 + SHM_V, pa0, pa1, pa2, pa3, pA0, pA1, m_reg, mnA, alA, C, thr_raw, j + 1, tm, mi, wid, r32, hi, btab, &negm);
        __syncthreads(); SWAIT(); SWRITE(1, SO);
        RESC(alA); __syncthreads();
    }
    SBAR(); qkt<DLO, DHI, QLDS>(pB0, pB1, K_lds + SHM_K, qr, qlds, r32, hi, negm);
    finishSM(pA0, pA1, alA, l_reg, pa0, pa1, pa2, pa3); SBAR();
    pv_sm<MODE, PRE>(o, vb0, pa0, pa1, pa2, pa3, pB0, pB1, m_reg, mnB, alB, C, thr_raw, NT - 1, tm, mi, wid, r32, hi, btab, &negm);
    __syncthreads(); RESC(alB);
    finishSM(pB0, pB1, alB, l_reg, pa0, pa1, pa2, pa3); SBAR();
    pv_d0(o, vb0 + SHM_V, pa0, pa1, pa2, pa3);
    l_out = l_reg; m_out = m_reg;
#undef SLOAD
#undef SWRITE
#undef SWAIT
#undef RESC
}
__device__ __forceinline__ void normalise(f32x16 (&o)[4], float l_reg, char* lds) {
    const int tid = fresh_tid(), wid = tid >> 6, lane = tid & 63, r32 = lane & 31, hi = lane >> 5;
    float* li_l = (float*)(lds + OFF_WS) + wid * 64;
    if (hi == 0) li_l[r32] = l_reg; asm volatile("s_waitcnt lgkmcnt(0)" ::: "memory");
#pragma unroll
    for (int r = 0; r < 16; ++r) { const float rl = __builtin_amdgcn_rcpf(li_l[crow(r, hi)]);
#pragma unroll
        for (int d0 = 0; d0 < 4; ++d0) o[d0][r] *= rl; }
    asm volatile("s_waitcnt lgkmcnt(0)" ::: "memory");
}
__device__ __forceinline__ void store_o(const f32x16 (&o)[4], bf16_t* Ob) {
    const int tid = fresh_tid(), wid = tid >> 6, lane = tid & 63, r32 = lane & 31, hi = lane >> 5;
    __hip_bfloat16* Ow = (__hip_bfloat16*)Ob + (long)(wid * QBLK) * LDO;
#pragma unroll
    for (int r = 0; r < 16; ++r) { const int orow = crow(r, hi);
#pragma unroll
        for (int d0 = 0; d0 < 4; ++d0) Ow[(long)orow * LDO + d0 * 32 + r32] = __float2bfloat16(o[d0][r]); }
}
__device__ __forceinline__ void store_o8(const f32x16 (&o)[4], unsigned char* Ob8) {
    const int tid = fresh_tid(), wid = tid >> 6, lane = tid & 63, r32 = lane & 31, hi = lane >> 5;
    unsigned char* Ow = Ob8 + (long)(wid * QBLK) * LDO;
#pragma unroll
    for (int r = 0; r < 16; r += 2) { const int orow = crow(r, hi);
#pragma unroll
        for (int d0 = 0; d0 < 4; ++d0) { const int w = __builtin_amdgcn_cvt_pk_fp8_f32(clamp8(o[d0][r] * S_A8), clamp8(o[d0][r + 1] * S_A8), 0, false);
            Ow[(long)orow * LDO + d0 * 32 + r32] = (unsigned char)(w & 0xff); Ow[(long)(orow + 1) * LDO + d0 * 32 + r32] = (unsigned char)((w >> 8) & 0xff); } }
}
template <int MODE>
__device__ __forceinline__ void unit_std(const bf16_t* Qb, const bf16_t* Kh, const bf16_t* Vh, const TileMap tm, const MaskInfo mi, float sink, bf16_t* Ob, char* lds) {
    f32x16 o[4]; float l, m;
    const float C = ATT_SCALE * LOG2E;
    attn_core<MODE, 0, 8, (MODE == 0 ? STD_SD : 1), (MODE != 0)>(Qb, Kh, Vh, tm, mi, C, THR / ATT_SCALE, lds, o, l, m);
    if constexpr (MODE == 1) l += __builtin_amdgcn_exp2f(sink * LOG2E - m * C);
    normalise(o, l, lds);
    if constexpr (MODE != 0 && L1ATT_FP8) store_o8(o, (unsigned char*)Ob); else store_o(o, Ob);
    __syncthreads();
}
__device__ __forceinline__ void unit_diff(const bf16_t* Qb, const bf16_t* Kh, const bf16_t* Vh, const TileMap tm, float lam, const float* subln_g, bf16_t* Ob, char* lds) {
    const int tid = fresh_tid(), lane = tid & 63, r32 = lane & 31;
    f32x16 o[4]; float l, m; const MaskInfo mi{0, 0, 0};
    const float C = A_SCALE * LOG2E;
    unsigned* stash = (unsigned*)(lds + OFF_STASH);
    attn_core<0, 0, 4, DIFF_SD>(Qb, Kh, Vh, tm, mi, C, THR / A_SCALE, lds, o, l, m);
    normalise(o, l, lds);
#pragma unroll
    for (int d0 = 0; d0 < 4; ++d0)
#pragma unroll
        for (int r = 0; r < 16; r += 2) stash[(d0 * 8 + (r >> 1)) * 512 + tid] = cvt_pk_bf16(o[d0][r], o[d0][r + 1]);
    __syncthreads();
    attn_core<0, 4, 8, DIFF_SD>(Qb, Kh, Vh, tm, mi, C, THR / A_SCALE, lds, o, l, m);
    normalise(o, l, lds);
    float ss[16];
#pragma unroll
    for (int r = 0; r < 16; ++r) ss[r] = 0.f;
#pragma unroll
    for (int d0 = 0; d0 < 4; ++d0)
#pragma unroll
        for (int r = 0; r < 16; r += 2) { const unsigned w = stash[(d0 * 8 + (r >> 1)) * 512 + tid];
            const float a = bf_lo(w) - lam * o[d0][r], b = bf_hi(w) - lam * o[d0][r + 1];
            o[d0][r] = a; o[d0][r + 1] = b; ss[r] += a * a; ss[r + 1] += b * b; }
#pragma unroll
    for (int r = 0; r < 16; ++r) {
#pragma unroll
        for (int x = 1; x < 32; x <<= 1) ss[r] += __shfl_xor(ss[r], x);
        ss[r] = (1.0f - LAMBDA_INIT) / sqrtf(ss[r] * (1.0f / 128.0f) + EPS); }
    float gg[4];
#pragma unroll
    for (int d0 = 0; d0 < 4; ++d0) gg[d0] = subln_g[d0 * 32 + r32];
#pragma unroll
    for (int d0 = 0; d0 < 4; ++d0)
#pragma unroll
        for (int r = 0; r < 16; ++r) o[d0][r] *= ss[r] * gg[d0];
    store_o(o, Ob);
    __syncthreads();
}
#undef SBAR
}

#define XB_TMO      128
#define XB_XCNT(j)  (256  + 64 * (j))
#define XB_XSUB(j)  (1280 + 64 * (j))
#define XB_XGEN(j)  (2304 + 64 * (j))
#define XB_TOP      3328
#define XB_TOPGEN   3392
#define XCD_BAR_WORDS 3456
#define XB_SPIN_CAP (1u << 22)
__device__ __forceinline__ unsigned xb_ld(unsigned* p)              { return __hip_atomic_load(p, __ATOMIC_RELAXED, __HIP_MEMORY_SCOPE_AGENT); }
__device__ __forceinline__ unsigned xb_add(unsigned* p, unsigned v) { return __hip_atomic_fetch_add(p, v, __ATOMIC_RELAXED, __HIP_MEMORY_SCOPE_AGENT); }
__device__ __forceinline__ unsigned xb_xcc_id() { return (unsigned)__builtin_amdgcn_s_getreg((3 << 11) | 20) & 0xFu; }
#define XB_SPIN(cond, bar) do { unsigned _sp = 0; while (cond) { __builtin_amdgcn_s_sleep(1); \
    if ((++_sp & 255u) == 0u) { if (xb_ld(&(bar)[XB_TMO])) break; if (_sp > XB_SPIN_CAP) { atomicAdd(&(bar)[XB_TMO], 1u); break; } } } } while (0)
struct XcdBarrier { unsigned* bar; unsigned x; volatile LAS unsigned* st; };
__device__ __forceinline__ XcdBarrier xcd_barrier_post(unsigned* bar, volatile LAS unsigned* st) {
    XcdBarrier b; b.bar = bar; b.x = xb_xcc_id(); b.st = st;
    if (threadIdx.x == 0) (void)xb_add(&bar[XB_XCNT(b.x)], 1u);
    return b;
}
__device__ __forceinline__ void xcd_barrier_complete(unsigned* bar, unsigned x, unsigned& nloc, unsigned& nx) {
    const unsigned G = gridDim.x * gridDim.y * gridDim.z;
    unsigned sum, cnt, mine, sp = 0u;
    for (;;) {
        sum = 0u; cnt = 0u; mine = 0u;
#pragma unroll
        for (unsigned j = 0; j < 16; ++j) { const unsigned c = xb_ld(&bar[XB_XCNT(j)]); sum += c; cnt += (c > 0u) ? 1u : 0u; mine = (j == x) ? c : mine; }
        if (sum == G) break;
        __builtin_amdgcn_s_sleep(1);
        if ((++sp & 255u) == 0u) { if (xb_ld(&bar[XB_TMO])) break; if (sp > XB_SPIN_CAP) { atomicAdd(&bar[XB_TMO], 1u); break; } }
    }
    nloc = mine > 0u ? mine : 1u; nx = cnt > 0u ? cnt : 1u;
}
__device__ __forceinline__ void xcd_barrier(const XcdBarrier& b) {
    asm volatile("s_waitcnt vmcnt(0)" ::: "memory");
    __syncthreads();
    if (threadIdx.x == 0) {
        unsigned* bar = b.bar;
        __builtin_amdgcn_s_waitcnt(0);
        unsigned nloc = b.st[0], nx = b.st[1];
        if (nloc == 0u) { xcd_barrier_complete(bar, b.x, nloc, nx); b.st[0] = nloc; b.st[1] = nx; }
        const unsigned old = xb_add(&bar[XB_XSUB(b.x)], 1u);
        const unsigned gen = old / nloc;
        if (old + 1u == (gen + 1u) * nloc) {
            __builtin_amdgcn_fence(__ATOMIC_RELEASE, "agent");
            asm volatile("s_waitcnt vmcnt(0)" ::: "memory");
            const unsigned og = xb_add(&bar[XB_TOP], 1u);
            const unsigned tg = og / nx;
            if (og + 1u == (tg + 1u) * nx) xb_add(&bar[XB_TOPGEN], 1u);
            else XB_SPIN(xb_ld(&bar[XB_TOPGEN]) == tg, bar);
            __builtin_amdgcn_fence(__ATOMIC_ACQUIRE, "agent");
            xb_add(&bar[XB_XGEN(b.x)], 1u);
            asm volatile("s_waitcnt vmcnt(0)" ::: "memory");
        } else {
            XB_SPIN(xb_ld(&bar[XB_XGEN(b.x)]) == gen, bar);
            __builtin_amdgcn_fence(__ATOMIC_ACQUIRE, "agent");
            asm volatile("s_waitcnt vmcnt(0)" ::: "memory");
        }
    }
    __syncthreads();
}

struct Args { const float* in[33]; float* out; unsigned char* ws; int ph_lo, ph_hi; };
struct Frame {
    LAS unsigned char* lds; int vcu, G;
};

__device__ __forceinline__ void transpose_item(const float* W, int ldw, int K, bf16_t* WT, int k0, int n0, long dst_row0, LAS float* scr, int lane) {
    { float tv[32]; const float* wp = W + (size_t)(k0 + (lane >> 5)) * ldw + n0 + (lane & 31);
#pragma unroll
      for (int i = 0; i < 32; ++i) tv[i] = wp[(size_t)(2 * i) * ldw];
#pragma unroll
      for (int i = 0; i < 32; ++i) scr[(2 * i + (lane >> 5)) * 33 + (lane & 31)] = tv[i]; }
    LDS_WAIT(); asm volatile("" ::: "memory");
    const int c = lane & 7;
#pragma unroll
    for (int j = 0; j < 4; ++j) { const int n = (lane >> 3) + 8 * j; const LAS float* s = scr + (8 * c) * 33 + n;
        u32x4 o; o.x = cvt_pk_bf16(s[0 * 33], s[1 * 33]); o.y = cvt_pk_bf16(s[2 * 33], s[3 * 33]); o.z = cvt_pk_bf16(s[4 * 33], s[5 * 33]); o.w = cvt_pk_bf16(s[6 * 33], s[7 * 33]);
        *(GAS u32x4*)(WT + (size_t)(dst_row0 + n) * K + k0 + 8 * c) = o; }
    LDS_WAIT(); asm volatile("" ::: "memory");
}
__device__ __forceinline__ void transpose_item8(const float* W, int ldw, int K, unsigned char* WT, int k0, int n0, long dst_row0, LAS float* scr, int lane, float scale) {
#pragma unroll
    for (int hb = 0; hb < 2; ++hb) { float tv[32]; const float* wp = W + (size_t)(k0 + 64 * hb + (lane >> 5)) * ldw + n0 + (lane & 31);
#pragma unroll
        for (int i = 0; i < 32; ++i) tv[i] = wp[(size_t)(2 * i) * ldw];
#pragma unroll
        for (int i = 0; i < 32; ++i) { const int kk = 64 * hb + 2 * i + (lane >> 5); scr[kk * 32 + (((lane & 31) + 8 * (kk >> 4)) & 31)] = tv[i]; } }
    LDS_WAIT(); asm volatile("" ::: "memory");
    const int c = lane & 7;
#pragma unroll
    for (int j = 0; j < 4; ++j) { const int n = (lane >> 3) + 8 * j; const LAS float* s = scr + (16 * c) * 32 + ((n + 8 * c) & 31);
        u32x4 o;
        o.x = pk4_fp8(s[0 * 32] * scale, s[1 * 32] * scale, s[2 * 32] * scale, s[3 * 32] * scale); o.y = pk4_fp8(s[4 * 32] * scale, s[5 * 32] * scale, s[6 * 32] * scale, s[7 * 32] * scale);
        o.z = pk4_fp8(s[8 * 32] * scale, s[9 * 32] * scale, s[10 * 32] * scale, s[11 * 32] * scale); o.w = pk4_fp8(s[12 * 32] * scale, s[13 * 32] * scale, s[14 * 32] * scale, s[15 * 32] * scale);
        *(GAS u32x4*)(WT + (size_t)(dst_row0 + n) * K + k0 + 16 * c) = o; }
    LDS_WAIT(); asm volatile("" ::: "memory");
}
__device__ __forceinline__ void tr_plain8(const float* W, int K, int N, unsigned char* WT, long row_off, LAS float* scr, int item, int lane) {
    const int nblk = N / 32, kb = item / nblk, nb = item % nblk;
    transpose_item8(W, N, K, WT, 128 * kb, 32 * nb, row_off + 32 * nb, scr, lane, S_W8);
}
__device__ __forceinline__ void tr_gu8(const float* W, int K, int N, unsigned char* WT, long row_off, int up, LAS float* scr, int item, int lane) {
    const int nblk = N / 32, kb = item / nblk, nb = item % nblk, n0 = 32 * nb;
    transpose_item8(W, N, K, WT, 128 * kb, n0, row_off + (long)(n0 >> 7) * 256 + (n0 & 127) + up * 128, scr, lane, S_W8);
}
__device__ __forceinline__ void tr_plain(const float* W, int K, int N, bf16_t* WT, long row_off, LAS float* scr, int item, int lane) {
    const int nblk = N / 32, kb = item / nblk, nb = item % nblk;
    transpose_item(W, N, K, WT, 64 * kb, 32 * nb, row_off + 32 * nb, scr, lane);
}
__device__ __forceinline__ void tr_gu(const float* W, int K, int N, bf16_t* WT, long row_off, int up, LAS float* scr, int item, int lane) {
    const int nblk = N / 32, kb = item / nblk, nb = item % nblk, n0 = 32 * nb;
    transpose_item(W, N, K, WT, 64 * kb, n0, row_off + (long)(n0 >> 7) * 256 + (n0 & 127) + up * 128, scr, lane);
}

template <bool OUT8 = false>
__device__ __forceinline__ void mod_row(const float* xrow, const float* g, const float* sh, const float* sc, bf16_t* orow, int lane, f32x4 (&v)[8], const float* xs = nullptr, size_t xs_stride = 0, int nxs = 0, float* xout = nullptr) {
    const f32x4* xr = (const f32x4*)xrow + lane;
    float s = 0.f;
#pragma unroll
    for (int j = 0; j < 8; ++j) { v[j] = xr[64 * j];
        if (xs) {
#pragma unroll
            for (int p = 0; p < 8; ++p) if (p < nxs) v[j] += ((const f32x4*)(xs + p * xs_stride))[64 * j + lane];
            if (xout) ((f32x4*)xout)[64 * j + lane] = v[j]; }
        s += (v[j].x * v[j].x + v[j].y * v[j].y) + (v[j].z * v[j].z + v[j].w * v[j].w); }
    const float rstd = 1.0f / sqrtf(wave_sum(s) * (1.0f / DM) + EPS);
    u32x2* o8 = (u32x2*)orow + lane;
#pragma unroll
    for (int j = 0; j < 8; ++j) { const f32x4 gg = ((const f32x4*)g)[64 * j + lane], ss = ((const f32x4*)sc)[64 * j + lane], hh = ((const f32x4*)sh)[64 * j + lane];
        v[j] = v[j] * rstd * gg * (ss + 1.0f) + hh;
        if constexpr (OUT8) ((unsigned*)orow)[64 * j + lane] = pk4_fp8(v[j].x * S_H8, v[j].y * S_H8, v[j].z * S_H8, v[j].w * S_H8);
        else { u32x2 w; w.x = cvt_pk_bf16(v[j].x, v[j].y); w.y = cvt_pk_bf16(v[j].z, v[j].w); o8[64 * j] = w; } }
}
__device__ __forceinline__ const float* in_row(const float* x, const float* ctx, int row) {
    const int b = row / RPB, t = row % RPB;
    return t < SEQ ? x + ((size_t)b * SEQ + t) * DM : ctx + ((size_t)b * NCTX + (t - SEQ)) * DM;
}

__device__ __forceinline__ void rope8(float (&f)[8], const float* cs, const float* sn) {
    const f32x4 c = *(const f32x4*)cs, s = *(const f32x4*)sn;
#pragma unroll
    for (int p = 0; p < 4; ++p) { const float x0 = f[2 * p], x1 = f[2 * p + 1]; f[2 * p] = x0 * c[p] - x1 * s[p]; f[2 * p + 1] = x0 * s[p] + x1 * c[p]; }
}
__device__ __forceinline__ void unpack8(const u32x4 w, float (&f)[8]) { f[0] = bf_lo(w.x); f[1] = bf_hi(w.x); f[2] = bf_lo(w.y); f[3] = bf_hi(w.y); f[4] = bf_lo(w.z); f[5] = bf_hi(w.z); f[6] = bf_lo(w.w); f[7] = bf_hi(w.w); }
__device__ __forceinline__ u32x4 pack8(const float (&f)[8]) { u32x4 w; w.x = cvt_pk_bf16(f[0], f[1]); w.y = cvt_pk_bf16(f[2], f[3]); w.z = cvt_pk_bf16(f[4], f[5]); w.w = cvt_pk_bf16(f[6], f[7]); return w; }
template <bool NORM, int ROPE_DIM>
__device__ __forceinline__ void fix_span(bf16_t* rowp, int col0, int nvec, const float* g, const float* cosT, const float* sinT, int lane) {
    for (int v = lane; v < nvec; v += 64) {
        const int e0 = v * 8;
        u32x4 w = *(u32x4*)(rowp + col0 + e0); float f[8]; unpack8(w, f);
        if constexpr (NORM) {
            float s = 0.f;
#pragma unroll
            for (int i = 0; i < 8; ++i) s += f[i] * f[i];
            s += __shfl_xor(s, 1); s += __shfl_xor(s, 2); s += __shfl_xor(s, 4); s += __shfl_xor(s, 8);
            const float rstd = 1.0f / sqrtf(s * (1.0f / 128.0f) + EPS);
            const f32x4 g0 = *(const f32x4*)(g + (e0 & 127)), g1 = *(const f32x4*)(g + (e0 & 127) + 4);
#pragma unroll
            for (int i = 0; i < 4; ++i) { f[i] = f[i] * rstd * g0[i]; f[4 + i] = f[4 + i] * rstd * g1[i]; }
        }
        if constexpr (ROPE_DIM == 64) { const int p0 = (e0 & 63) >> 1; rope8(f, cosT + p0, sinT + p0); }
        if constexpr (ROPE_DIM == 128) { const int p0 = (e0 & 127) >> 1; rope8(f, cosT + p0, sinT + p0); }
        *(u32x4*)(rowp + col0 + e0) = pack8(f);
    }
}

__global__ void __launch_bounds__(512, 2) hybrid_fwd(Args args) {
    extern __shared__ __attribute__((aligned(16))) unsigned char lds[];
    Frame F;
    F.lds = (LAS unsigned char*)lds;
    F.G = gridDim.x; { const int bx = blockIdx.x; F.vcu = (F.G % 8 == 0) ? (bx % 8) * (F.G / 8) + bx / 8 : bx; }
    volatile LAS unsigned* MISC = (volatile LAS unsigned*)(F.lds + MISC_OFF);
    unsigned char* ws = args.ws;
    gu32* ctl = (gu32*)(ws + WS_CTL);
    for (int u = threadIdx.x; u < 64; u += 512) MISC[u] = 0u;
    __syncthreads();
    XcdBarrier bar; bar.bar = (unsigned*)(ctl + CW_BAR); bar.x = 0; bar.st = nullptr;
#if !MK_PER_PHASE
    bar = xcd_barrier_post((unsigned*)(ctl + CW_BAR), MISC + 8);
#define GRID_BAR() xcd_barrier(bar)
#else
#define GRID_BAR() do { } while (0)
#endif
    const int lo = args.ph_lo, hi = args.ph_hi;
#ifndef PH_MASK
#define PH_MASK 0xFFFFFu
#endif
#define IN(k) ((((PH_MASK) >> (k)) & 1u) && lo <= (k) && (k) < hi)
#ifndef DBL_MASK
#define DBL_MASK 0u
#endif
#define NREP(k) ((((DBL_MASK) >> (k)) & 1u) ? 2 : 1)
#define SEAM(k) do { if (IN(k) && IN((k) + 1)) GRID_BAR(); } while (0)

#define MODS ((float*)(ws + WS_MODS))
#define ADAP ((float*)(ws + WS_ADAP))
#define cosA ((float*)(ws + WS_ROPE))
#define sinA (cosA + 4096 * 32)
#define cosB (cosA + 2 * 4096 * 32)
#define sinB (cosA + 2 * 4096 * 32 + 4096 * 64)
#define ROUTE ((int*)(ws + WS_ROUTE))
#define GATES ((float*)(ws + WS_GATES))
#define SLOT ((int*)(ws + WS_SLOT))
#define CNT ((int*)(ws + WS_CNT))
#define TILEE ((int*)(ws + WS_TILEE))
#define W_IN0 ((bf16_t*)(ws + WS_WIN0))
#define W_OUT0 ((bf16_t*)(ws + WS_WOUT0))
#define W_GU0 ((bf16_t*)(ws + WS_WGU0))
#define W_DN0 ((bf16_t*)(ws + WS_WDN0))
#define W_IN1 ((bf16_t*)(ws + WS_WIN1))
#define W_OUT1 ((bf16_t*)(ws + WS_WOUT1))
#define W_GU1 ((bf16_t*)(ws + WS_WGU1))
#define W_DN1 ((bf16_t*)(ws + WS_WDN1))
#define XR ((float*)(ws + WS_XR))
#define H ((bf16_t*)(ws + WS_H))
#define AO ((bf16_t*)(ws + WS_AO))
#define Y ((bf16_t*)(ws + WS_Y))
#define QKV ((bf16_t*)(ws + WS_QKV))
#define XG ((bf16_t*)(ws + WS_XG))
#define MID ((bf16_t*)(ws + WS_MID))
#define MODS1 (MODS + 5 * 12288)
#define SLAB0 ((float*)(ws + WS_SLAB0))
#define SLAB1 ((float*)(ws + WS_SLAB1))
#define SLABW ((float*)(ws + WS_SLABW))
#define x_in (args.in[0])
#define c_in (args.in[1])
#define ctx_in (args.in[2])
#define cctx_in (args.in[3])
    const int NGW = F.G * 8;
#define PH_LOCALS const int tid = fresh_tid(), lane = tid & 63, wave = __builtin_amdgcn_readfirstlane(tid >> 6), gw = F.vcu * 8 + wave; (void)tid; (void)lane; (void)wave; (void)gw

    if (IN(0)) for (int rep_ = 0; rep_ < NREP(0); ++rep_) {
        PH_LOCALS;
        LAS float* scr = (LAS float*)(F.lds + wave * 16384);
        LAS float* sil = (LAS float*)(F.lds + 98304);
        __syncthreads();
        for (int i = tid; i < 5 * DM; i += 512) { const float v = (i < 4 * DM) ? c_in[i] : cctx_in[i - 4 * DM]; sil[i] = v / (1.0f + __expf(-v)); }
        __syncthreads();
        for (int it = gw; it < 2 * 48 * 32; it += NGW) {
            const int l = it / (48 * 32), r = it % (48 * 32), cg = r / 32, kc = r % 32;
            const float* W = args.in[l ? 22 : 6] + (size_t)(kc * 64) * 12288 + cg * 256 + lane * 4;
            f32x4 a[5];
#pragma unroll
            for (int b = 0; b < 5; ++b) a[b] = (f32x4){0.f, 0.f, 0.f, 0.f};
#pragma unroll 8
            for (int k = 0; k < 64; ++k) { const f32x4 w = *(const f32x4*)(W + (size_t)k * 12288);
#pragma unroll
                for (int b = 0; b < 5; ++b) a[b] += w * sil[b * DM + kc * 64 + k]; }
#pragma unroll
            for (int b = 0; b < 5; ++b) *(f32x4*)(ADAP + ((size_t)(l * 32 + kc) * 5 + b) * 12288 + cg * 256 + lane * 4) = a[b];
        }
        __syncthreads();
        {
            constexpr int I_IN = (DM / 64) * (PROJ / 32), I_OUT = (DM / 64) * (DM / 32);
            constexpr int I_GU = (FFN0_FP8 == 2) ? (DM / 128) * (DFF / 32) : (DM / 64) * (DFF / 32), I_DN = (FFN0_FP8 >= 1) ? (DFF / 128) * (DM / 32) : (DFF / 64) * (DM / 32);
            constexpr int I_EGU = (DM / 128) * (DEX / 32), I_EDN = (DEX / 128) * (DM / 32);
            constexpr int I_IN8 = (DM / 128) * (PROJ / 32), I_OUT8 = (DM / 128) * (DM / 32);
            constexpr int NIT = I_IN + (L1ATT_FP8 ? I_IN8 : I_IN) + I_OUT + (L1ATT_FP8 ? I_OUT8 : I_OUT) + 2 * I_GU + I_DN;
            for (int it = gw; it < NIT; it += NGW) {
                int r = it;
                if (r < I_IN) { tr_plain(args.in[8], DM, PROJ, W_IN0, 0, scr, r, lane); continue; } r -= I_IN;
#if L1ATT_FP8
                if (r < I_IN8) { tr_plain8(args.in[24], DM, PROJ, (unsigned char*)W_IN1, 0, scr, r, lane); continue; } r -= I_IN8;
#else
                if (r < I_IN) { tr_plain(args.in[24], DM, PROJ, W_IN1, 0, scr, r, lane); continue; } r -= I_IN;
#endif
                if (r < I_OUT) { tr_plain(args.in[9], DM, DM, W_OUT0, 0, scr, r, lane); continue; } r -= I_OUT;
#if L1ATT_FP8
                if (r < I_OUT8) { tr_plain8(args.in[25], DM, DM, (unsigned char*)W_OUT1, 0, scr, r, lane); continue; } r -= I_OUT8;
#else
                if (r < I_OUT) { tr_plain(args.in[25], DM, DM, W_OUT1, 0, scr, r, lane); continue; } r -= I_OUT;
#endif
#if FFN0_FP8 == 2
                if (r < I_GU) { tr_gu8(args.in[17], DM, DFF, (unsigned char*)W_GU0, 0, 0, scr, r, lane); continue; } r -= I_GU;
                if (r < I_GU) { tr_gu8(args.in[18], DM, DFF, (unsigned char*)W_GU0, 0, 1, scr, r, lane); continue; } r -= I_GU;
#else
                if (r < I_GU) { tr_gu(args.in[17], DM, DFF, W_GU0, 0, 0, scr, r, lane); continue; } r -= I_GU;
                if (r < I_GU) { tr_gu(args.in[18], DM, DFF, W_GU0, 0, 1, scr, r, lane); continue; } r -= I_GU;
#endif
#if FFN0_FP8 >= 1
                if (r < I_DN) { tr_plain8(args.in[19], DFF, DM, (unsigned char*)W_DN0, 0, scr, r, lane); continue; } r -= I_DN;
#else
                if (r < I_DN) { tr_plain(args.in[19], DFF, DM, W_DN0, 0, scr, r, lane); continue; } r -= I_DN;
#endif
            }
            constexpr int NITX = NE * (2 * I_EGU + I_EDN);
            const float* wp; int ldw; unsigned char* wt; int Kb;
#define XDECODE(IT, WP, LDW, WT, KB) do { int r_ = (IT); const int e_ = r_ / (2 * I_EGU + I_EDN); r_ -= e_ * (2 * I_EGU + I_EDN); \
                if (r_ < 2 * I_EGU) { const int up_ = r_ >= I_EGU; r_ -= up_ * I_EGU; const int nblk_ = DEX / 32, kb_ = r_ / nblk_, n0_ = 32 * (r_ % nblk_); \
                    WP = args.in[29 + up_] + (size_t)e_ * DM * DEX + (size_t)(128 * kb_ + (lane >> 5)) * DEX + n0_ + (lane & 31); LDW = DEX; KB = DM; \
                    WT = (unsigned char*)W_GU1 + ((size_t)e_ * 2 * DEX + (size_t)(n0_ >> 7) * 256 + (n0_ & 127) + up_ * 128) * DM + 128 * kb_; } \
                else { r_ -= 2 * I_EGU; const int nblk_ = DM / 32, kb_ = r_ / nblk_, n0_ = 32 * (r_ % nblk_); \
                    WP = args.in[31] + (size_t)e_ * DEX * DM + (size_t)(128 * kb_ + (lane >> 5)) * DM + n0_ + (lane & 31); LDW = DM; KB = DEX; \
                    WT = (unsigned char*)W_DN1 + ((size_t)e_ * DM + n0_) * DEX + 128 * kb_; } } while (0)
#define XLOAD(T, WP, LDW, HB) do { _Pragma("unroll") for (int i_ = 0; i_ < 32; ++i_) T[i_] = (WP)[(size_t)(64 * (HB) + 2 * i_) * (LDW)]; } while (0)
#define XWRITE(T, HB) do { _Pragma("unroll") for (int i_ = 0; i_ < 32; ++i_) { const int kk_ = 64 * (HB) + 2 * i_ + (lane >> 5); scr[kk_ * 32 + (((lane & 31) + 8 * (kk_ >> 4)) & 31)] = T[i_]; } } while (0)
            float ta[32], tb[32];
            int itx = gw;
            if (itx < NITX) { XDECODE(itx, wp, ldw, wt, Kb); XLOAD(ta, wp, ldw, 0); }
            while (itx < NITX) {
                XLOAD(tb, wp, ldw, 1);
                XWRITE(ta, 0);
                unsigned char* wt_c = wt; const int Kb_c = Kb;
                const int nxt = itx + NGW;
                if (nxt < NITX) { XDECODE(nxt, wp, ldw, wt, Kb); XLOAD(ta, wp, ldw, 0); }
                XWRITE(tb, 1);
                LDS_WAIT(); asm volatile("" ::: "memory");
                { const int c = lane & 7;
#pragma unroll
                  for (int j = 0; j < 4; ++j) { const int n = (lane >> 3) + 8 * j; const LAS float* sp = scr + (16 * c) * 32 + ((n + 8 * c) & 31);
                      u32x4 o;
                      o.x = pk4_fp8(sp[0 * 32] * S_W8, sp[1 * 32] * S_W8, sp[2 * 32] * S_W8, sp[3 * 32] * S_W8); o.y = pk4_fp8(sp[4 * 32] * S_W8, sp[5 * 32] * S_W8, sp[6 * 32] * S_W8, sp[7 * 32] * S_W8);
                      o.z = pk4_fp8(sp[8 * 32] * S_W8, sp[9 * 32] * S_W8, sp[10 * 32] * S_W8, sp[11 * 32] * S_W8); o.w = pk4_fp8(sp[12 * 32] * S_W8, sp[13 * 32] * S_W8, sp[14 * 32] * S_W8, sp[15 * 32] * S_W8);
                      *(GAS u32x4*)(wt_c + (size_t)n * Kb_c + 16 * c) = o; } }
                LDS_WAIT(); asm volatile("" ::: "memory");
                itx = nxt;
            }
#undef XDECODE
#undef XLOAD
#undef XWRITE
        }
    }
    SEAM(0);
    if (IN(1)) for (int rep_ = 0; rep_ < NREP(1); ++rep_) {
        PH_LOCALS;
        for (int i = blockIdx.x * 512 + tid; i < 2 * 5 * 12288; i += F.G * 512) {
            const int l = i / (5 * 12288), r = i % (5 * 12288), b = r / 12288, j = r % 12288;
            float s = args.in[l ? 23 : 7][j];
            for (int kc = 0; kc < 32; ++kc) s += ADAP[((size_t)(l * 32 + kc) * 5 + b) * 12288 + j];
            MODS[i] = s;
        }
        if (blockIdx.x == 0 && wave == 0) {
            const float a = wave_sum(args.in[10][lane] * args.in[11][lane]), b = wave_sum(args.in[12][lane] * args.in[13][lane]);
            if (lane == 0) MODS[2 * 5 * 12288] = expf(a) - expf(b) + LAMBDA_INIT;
        }
    }
    SEAM(1);
    if (IN(2)) for (int rep_ = 0; rep_ < NREP(2); ++rep_) {
        PH_LOCALS;
        for (int row = gw; row < MROWS; row += NGW) {
            const int b = row / RPB, t = row % RPB; const float* md = MODS + (size_t)(t < SEQ ? b : 4) * 12288;
            f32x4 v[8]; mod_row(in_row(x_in, ctx_in, row), args.in[4], md + 0 * DM, md + 1 * DM, H + (size_t)row * DM, lane, v);
        }
    }
    SEAM(2);
    if (IN(3)) for (int rep_ = 0; rep_ < NREP(3); ++rep_) {
        PH_LOCALS;
        pg8::Gemm g{H, W_IN0, DM}; pg8::Order<pg8::MapId> S; S.init(MROWS / 256, PROJ / 256, F.G, (int)blockIdx.x, pg8::MapId{}, DM / 64);
        { LAS float* gl = (LAS float*)(F.lds + RING_BYTES) + 2048; if (tid < 256) gl[tid] = tid < 128 ? args.in[15][tid] : args.in[16][tid - 128]; __syncthreads(); }
        pg8::EpiQKV<0> E{QKV, cosA, sinA, cosB, sinB, args.in[15], args.in[16], (LAS float*)(F.lds + RING_BYTES), 1.0f};
        pg8::gemm_phase(F.lds, g, S, E);
    }
    SEAM(3);
    if (IN(5)) for (int rep_ = 0; rep_ < NREP(5); ++rep_) {
        PH_LOCALS;
        const float lam = MODS[2 * 5 * 12288];
        for (int k = F.vcu; k < 256; k += F.G) {
            for (int i = 0; i < 3; ++i) {
                int b, h, qt;
                if (i < 2) { const int u = 2 * k + i; b = u >> 7; h = (u >> 4) & 7; qt = u & 15; } else { if (k >= 32) break; b = k >> 3; h = k & 7; qt = 16; }
                const size_t rb = (size_t)b * RPB;
                const att::TileMap tm = (qt < 16) ? att::TileMap{0, 0, 0, 68} : att::TileMap{0, 0, SEQ, 4};
#ifndef NO_DIFF
                att::unit_diff(QKV + (rb + qt * 256) * PROJ + h * 128, QKV + rb * PROJ + 2048 + h * 128, QKV + rb * PROJ + 3072 + h * 128, tm, lam, args.in[14],
                               AO + (rb + qt * 256) * DM + h * 128, (char*)lds);
#endif
            }
            for (int i = 0; i < 3; ++i) {
                int b, h, qt;
                if (i < 2) { const int u = 2 * k + i; b = u >> 7; h = (u >> 4) & 7; qt = u & 15; } else { if (k < 32 || k >= 64) break; b = (k - 32) >> 3; h = k & 7; qt = 16; }
                const size_t rb = (size_t)b * RPB; const int kv = h >> 2;
                const att::TileMap tm = (qt < 16) ? att::TileMap{0, 0, 0, 68} : att::TileMap{0, 0, SEQ, 4};
#ifndef NO_STD0
                att::unit_std<0>(QKV + (rb + qt * 256) * PROJ + 1024 + h * 128, QKV + rb * PROJ + 4096 + kv * 128, QKV + rb * PROJ + 4352 + kv * 128, tm, att::MaskInfo{0, 0, 0}, 0.f,
                                 AO + (rb + qt * 256) * DM + 1024 + h * 128, (char*)lds);
#endif
            }
        }
    }
    SEAM(5);
    if (IN(6)) for (int rep_ = 0; rep_ < NREP(6); ++rep_) {
        PH_LOCALS;
        pg8::Gemm g{AO, W_OUT0, DM}; pg8::Order<pg8::MapL0Split> S; S.init(NTOK / 256, DM / 256, F.G, (int)blockIdx.x, pg8::MapL0Split{}, DM / 64, 4, 8);
        pg8::EpiResid E{x_in, ctx_in, XR, MODS, 2, 1, SLABW, 1.0f};
        pg8::gemm_phase<pg8::EpiResid, pg8::Order<pg8::MapL0Split>>(F.lds, g, S, E);
    }
    SEAM(6);
    if (IN(7)) for (int rep_ = 0; rep_ < NREP(7); ++rep_) {
        PH_LOCALS;
        for (int row = gw; row < MROWS; row += NGW) {
            const int b = row / RPB, t = row % RPB; const float* md = MODS + (size_t)(t < SEQ ? b : 4) * 12288;
#if FFN0_FP8 == 2
            f32x4 v[8]; mod_row<true>(t < SEQ ? XR + (size_t)row * DM : in_row(x_in, ctx_in, row), args.in[5], md + 3 * DM, md + 4 * DM, (bf16_t*)((unsigned char*)H + (size_t)row * DM), lane, v,
                                      t < SEQ ? nullptr : SLABW + ((size_t)b * NCTX + (t - SEQ)) * DM, (size_t)NB * NCTX * DM, 8, XR + (size_t)row * DM);
#else
            f32x4 v[8]; mod_row(t < SEQ ? XR + (size_t)row * DM : in_row(x_in, ctx_in, row), args.in[5], md + 3 * DM, md + 4 * DM, H + (size_t)row * DM, lane, v,
                                t < SEQ ? nullptr : SLABW + ((size_t)b * NCTX + (t - SEQ)) * DM, (size_t)NB * NCTX * DM, 8, XR + (size_t)row * DM);
#endif
        }
    }
    SEAM(7);
    if (IN(8)) for (int rep_ = 0; rep_ < NREP(8); ++rep_) {
        PH_LOCALS;
#if FFN0_FP8 == 2
        pg8::Gemm g{H, W_GU0, DM / 2}; pg8::Order<pg8::MapId> S; S.init(MROWS / 256, 2 * DFF / 256, F.G, (int)blockIdx.x, pg8::MapId{}, DM / 128);
        pg8::EpiSwiGLU8 E{(unsigned char*)MID, DFF, 2 * DFF / 256, 1.0f / (S_H8 * S_W8), S_M8 / (S_H8 * S_W8)};
        pg8::gemm_phase<pg8::EpiSwiGLU8, pg8::Order<pg8::MapId>, true>(F.lds, g, S, E);
#elif FFN0_FP8 == 1
        pg8::Gemm g{H, W_GU0, DM}; pg8::Order<pg8::MapId> S; S.init(MROWS / 256, 2 * DFF / 256, F.G, (int)blockIdx.x, pg8::MapId{}, DM / 64);
        pg8::EpiSwiGLU8 E{(unsigned char*)MID, DFF, 2 * DFF / 256, 1.0f, S_M8};
        pg8::gemm_phase(F.lds, g, S, E);
#else
        pg8::Gemm g{H, W_GU0, DM}; pg8::Order<pg8::MapId> S; S.init(MROWS / 256, 2 * DFF / 256, F.G, (int)blockIdx.x, pg8::MapId{}, DM / 64);
        pg8::EpiSwiGLU E{MID, DFF, 2 * DFF / 256};
        pg8::gemm_phase(F.lds, g, S, E);
#endif
    }
    SEAM(8);
    if (IN(9)) for (int rep_ = 0; rep_ < NREP(9); ++rep_) {
        PH_LOCALS;
#if FFN0_FP8 >= 1
        pg8::Gemm g{MID, W_DN0, DFF / 2}; pg8::Order<pg8::MapL0Split> S; S.init(NTOK / 256, DM / 256, F.G, (int)blockIdx.x, pg8::MapL0Split{}, DFF / 128, 4, NS0);
        pg8::EpiResid E{x_in, ctx_in, XR, MODS, 5, 0, SLAB0, 1.0f / (S_M8 * S_W8)};
        pg8::gemm_phase<pg8::EpiResid, pg8::Order<pg8::MapL0Split>, true>(F.lds, g, S, E);
#else
        pg8::Gemm g{MID, W_DN0, DFF}; pg8::Order<pg8::MapL0Split> S; S.init(NTOK / 256, DM / 256, F.G, (int)blockIdx.x, pg8::MapL0Split{}, DFF / 64, 4, NS0);
        pg8::EpiResid E{x_in, ctx_in, XR, MODS, 5, 0, SLAB0, 1.0f};
        pg8::gemm_phase(F.lds, g, S, E);
#endif
    }
    SEAM(9);
    if (IN(10)) for (int rep_ = 0; rep_ < NREP(10); ++rep_) {
        PH_LOCALS;
        for (int row = gw; row < MROWS; row += NGW) {
            const int b = row / RPB, t = row % RPB; const float* md = MODS1 + (size_t)(t < SEQ ? b : 4) * 12288;
#if L1ATT_FP8
            f32x4 v[8]; mod_row<true>(XR + (size_t)row * DM, args.in[20], md + 0 * DM, md + 1 * DM, (bf16_t*)((unsigned char*)H + (size_t)row * DM), lane, v, t < SEQ ? nullptr : SLAB0 + ((size_t)b * NCTX + (t - SEQ)) * DM, (size_t)NB * NCTX * DM, NS0);
#else
            f32x4 v[8]; mod_row(XR + (size_t)row * DM, args.in[20], md + 0 * DM, md + 1 * DM, H + (size_t)row * DM, lane, v, t < SEQ ? nullptr : SLAB0 + ((size_t)b * NCTX + (t - SEQ)) * DM, (size_t)NB * NCTX * DM, NS0);
#endif
        }
    }
    SEAM(10);
    if (IN(11)) for (int rep_ = 0; rep_ < NREP(11); ++rep_) {
        PH_LOCALS;
        pg8::Gemm g{H, W_IN1, L1ATT_FP8 ? DM / 2 : DM}; pg8::Order<pg8::MapId> S; S.init(MROWS / 256, PROJ / 256, F.G, (int)blockIdx.x, pg8::MapId{}, L1ATT_FP8 ? DM / 128 : DM / 64);
#if L1ATT_FP8
        pg8::EpiQKV<1> E{QKV, cosA, sinA, cosB, sinB, nullptr, nullptr, (LAS float*)(F.lds + RING_BYTES), 1.0f / (S_H8 * S_W8)};
        pg8::gemm_phase<pg8::EpiQKV<1>, pg8::Order<pg8::MapId>, true>(F.lds, g, S, E);
#else
        pg8::EpiQKV<1> E{QKV, cosA, sinA, cosB, sinB, nullptr, nullptr, (LAS float*)(F.lds + RING_BYTES), 1.0f};
        pg8::gemm_phase(F.lds, g, S, E);
#endif
    }
    SEAM(11);
    if (IN(13)) for (int rep_ = 0; rep_ < NREP(13); ++rep_) {
        PH_LOCALS;
        float* btab = (float*)(lds + att::OFF_BIAS);
        for (int k = F.vcu; k < 256; k += F.G) {
            for (int i = 0; i < 2; ++i) {
                const int u = 2 * k + i, b = u >> 7, h = (u >> 4) & 7, qt = u & 15, kv = h >> 2; const size_t rb = (size_t)b * RPB;
                const int q0 = qt * 256, ks = (q0 - 128) < 0 ? 0 : (q0 - 128), ke = (q0 + 384) > SEQ ? SEQ : (q0 + 384);
                const att::TileMap tm{4, SEQ, ks, 4 + (ke - ks) / 64};
#ifndef NO_WIN
                att::unit_std<1>(QKV + (rb + q0) * PROJ + h * 128, QKV + rb * PROJ + 2048 + kv * 128, QKV + rb * PROJ + 2304 + kv * 128, tm, att::MaskInfo{q0, 0, 0}, args.in[26][h],
                                 L1ATT_FP8 ? (bf16_t*)((unsigned char*)AO + (rb + q0) * DM + h * 128) : AO + (rb + q0) * DM + h * 128, (char*)lds);
#endif
            }
            for (int i = 0; i < 2; ++i) {
                const int u = 2 * k + i, b = u >> 7, h = (u >> 4) & 7, qt = u & 15; const size_t rb = (size_t)b * RPB;
                const int r0 = qt * 4; int lo_ = r0 - 4; lo_ = lo_ < 0 ? 0 : (lo_ > 52 ? 52 : lo_);
                for (int j = tid; j < 15 * 31; j += 512) btab[j] = args.in[27][h * 465 + j] * (1.0f / ATT_SCALE);
                __syncthreads();
                const att::TileMap tm{4, SEQ, lo_ * 64, 16};
#ifndef NO_NA
                att::unit_std<2>(QKV + (rb + qt * 256) * PROJ + 1024 + h * 128, QKV + rb * PROJ + 2560 + h * 128, QKV + rb * PROJ + 3584 + h * 128, tm, att::MaskInfo{0, r0, lo_}, 0.f,
                                 L1ATT_FP8 ? (bf16_t*)((unsigned char*)AO + (rb + qt * 256) * DM + 1024 + h * 128) : AO + (rb + qt * 256) * DM + 1024 + h * 128, (char*)lds);
#endif
            }
        }
    }
    SEAM(13);
    if (IN(14)) for (int rep_ = 0; rep_ < NREP(14); ++rep_) {
        PH_LOCALS;
#if L1ATT_FP8
        pg8::Gemm g{AO, W_OUT1, DM / 2}; pg8::Order<pg8::MapLatent> S; S.init(NTOK / 256, DM / 256, F.G, (int)blockIdx.x, pg8::MapLatent{}, DM / 128);
        pg8::EpiResid E{x_in, ctx_in, XR, MODS1, 2, 0, nullptr, 1.0f / (S_A8 * S_W8)};
        pg8::gemm_phase<pg8::EpiResid, pg8::Order<pg8::MapLatent>, true>(F.lds, g, S, E);
#else
        pg8::Gemm g{AO, W_OUT1, DM}; pg8::Order<pg8::MapLatent> S; S.init(NTOK / 256, DM / 256, F.G, (int)blockIdx.x, pg8::MapLatent{}, DM / 64);
        pg8::EpiResid E{x_in, ctx_in, XR, MODS1, 2, 0, nullptr, 1.0f};
        pg8::gemm_phase(F.lds, g, S, E);
#endif
    }
    SEAM(14);
    if (IN(15)) for (int rep_ = 0; rep_ < NREP(15); ++rep_) {
        PH_LOCALS;
        LAS float* wt = (LAS float*)F.lds;
        LAS int* ce = (LAS int*)(F.lds + 65536);
        for (int i = tid; i < DM * NE; i += 512) { const int kk = i >> 3, e = i & 7; wt[e * DM + kk] = args.in[28][i]; }
        __syncthreads();
        for (int chunk = blockIdx.x; chunk < NTOK / 64; chunk += F.G) {
            for (int i = 0; i < 8; ++i) {
                const int tl = wave * 8 + i, n = chunk * 64 + tl, b = n >> 12, t = n & 4095, row = b * RPB + t;
                const float* md = MODS1 + (size_t)b * 12288;
                f32x4 v[8]; mod_row<true>(XR + (size_t)row * DM, args.in[21], md + 3 * DM, md + 4 * DM, (bf16_t*)((unsigned char*)H + (size_t)row * DM), lane, v);
                float lg[8];
#pragma unroll
                for (int e = 0; e < 8; ++e) { float s = 0.f;
#pragma unroll
                    for (int j = 0; j < 8; ++j) { const f32x4 w = *(const LAS f32x4*)(wt + e * DM + 256 * j + 4 * lane); s += (v[j].x * w.x + v[j].y * w.y) + (v[j].z * w.z + v[j].w * w.w); }
                    lg[e] = wave_sum(s); }
                int e0 = 0; float l0 = lg[0];
#pragma unroll
                for (int e = 1; e < 8; ++e) if (lg[e] > l0) { l0 = lg[e]; e0 = e; }
                int e1 = -1; float l1 = -3.4e38f;
#pragma unroll
                for (int e = 0; e < 8; ++e) if (e != e0 && lg[e] > l1) { l1 = lg[e]; e1 = e; }
                if (lane == 0) { ce[tl * 2] = e0; ce[tl * 2 + 1] = e1; const float g1 = 1.0f / (1.0f + expf(l0 - l1)); GATES[n * 2] = 1.0f - g1; GATES[n * 2 + 1] = g1; }
            }
            __syncthreads();
            if (wave == 0) {
                const int e0 = ce[lane * 2], e1 = ce[lane * 2 + 1]; int rk0 = 0, rk1 = 0;
                const unsigned long long below = (1ull << lane) - 1ull;
#pragma unroll
                for (int e = 0; e < 8; ++e) {
                    const unsigned long long m0 = __ballot(e0 == e), m1 = __ballot(e1 == e);
                    const int c0 = __popcll(m0);
                    if (e0 == e) rk0 = __popcll(m0 & below);
                    if (e1 == e) rk1 = c0 + __popcll(m1 & below);
                    if (lane == 0) CNT[chunk * 8 + e] = c0 + __popcll(m1);
                }
                const int n = chunk * 64 + lane;
                ROUTE[n * 4 + 0] = e0; ROUTE[n * 4 + 1] = e1; ROUTE[n * 4 + 2] = rk0; ROUTE[n * 4 + 3] = rk1;
            }
            __syncthreads();
        }
    }
    SEAM(15);
    if (IN(16)) for (int rep_ = 0; rep_ < NREP(16); ++rep_) {
        PH_LOCALS;
        LAS int* tot = (LAS int*)F.lds; LAS int* pre = tot + 8; LAS int* base = tot + 16;
        for (int chunk = blockIdx.x; chunk < NTOK / 64; chunk += F.G) {
            { const int e = wave; int a = 0, p = 0;
#pragma unroll
              for (int i = 0; i < 4; ++i) { const int c = 4 * lane + i; const int v = CNT[c * 8 + e]; a += v; p += (c < chunk) ? v : 0; }
              a = (int)wave_sum((float)a); p = (int)wave_sum((float)p);
              if (lane == 0) { tot[e] = a; pre[e] = p; } }
            __syncthreads();
            if (tid == 0) { int s = 0; for (int e = 0; e < 8; ++e) { base[e] = s; s += (tot[e] + 255) / 256 * 256; } base[8] = s; }
            __syncthreads();
            if (chunk == 0 && tid < CAP_TILES + 1) {
                const int ntile = base[8] / 256;
                if (tid == CAP_TILES) TILEE[CAP_TILES] = ntile;
                else { int e = 0; for (int q = 1; q < 8; ++q) if (tid * 256 >= base[q]) e = q; TILEE[tid] = e; }
            }
            for (int i = 0; i < 8; ++i) {
                const int tl = wave * 8 + i, n = chunk * 64 + tl, b = n >> 12, t = n & 4095, row = b * RPB + t;
                const int e0 = ROUTE[n * 4 + 0], e1 = ROUTE[n * 4 + 1], rk0 = ROUTE[n * 4 + 2], rk1 = ROUTE[n * 4 + 3];
                const int s0 = base[e0] + pre[e0] + rk0, s1 = base[e1] + pre[e1] + rk1;
                if (lane == 0) { SLOT[n * 2] = s0; SLOT[n * 2 + 1] = s1; }
                const u32x4* src = (const u32x4*)((const unsigned char*)H + (size_t)row * DM) + lane;
                u32x4* d0 = (u32x4*)((unsigned char*)XG + (size_t)s0 * DM) + lane; u32x4* d1 = (u32x4*)((unsigned char*)XG + (size_t)s1 * DM) + lane;
#pragma unroll
                for (int j = 0; j < 2; ++j) { const u32x4 w = src[64 * j]; d0[64 * j] = w; d1[64 * j] = w; }
            }
            __syncthreads();
        }
    }
    SEAM(16);
    if (IN(17)) for (int rep_ = 0; rep_ < NREP(17); ++rep_) {
        PH_LOCALS;
        const int ntile = TILEE[CAP_TILES];
        pg8::Gemm g{XG, W_GU1, DM / 2}; pg8::Order<pg8::MapMoe> S; S.init(ntile, 2 * DEX / 256, F.G, (int)blockIdx.x, pg8::MapMoe{TILEE, 2 * DEX / 256}, DM / 128);
        pg8::EpiSwiGLU8 E{(unsigned char*)MID, DEX, 2 * DEX / 256, 1.0f / (S_H8 * S_W8), S_M8 / (S_H8 * S_W8)};
        pg8::gemm_phase<pg8::EpiSwiGLU8, pg8::Order<pg8::MapMoe>, true>(F.lds, g, S, E);
    }
    SEAM(17);
    if (IN(18)) for (int rep_ = 0; rep_ < NREP(18); ++rep_) {
        PH_LOCALS;
        const int ntile = TILEE[CAP_TILES];
        pg8::Gemm g{MID, W_DN1, DEX / 2}; pg8::Order<pg8::MapMoe> S; S.init(ntile < 128 ? ntile : 128, DM / 256, F.G, (int)blockIdx.x, pg8::MapMoe{TILEE, DM / 256}, DEX / 128, ntile < 128 ? 0 : ntile - 128, 4);
        pg8::EpiBf16 E{Y, DM, DM / 256, 1.0f / (S_M8 * S_W8), SLAB1};
        pg8::gemm_phase<pg8::EpiBf16, pg8::Order<pg8::MapMoe>, true>(F.lds, g, S, E);
    }
    SEAM(18);
    if (IN(19)) for (int rep_ = 0; rep_ < NREP(19); ++rep_) {
        PH_LOCALS;
        for (int n = gw; n < NTOK; n += NGW) {
            const int b = n >> 12, t = n & 4095, row = b * RPB + t;
            const int s0 = SLOT[n * 2], s1 = SLOT[n * 2 + 1]; const float g0 = GATES[n * 2], g1 = GATES[n * 2 + 1];
            const float* gt = MODS1 + (size_t)b * 12288 + 5 * DM;
            const f32x4* xr = (const f32x4*)(XR + (size_t)row * DM) + lane;
            f32x4 v[8]; float s = 0.f;
#pragma unroll
            for (int j = 0; j < 8; ++j) { f32x4 ya, yb;
                if (s0 < 128 * 256) { const u32x2 a = ((const u32x2*)(Y + (size_t)s0 * DM))[64 * j + lane]; ya = (f32x4){bf_lo(a.x), bf_hi(a.x), bf_lo(a.y), bf_hi(a.y)}; }
                else { ya = (f32x4){0.f, 0.f, 0.f, 0.f};
#pragma unroll
                    for (int p = 0; p < 4; ++p) ya += ((const f32x4*)(SLAB1 + ((size_t)p * (7 * 256) + (s0 - 128 * 256)) * DM))[64 * j + lane]; }
                if (s1 < 128 * 256) { const u32x2 a = ((const u32x2*)(Y + (size_t)s1 * DM))[64 * j + lane]; yb = (f32x4){bf_lo(a.x), bf_hi(a.x), bf_lo(a.y), bf_hi(a.y)}; }
                else { yb = (f32x4){0.f, 0.f, 0.f, 0.f};
#pragma unroll
                    for (int p = 0; p < 4; ++p) yb += ((const f32x4*)(SLAB1 + ((size_t)p * (7 * 256) + (s1 - 128 * 256)) * DM))[64 * j + lane]; }
                const f32x4 gg = ((const f32x4*)gt)[64 * j + lane];
                v[j] = xr[64 * j] + gg * (ya * g0 + yb * g1); s += (v[j].x * v[j].x + v[j].y * v[j].y) + (v[j].z * v[j].z + v[j].w * v[j].w); }
            const float rstd = 1.0f / sqrtf(wave_sum(s) * (1.0f / DM) + EPS);
            f32x4* op = (f32x4*)(args.out + (size_t)n * DM) + lane;
#pragma unroll
            for (int j = 0; j < 8; ++j) op[64 * j] = v[j] * rstd * ((const f32x4*)args.in[32])[64 * j + lane];
        }
    }
#undef IN
#undef SEAM
}

constexpr int N_PHASES = 20;
extern "C" void kernel_launch(void* const* d_in, const int* in_sizes, int n_in, void* d_out, int out_size, void* d_ws, size_t ws_size, hipStream_t stream) {
    static int grid = 0;
    if (grid == 0) {
        if (n_in != 33 || ws_size < WS_END) { fprintf(stderr, "kernel_launch: need 33 inputs and %zu bytes of workspace; got %d, %zu\n", (size_t)WS_END, n_in, ws_size); grid = -1; return; }
        int dev = 0, cus = 0, per_cu = 0;
        if (hipGetDevice(&dev) != hipSuccess || hipDeviceGetAttribute(&cus, hipDeviceAttributeMultiprocessorCount, dev) != hipSuccess) { grid = -1; return; }
        if (hipFuncSetAttribute((const void*)hybrid_fwd, hipFuncAttributeMaxDynamicSharedMemorySize, LDS_BYTES) != hipSuccess) { fprintf(stderr, "kernel_launch: hipFuncSetAttribute failed\n"); grid = -1; return; }
        if (hipOccupancyMaxActiveBlocksPerMultiprocessor(&per_cu, (const void*)hybrid_fwd, 512, LDS_BYTES) != hipSuccess || per_cu < 1)
            fprintf(stderr, "kernel_launch: occupancy query reports %d workgroups per CU\n", per_cu);
        (void)hipGetLastError();
        grid = cus;
    }
    if (grid < 0) return;
    (void)hipMemsetAsync((char*)d_ws + WS_CTL, 0, CTL_ZERO_BYTES, stream);
    Args a{};
    for (int i = 0; i < 33; ++i) a.in[i] = (const float*)d_in[i];
    a.out = (float*)d_out; a.ws = (unsigned char*)d_ws;
#if MK_PER_PHASE
    for (int p = 0; p < N_PHASES; ++p) { a.ph_lo = p; a.ph_hi = p + 1; hipLaunchKernelGGL(hybrid_fwd, dim3(grid), dim3(512), LDS_BYTES, stream, a); }
#else
    a.ph_lo = 0; a.ph_hi = N_PHASES;
    hipLaunchKernelGGL(hybrid_fwd, dim3(grid), dim3(512), LDS_BYTES, stream, a);
#endif
    const hipError_t le = hipPeekAtLastError();
    if (le != hipSuccess) fprintf(stderr, "kernel_launch: launch failed: %s\n", hipGetErrorName(le));
}
```

```cpp
#include <hip/hip_runtime.h>
#include <hip/hip_bf16.h>
#include <cstdio>
#include <cstdint>

#ifndef MK_PER_PHASE
#define MK_PER_PHASE 0
#endif

#ifndef PRESCALE
#define PRESCALE 1
#endif
#ifndef L1ATT_FP8
#define L1ATT_FP8 1
#endif
#ifndef FFN0_FP8
#define FFN0_FP8 1
#endif
#define GAS __attribute__((address_space(1)))
#define LAS __attribute__((address_space(3)))
typedef unsigned short bf16_t;
typedef short bf16x8 __attribute__((ext_vector_type(8)));
typedef short s16x4 __attribute__((ext_vector_type(4)));
typedef float f32x2 __attribute__((ext_vector_type(2)));
typedef float f32x4 __attribute__((ext_vector_type(4)));
typedef float f32x16 __attribute__((ext_vector_type(16)));
typedef unsigned u32x2 __attribute__((ext_vector_type(2)));
typedef unsigned u32x4 __attribute__((ext_vector_type(4)));
typedef GAS unsigned gu32;

constexpr int DM = 2048, NB = 4, SEQ = 4096, NCTX = 256, RPB = SEQ + NCTX, MROWS = NB * RPB;
constexpr int NTOK = NB * SEQ;
constexpr int PROJ = 4608, DFF = 5632, NE = 8, DEX = 7168;
constexpr int CAP_TILES = 136, CAP = CAP_TILES * 256;
constexpr float EPS = 1e-6f;
constexpr float LOG2E = 1.4426950408889634f;
constexpr float ATT_SCALE = 0.088388347648318440f;
constexpr float A_SCALE = 0.125f;
constexpr float LAMBDA_INIT = 0.2f;

constexpr size_t MiB = 1u << 20;
constexpr size_t WS_CTL = 0, CTL_ZERO_BYTES = 32 * 1024;
constexpr size_t WS_MODS = 1 * MiB;
constexpr size_t WS_ADAP = 2 * MiB;
constexpr size_t WS_ROPE = 18 * MiB;
constexpr size_t WS_ROUTE = 22 * MiB;
constexpr size_t WS_GATES = WS_ROUTE + 512 * 1024;
constexpr size_t WS_SLOT = WS_GATES + 256 * 1024;
constexpr size_t WS_CNT = WS_SLOT + 256 * 1024;
constexpr size_t WS_TILEE = WS_CNT + 64 * 1024;
constexpr size_t WS_WIN0 = 34 * MiB, WS_WOUT0 = 52 * MiB, WS_WGU0 = 60 * MiB, WS_WDN0 = 104 * MiB;
constexpr size_t WS_WIN1 = 126 * MiB, WS_WOUT1 = 144 * MiB, WS_WGU1 = 152 * MiB, WS_WDN1 = 600 * MiB;
constexpr size_t WS_XR = 824 * MiB;
constexpr size_t WS_H = 960 * MiB;
constexpr size_t WS_AO = 1028 * MiB;
constexpr size_t WS_Y = WS_H;
constexpr size_t WS_QKV = 1096 * MiB;
constexpr size_t WS_XG = WS_QKV;
constexpr size_t WS_MID = 1249 * MiB;
constexpr size_t WS_SLAB0 = 1500 * MiB;
constexpr size_t WS_SLAB1 = 1540 * MiB;
constexpr size_t WS_SLABW = 1600 * MiB;
constexpr size_t WS_END = 1725 * MiB;
constexpr int CW_TMO = 0, CW_BAR = 4096;
constexpr int NS0 = FFN0_FP8 ? 2 : 4;

constexpr int RING_BYTES = 131072;
constexpr int LDS_BYTES = 147456;
constexpr int MISC_OFF = LDS_BYTES - 256;

#define RLX_AGENT __ATOMIC_RELAXED, __HIP_MEMORY_SCOPE_AGENT
#define LDS_WAIT() asm volatile("s_waitcnt lgkmcnt(0)" ::: "memory")
#define VM_WAIT() asm volatile("s_waitcnt vmcnt(0)" ::: "memory")
__device__ __forceinline__ unsigned cvt_pk_bf16(float lo, float hi) { unsigned r; asm volatile("v_cvt_pk_bf16_f32 %0, %1, %2" : "=v"(r) : "v"(lo), "v"(hi)); return r; }
__device__ __forceinline__ float bf_lo(unsigned w) { return __uint_as_float(w << 16); }
__device__ __forceinline__ float bf_hi(unsigned w) { return __uint_as_float(w & 0xffff0000u); }
typedef int i32x8 __attribute__((ext_vector_type(8)));
constexpr float S_H8 = 16.0f, S_W8 = 1024.0f, S_M8 = 4.0f, S_A8 = 64.0f;
__device__ __forceinline__ float clamp8(float x) { return __builtin_amdgcn_fmed3f(x, -448.0f, 448.0f); }
__device__ __forceinline__ unsigned pk4_fp8(float a, float b, float c, float d) {
    int w = 0; w = __builtin_amdgcn_cvt_pk_fp8_f32(clamp8(a), clamp8(b), w, false); w = __builtin_amdgcn_cvt_pk_fp8_f32(clamp8(c), clamp8(d), w, true); return (unsigned)w; }
__device__ __forceinline__ float wave_sum(float v) {
#pragma unroll
    for (int o = 1; o < 64; o <<= 1) v += __shfl_xor(v, o);
    return v;
}
__device__ __forceinline__ int fresh_tid() { int t = threadIdx.x; asm volatile("" : "+v"(t)); return t; }
__device__ __forceinline__ float fast_silu(float x) { return x * __builtin_amdgcn_rcpf(1.0f + __builtin_amdgcn_exp2f(-x * LOG2E)); }

namespace pg8 {
constexpr int BM = 256, BK = 64, HALF = 128, HTB = HALF * BK * 2, STAGE_BYTES = 8 * HTB, NXCD = 8, WGM = 4;
__host__ __device__ __forceinline__ int lds_byte(int r, int c) { const int st = (r >> 4) * 2 + (c >> 5), rr = r & 15, cc = c & 31, ob = rr * 64 + cc * 2; return st * 1024 + (ob ^ (((ob >> 9) & 1) << 5)); }
__host__ __device__ __forceinline__ void stage_rc(int b, int& R, int& C) { const int st = b / 1024, sb = b % 1024, swz = sb ^ (((sb >> 9) & 1) << 5); R = (st >> 1) * 16 + swz / 64; C = (st & 1) * 32 + (swz % 64) / 2; }
__host__ __device__ __forceinline__ int perm32(int rho) { const int n = rho >> 4, i = rho & 15; return 8 * (i >> 2) + 4 * n + (i & 3); }

typedef int i32x4_t __attribute__((ext_vector_type(4)));
struct Unit { int pm, pn, kofs, nt, flag; };
struct Gemm { const bf16_t* A; const bf16_t* Bt; int K; };

struct MapId { __device__ __forceinline__ void operator()(int pm, int pn, Unit& u) const { u.pm = pm; u.pn = pn; } };
struct MapL0Split { __device__ __forceinline__ void operator()(int pm, int pn, Unit& u) const { u.pm = pm < 64 ? (pm >> 4) * 17 + (pm & 15) : (pm - 64) * 17 + 16; u.pn = pn; } };
struct MapLatent { __device__ __forceinline__ void operator()(int pm, int pn, Unit& u) const { u.pm = (pm >> 4) * 17 + (pm & 15); u.pn = pn; } };
struct MapMoe { const int* tile_e; int npe; __device__ __forceinline__ void operator()(int pm, int pn, Unit& u) const { u.pm = pm; u.pn = tile_e[pm] * npe + pn; } };
template <class Map> struct Order {
    int nM, nN, nwg, G, c, ntf, exn, S; Map map;
    __device__ __forceinline__ void init(int nM_, int nN_, int G_, int c_, Map m, int ntf_, int ex_nM = 0, int S_ = 1) { nM = nM_; nN = nN_; nwg = nM * nN; G = G_; c = c_; map = m; ntf = ntf_; S = S_; exn = ex_nM * nN_ * S_; }
    __device__ __forceinline__ bool next(int i, Unit& u) const {
        const long L = (long)i * G + c; u.kofs = 0; u.nt = ntf; u.flag = 0;
        if (L >= nwg) { const long sidx = L - nwg; if (sidx >= exn) return false; const int part = (int)(sidx % S), ux = (int)(sidx / S);
            map(nM + ux / nN, ux % nN, u); u.nt = ntf / S; u.kofs = part * u.nt * (BK * 2); u.flag = 1 + part; return true; }
        int wgid = (int)L; { const int q = nwg / NXCD, r = nwg % NXCD, xcd = wgid % NXCD, off = wgid / NXCD; wgid = (xcd < r ? xcd * (q + 1) : r * (q + 1) + (xcd - r) * q) + off; }
        const int nig = WGM * nN, gid = wgid / nig, fm = gid * WGM, gsz = (nM - fm) < WGM ? (nM - fm) : WGM;
        map(fm + ((wgid % nig) % gsz), (wgid % nig) / gsz, u); return true;
    }
    __device__ __forceinline__ void a_ready(const Unit&) const {}
    __device__ __forceinline__ void done(const Unit&) const {}
};

struct EpiBf16 {
    static constexpr bool PERM = true;
    bf16_t* O; int ldc; int npn; float sc; float* slab;
    __device__ __forceinline__ void operator()(const f32x4 (&acc)[2][2][4][2], const Unit& u, int wr, int wc, int fr, int fq) const {
        const int row0 = u.pm * BM + wr * 64 + fr, col0 = (u.pn % npn) * BM + wc * 32 + 8 * fq;
        if (u.flag) {
            float* sp = slab + ((size_t)(u.flag - 1) * (7 * 256) + (size_t)(u.pm - 128) * BM + wr * 64 + fr) * ldc + col0;
#pragma unroll
            for (int ai = 0; ai < 2; ++ai)
#pragma unroll
                for (int m = 0; m < 4; ++m)
#pragma unroll
                    for (int bj = 0; bj < 2; ++bj) { float* p = sp + (size_t)(ai * HALF + m * 16) * ldc + bj * HALF;
                        *(f32x4*)p = acc[ai][bj][m][0] * sc; *(f32x4*)(p + 4) = acc[ai][bj][m][1] * sc; }
            return;
        }
#pragma unroll
        for (int ai = 0; ai < 2; ++ai)
#pragma unroll
            for (int m = 0; m < 4; ++m) { bf16_t* rowp = O + (size_t)(row0 + ai * HALF + m * 16) * ldc + col0;
#pragma unroll
                for (int bj = 0; bj < 2; ++bj) { const f32x4 v0 = acc[ai][bj][m][0] * sc, v1 = acc[ai][bj][m][1] * sc;
                    u32x4 w; w.x = cvt_pk_bf16(v0[0], v0[1]); w.y = cvt_pk_bf16(v0[2], v0[3]); w.z = cvt_pk_bf16(v1[0], v1[1]); w.w = cvt_pk_bf16(v1[2], v1[3]);
                    *(u32x4*)(rowp + bj * HALF) = w; } }
    }
};
template <int LAYER> struct EpiQKV {
    static constexpr bool PERM = true;
    bf16_t* O; const float* cA; const float* sA; const float* cB; const float* sB; const float* qg; const float* kg; LAS float* scr; float asc;
    __device__ __forceinline__ void operator()(const f32x4 (&acc)[2][2][4][2], const Unit& u, int wr, int wc, int fr, int fq) const {
        const int tt = u.pm % 17, pn = u.pn; const bool latent = tt < 16;
        int kind0, kind1; bool norm = false;
        if constexpr (LAYER == 0) { const int k = (pn < 4 || (pn >= 8 && pn < 12)) ? 1 : ((pn >= 4 && pn < 8) || pn == 16) ? 2 : 0; kind0 = kind1 = k; norm = (k == 2); }
        else { kind0 = kind1 = (pn < 4 || pn == 8) ? 2 : 0; }
        const int row0 = u.pm * BM + wr * 64 + fr, col0 = pn * BM + wc * 32 + 8 * fq, ch = wc * 32 + 8 * fq;
        if (norm) {
#pragma unroll
            for (int ai = 0; ai < 2; ++ai)
#pragma unroll
                for (int m = 0; m < 4; ++m)
#pragma unroll
                    for (int bj = 0; bj < 2; ++bj) { const f32x4 a = acc[ai][bj][m][0], b = acc[ai][bj][m][1];
                        float q = (a[0] * a[0] + a[1] * a[1]) + (a[2] * a[2] + a[3] * a[3]) + (b[0] * b[0] + b[1] * b[1]) + (b[2] * b[2] + b[3] * b[3]);
                        q += __shfl_xor(q, 16); q += __shfl_xor(q, 32);
                        if (fq == 0) scr[((ai * HALF + wr * 64 + m * 16 + fr) * 2 + bj) * 4 + wc] = q; }
            asm volatile("s_waitcnt lgkmcnt(0)" ::: "memory"); __builtin_amdgcn_s_barrier(); asm volatile("" ::: "memory");
        }
        f32x4 g0 = {1.f, 1.f, 1.f, 1.f}, g1 = g0;
        if (norm) { const LAS float* gl = scr + 2048 + ((pn == 16) ? 128 : 0) + ch; g0 = *(const LAS f32x4*)gl; g1 = *(const LAS f32x4*)(gl + 4); }
        const int kmax = kind0 > kind1 ? kind0 : kind1;
        const int npair = (kmax == 1) ? 16 : 32, p0 = (kmax == 1) ? ((ch & 63) >> 1) : (ch >> 1), q0 = p0 & (npair - 1); const bool use_row = p0 < npair;
        f32x4 frq;
#pragma unroll
        for (int i = 0; i < 4; ++i) frq[i] = __builtin_amdgcn_exp2f(-(float)(q0 + i) * (13.287712379549449f / (float)npair)) * 0.15915494309189535f;
#pragma unroll
        for (int ai = 0; ai < 2; ++ai)
#pragma unroll
            for (int m = 0; m < 4; ++m) { const int r = ai * HALF + wr * 64 + m * 16 + fr, t = tt * 256 + r;
                bf16_t* rowp = O + (size_t)(row0 + ai * HALF + m * 16) * PROJ + col0;
                f32x4 cs = {1.f, 1.f, 1.f, 1.f}, sn = {0.f, 0.f, 0.f, 0.f};
                if (latent && kmax != 0) { const float pos = (float)(use_row ? (t >> 6) : (t & 63));
#pragma unroll
                    for (int i = 0; i < 4; ++i) { const float x = pos * frq[i]; cs[i] = __builtin_amdgcn_cosf(x); sn[i] = __builtin_amdgcn_sinf(x); } }
#pragma unroll
                for (int bj = 0; bj < 2; ++bj) { f32x4 v0 = acc[ai][bj][m][0] * asc, v1 = acc[ai][bj][m][1] * asc; const int kind = bj ? kind1 : kind0;
                    if (norm) { const f32x4 p = *(const LAS f32x4*)(scr + ((ai * HALF + wr * 64 + m * 16 + fr) * 2 + bj) * 4);
                        const float rsv = 1.0f / sqrtf(((p[0] + p[1]) + (p[2] + p[3])) * (1.0f / 128.0f) + EPS); v0 = v0 * rsv * g0; v1 = v1 * rsv * g1; }
                    if (latent && kind != 0) {
                        const f32x4 a = v0, b = v1;
                        v0[0] = a[0] * cs[0] - a[1] * sn[0]; v0[1] = a[0] * sn[0] + a[1] * cs[0]; v0[2] = a[2] * cs[1] - a[3] * sn[1]; v0[3] = a[2] * sn[1] + a[3] * cs[1];
                        v1[0] = b[0] * cs[2] - b[1] * sn[2]; v1[1] = b[0] * sn[2] + b[1] * cs[2]; v1[2] = b[2] * cs[3] - b[3] * sn[3]; v1[3] = b[2] * sn[3] + b[3] * cs[3]; }
                    if constexpr (LAYER == 0 && PRESCALE) { const float qs = pn < 4 ? A_SCALE * LOG2E : (pn < 8 ? ATT_SCALE * LOG2E : 1.0f); v0 = v0 * qs; v1 = v1 * qs; }
                    u32x4 w; w.x = cvt_pk_bf16(v0[0], v0[1]); w.y = cvt_pk_bf16(v0[2], v0[3]); w.z = cvt_pk_bf16(v1[0], v1[1]); w.w = cvt_pk_bf16(v1[2], v1[3]);
                    *(u32x4*)(rowp + bj * HALF) = w; } }
    }
};
struct EpiSwiGLU {
    static constexpr bool PERM = true;
    bf16_t* O; int ldc; int npn;
    __device__ __forceinline__ void operator()(const f32x4 (&acc)[2][2][4][2], const Unit& u, int wr, int wc, int fr, int fq) const {
        const int row0 = u.pm * BM + wr * 64 + fr, col0 = (u.pn % npn) * HALF + wc * 32 + 8 * fq;
#pragma unroll
        for (int ai = 0; ai < 2; ++ai)
#pragma unroll
            for (int m = 0; m < 4; ++m) { bf16_t* rowp = O + (size_t)(row0 + ai * HALF + m * 16) * ldc + col0;
                const f32x4 g0 = acc[ai][0][m][0], g1 = acc[ai][0][m][1], u0 = acc[ai][1][m][0], u1 = acc[ai][1][m][1];
                u32x4 w;
                w.x = cvt_pk_bf16(fast_silu(g0[0]) * u0[0], fast_silu(g0[1]) * u0[1]); w.y = cvt_pk_bf16(fast_silu(g0[2]) * u0[2], fast_silu(g0[3]) * u0[3]);
                w.z = cvt_pk_bf16(fast_silu(g1[0]) * u1[0], fast_silu(g1[1]) * u1[1]); w.w = cvt_pk_bf16(fast_silu(g1[2]) * u1[2], fast_silu(g1[3]) * u1[3]);
                *(u32x4*)rowp = w; }
    }
};
struct EpiSwiGLU8 {
    static constexpr bool PERM = true;
    unsigned char* O; int ldc; int npn; float si, so;
    __device__ __forceinline__ float one(float ag, float au, float kneg, float c0) const {
        const float e = __builtin_amdgcn_exp2f(ag * kneg); return (ag * au) * __builtin_amdgcn_rcpf(fmaf(e, c0, c0)); }
    __device__ __forceinline__ void operator()(const f32x4 (&acc)[2][2][4][2], const Unit& u, int wr, int wc, int fr, int fq) const {
        const int row0 = u.pm * BM + wr * 64 + fr, col0 = (u.pn % npn) * HALF + wc * 32 + 8 * fq;
        const float kneg = -si * LOG2E, c0 = 1.0f / (si * so);
#pragma unroll
        for (int ai = 0; ai < 2; ++ai)
#pragma unroll
            for (int m = 0; m < 4; ++m) { unsigned char* rowp = O + (size_t)(row0 + ai * HALF + m * 16) * ldc + col0;
                const f32x4 g0 = acc[ai][0][m][0], g1 = acc[ai][0][m][1], u0 = acc[ai][1][m][0], u1 = acc[ai][1][m][1];
                u32x2 w;
                w.x = pk4_fp8(one(g0[0], u0[0], kneg, c0), one(g0[1], u0[1], kneg, c0), one(g0[2], u0[2], kneg, c0), one(g0[3], u0[3], kneg, c0));
                w.y = pk4_fp8(one(g1[0], u1[0], kneg, c0), one(g1[1], u1[1], kneg, c0), one(g1[2], u1[2], kneg, c0), one(g1[3], u1[3], kneg, c0));
                *(u32x2*)rowp = w; }
    }
};
struct EpiResid {
    static constexpr bool PERM = false;
    const float* x_in; const float* ctx_in; float* XR; const float* mods; int gate_chunk; int from_input; float* slab; float asc;
    __device__ __forceinline__ void operator()(const f32x4 (&acc)[2][2][4][2], const Unit& u, int wr, int wc, int fr, int fq) const {
        const int b = u.pm / 17, tt = u.pm % 17;
        float* outp = XR + (size_t)u.pm * BM * DM;
        const float* basep = from_input ? (tt < 16 ? x_in + ((size_t)b * SEQ + (size_t)tt * 256) * DM : ctx_in + (size_t)b * NCTX * DM) : outp;
        const float* gate = mods + (size_t)(tt < 16 ? b : 4) * 12288 + gate_chunk * DM;
        const int col0 = u.pn * BM + wc * 32 + 4 * fq;
        f32x4 gv[2][2];
#pragma unroll
        for (int bj = 0; bj < 2; ++bj)
#pragma unroll
            for (int n = 0; n < 2; ++n) gv[bj][n] = *(const f32x4*)(gate + col0 + bj * HALF + n * 16) * asc;
        if (u.flag) {
            float* sp = slab + ((size_t)(u.flag - 1) * (NB * NCTX) + (size_t)b * NCTX) * DM;
#pragma unroll
            for (int ai = 0; ai < 2; ++ai)
#pragma unroll
                for (int m = 0; m < 4; ++m) { const size_t off = (size_t)(ai * HALF + wr * 64 + m * 16 + fr) * DM + col0;
#pragma unroll
                    for (int bj = 0; bj < 2; ++bj)
#pragma unroll
                        for (int n = 0; n < 2; ++n) *(f32x4*)(sp + off + bj * HALF + n * 16) = gv[bj][n] * acc[ai][bj][m][n]; }
            return;
        }
#pragma unroll
        for (int ai = 0; ai < 2; ++ai)
#pragma unroll
            for (int m = 0; m < 4; ++m) { const size_t off = (size_t)(ai * HALF + wr * 64 + m * 16 + fr) * DM + col0;
#pragma unroll
                for (int bj = 0; bj < 2; ++bj)
#pragma unroll
                    for (int n = 0; n < 2; ++n) { const f32x4 bs = *(const f32x4*)(basep + off + bj * HALF + n * 16);
                        *(f32x4*)(outp + off + bj * HALF + n * 16) = bs + gv[bj][n] * acc[ai][bj][m][n]; }
                if (m & 1) asm volatile("" ::: "memory"); }
    }
};

template <class Epi, class Sched, bool FP8 = false, bool ALIGN_EPI = true, bool SP2 = true>
__device__ __forceinline__ void gemm_phase(LAS unsigned char* lds, const Gemm g, const Sched& S, const Epi& E) {
    const int tid = fresh_tid(), wid = __builtin_amdgcn_readfirstlane(tid >> 6), lane = tid & 63, wr = wid >> 2, wc = wid & 3, fr = lane & 15, fq = lane >> 4;
    const int K = g.K;
    unsigned voffA[2], voffB[2];
#pragma unroll
    for (int i = 0; i < 2; ++i) { int R, C; stage_rc(tid * 16 + i * 8192, R, C); const int Rb = Epi::PERM ? ((R & ~31) + perm32(R & 31)) : R;
        voffA[i] = (unsigned)(R * K + C) * 2u; voffB[i] = (unsigned)(Rb * K + C) * 2u; }
    const size_t kstep = (size_t)(BK * 2);
    const size_t hstep = (size_t)HALF * K * 2;
    const size_t tstep = 2 * hstep;
    const unsigned ldsw = (unsigned)wid * 1024u;
    const int aoff = FP8 ? lds_byte(wr * 64 + fr, fq * 16) : lds_byte(wr * 64 + fr, fq * 8), boff = FP8 ? lds_byte(wc * 32 + fr, fq * 16) : lds_byte(wc * 32 + fr, fq * 8);
#define PG8_SA(b, h) (((b) * 2 + (h)) * HTB)
#define PG8_SB(b, h) ((4 + (b) * 2 + (h)) * HTB)
#define PG8_STAGE(bufoff, gbase, voff) do { _Pragma("unroll") for (int _i = 0; _i < 2; ++_i) \
        __builtin_amdgcn_global_load_lds((const unsigned*)((const char*)(gbase) + (voff)[_i]), (LAS unsigned*)(lds + (bufoff) + ldsw + _i * 8192), 16, 0, 0); } while (0)
#define PG8_LD16(p) (*(const LAS i32x4_t*)(p))
#define PG8_LDA(dst, b, h) do { if constexpr (FP8) { _Pragma("unroll") for (int m = 0; m < 4; ++m) { const LAS unsigned char* _p = lds + PG8_SA(b, h) + aoff + m * 2048; \
            dst##8[m] = __builtin_shufflevector(PG8_LD16(_p), PG8_LD16(_p + 16), 0, 1, 2, 3, 4, 5, 6, 7); } } else { \
        _Pragma("unroll") for (int m = 0; m < 4; ++m) _Pragma("unroll") for (int k = 0; k < 2; ++k) dst[m][k] = *(const LAS bf16x8*)(lds + PG8_SA(b, h) + aoff + m * 2048 + k * 1024); } } while (0)
#define PG8_LDB(dst, b, h) do { if constexpr (FP8) { _Pragma("unroll") for (int n = 0; n < 2; ++n) { const LAS unsigned char* _p = lds + PG8_SB(b, h) + boff + n * 2048; \
            dst##8[n] = __builtin_shufflevector(PG8_LD16(_p), PG8_LD16(_p + 16), 0, 1, 2, 3, 4, 5, 6, 7); } } else { \
        _Pragma("unroll") for (int n = 0; n < 2; ++n) _Pragma("unroll") for (int k = 0; k < 2; ++k) dst[n][k] = *(const LAS bf16x8*)(lds + PG8_SB(b, h) + boff + n * 2048 + k * 1024); } } while (0)
#define PG8_MMA(ai, bj, At, Bt) do { __builtin_amdgcn_s_setprio(1); _Pragma("unroll") for (int m = 0; m < 4; ++m) _Pragma("unroll") for (int n = 0; n < 2; ++n) { if constexpr (FP8) \
        asm volatile("v_mfma_f32_16x16x128_f8f6f4 %0, %1, %2, %0" : "+v"(acc[ai][bj][m][n]) : "v"(Bt##8[n]), "v"(At##8[m])); else { _Pragma("unroll") for (int k = 0; k < 2; ++k) \
        acc[ai][bj][m][n] = __builtin_amdgcn_mfma_f32_16x16x32_bf16(Bt[n][k], At[m][k], acc[ai][bj][m][n], 0, 0, 0); } } __builtin_amdgcn_s_setprio(0); } while (0)
#define PG8_WAIT_V(n) asm volatile("s_waitcnt vmcnt(" #n ")" ::: "memory")
#define PG8_WAIT_L(n) asm volatile("s_waitcnt lgkmcnt(" #n ")" ::: "memory")
#define PG8_BAR __builtin_amdgcn_s_barrier()
#define PG8_SCHED __builtin_amdgcn_sched_barrier(0)
    Unit cur, nxt; int ui = 0;
    if (!S.next(0, cur)) return;
    f32x4 acc[2][2][4][2];
#pragma unroll
    for (int a = 0; a < 2; ++a)
#pragma unroll
        for (int b = 0; b < 2; ++b)
#pragma unroll
            for (int m = 0; m < 4; ++m)
#pragma unroll
                for (int n = 0; n < 2; ++n) acc[a][b][m][n] = (f32x4){0.f, 0.f, 0.f, 0.f};
    bf16x8 At[4][2], B0[2][2], B1[2][2]; i32x8 At8[4], B08[2], B18[2];
    const char* cA = (const char*)g.A + (size_t)cur.pm * tstep + cur.kofs; const char* cB = (const char*)g.Bt + (size_t)cur.pn * tstep + cur.kofs;
    S.a_ready(cur);
    if constexpr (SP2) {
        PG8_STAGE(PG8_SB(0, 0), cB, voffB); PG8_STAGE(PG8_SB(0, 1), cB + hstep, voffB); PG8_STAGE(PG8_SA(0, 0), cA, voffA); PG8_STAGE(PG8_SA(0, 1), cA + hstep, voffA);
        if (wr == 1) PG8_BAR;
        PG8_WAIT_V(2); PG8_BAR;
        PG8_STAGE(PG8_SB(1, 0), cB + kstep, voffB); PG8_STAGE(PG8_SA(1, 0), cA + kstep, voffA); PG8_STAGE(PG8_SB(1, 1), cB + hstep + kstep, voffB);
        PG8_WAIT_V(6); PG8_BAR;
    } else {
        PG8_STAGE(PG8_SB(0, 0), cB, voffB); PG8_STAGE(PG8_SA(0, 0), cA, voffA); PG8_STAGE(PG8_SB(0, 1), cB + hstep, voffB); PG8_STAGE(PG8_SA(0, 1), cA + hstep, voffA);
        if (wr == 1) PG8_BAR;
        PG8_WAIT_V(4); PG8_BAR;
        PG8_STAGE(PG8_SB(1, 0), cB + kstep, voffB); PG8_STAGE(PG8_SA(1, 0), cA + kstep, voffA); PG8_STAGE(PG8_SB(1, 1), cB + hstep + kstep, voffB);
        PG8_WAIT_V(6); PG8_BAR;
    }
    for (;;) {
        const bool has_next = S.next(ui + 1, nxt);
        const char* nA = has_next ? (const char*)g.A + (size_t)nxt.pm * tstep + nxt.kofs : cA; const char* nB = has_next ? (const char*)g.Bt + (size_t)nxt.pn * tstep + nxt.kofs : cB;
        const int nt = cur.nt;
        for (int t = 0; t < nt; t += 2) {
            const bool last = (t == nt - 2);
            const char* a1 = cA + (size_t)(t + 1) * kstep;
            const char* a2 = last ? nA : cA + (size_t)(t + 2) * kstep; const char* b2 = last ? nB : cB + (size_t)(t + 2) * kstep;
            const char* a3 = a2 + kstep; const char* b3 = b2 + kstep;
            if (last && has_next) S.a_ready(nxt);
            if constexpr (SP2) {
            PG8_LDB(B0, 0, 0); PG8_LDB(B1, 0, 1); PG8_SCHED; PG8_LDA(At, 0, 0); PG8_STAGE(PG8_SA(1, 1), a1 + hstep, voffA);
            PG8_WAIT_V(8); PG8_WAIT_L(0); PG8_BAR; PG8_MMA(0, 0, At, B0); PG8_MMA(0, 1, At, B1); PG8_BAR; PG8_SCHED;
            PG8_LDA(At, 0, 1); PG8_STAGE(PG8_SB(0, 0), b2, voffB); PG8_STAGE(PG8_SB(0, 1), b2 + hstep, voffB); PG8_STAGE(PG8_SA(0, 0), a2, voffA);
            PG8_WAIT_V(8); PG8_WAIT_L(0); PG8_BAR; PG8_MMA(1, 0, At, B0); PG8_MMA(1, 1, At, B1); PG8_BAR; PG8_SCHED;
            PG8_LDB(B0, 1, 0); PG8_LDB(B1, 1, 1); PG8_SCHED; PG8_LDA(At, 1, 0); PG8_STAGE(PG8_SA(0, 1), a2 + hstep, voffA);
            PG8_WAIT_V(8); PG8_WAIT_L(0); PG8_BAR; PG8_MMA(0, 0, At, B0); PG8_MMA(0, 1, At, B1); PG8_BAR; PG8_SCHED;
            PG8_LDA(At, 1, 1); PG8_STAGE(PG8_SB(1, 0), b3, voffB); PG8_STAGE(PG8_SB(1, 1), b3 + hstep, voffB); PG8_STAGE(PG8_SA(1, 0), a3, voffA);
            PG8_WAIT_V(8); PG8_WAIT_L(0); PG8_BAR; PG8_MMA(1, 0, At, B0); PG8_MMA(1, 1, At, B1); PG8_BAR; PG8_SCHED;
            } else {
            PG8_LDB(B0, 0, 0); PG8_SCHED; PG8_LDA(At, 0, 0); PG8_STAGE(PG8_SA(1, 1), a1 + hstep, voffA);
            PG8_WAIT_L(8); PG8_BAR; PG8_WAIT_L(0); PG8_MMA(0, 0, At, B0); PG8_BAR; PG8_SCHED;
            PG8_LDB(B1, 0, 1); PG8_STAGE(PG8_SB(0, 0), b2, voffB);
            PG8_BAR; PG8_WAIT_L(0); PG8_MMA(0, 1, At, B1); PG8_BAR;
            PG8_LDA(At, 0, 1); PG8_STAGE(PG8_SA(0, 0), a2, voffA);
            PG8_BAR; PG8_WAIT_L(0); PG8_MMA(1, 0, At, B0); PG8_BAR; PG8_SCHED;
            PG8_STAGE(PG8_SB(0, 1), b2 + hstep, voffB);
            PG8_WAIT_V(6); PG8_BAR; PG8_MMA(1, 1, At, B1); PG8_BAR;
            PG8_LDB(B0, 1, 0); PG8_SCHED; PG8_LDA(At, 1, 0); PG8_STAGE(PG8_SA(0, 1), a2 + hstep, voffA);
            PG8_WAIT_L(8); PG8_BAR; PG8_WAIT_L(0); PG8_MMA(0, 0, At, B0); PG8_BAR; PG8_SCHED;
            PG8_LDB(B1, 1, 1); PG8_STAGE(PG8_SB(1, 0), b3, voffB);
            PG8_BAR; PG8_WAIT_L(0); PG8_MMA(0, 1, At, B1); PG8_BAR;
            PG8_LDA(At, 1, 1); PG8_STAGE(PG8_SA(1, 0), a3, voffA);
            PG8_BAR; PG8_WAIT_L(0); PG8_MMA(1, 0, At, B0); PG8_BAR; PG8_SCHED;
            PG8_STAGE(PG8_SB(1, 1), b3 + hstep, voffB);
            PG8_WAIT_V(6); PG8_BAR; PG8_MMA(1, 1, At, B1); PG8_BAR;
            }
        }
        if constexpr (ALIGN_EPI) { if (wr == 0) PG8_BAR; }
        if constexpr (FP8) asm volatile("s_nop 15\n\ts_nop 15" ::: "memory");
        E(acc, cur, wr, wc, fr, fq); S.done(cur);
        if (!has_next) break;
#pragma unroll
        for (int a = 0; a < 2; ++a)
#pragma unroll
            for (int b = 0; b < 2; ++b)
#pragma unroll
                for (int m = 0; m < 4; ++m)
#pragma unroll
                    for (int n = 0; n < 2; ++n) acc[a][b][m][n] = (f32x4){0.f, 0.f, 0.f, 0.f};
        cur = nxt; cA = nA; cB = nB; ++ui;
        if constexpr (ALIGN_EPI) { if (wr == 1) PG8_BAR; }
    }
    PG8_WAIT_V(0);
    if constexpr (!ALIGN_EPI) { if (wr == 0) PG8_BAR; }
    PG8_BAR;
#undef PG8_SA
#undef PG8_SB
#undef PG8_STAGE
#undef PG8_LDA
#undef PG8_LDB
#undef PG8_MMA
#undef PG8_LD16
#undef PG8_WAIT_V
#undef PG8_WAIT_L
#undef PG8_BAR
#undef PG8_SCHED
}
}

namespace att {
constexpr int D = 128, NW = 8, QBLK = 32, KVBLK = 64;
constexpr int LDQK = PROJ, LDO = DM;
constexpr float THR = 8.f;
#ifndef DIFF_SD
#define DIFF_SD 2
#endif
#ifndef STD_SD
#define STD_SD 1
#endif
constexpr int SHM_V = KVBLK * D * 2, SHM_K = KVBLK * D * 2;
constexpr int OFF_WS = 2 * SHM_V + 2 * SHM_K, OFF_STASH = OFF_WS + NW * 64 * 4, OFF_BIAS = OFF_STASH + 65536, ATT_LDS = OFF_BIAS + 2048;
static_assert(ATT_LDS <= MISC_OFF, "attention LDS");
#define KSWZ(row, colB) ((row) * 256 + ((colB) ^ (((row) & 7) << 4)))
#define SBAR() __builtin_amdgcn_sched_barrier(0)
__device__ __forceinline__ int crow(int r, int hi) { return (r & 3) + 8 * (r >> 2) + 4 * hi; }
struct TileMap { int NC, cbase, lbase, NT; __device__ __forceinline__ int krow(int j) const { return j < NC ? cbase + 64 * j : lbase + 64 * (j - NC); } };
struct MaskInfo { int q0, r0, lo; };

template <int MODE>
__device__ __forceinline__ void apply_mask(f32x16& p0, f32x16& p1, int j, const TileMap& tm, const MaskInfo& mi, int wid, int r32, int hi, const float* btab) {
    if constexpr (MODE == 1) {
        if (j >= tm.NC) {
            const int kp0 = tm.lbase + 64 * (j - tm.NC), qw = mi.q0 + wid * 32;
            if (kp0 - (qw + 31) < -128 || kp0 + 63 - qw > 128) {
                const int dq = kp0 - (qw + r32) + 4 * hi;
#pragma unroll
                for (int r = 0; r < 16; ++r) { const int d = dq + (r & 3) + 8 * (r >> 2);
                    if (d > 128 || d < -128) p0[r] = -1e30f;
                    if (d + 32 > 128 || d + 32 < -128) p1[r] = -1e30f; }
            }
        }
    } else if constexpr (MODE == 2) {
        if (j >= tm.NC) {
            const int kr = mi.lo + (j - tm.NC), rq = mi.r0 + (wid >> 1);
            int rs = rq - 4; rs = rs < 0 ? 0 : (rs > 56 ? 56 : rs);
            if (kr >= rs && kr < rs + 8) {
                const int cq = (wid & 1) * 32 + r32; int cs = cq - 8; cs = cs < 0 ? 0 : (cs > 48 ? 48 : cs);
                const float* bt = btab + (kr - rq + 7) * 31 + (4 * hi - cq + 15);
                const int cb = 4 * hi - cs;
#pragma unroll
                for (int r = 0; r < 16; ++r) { const int ko = (r & 3) + 8 * (r >> 2);
                    p0[r] = ((unsigned)(ko + cb) < 16u) ? p0[r] + bt[ko] : -1e30f;
                    if ((r & 7) == 7) SBAR(); }
#pragma unroll
                for (int r = 0; r < 16; ++r) { const int ko = (r & 3) + 8 * (r >> 2);
                    p1[r] = ((unsigned)(ko + 32 + cb) < 16u) ? p1[r] + bt[ko + 32] : -1e30f;
                    if ((r & 7) == 7) SBAR(); }
            } else {
#pragma unroll
                for (int r = 0; r < 16; ++r) { p0[r] = -1e30f; p1[r] = -1e30f; }
            }
        }
    }
}
__device__ __forceinline__ void partialSM(f32x16& p0, f32x16& p1, float& m_reg, float& mn, float& alpha, const float C, const float thr_raw) {
    float pmax = p0[0];
#pragma unroll
    for (int r = 1; r < 16; ++r) pmax = fmaxf(pmax, p0[r]);
#pragma unroll
    for (int r = 0; r < 16; ++r) pmax = fmaxf(pmax, p1[r]);
    { auto rr = __builtin_amdgcn_permlane32_swap(__float_as_uint(pmax), __float_as_uint(pmax), false, false);
      pmax = fmaxf(__uint_as_float(rr[0]), __uint_as_float(rr[1])); }
    if (__builtin_expect(__all(pmax - m_reg <= thr_raw), 1)) { mn = m_reg; alpha = 1.f; }
    else { mn = fmaxf(m_reg, pmax); alpha = __builtin_amdgcn_exp2f((m_reg - mn) * C); m_reg = mn; }
    const float mnC = -mn * C;
#pragma unroll
    for (int r = 0; r < 16; ++r) p0[r] = fmaf(p0[r], C, mnC);
#pragma unroll
    for (int r = 0; r < 16; ++r) p1[r] = fmaf(p1[r], C, mnC);
#pragma unroll
    for (int r = 0; r < 16; ++r) p0[r] = __builtin_amdgcn_exp2f(p0[r]);
}
__device__ __forceinline__ void finishSM(f32x16& p0, f32x16& p1, float alpha, float& l_reg, bf16x8& pa0, bf16x8& pa1, bf16x8& pa2, bf16x8& pa3) {
#pragma unroll
    for (int r = 0; r < 16; ++r) p1[r] = __builtin_amdgcn_exp2f(p1[r]);
    float ps = 0;
#pragma unroll
    for (int r = 0; r < 16; ++r) ps += p0[r];
#pragma unroll
    for (int r = 0; r < 16; ++r) ps += p1[r];
    { auto rr = __builtin_amdgcn_permlane32_swap(__float_as_uint(ps), __float_as_uint(ps), false, false);
      ps = __uint_as_float(rr[0]) + __uint_as_float(rr[1]); }
    l_reg = l_reg * alpha + ps;
#define PK4(P, BASE, OUT) do { unsigned a0 = cvt_pk_bf16(P[BASE + 0], P[BASE + 1]), a1 = cvt_pk_bf16(P[BASE + 2], P[BASE + 3]);   \
    unsigned b0 = cvt_pk_bf16(P[BASE + 4], P[BASE + 5]), b1 = cvt_pk_bf16(P[BASE + 6], P[BASE + 7]);                              \
    auto r0 = __builtin_amdgcn_permlane32_swap(a0, b0, false, false); auto r1 = __builtin_amdgcn_permlane32_swap(a1, b1, false, false); \
    u32x4 w = {r0[0], r1[0], r0[1], r1[1]}; OUT = *reinterpret_cast<bf16x8*>(&w); } while (0)
    PK4(p0, 0, pa0); PK4(p0, 8, pa1); PK4(p1, 0, pa2); PK4(p1, 8, pa3);
#undef PK4
}
template <int DLO, int DHI, bool QLDS>
__device__ __forceinline__ void qkt(f32x16& p0, f32x16& p1, const char* Ks, const bf16x8* qr, const char* qlds, int r32, int hi, const f32x16& cinit = f32x16{}) {
#pragma unroll
    for (int d0 = DLO; d0 < DHI; ++d0) { const int cb = (d0 * 16 + hi * 8) * 2;
        bf16x8 q; if constexpr (QLDS) q = *(const volatile LAS bf16x8*)((const LAS char*)qlds + d0 * 8192); else q = qr[d0];
        const bf16x8 b0 = *reinterpret_cast<const bf16x8*>(Ks + KSWZ(r32, cb));
        const bf16x8 b1 = *reinterpret_cast<const bf16x8*>(Ks + KSWZ(32 + r32, cb));
        if (d0 == DLO) {
            if constexpr (PRESCALE && !QLDS) {
                asm("v_mfma_f32_32x32x16_bf16 %0, %1, %2, %3" : "=&v"(p0) : "v"(b0), "v"(q), "v"(cinit));
                asm("v_mfma_f32_32x32x16_bf16 %0, %1, %2, %3" : "=&v"(p1) : "v"(b1), "v"(q), "v"(cinit)); }
            else { p0 = __builtin_amdgcn_mfma_f32_32x32x16_bf16(b0, q, cinit, 0, 0, 0); p1 = __builtin_amdgcn_mfma_f32_32x32x16_bf16(b1, q, cinit, 0, 0, 0); } }
        else { p0 = __builtin_amdgcn_mfma_f32_32x32x16_bf16(b0, q, p0, 0, 0, 0); p1 = __builtin_amdgcn_mfma_f32_32x32x16_bf16(b1, q, p1, 0, 0, 0); } }
}
constexpr float THR_L2 = THR * LOG2E;
__device__ __forceinline__ void presm_decide(f32x16& p0, f32x16& p1, float pmax, float& m_hat, float& alpha, f32x16& negm, bool first) {
    { auto rr = __builtin_amdgcn_permlane32_swap(__float_as_uint(pmax), __float_as_uint(pmax), false, false);
      pmax = fmaxf(__uint_as_float(rr[0]), __uint_as_float(rr[1])); }
    if (!first && __builtin_expect(__all(pmax <= THR_L2), 1)) { alpha = 1.f; }
    else { const float dl = first ? pmax : fmaxf(pmax, 0.f); m_hat += dl; alpha = first ? 1.f : __builtin_amdgcn_exp2f(-dl);
#pragma unroll
        for (int r = 0; r < 16; ++r) { p0[r] -= dl; p1[r] -= dl; }
#pragma unroll
        for (int r = 0; r < 16; ++r) negm[r] = -m_hat; }
}
__device__ __forceinline__ int v_st(int k, int c) { const int kk = (k & ~0xC) | ((k & 4) << 1) | ((k & 8) >> 1); return ((kk >> 3) * 4 + (c >> 5)) * 512 + ((kk & 7) * 32 + (c & 31)) * 2; }
__device__ __forceinline__ int v_rd_base(int lane) { return ((lane & 3) << 3) | (((lane >> 2) & 3) << 6) | (((lane >> 4) & 1) << 5) | (((lane >> 5) & 1) << 8); }
constexpr int v_rd_off(int d0, int ks, int half) { return d0 * 512 + ks * 4096 + half * 2048; }
template <int OFF> __device__ __forceinline__ s16x4 tr_read(int vb) {
    s16x4 r; asm volatile("ds_read_b64_tr_b16 %0, %1 offset:%2" : "=&v"(r) : "v"(vb), "i"(OFF) : "memory"); return r;
}
template <int D0> __device__ __forceinline__ void pv_one(f32x16& od, int vb, bf16x8 pa0, bf16x8 pa1, bf16x8 pa2, bf16x8 pa3) {
    const s16x4 l0 = tr_read<v_rd_off(D0, 0, 0)>(vb), h0 = tr_read<v_rd_off(D0, 0, 1)>(vb), l1 = tr_read<v_rd_off(D0, 1, 0)>(vb), h1 = tr_read<v_rd_off(D0, 1, 1)>(vb);
    const s16x4 l2 = tr_read<v_rd_off(D0, 2, 0)>(vb), h2 = tr_read<v_rd_off(D0, 2, 1)>(vb), l3 = tr_read<v_rd_off(D0, 3, 0)>(vb), h3 = tr_read<v_rd_off(D0, 3, 1)>(vb);
    asm volatile("s_waitcnt lgkmcnt(0)" ::: "memory"); SBAR();
#define PK(L, H) (bf16x8){L[0], L[1], L[2], L[3], H[0], H[1], H[2], H[3]}
    od = __builtin_amdgcn_mfma_f32_32x32x16_bf16(pa0, PK(l0, h0), od, 0, 0, 0);
    od = __builtin_amdgcn_mfma_f32_32x32x16_bf16(pa1, PK(l1, h1), od, 0, 0, 0);
    od = __builtin_amdgcn_mfma_f32_32x32x16_bf16(pa2, PK(l2, h2), od, 0, 0, 0);
    od = __builtin_amdgcn_mfma_f32_32x32x16_bf16(pa3, PK(l3, h3), od, 0, 0, 0);
#undef PK
}
__device__ __forceinline__ void pv_d0(f32x16* o, int vb, bf16x8 pa0, bf16x8 pa1, bf16x8 pa2, bf16x8 pa3) {
    pv_one<0>(o[0], vb, pa0, pa1, pa2, pa3); pv_one<1>(o[1], vb, pa0, pa1, pa2, pa3); pv_one<2>(o[2], vb, pa0, pa1, pa2, pa3); pv_one<3>(o[3], vb, pa0, pa1, pa2, pa3);
}
template <int MODE, bool PRE = false>
__device__ __forceinline__ void pv_sm(f32x16* o, int vb, bf16x8 pa0, bf16x8 pa1, bf16x8 pa2, bf16x8 pa3, f32x16& p0, f32x16& p1, float& m_reg, float& mn, float& alpha, const float C, const float thr_raw,
                                      int j, const TileMap& tm, const MaskInfo& mi, int wid, int r32, int hi, const float* btab, f32x16* negm = nullptr) {
    if constexpr (PRE) {
        pv_one<0>(o[0], vb, pa0, pa1, pa2, pa3);
        float pmax = p0[0];
#pragma unroll
        for (int r = 1; r < 16; ++r) pmax = fmaxf(pmax, p0[r]);
        pv_one<1>(o[1], vb, pa0, pa1, pa2, pa3);
#pragma unroll
        for (int r = 0; r < 16; ++r) pmax = fmaxf(pmax, p1[r]);
        pv_one<2>(o[2], vb, pa0, pa1, pa2, pa3);
        presm_decide(p0, p1, pmax, m_reg, alpha, *negm, false);
        pv_one<3>(o[3], vb, pa0, pa1, pa2, pa3);
#pragma unroll
        for (int r = 0; r < 16; ++r) p0[r] = __builtin_amdgcn_exp2f(p0[r]);
        return;
    }
    pv_one<0>(o[0], vb, pa0, pa1, pa2, pa3);
    apply_mask<MODE>(p0, p1, j, tm, mi, wid, r32, hi, btab);
    float pmax = p0[0];
#pragma unroll
    for (int r = 1; r < 16; ++r) pmax = fmaxf(pmax, p0[r]);
    pv_one<1>(o[1], vb, pa0, pa1, pa2, pa3);
#pragma unroll
    for (int r = 0; r < 16; ++r) pmax = fmaxf(pmax, p1[r]);
    { auto rr = __builtin_amdgcn_permlane32_swap(__float_as_uint(pmax), __float_as_uint(pmax), false, false);
      pmax = fmaxf(__uint_as_float(rr[0]), __uint_as_float(rr[1])); }
    if (__builtin_expect(__all(pmax - m_reg <= thr_raw), 1)) { mn = m_reg; alpha = 1.f; }
    else { mn = fmaxf(m_reg, pmax); alpha = __builtin_amdgcn_exp2f((m_reg - mn) * C); m_reg = mn; }
    const float mnC = -mn * C;
    pv_one<2>(o[2], vb, pa0, pa1, pa2, pa3);
#pragma unroll
    for (int r = 0; r < 16; ++r) p0[r] = fmaf(p0[r], C, mnC);
#pragma unroll
    for (int r = 0; r < 16; ++r) p1[r] = fmaf(p1[r], C, mnC);
    pv_one<3>(o[3], vb, pa0, pa1, pa2, pa3);
#pragma unroll
    for (int r = 0; r < 16; ++r) p0[r] = __builtin_amdgcn_exp2f(p0[r]);
}

template <int MODE, int DLO, int DHI, int SD = 2, bool QLDS = false>
__device__ __forceinline__ void attn_core(const bf16_t* __restrict__ Qb, const bf16_t* __restrict__ Kh, const bf16_t* __restrict__ Vh, const TileMap tm, const MaskInfo mi,
                                          const float C, const float thr_raw, char* lds, f32x16 (&o)[4], float& l_out, float& m_out) {
    const int tid = fresh_tid(), wid = tid >> 6, lane = tid & 63, r32 = lane & 31, hi = lane >> 5;
    char* V_lds = lds; char* K_lds = lds + 2 * SHM_V;
    float* ws = (float*)(lds + OFF_WS) + wid * 64; float* al_l = ws + 32;
    const float* btab = (const float*)(lds + OFF_BIAS);
    constexpr bool PRE = (MODE == 0) && (PRESCALE != 0);
    float m_reg = PRE ? 0.f : -1e30f, l_reg = 0; f32x16 negm = f32x16{};
#pragma unroll
    for (int d = 0; d < 4; ++d) o[d] = f32x16{};
    bf16x8 qr[8];
    const unsigned qoff = (unsigned)((wid * QBLK + r32) * LDQK + hi * 8);
#pragma unroll
    for (int d0 = 0; d0 < 8; ++d0) { if (d0 >= DLO && d0 < DHI) qr[d0] = *reinterpret_cast<const bf16x8*>(Qb + qoff + d0 * 16); else qr[d0] = bf16x8{}; }
    const char* qlds = lds + OFF_STASH + tid * 16;
    if constexpr (QLDS) {
#pragma unroll
        for (int d0 = DLO; d0 < DHI; ++d0) *(bf16x8*)(lds + OFF_STASH + tid * 16 + d0 * 8192) = qr[d0];
        asm volatile("s_waitcnt lgkmcnt(0)" ::: "memory");
    }
    const int sr = tid >> 4, sc = (tid & 15) * 8, vst0 = v_st(sr, sc), vst1 = v_st(32 + sr, sc);
    const unsigned loff = (unsigned)(sr * LDQK + sc);
    const int vb0 = (int)(uintptr_t)V_lds + v_rd_base(lane);
    struct { bf16x8 vs0, vs1, ks0, ks1; } sr_[SD];
#define SLOAD(i, k0) do { const size_t _k0 = (size_t)(k0) * LDQK; const bf16_t* _kt = Kh + _k0; const bf16_t* _vt = Vh + _k0; \
    sr_[i].vs0 = *reinterpret_cast<const bf16x8*>(_vt + loff); sr_[i].vs1 = *reinterpret_cast<const bf16x8*>(_vt + 32 * LDQK + loff); \
    sr_[i].ks0 = *reinterpret_cast<const bf16x8*>(_kt + loff); sr_[i].ks1 = *reinterpret_cast<const bf16x8*>(_kt + 32 * LDQK + loff); } while (0)
#define SWRITE(b, i) do { *(bf16x8*)(V_lds + (b) * SHM_V + vst0) = sr_[i].vs0; *(bf16x8*)(V_lds + (b) * SHM_V + vst1) = sr_[i].vs1; const int kc = sc * 2; \
    *(bf16x8*)(K_lds + (b) * SHM_K + KSWZ(sr, kc)) = sr_[i].ks0; *(bf16x8*)(K_lds + (b) * SHM_K + KSWZ(32 + sr, kc)) = sr_[i].ks1; } while (0)
#define SWAIT() do { if constexpr (SD == 2) asm volatile("s_waitcnt vmcnt(4)" ::: "memory"); else asm volatile("s_waitcnt vmcnt(0)" ::: "memory"); } while (0)
#define RESC(a) do { if (__any((a) < 1.f)) { if (hi == 0) al_l[r32] = (a); asm volatile("s_waitcnt lgkmcnt(0)" ::: "memory"); \
    _Pragma("unroll") for (int d = 0; d < 4; ++d) _Pragma("unroll") for (int r = 0; r < 16; ++r) o[d][r] *= al_l[crow(r, hi)]; } } while (0)
    f32x16 pA0, pA1, pB0, pB1; float mnA, mnB, alA, alB; bf16x8 pa0, pa1, pa2, pa3; const int NT = tm.NT;
    constexpr int SE = 0, SO = SD - 1;
    SLOAD(SE, tm.krow(0)); asm volatile("s_waitcnt vmcnt(0)" ::: "memory"); SWRITE(0, SE); __syncthreads();
    qkt<DLO, DHI, QLDS>(pA0, pA1, K_lds, qr, qlds, r32, hi, negm); apply_mask<MODE>(pA0, pA1, 0, tm, mi, wid, r32, hi, btab);
    if constexpr (PRE) { float pmax = pA0[0];
#pragma unroll
        for (int r = 1; r < 16; ++r) pmax = fmaxf(pmax, pA0[r]);
#pragma unroll
        for (int r = 0; r < 16; ++r) pmax = fmaxf(pmax, pA1[r]);
        presm_decide(pA0, pA1, pmax, m_reg, alA, negm, true);
#pragma unroll
        for (int r = 0; r < 16; ++r) pA0[r] = __builtin_amdgcn_exp2f(pA0[r]); }
    else partialSM(pA0, pA1, m_reg, mnA, alA, C, thr_raw);
    SLOAD(SO, tm.krow(1)); if constexpr (SD == 2) { if (2 < NT) SLOAD(SE, tm.krow(2)); }
    SWAIT(); SWRITE(1, SO); __syncthreads();
    for (int j = 1; j + 1 < NT; j += 2) {
        SBAR(); qkt<DLO, DHI, QLDS>(pB0, pB1, K_lds + SHM_K, qr, qlds, r32, hi, negm);
        finishSM(pA0, pA1, alA, l_reg, pa0, pa1, pa2, pa3); SBAR();
        SLOAD(SO, tm.krow(j + SD)); SBAR();
        pv_sm<MODE, PRE>(o, vb0, pa0, pa1, pa2, pa3, pB0, pB1, m_reg, mnB, alB, C, thr_raw, j, tm, mi, wid, r32, hi, btab, &negm);
        __syncthreads(); SWAIT(); SWRITE(0, SE);
        RESC(alB); __syncthreads();
        SBAR(); qkt<DLO, DHI, QLDS>(pA0, pA1, K_lds, qr, qlds, r32, hi, negm);
        finishSM(pB0, pB1, alB, l_reg, pa0, pa1, pa2, pa3); SBAR();
        if (SD == 1 || j + 3 < NT) SLOAD(SE, tm.krow(j + 1 + SD)); SBAR();
        pv_sm<MODE, PRE>(o, vb0 + SHM_V, pa0, pa1, pa2, pa3, pA0, pA1, m_reg, mnA, alA, C, thr_raw, j + 1, tm, mi, wid, r32, hi, btab, &negm);
        __syncthreads(); SWAIT(); SWRITE(1, SO);
        RESC(alA); __syncthreads();
    }
    SBAR(); qkt<DLO, DHI, QLDS>(pB0, pB1, K_lds + SHM_K, qr, qlds, r32, hi, negm);
    finishSM(pA0, pA1, alA, l_reg, pa0, pa1, pa2, pa3); SBAR();
    pv_sm<MODE, PRE>(o, vb0, pa0, pa1, pa2, pa3, pB0, pB1, m_reg, mnB, alB, C, thr_raw, NT - 1, tm, mi, wid, r32, hi, btab, &negm);
    __syncthreads(); RESC(alB);
    finishSM(pB0, pB1, alB, l_reg, pa0, pa1, pa2, pa3); SBAR();
    pv_d0(o, vb0 + SHM_V, pa0, pa1, pa2, pa3);
    l_out = l_reg; m_out = m_reg;
#undef SLOAD
#undef SWRITE
#undef SWAIT
#undef RESC
}
__device__ __forceinline__ void normalise(f32x16 (&o)[4], float l_reg, char* lds) {
    const int tid = fresh_tid(), wid = tid >> 6, lane = tid & 63, r32 = lane & 31, hi = lane >> 5;
    float* li_l = (float*)(lds + OFF_WS) + wid * 64;
    if (hi == 0) li_l[r32] = l_reg; asm volatile("s_waitcnt lgkmcnt(0)" ::: "memory");
#pragma unroll
    for (int r = 0; r < 16; ++r) { const float rl = __builtin_amdgcn_rcpf(li_l[crow(r, hi)]);
#pragma unroll
        for (int d0 = 0; d0 < 4; ++d0) o[d0][r] *= rl; }
    asm volatile("s_waitcnt lgkmcnt(0)" ::: "memory");
}
__device__ __forceinline__ void store_o(const f32x16 (&o)[4], bf16_t* Ob) {
    const int tid = fresh_tid(), wid = tid >> 6, lane = tid & 63, r32 = lane & 31, hi = lane >> 5;
    __hip_bfloat16* Ow = (__hip_bfloat16*)Ob + (long)(wid * QBLK) * LDO;
#pragma unroll
    for (int r = 0; r < 16; ++r) { const int orow = crow(r, hi);
#pragma unroll
        for (int d0 = 0; d0 < 4; ++d0) Ow[(long)orow * LDO + d0 * 32 + r32] = __float2bfloat16(o[d0][r]); }
}
__device__ __forceinline__ void store_o8(const f32x16 (&o)[4], unsigned char* Ob8) {
    const int tid = fresh_tid(), wid = tid >> 6, lane = tid & 63, r32 = lane & 31, hi = lane >> 5;
    unsigned char* Ow = Ob8 + (long)(wid * QBLK) * LDO;
#pragma unroll
    for (int r = 0; r < 16; r += 2) { const int orow = crow(r, hi);
#pragma unroll
        for (int d0 = 0; d0 < 4; ++d0) { const int w = __builtin_amdgcn_cvt_pk_fp8_f32(clamp8(o[d0][r] * S_A8), clamp8(o[d0][r + 1] * S_A8), 0, false);
            Ow[(long)orow * LDO + d0 * 32 + r32] = (unsigned char)(w & 0xff); Ow[(long)(orow + 1) * LDO + d0 * 32 + r32] = (unsigned char)((w >> 8) & 0xff); } }
}
template <int MODE>
__device__ __forceinline__ void unit_std(const bf16_t* Qb, const bf16_t* Kh, const bf16_t* Vh, const TileMap tm, const MaskInfo mi, float sink, bf16_t* Ob, char* lds) {
    f32x16 o[4]; float l, m;
    const float C = ATT_SCALE * LOG2E;
    attn_core<MODE, 0, 8, (MODE == 0 ? STD_SD : 1), (MODE != 0)>(Qb, Kh, Vh, tm, mi, C, THR / ATT_SCALE, lds, o, l, m);
    if constexpr (MODE == 1) l += __builtin_amdgcn_exp2f(sink * LOG2E - m * C);
    normalise(o, l, lds);
    if constexpr (MODE != 0 && L1ATT_FP8) store_o8(o, (unsigned char*)Ob); else store_o(o, Ob);
    __syncthreads();
}
__device__ __forceinline__ void unit_diff(const bf16_t* Qb, const bf16_t* Kh, const bf16_t* Vh, const TileMap tm, float lam, const float* subln_g, bf16_t* Ob, char* lds) {
    const int tid = fresh_tid(), lane = tid & 63, r32 = lane & 31;
    f32x16 o[4]; float l, m; const MaskInfo mi{0, 0, 0};
    const float C = A_SCALE * LOG2E;
    unsigned* stash = (unsigned*)(lds + OFF_STASH);
    attn_core<0, 0, 4, DIFF_SD>(Qb, Kh, Vh, tm, mi, C, THR / A_SCALE, lds, o, l, m);
    normalise(o, l, lds);
#pragma unroll
    for (int d0 = 0; d0 < 4; ++d0)
#pragma unroll
        for (int r = 0; r < 16; r += 2) stash[(d0 * 8 + (r >> 1)) * 512 + tid] = cvt_pk_bf16(o[d0][r], o[d0][r + 1]);
    __syncthreads();
    attn_core<0, 4, 8, DIFF_SD>(Qb, Kh, Vh, tm, mi, C, THR / A_SCALE, lds, o, l, m);
    normalise(o, l, lds);
    float ss[16];
#pragma unroll
    for (int r = 0; r < 16; ++r) ss[r] = 0.f;
#pragma unroll
    for (int d0 = 0; d0 < 4; ++d0)
#pragma unroll
        for (int r = 0; r < 16; r += 2) { const unsigned w = stash[(d0 * 8 + (r >> 1)) * 512 + tid];
            const float a = bf_lo(w) - lam * o[d0][r], b = bf_hi(w) - lam * o[d0][r + 1];
            o[d0][r] = a; o[d0][r + 1] = b; ss[r] += a * a; ss[r + 1] += b * b; }
#pragma unroll
    for (int r = 0; r < 16; ++r) {
#pragma unroll
        for (int x = 1; x < 32; x <<= 1) ss[r] += __shfl_xor(ss[r], x);
        ss[r] = (1.0f - LAMBDA_INIT) / sqrtf(ss[r] * (1.0f / 128.0f) + EPS); }
    float gg[4];
#pragma unroll
    for (int d0 = 0; d0 < 4; ++d0) gg[d0] = subln_g[d0 * 32 + r32];
#pragma unroll
    for (int d0 = 0; d0 < 4; ++d0)
#pragma unroll
        for (int r = 0; r < 16; ++r) o[d0][r] *= ss[r] * gg[d0];
    store_o(o, Ob);
    __syncthreads();
}
#undef SBAR
}

#define XB_TMO      128
#define XB_XCNT(j)  (256  + 64 * (j))
#define XB_XSUB(j)  (1280 + 64 * (j))
#define XB_XGEN(j)  (2304 + 64 * (j))
#define XB_TOP      3328
#define XB_TOPGEN   3392
#define XCD_BAR_WORDS 3456
#define XB_SPIN_CAP (1u << 22)
__device__ __forceinline__ unsigned xb_ld(unsigned* p)              { return __hip_atomic_load(p, __ATOMIC_RELAXED, __HIP_MEMORY_SCOPE_AGENT); }
__device__ __forceinline__ unsigned xb_add(unsigned* p, unsigned v) { return __hip_atomic_fetch_add(p, v, __ATOMIC_RELAXED, __HIP_MEMORY_SCOPE_AGENT); }
__device__ __forceinline__ unsigned xb_xcc_id() { return (unsigned)__builtin_amdgcn_s_getreg((3 << 11) | 20) & 0xFu; }
#define XB_SPIN(cond, bar) do { unsigned _sp = 0; while (cond) { __builtin_amdgcn_s_sleep(1); \
    if ((++_sp & 255u) == 0u) { if (xb_ld(&(bar)[XB_TMO])) break; if (_sp > XB_SPIN_CAP) { atomicAdd(&(bar)[XB_TMO], 1u); break; } } } } while (0)
struct XcdBarrier { unsigned* bar; unsigned x; volatile LAS unsigned* st; };
__device__ __forceinline__ XcdBarrier xcd_barrier_post(unsigned* bar, volatile LAS unsigned* st) {
    XcdBarrier b; b.bar = bar; b.x = xb_xcc_id(); b.st = st;
    if (threadIdx.x == 0) (void)xb_add(&bar[XB_XCNT(b.x)], 1u);
    return b;
}
__device__ __forceinline__ void xcd_barrier_complete(unsigned* bar, unsigned x, unsigned& nloc, unsigned& nx) {
    const unsigned G = gridDim.x * gridDim.y * gridDim.z;
    unsigned sum, cnt, mine, sp = 0u;
    for (;;) {
        sum = 0u; cnt = 0u; mine = 0u;
#pragma unroll
        for (unsigned j = 0; j < 16; ++j) { const unsigned c = xb_ld(&bar[XB_XCNT(j)]); sum += c; cnt += (c > 0u) ? 1u : 0u; mine = (j == x) ? c : mine; }
        if (sum == G) break;
        __builtin_amdgcn_s_sleep(1);
        if ((++sp & 255u) == 0u) { if (xb_ld(&bar[XB_TMO])) break; if (sp > XB_SPIN_CAP) { atomicAdd(&bar[XB_TMO], 1u); break; } }
    }
    nloc = mine > 0u ? mine : 1u; nx = cnt > 0u ? cnt : 1u;
}
__device__ __forceinline__ void xcd_barrier(const XcdBarrier& b) {
    asm volatile("s_waitcnt vmcnt(0)" ::: "memory");
    __syncthreads();
    if (threadIdx.x == 0) {
        unsigned* bar = b.bar;
        __builtin_amdgcn_s_waitcnt(0);
        unsigned nloc = b.st[0], nx = b.st[1];
        if (nloc == 0u) { xcd_barrier_complete(bar, b.x, nloc, nx); b.st[0] = nloc; b.st[1] = nx; }
        const unsigned old = xb_add(&bar[XB_XSUB(b.x)], 1u);
        const unsigned gen = old / nloc;
        if (old + 1u == (gen + 1u) * nloc) {
            __builtin_amdgcn_fence(__ATOMIC_RELEASE, "agent");
            asm volatile("s_waitcnt vmcnt(0)" ::: "memory");
            const unsigned og = xb_add(&bar[XB_TOP], 1u);
            const unsigned tg = og / nx;
            if (og + 1u == (tg + 1u) * nx) xb_add(&bar[XB_TOPGEN], 1u);
            else XB_SPIN(xb_ld(&bar[XB_TOPGEN]) == tg, bar);
            __builtin_amdgcn_fence(__ATOMIC_ACQUIRE, "agent");
            xb_add(&bar[XB_XGEN(b.x)], 1u);
            asm volatile("s_waitcnt vmcnt(0)" ::: "memory");
        } else {
            XB_SPIN(xb_ld(&bar[XB_XGEN(b.x)]) == gen, bar);
            __builtin_amdgcn_fence(__ATOMIC_ACQUIRE, "agent");
            asm volatile("s_waitcnt vmcnt(0)" ::: "memory");
        }
    }
    __syncthreads();
}

struct Args { const float* in[33]; float* out; unsigned char* ws; int ph_lo, ph_hi; };
struct Frame {
    LAS unsigned char* lds; int vcu, G;
};

__device__ __forceinline__ void transpose_item(const float* W, int ldw, int K, bf16_t* WT, int k0, int n0, long dst_row0, LAS float* scr, int lane) {
    { float tv[32]; const float* wp = W + (size_t)(k0 + (lane >> 5)) * ldw + n0 + (lane & 31);
#pragma unroll
      for (int i = 0; i < 32; ++i) tv[i] = wp[(size_t)(2 * i) * ldw];
#pragma unroll
      for (int i = 0; i < 32; ++i) scr[(2 * i + (lane >> 5)) * 33 + (lane & 31)] = tv[i]; }
    LDS_WAIT(); asm volatile("" ::: "memory");
    const int c = lane & 7;
#pragma unroll
    for (int j = 0; j < 4; ++j) { const int n = (lane >> 3) + 8 * j; const LAS float* s = scr + (8 * c) * 33 + n;
        u32x4 o; o.x = cvt_pk_bf16(s[0 * 33], s[1 * 33]); o.y = cvt_pk_bf16(s[2 * 33], s[3 * 33]); o.z = cvt_pk_bf16(s[4 * 33], s[5 * 33]); o.w = cvt_pk_bf16(s[6 * 33], s[7 * 33]);
        *(GAS u32x4*)(WT + (size_t)(dst_row0 + n) * K + k0 + 8 * c) = o; }
    LDS_WAIT(); asm volatile("" ::: "memory");
}
__device__ __forceinline__ void transpose_item8(const float* W, int ldw, int K, unsigned char* WT, int k0, int n0, long dst_row0, LAS float* scr, int lane, float scale) {
#pragma unroll
    for (int hb = 0; hb < 2; ++hb) { float tv[32]; const float* wp = W + (size_t)(k0 + 64 * hb + (lane >> 5)) * ldw + n0 + (lane & 31);
#pragma unroll
        for (int i = 0; i < 32; ++i) tv[i] = wp[(size_t)(2 * i) * ldw];
#pragma unroll
        for (int i = 0; i < 32; ++i) { const int kk = 64 * hb + 2 * i + (lane >> 5); scr[kk * 32 + (((lane & 31) + 8 * (kk >> 4)) & 31)] = tv[i]; } }
    LDS_WAIT(); asm volatile("" ::: "memory");
    const int c = lane & 7;
#pragma unroll
    for (int j = 0; j < 4; ++j) { const int n = (lane >> 3) + 8 * j; const LAS float* s = scr + (16 * c) * 32 + ((n + 8 * c) & 31);
        u32x4 o;
        o.x = pk4_fp8(s[0 * 32] * scale, s[1 * 32] * scale, s[2 * 32] * scale, s[3 * 32] * scale); o.y = pk4_fp8(s[4 * 32] * scale, s[5 * 32] * scale, s[6 * 32] * scale, s[7 * 32] * scale);
        o.z = pk4_fp8(s[8 * 32] * scale, s[9 * 32] * scale, s[10 * 32] * scale, s[11 * 32] * scale); o.w = pk4_fp8(s[12 * 32] * scale, s[13 * 32] * scale, s[14 * 32] * scale, s[15 * 32] * scale);
        *(GAS u32x4*)(WT + (size_t)(dst_row0 + n) * K + k0 + 16 * c) = o; }
    LDS_WAIT(); asm volatile("" ::: "memory");
}
__device__ __forceinline__ void tr_plain8(const float* W, int K, int N, unsigned char* WT, long row_off, LAS float* scr, int item, int lane) {
    const int nblk = N / 32, kb = item / nblk, nb = item % nblk;
    transpose_item8(W, N, K, WT, 128 * kb, 32 * nb, row_off + 32 * nb, scr, lane, S_W8);
}
__device__ __forceinline__ void tr_gu8(const float* W, int K, int N, unsigned char* WT, long row_off, int up, LAS float* scr, int item, int lane) {
    const int nblk = N / 32, kb = item / nblk, nb = item % nblk, n0 = 32 * nb;
    transpose_item8(W, N, K, WT, 128 * kb, n0, row_off + (long)(n0 >> 7) * 256 + (n0 & 127) + up * 128, scr, lane, S_W8);
}
__device__ __forceinline__ void tr_plain(const float* W, int K, int N, bf16_t* WT, long row_off, LAS float* scr, int item, int lane) {
    const int nblk = N / 32, kb = item / nblk, nb = item % nblk;
    transpose_item(W, N, K, WT, 64 * kb, 32 * nb, row_off + 32 * nb, scr, lane);
}
__device__ __forceinline__ void tr_gu(const float* W, int K, int N, bf16_t* WT, long row_off, int up, LAS float* scr, int item, int lane) {
    const int nblk = N / 32, kb = item / nblk, nb = item % nblk, n0 = 32 * nb;
    transpose_item(W, N, K, WT, 64 * kb, n0, row_off + (long)(n0 >> 7) * 256 + (n0 & 127) + up * 128, scr, lane);
}

template <bool OUT8 = false>
__device__ __forceinline__ void mod_row(const float* xrow, const float* g, const float* sh, const float* sc, bf16_t* orow, int lane, f32x4 (&v)[8], const float* xs = nullptr, size_t xs_stride = 0, int nxs = 0, float* xout = nullptr) {
    const f32x4* xr = (const f32x4*)xrow + lane;
    float s = 0.f;
#pragma unroll
    for (int j = 0; j < 8; ++j) { v[j] = xr[64 * j];
        if (xs) {
#pragma unroll
            for (int p = 0; p < 8; ++p) if (p < nxs) v[j] += ((const f32x4*)(xs + p * xs_stride))[64 * j + lane];
            if (xout) ((f32x4*)xout)[64 * j + lane] = v[j]; }
        s += (v[j].x * v[j].x + v[j].y * v[j].y) + (v[j].z * v[j].z + v[j].w * v[j].w); }
    const float rstd = 1.0f / sqrtf(wave_sum(s) * (1.0f / DM) + EPS);
    u32x2* o8 = (u32x2*)orow + lane;
#pragma unroll
    for (int j = 0; j < 8; ++j) { const f32x4 gg = ((const f32x4*)g)[64 * j + lane], ss = ((const f32x4*)sc)[64 * j + lane], hh = ((const f32x4*)sh)[64 * j + lane];
        v[j] = v[j] * rstd * gg * (ss + 1.0f) + hh;
        if constexpr (OUT8) ((unsigned*)orow)[64 * j + lane] = pk4_fp8(v[j].x * S_H8, v[j].y * S_H8, v[j].z * S_H8, v[j].w * S_H8);
        else { u32x2 w; w.x = cvt_pk_bf16(v[j].x, v[j].y); w.y = cvt_pk_bf16(v[j].z, v[j].w); o8[64 * j] = w; } }
}
__device__ __forceinline__ const float* in_row(const float* x, const float* ctx, int row) {
    const int b = row / RPB, t = row % RPB;
    return t < SEQ ? x + ((size_t)b * SEQ + t) * DM : ctx + ((size_t)b * NCTX + (t - SEQ)) * DM;
}

__device__ __forceinline__ void rope8(float (&f)[8], const float* cs, const float* sn) {
    const f32x4 c = *(const f32x4*)cs, s = *(const f32x4*)sn;
#pragma unroll
    for (int p = 0; p < 4; ++p) { const float x0 = f[2 * p], x1 = f[2 * p + 1]; f[2 * p] = x0 * c[p] - x1 * s[p]; f[2 * p + 1] = x0 * s[p] + x1 * c[p]; }
}
__device__ __forceinline__ void unpack8(const u32x4 w, float (&f)[8]) { f[0] = bf_lo(w.x); f[1] = bf_hi(w.x); f[2] = bf_lo(w.y); f[3] = bf_hi(w.y); f[4] = bf_lo(w.z); f[5] = bf_hi(w.z); f[6] = bf_lo(w.w); f[7] = bf_hi(w.w); }
__device__ __forceinline__ u32x4 pack8(const float (&f)[8]) { u32x4 w; w.x = cvt_pk_bf16(f[0], f[1]); w.y = cvt_pk_bf16(f[2], f[3]); w.z = cvt_pk_bf16(f[4], f[5]); w.w = cvt_pk_bf16(f[6], f[7]); return w; }
template <bool NORM, int ROPE_DIM>
__device__ __forceinline__ void fix_span(bf16_t* rowp, int col0, int nvec, const float* g, const float* cosT, const float* sinT, int lane) {
    for (int v = lane; v < nvec; v += 64) {
        const int e0 = v * 8;
        u32x4 w = *(u32x4*)(rowp + col0 + e0); float f[8]; unpack8(w, f);
        if constexpr (NORM) {
            float s = 0.f;
#pragma unroll
            for (int i = 0; i < 8; ++i) s += f[i] * f[i];
            s += __shfl_xor(s, 1); s += __shfl_xor(s, 2); s += __shfl_xor(s, 4); s += __shfl_xor(s, 8);
            const float rstd = 1.0f / sqrtf(s * (1.0f / 128.0f) + EPS);
            const f32x4 g0 = *(const f32x4*)(g + (e0 & 127)), g1 = *(const f32x4*)(g + (e0 & 127) + 4);
#pragma unroll
            for (int i = 0; i < 4; ++i) { f[i] = f[i] * rstd * g0[i]; f[4 + i] = f[4 + i] * rstd * g1[i]; }
        }
        if constexpr (ROPE_DIM == 64) { const int p0 = (e0 & 63) >> 1; rope8(f, cosT + p0, sinT + p0); }
        if constexpr (ROPE_DIM == 128) { const int p0 = (e0 & 127) >> 1; rope8(f, cosT + p0, sinT + p0); }
        *(u32x4*)(rowp + col0 + e0) = pack8(f);
    }
}

__global__ void __launch_bounds__(512, 2) hybrid_fwd(Args args) {
    extern __shared__ __attribute__((aligned(16))) unsigned char lds[];
    Frame F;
    F.lds = (LAS unsigned char*)lds;
    F.G = gridDim.x; { const int bx = blockIdx.x; F.vcu = (F.G % 8 == 0) ? (bx % 8) * (F.G / 8) + bx / 8 : bx; }
    volatile LAS unsigned* MISC = (volatile LAS unsigned*)(F.lds + MISC_OFF);
    unsigned char* ws = args.ws;
    gu32* ctl = (gu32*)(ws + WS_CTL);
    for (int u = threadIdx.x; u < 64; u += 512) MISC[u] = 0u;
    __syncthreads();
    XcdBarrier bar; bar.bar = (unsigned*)(ctl + CW_BAR); bar.x = 0; bar.st = nullptr;
#if !MK_PER_PHASE
    bar = xcd_barrier_post((unsigned*)(ctl + CW_BAR), MISC + 8);
#define GRID_BAR() xcd_barrier(bar)
#else
#define GRID_BAR() do { } while (0)
#endif
    const int lo = args.ph_lo, hi = args.ph_hi;
#ifndef PH_MASK
#define PH_MASK 0xFFFFFu
#endif
#define IN(k) ((((PH_MASK) >> (k)) & 1u) && lo <= (k) && (k) < hi)
#ifndef DBL_MASK
#define DBL_MASK 0u
#endif
#define NREP(k) ((((DBL_MASK) >> (k)) & 1u) ? 2 : 1)
#define SEAM(k) do { if (IN(k) && IN((k) + 1)) GRID_BAR(); } while (0)

#define MODS ((float*)(ws + WS_MODS))
#define ADAP ((float*)(ws + WS_ADAP))
#define cosA ((float*)(ws + WS_ROPE))
#define sinA (cosA + 4096 * 32)
#define cosB (cosA + 2 * 4096 * 32)
#define sinB (cosA + 2 * 4096 * 32 + 4096 * 64)
#define ROUTE ((int*)(ws + WS_ROUTE))
#define GATES ((float*)(ws + WS_GATES))
#define SLOT ((int*)(ws + WS_SLOT))
#define CNT ((int*)(ws + WS_CNT))
#define TILEE ((int*)(ws + WS_TILEE))
#define W_IN0 ((bf16_t*)(ws + WS_WIN0))
#define W_OUT0 ((bf16_t*)(ws + WS_WOUT0))
#define W_GU0 ((bf16_t*)(ws + WS_WGU0))
#define W_DN0 ((bf16_t*)(ws + WS_WDN0))
#define W_IN1 ((bf16_t*)(ws + WS_WIN1))
#define W_OUT1 ((bf16_t*)(ws + WS_WOUT1))
#define W_GU1 ((bf16_t*)(ws + WS_WGU1))
#define W_DN1 ((bf16_t*)(ws + WS_WDN1))
#define XR ((float*)(ws + WS_XR))
#define H ((bf16_t*)(ws + WS_H))
#define AO ((bf16_t*)(ws + WS_AO))
#define Y ((bf16_t*)(ws + WS_Y))
#define QKV ((bf16_t*)(ws + WS_QKV))
#define XG ((bf16_t*)(ws + WS_XG))
#define MID ((bf16_t*)(ws + WS_MID))
#define MODS1 (MODS + 5 * 12288)
#define SLAB0 ((float*)(ws + WS_SLAB0))
#define SLAB1 ((float*)(ws + WS_SLAB1))
#define SLABW ((float*)(ws + WS_SLABW))
#define x_in (args.in[0])
#define c_in (args.in[1])
#define ctx_in (args.in[2])
#define cctx_in (args.in[3])
    const int NGW = F.G * 8;
#define PH_LOCALS const int tid = fresh_tid(), lane = tid & 63, wave = __builtin_amdgcn_readfirstlane(tid >> 6), gw = F.vcu * 8 + wave; (void)tid; (void)lane; (void)wave; (void)gw

    if (IN(0)) for (int rep_ = 0; rep_ < NREP(0); ++rep_) {
        PH_LOCALS;
        LAS float* scr = (LAS float*)(F.lds + wave * 16384);
        LAS float* sil = (LAS float*)(F.lds + 98304);
        __syncthreads();
        for (int i = tid; i < 5 * DM; i += 512) { const float v = (i < 4 * DM) ? c_in[i] : cctx_in[i - 4 * DM]; sil[i] = v / (1.0f + __expf(-v)); }
        __syncthreads();
        for (int it = gw; it < 2 * 48 * 32; it += NGW) {
            const int l = it / (48 * 32), r = it % (48 * 32), cg = r / 32, kc = r % 32;
            const float* W = args.in[l ? 22 : 6] + (size_t)(kc * 64) * 12288 + cg * 256 + lane * 4;
            f32x4 a[5];
#pragma unroll
            for (int b = 0; b < 5; ++b) a[b] = (f32x4){0.f, 0.f, 0.f, 0.f};
#pragma unroll 8
            for (int k = 0; k < 64; ++k) { const f32x4 w = *(const f32x4*)(W + (size_t)k * 12288);
#pragma unroll
                for (int b = 0; b < 5; ++b) a[b] += w * sil[b * DM + kc * 64 + k]; }
#pragma unroll
            for (int b = 0; b < 5; ++b) *(f32x4*)(ADAP + ((size_t)(l * 32 + kc) * 5 + b) * 12288 + cg * 256 + lane * 4) = a[b];
        }
        __syncthreads();
        {
            constexpr int I_IN = (DM / 64) * (PROJ / 32), I_OUT = (DM / 64) * (DM / 32);
            constexpr int I_GU = (FFN0_FP8 == 2) ? (DM / 128) * (DFF / 32) : (DM / 64) * (DFF / 32), I_DN = (FFN0_FP8 >= 1) ? (DFF / 128) * (DM / 32) : (DFF / 64) * (DM / 32);
            constexpr int I_EGU = (DM / 128) * (DEX / 32), I_EDN = (DEX / 128) * (DM / 32);
            constexpr int I_IN8 = (DM / 128) * (PROJ / 32), I_OUT8 = (DM / 128) * (DM / 32);
            constexpr int NIT = I_IN + (L1ATT_FP8 ? I_IN8 : I_IN) + I_OUT + (L1ATT_FP8 ? I_OUT8 : I_OUT) + 2 * I_GU + I_DN;
            for (int it = gw; it < NIT; it += NGW) {
                int r = it;
                if (r < I_IN) { tr_plain(args.in[8], DM, PROJ, W_IN0, 0, scr, r, lane); continue; } r -= I_IN;
#if L1ATT_FP8
                if (r < I_IN8) { tr_plain8(args.in[24], DM, PROJ, (unsigned char*)W_IN1, 0, scr, r, lane); continue; } r -= I_IN8;
#else
                if (r < I_IN) { tr_plain(args.in[24], DM, PROJ, W_IN1, 0, scr, r, lane); continue; } r -= I_IN;
#endif
                if (r < I_OUT) { tr_plain(args.in[9], DM, DM, W_OUT0, 0, scr, r, lane); continue; } r -= I_OUT;
#if L1ATT_FP8
                if (r < I_OUT8) { tr_plain8(args.in[25], DM, DM, (unsigned char*)W_OUT1, 0, scr, r, lane); continue; } r -= I_OUT8;
#else
                if (r < I_OUT) { tr_plain(args.in[25], DM, DM, W_OUT1, 0, scr, r, lane); continue; } r -= I_OUT;
#endif
#if FFN0_FP8 == 2
                if (r < I_GU) { tr_gu8(args.in[17], DM, DFF, (unsigned char*)W_GU0, 0, 0, scr, r, lane); continue; } r -= I_GU;
                if (r < I_GU) { tr_gu8(args.in[18], DM, DFF, (unsigned char*)W_GU0, 0, 1, scr, r, lane); continue; } r -= I_GU;
#else
                if (r < I_GU) { tr_gu(args.in[17], DM, DFF, W_GU0, 0, 0, scr, r, lane); continue; } r -= I_GU;
                if (r < I_GU) { tr_gu(args.in[18], DM, DFF, W_GU0, 0, 1, scr, r, lane); continue; } r -= I_GU;
#endif
#if FFN0_FP8 >= 1
                if (r < I_DN) { tr_plain8(args.in[19], DFF, DM, (unsigned char*)W_DN0, 0, scr, r, lane); continue; } r -= I_DN;
#else
                if (r < I_DN) { tr_plain(args.in[19], DFF, DM, W_DN0, 0, scr, r, lane); continue; } r -= I_DN;
#endif
            }
            constexpr int NITX = NE * (2 * I_EGU + I_EDN);
            const float* wp; int ldw; unsigned char* wt; int Kb;
#define XDECODE(IT, WP, LDW, WT, KB) do { int r_ = (IT); const int e_ = r_ / (2 * I_EGU + I_EDN); r_ -= e_ * (2 * I_EGU + I_EDN); \
                if (r_ < 2 * I_EGU) { const int up_ = r_ >= I_EGU; r_ -= up_ * I_EGU; const int nblk_ = DEX / 32, kb_ = r_ / nblk_, n0_ = 32 * (r_ % nblk_); \
                    WP = args.in[29 + up_] + (size_t)e_ * DM * DEX + (size_t)(128 * kb_ + (lane >> 5)) * DEX + n0_ + (lane & 31); LDW = DEX; KB = DM; \
                    WT = (unsigned char*)W_GU1 + ((size_t)e_ * 2 * DEX + (size_t)(n0_ >> 7) * 256 + (n0_ & 127) + up_ * 128) * DM + 128 * kb_; } \
                else { r_ -= 2 * I_EGU; const int nblk_ = DM / 32, kb_ = r_ / nblk_, n0_ = 32 * (r_ % nblk_); \
                    WP = args.in[31] + (size_t)e_ * DEX * DM + (size_t)(128 * kb_ + (lane >> 5)) * DM + n0_ + (lane & 31); LDW = DM; KB = DEX; \
                    WT = (unsigned char*)W_DN1 + ((size_t)e_ * DM + n0_) * DEX + 128 * kb_; } } while (0)
#define XLOAD(T, WP, LDW, HB) do { _Pragma("unroll") for (int i_ = 0; i_ < 32; ++i_) T[i_] = (WP)[(size_t)(64 * (HB) + 2 * i_) * (LDW)]; } while (0)
#define XWRITE(T, HB) do { _Pragma("unroll") for (int i_ = 0; i_ < 32; ++i_) { const int kk_ = 64 * (HB) + 2 * i_ + (lane >> 5); scr[kk_ * 32 + (((lane & 31) + 8 * (kk_ >> 4)) & 31)] = T[i_]; } } while (0)
            float ta[32], tb[32];
            int itx = gw;
            if (itx < NITX) { XDECODE(itx, wp, ldw, wt, Kb); XLOAD(ta, wp, ldw, 0); }
            while (itx < NITX) {
                XLOAD(tb, wp, ldw, 1);
                XWRITE(ta, 0);
                unsigned char* wt_c = wt; const int Kb_c = Kb;
                const int nxt = itx + NGW;
                if (nxt < NITX) { XDECODE(nxt, wp, ldw, wt, Kb); XLOAD(ta, wp, ldw, 0); }
                XWRITE(tb, 1);
                LDS_WAIT(); asm volatile("" ::: "memory");
                { const int c = lane & 7;
#pragma unroll
                  for (int j = 0; j < 4; ++j) { const int n = (lane >> 3) + 8 * j; const LAS float* sp = scr + (16 * c) * 32 + ((n + 8 * c) & 31);
                      u32x4 o;
                      o.x = pk4_fp8(sp[0 * 32] * S_W8, sp[1 * 32] * S_W8, sp[2 * 32] * S_W8, sp[3 * 32] * S_W8); o.y = pk4_fp8(sp[4 * 32] * S_W8, sp[5 * 32] * S_W8, sp[6 * 32] * S_W8, sp[7 * 32] * S_W8);
                      o.z = pk4_fp8(sp[8 * 32] * S_W8, sp[9 * 32] * S_W8, sp[10 * 32] * S_W8, sp[11 * 32] * S_W8); o.w = pk4_fp8(sp[12 * 32] * S_W8, sp[13 * 32] * S_W8, sp[14 * 32] * S_W8, sp[15 * 32] * S_W8);
                      *(GAS u32x4*)(wt_c + (size_t)n * Kb_c + 16 * c) = o; } }
                LDS_WAIT(); asm volatile("" ::: "memory");
                itx = nxt;
            }
#undef XDECODE
#undef XLOAD
#undef XWRITE
        }
    }
    SEAM(0);
    if (IN(1)) for (int rep_ = 0; rep_ < NREP(1); ++rep_) {
        PH_LOCALS;
        for (int i = blockIdx.x * 512 + tid; i < 2 * 5 * 12288; i += F.G * 512) {
            const int l = i / (5 * 12288), r = i % (5 * 12288), b = r / 12288, j = r % 12288;
            float s = args.in[l ? 23 : 7][j];
            for (int kc = 0; kc < 32; ++kc) s += ADAP[((size_t)(l * 32 + kc) * 5 + b) * 12288 + j];
            MODS[i] = s;
        }
        if (blockIdx.x == 0 && wave == 0) {
            const float a = wave_sum(args.in[10][lane] * args.in[11][lane]), b = wave_sum(args.in[12][lane] * args.in[13][lane]);
            if (lane == 0) MODS[2 * 5 * 12288] = expf(a) - expf(b) + LAMBDA_INIT;
        }
    }
    SEAM(1);
    if (IN(2)) for (int rep_ = 0; rep_ < NREP(2); ++rep_) {
        PH_LOCALS;
        for (int row = gw; row < MROWS; row += NGW) {
            const int b = row / RPB, t = row % RPB; const float* md = MODS + (size_t)(t < SEQ ? b : 4) * 12288;
            f32x4 v[8]; mod_row(in_row(x_in, ctx_in, row), args.in[4], md + 0 * DM, md + 1 * DM, H + (size_t)row * DM, lane, v);
        }
    }
    SEAM(2);
    if (IN(3)) for (int rep_ = 0; rep_ < NREP(3); ++rep_) {
        PH_LOCALS;
        pg8::Gemm g{H, W_IN0, DM}; pg8::Order<pg8::MapId> S; S.init(MROWS / 256, PROJ / 256, F.G, (int)blockIdx.x, pg8::MapId{}, DM / 64);
        { LAS float* gl = (LAS float*)(F.lds + RING_BYTES) + 2048; if (tid < 256) gl[tid] = tid < 128 ? args.in[15][tid] : args.in[16][tid - 128]; __syncthreads(); }
        pg8::EpiQKV<0> E{QKV, cosA, sinA, cosB, sinB, args.in[15], args.in[16], (LAS float*)(F.lds + RING_BYTES), 1.0f};
        pg8::gemm_phase(F.lds, g, S, E);
    }
    SEAM(3);
    if (IN(5)) for (int rep_ = 0; rep_ < NREP(5); ++rep_) {
        PH_LOCALS;
        const float lam = MODS[2 * 5 * 12288];
        for (int k = F.vcu; k < 256; k += F.G) {
            for (int i = 0; i < 3; ++i) {
                int b, h, qt;
                if (i < 2) { const int u = 2 * k + i; b = u >> 7; h = (u >> 4) & 7; qt = u & 15; } else { if (k >= 32) break; b = k >> 3; h = k & 7; qt = 16; }
                const size_t rb = (size_t)b * RPB;
                const att::TileMap tm = (qt < 16) ? att::TileMap{0, 0, 0, 68} : att::TileMap{0, 0, SEQ, 4};
#ifndef NO_DIFF
                att::unit_diff(QKV + (rb + qt * 256) * PROJ + h * 128, QKV + rb * PROJ + 2048 + h * 128, QKV + rb * PROJ + 3072 + h * 128, tm, lam, args.in[14],
                               AO + (rb + qt * 256) * DM + h * 128, (char*)lds);
#endif
            }
            for (int i = 0; i < 3; ++i) {
                int b, h, qt;
                if (i < 2) { const int u = 2 * k + i; b = u >> 7; h = (u >> 4) & 7; qt = u & 15; } else { if (k < 32 || k >= 64) break; b = (k - 32) >> 3; h = k & 7; qt = 16; }
                const size_t rb = (size_t)b * RPB; const int kv = h >> 2;
                const att::TileMap tm = (qt < 16) ? att::TileMap{0, 0, 0, 68} : att::TileMap{0, 0, SEQ, 4};
#ifndef NO_STD0
                att::unit_std<0>(QKV + (rb + qt * 256) * PROJ + 1024 + h * 128, QKV + rb * PROJ + 4096 + kv * 128, QKV + rb * PROJ + 4352 + kv * 128, tm, att::MaskInfo{0, 0, 0}, 0.f,
                                 AO + (rb + qt * 256) * DM + 1024 + h * 128, (char*)lds);
#endif
            }
        }
    }
    SEAM(5);
    if (IN(6)) for (int rep_ = 0; rep_ < NREP(6); ++rep_) {
        PH_LOCALS;
        pg8::Gemm g{AO, W_OUT0, DM}; pg8::Order<pg8::MapL0Split> S; S.init(NTOK / 256, DM / 256, F.G, (int)blockIdx.x, pg8::MapL0Split{}, DM / 64, 4, 8);
        pg8::EpiResid E{x_in, ctx_in, XR, MODS, 2, 1, SLABW, 1.0f};
        pg8::gemm_phase<pg8::EpiResid, pg8::Order<pg8::MapL0Split>>(F.lds, g, S, E);
    }
    SEAM(6);
    if (IN(7)) for (int rep_ = 0; rep_ < NREP(7); ++rep_) {
        PH_LOCALS;
        for (int row = gw; row < MROWS; row += NGW) {
            const int b = row / RPB, t = row % RPB; const float* md = MODS + (size_t)(t < SEQ ? b : 4) * 12288;
#if FFN0_FP8 == 2
            f32x4 v[8]; mod_row<true>(t < SEQ ? XR + (size_t)row * DM : in_row(x_in, ctx_in, row), args.in[5], md + 3 * DM, md + 4 * DM, (bf16_t*)((unsigned char*)H + (size_t)row * DM), lane, v,
                                      t < SEQ ? nullptr : SLABW + ((size_t)b * NCTX + (t - SEQ)) * DM, (size_t)NB * NCTX * DM, 8, XR + (size_t)row * DM);
#else
            f32x4 v[8]; mod_row(t < SEQ ? XR + (size_t)row * DM : in_row(x_in, ctx_in, row), args.in[5], md + 3 * DM, md + 4 * DM, H + (size_t)row * DM, lane, v,
                                t < SEQ ? nullptr : SLABW + ((size_t)b * NCTX + (t - SEQ)) * DM, (size_t)NB * NCTX * DM, 8, XR + (size_t)row * DM);
#endif
        }
    }
    SEAM(7);
    if (IN(8)) for (int rep_ = 0; rep_ < NREP(8); ++rep_) {
        PH_LOCALS;
#if FFN0_FP8 == 2
        pg8::Gemm g{H, W_GU0, DM / 2}; pg8::Order<pg8::MapId> S; S.init(MROWS / 256, 2 * DFF / 256, F.G, (int)blockIdx.x, pg8::MapId{}, DM / 128);
        pg8::EpiSwiGLU8 E{(unsigned char*)MID, DFF, 2 * DFF / 256, 1.0f / (S_H8 * S_W8), S_M8 / (S_H8 * S_W8)};
        pg8::gemm_phase<pg8::EpiSwiGLU8, pg8::Order<pg8::MapId>, true>(F.lds, g, S, E);
#elif FFN0_FP8 == 1
        pg8::Gemm g{H, W_GU0, DM}; pg8::Order<pg8::MapId> S; S.init(MROWS / 256, 2 * DFF / 256, F.G, (int)blockIdx.x, pg8::MapId{}, DM / 64);
        pg8::EpiSwiGLU8 E{(unsigned char*)MID, DFF, 2 * DFF / 256, 1.0f, S_M8};
        pg8::gemm_phase(F.lds, g, S, E);
#else
        pg8::Gemm g{H, W_GU0, DM}; pg8::Order<pg8::MapId> S; S.init(MROWS / 256, 2 * DFF / 256, F.G, (int)blockIdx.x, pg8::MapId{}, DM / 64);
        pg8::EpiSwiGLU E{MID, DFF, 2 * DFF / 256};
        pg8::gemm_phase(F.lds, g, S, E);
#endif
    }
    SEAM(8);
    if (IN(9)) for (int rep_ = 0; rep_ < NREP(9); ++rep_) {
        PH_LOCALS;
#if FFN0_FP8 >= 1
        pg8::Gemm g{MID, W_DN0, DFF / 2}; pg8::Order<pg8::MapL0Split> S; S.init(NTOK / 256, DM / 256, F.G, (int)blockIdx.x, pg8::MapL0Split{}, DFF / 128, 4, NS0);
        pg8::EpiResid E{x_in, ctx_in, XR, MODS, 5, 0, SLAB0, 1.0f / (S_M8 * S_W8)};
        pg8::gemm_phase<pg8::EpiResid, pg8::Order<pg8::MapL0Split>, true>(F.lds, g, S, E);
#else
        pg8::Gemm g{MID, W_DN0, DFF}; pg8::Order<pg8::MapL0Split> S; S.init(NTOK / 256, DM / 256, F.G, (int)blockIdx.x, pg8::MapL0Split{}, DFF / 64, 4, NS0);
        pg8::EpiResid E{x_in, ctx_in, XR, MODS, 5, 0, SLAB0, 1.0f};
        pg8::gemm_phase(F.lds, g, S, E);
#endif
    }
    SEAM(9);
    if (IN(10)) for (int rep_ = 0; rep_ < NREP(10); ++rep_) {
        PH_LOCALS;
        for (int row = gw; row < MROWS; row += NGW) {
            const int b = row / RPB, t = row % RPB; const float* md = MODS1 + (size_t)(t < SEQ ? b : 4) * 12288;
#if L1ATT_FP8
            f32x4 v[8]; mod_row<true>(XR + (size_t)row * DM, args.in[20], md + 0 * DM, md + 1 * DM, (bf16_t*)((unsigned char*)H + (size_t)row * DM), lane, v, t < SEQ ? nullptr : SLAB0 + ((size_t)b * NCTX + (t - SEQ)) * DM, (size_t)NB * NCTX * DM, NS0);
#else
            f32x4 v[8]; mod_row(XR + (size_t)row * DM, args.in[20], md + 0 * DM, md + 1 * DM, H + (size_t)row * DM, lane, v, t < SEQ ? nullptr : SLAB0 + ((size_t)b * NCTX + (t - SEQ)) * DM, (size_t)NB * NCTX * DM, NS0);
#endif
        }
    }
    SEAM(10);
    if (IN(11)) for (int rep_ = 0; rep_ < NREP(11); ++rep_) {
        PH_LOCALS;
        pg8::Gemm g{H, W_IN1, L1ATT_FP8 ? DM / 2 : DM}; pg8::Order<pg8::MapId> S; S.init(MROWS / 256, PROJ / 256, F.G, (int)blockIdx.x, pg8::MapId{}, L1ATT_FP8 ? DM / 128 : DM / 64);
#if L1ATT_FP8
        pg8::EpiQKV<1> E{QKV, cosA, sinA, cosB, sinB, nullptr, nullptr, (LAS float*)(F.lds + RING_BYTES), 1.0f / (S_H8 * S_W8)};
        pg8::gemm_phase<pg8::EpiQKV<1>, pg8::Order<pg8::MapId>, true>(F.lds, g, S, E);
#else
        pg8::EpiQKV<1> E{QKV, cosA, sinA, cosB, sinB, nullptr, nullptr, (LAS float*)(F.lds + RING_BYTES), 1.0f};
        pg8::gemm_phase(F.lds, g, S, E);
#endif
    }
    SEAM(11);
    if (IN(13)) for (int rep_ = 0; rep_ < NREP(13); ++rep_) {
        PH_LOCALS;
        float* btab = (float*)(lds + att::OFF_BIAS);
        for (int k = F.vcu; k < 256; k += F.G) {
            for (int i = 0; i < 2; ++i) {
                const int u = 2 * k + i, b = u >> 7, h = (u >> 4) & 7, qt = u & 15, kv = h >> 2; const size_t rb = (size_t)b * RPB;
                const int q0 = qt * 256, ks = (q0 - 128) < 0 ? 0 : (q0 - 128), ke = (q0 + 384) > SEQ ? SEQ : (q0 + 384);
                const att::TileMap tm{4, SEQ, ks, 4 + (ke - ks) / 64};
#ifndef NO_WIN
                att::unit_std<1>(QKV + (rb + q0) * PROJ + h * 128, QKV + rb * PROJ + 2048 + kv * 128, QKV + rb * PROJ + 2304 + kv * 128, tm, att::MaskInfo{q0, 0, 0}, args.in[26][h],
                                 L1ATT_FP8 ? (bf16_t*)((unsigned char*)AO + (rb + q0) * DM + h * 128) : AO + (rb + q0) * DM + h * 128, (char*)lds);
#endif
            }
            for (int i = 0; i < 2; ++i) {
                const int u = 2 * k + i, b = u >> 7, h = (u >> 4) & 7, qt = u & 15; const size_t rb = (size_t)b * RPB;
                const int r0 = qt * 4; int lo_ = r0 - 4; lo_ = lo_ < 0 ? 0 : (lo_ > 52 ? 52 : lo_);
                for (int j = tid; j < 15 * 31; j += 512) btab[j] = args.in[27][h * 465 + j] * (1.0f / ATT_SCALE);
                __syncthreads();
                const att::TileMap tm{4, SEQ, lo_ * 64, 16};
#ifndef NO_NA
                att::unit_std<2>(QKV + (rb + qt * 256) * PROJ + 1024 + h * 128, QKV + rb * PROJ + 2560 + h * 128, QKV + rb * PROJ + 3584 + h * 128, tm, att::MaskInfo{0, r0, lo_}, 0.f,
                                 L1ATT_FP8 ? (bf16_t*)((unsigned char*)AO + (rb + qt * 256) * DM + 1024 + h * 128) : AO + (rb + qt * 256) * DM + 1024 + h * 128, (char*)lds);
#endif
            }
        }
    }
    SEAM(13);
    if (IN(14)) for (int rep_ = 0; rep_ < NREP(14); ++rep_) {
        PH_LOCALS;
#if L1ATT_FP8
        pg8::Gemm g{AO, W_OUT1, DM / 2}; pg8::Order<pg8::MapLatent> S; S.init(NTOK / 256, DM / 256, F.G, (int)blockIdx.x, pg8::MapLatent{}, DM / 128);
        pg8::EpiResid E{x_in, ctx_in, XR, MODS1, 2, 0, nullptr, 1.0f / (S_A8 * S_W8)};
        pg8::gemm_phase<pg8::EpiResid, pg8::Order<pg8::MapLatent>, true>(F.lds, g, S, E);
#else
        pg8::Gemm g{AO, W_OUT1, DM}; pg8::Order<pg8::MapLatent> S; S.init(NTOK / 256, DM / 256, F.G, (int)blockIdx.x, pg8::MapLatent{}, DM / 64);
        pg8::EpiResid E{x_in, ctx_in, XR, MODS1, 2, 0, nullptr, 1.0f};
        pg8::gemm_phase(F.lds, g, S, E);
#endif
    }
    SEAM(14);
    if (IN(15)) for (int rep_ = 0; rep_ < NREP(15); ++rep_) {
        PH_LOCALS;
        LAS float* wt = (LAS float*)F.lds;
        LAS int* ce = (LAS int*)(F.lds + 65536);
        for (int i = tid; i < DM * NE; i += 512) { const int kk = i >> 3, e = i & 7; wt[e * DM + kk] = args.in[28][i]; }
        __syncthreads();
        for (int chunk = blockIdx.x; chunk < NTOK / 64; chunk += F.G) {
            for (int i = 0; i < 8; ++i) {
                const int tl = wave * 8 + i, n = chunk * 64 + tl, b = n >> 12, t = n & 4095, row = b * RPB + t;
                const float* md = MODS1 + (size_t)b * 12288;
                f32x4 v[8]; mod_row<true>(XR + (size_t)row * DM, args.in[21], md + 3 * DM, md + 4 * DM, (bf16_t*)((unsigned char*)H + (size_t)row * DM), lane, v);
                float lg[8];
#pragma unroll
                for (int e = 0; e < 8; ++e) { float s = 0.f;
#pragma unroll
                    for (int j = 0; j < 8; ++j) { const f32x4 w = *(const LAS f32x4*)(wt + e * DM + 256 * j + 4 * lane); s += (v[j].x * w.x + v[j].y * w.y) + (v[j].z * w.z + v[j].w * w.w); }
                    lg[e] = wave_sum(s); }
                int e0 = 0; float l0 = lg[0];
#pragma unroll
                for (int e = 1; e < 8; ++e) if (lg[e] > l0) { l0 = lg[e]; e0 = e; }
                int e1 = -1; float l1 = -3.4e38f;
#pragma unroll
                for (int e = 0; e < 8; ++e) if (e != e0 && lg[e] > l1) { l1 = lg[e]; e1 = e; }
                if (lane == 0) { ce[tl * 2] = e0; ce[tl * 2 + 1] = e1; const float g1 = 1.0f / (1.0f + expf(l0 - l1)); GATES[n * 2] = 1.0f - g1; GATES[n * 2 + 1] = g1; }
            }
            __syncthreads();
            if (wave == 0) {
                const int e0 = ce[lane * 2], e1 = ce[lane * 2 + 1]; int rk0 = 0, rk1 = 0;
                const unsigned long long below = (1ull << lane) - 1ull;
#pragma unroll
                for (int e = 0; e < 8; ++e) {
                    const unsigned long long m0 = __ballot(e0 == e), m1 = __ballot(e1 == e);
                    const int c0 = __popcll(m0);
                    if (e0 == e) rk0 = __popcll(m0 & below);
                    if (e1 == e) rk1 = c0 + __popcll(m1 & below);
                    if (lane == 0) CNT[chunk * 8 + e] = c0 + __popcll(m1);
                }
                const int n = chunk * 64 + lane;
                ROUTE[n * 4 + 0] = e0; ROUTE[n * 4 + 1] = e1; ROUTE[n * 4 + 2] = rk0; ROUTE[n * 4 + 3] = rk1;
            }
            __syncthreads();
        }
    }
    SEAM(15);
    if (IN(16)) for (int rep_ = 0; rep_ < NREP(16); ++rep_) {
        PH_LOCALS;
        LAS int* tot = (LAS int*)F.lds; LAS int* pre = tot + 8; LAS int* base = tot + 16;
        for (int chunk = blockIdx.x; chunk < NTOK / 64; chunk += F.G) {
            { const int e = wave; int a = 0, p = 0;
#pragma unroll
              for (int i = 0; i < 4; ++i) { const int c = 4 * lane + i; const int v = CNT[c * 8 + e]; a += v; p += (c < chunk) ? v : 0; }
              a = (int)wave_sum((float)a); p = (int)wave_sum((float)p);
              if (lane == 0) { tot[e] = a; pre[e] = p; } }
            __syncthreads();
            if (tid == 0) { int s = 0; for (int e = 0; e < 8; ++e) { base[e] = s; s += (tot[e] + 255) / 256 * 256; } base[8] = s; }
            __syncthreads();
            if (chunk == 0 && tid < CAP_TILES + 1) {
                const int ntile = base[8] / 256;
                if (tid == CAP_TILES) TILEE[CAP_TILES] = ntile;
                else { int e = 0; for (int q = 1; q < 8; ++q) if (tid * 256 >= base[q]) e = q; TILEE[tid] = e; }
            }
            for (int i = 0; i < 8; ++i) {
                const int tl = wave * 8 + i, n = chunk * 64 + tl, b = n >> 12, t = n & 4095, row = b * RPB + t;
                const int e0 = ROUTE[n * 4 + 0], e1 = ROUTE[n * 4 + 1], rk0 = ROUTE[n * 4 + 2], rk1 = ROUTE[n * 4 + 3];
                const int s0 = base[e0] + pre[e0] + rk0, s1 = base[e1] + pre[e1] + rk1;
                if (lane == 0) { SLOT[n * 2] = s0; SLOT[n * 2 + 1] = s1; }
                const u32x4* src = (const u32x4*)((const unsigned char*)H + (size_t)row * DM) + lane;
                u32x4* d0 = (u32x4*)((unsigned char*)XG + (size_t)s0 * DM) + lane; u32x4* d1 = (u32x4*)((unsigned char*)XG + (size_t)s1 * DM) + lane;
#pragma unroll
                for (int j = 0; j < 2; ++j) { const u32x4 w = src[64 * j]; d0[64 * j] = w; d1[64 * j] = w; }
            }
            __syncthreads();
        }
    }
    SEAM(16);
    if (IN(17)) for (int rep_ = 0; rep_ < NREP(17); ++rep_) {
        PH_LOCALS;
        const int ntile = TILEE[CAP_TILES];
        pg8::Gemm g{XG, W_GU1, DM / 2}; pg8::Order<pg8::MapMoe> S; S.init(ntile, 2 * DEX / 256, F.G, (int)blockIdx.x, pg8::MapMoe{TILEE, 2 * DEX / 256}, DM / 128);
        pg8::EpiSwiGLU8 E{(unsigned char*)MID, DEX, 2 * DEX / 256, 1.0f / (S_H8 * S_W8), S_M8 / (S_H8 * S_W8)};
        pg8::gemm_phase<pg8::EpiSwiGLU8, pg8::Order<pg8::MapMoe>, true>(F.lds, g, S, E);
    }
    SEAM(17);
    if (IN(18)) for (int rep_ = 0; rep_ < NREP(18); ++rep_) {
        PH_LOCALS;
        const int ntile = TILEE[CAP_TILES];
        pg8::Gemm g{MID, W_DN1, DEX / 2}; pg8::Order<pg8::MapMoe> S; S.init(ntile < 128 ? ntile : 128, DM / 256, F.G, (int)blockIdx.x, pg8::MapMoe{TILEE, DM / 256}, DEX / 128, ntile < 128 ? 0 : ntile - 128, 4);
        pg8::EpiBf16 E{Y, DM, DM / 256, 1.0f / (S_M8 * S_W8), SLAB1};
        pg8::gemm_phase<pg8::EpiBf16, pg8::Order<pg8::MapMoe>, true>(F.lds, g, S, E);
    }
    SEAM(18);
    if (IN(19)) for (int rep_ = 0; rep_ < NREP(19); ++rep_) {
        PH_LOCALS;
        for (int n = gw; n < NTOK; n += NGW) {
            const int b = n >> 12, t = n & 4095, row = b * RPB + t;
            const int s0 = SLOT[n * 2], s1 = SLOT[n * 2 + 1]; const float g0 = GATES[n * 2], g1 = GATES[n * 2 + 1];
            const float* gt = MODS1 + (size_t)b * 12288 + 5 * DM;
            const f32x4* xr = (const f32x4*)(XR + (size_t)row * DM) + lane;
            f32x4 v[8]; float s = 0.f;
#pragma unroll
            for (int j = 0; j < 8; ++j) { f32x4 ya, yb;
                if (s0 < 128 * 256) { const u32x2 a = ((const u32x2*)(Y + (size_t)s0 * DM))[64 * j + lane]; ya = (f32x4){bf_lo(a.x), bf_hi(a.x), bf_lo(a.y), bf_hi(a.y)}; }
                else { ya = (f32x4){0.f, 0.f, 0.f, 0.f};
#pragma unroll
                    for (int p = 0; p < 4; ++p) ya += ((const f32x4*)(SLAB1 + ((size_t)p * (7 * 256) + (s0 - 128 * 256)) * DM))[64 * j + lane]; }
                if (s1 < 128 * 256) { const u32x2 a = ((const u32x2*)(Y + (size_t)s1 * DM))[64 * j + lane]; yb = (f32x4){bf_lo(a.x), bf_hi(a.x), bf_lo(a.y), bf_hi(a.y)}; }
                else { yb = (f32x4){0.f, 0.f, 0.f, 0.f};
#pragma unroll
                    for (int p = 0; p < 4; ++p) yb += ((const f32x4*)(SLAB1 + ((size_t)p * (7 * 256) + (s1 - 128 * 256)) * DM))[64 * j + lane]; }
                const f32x4 gg = ((const f32x4*)gt)[64 * j + lane];
                v[j] = xr[64 * j] + gg * (ya * g0 + yb * g1); s += (v[j].x * v[j].x + v[j].y * v[j].y) + (v[j].z * v[j].z + v[j].w * v[j].w); }
            const float rstd = 1.0f / sqrtf(wave_sum(s) * (1.0f / DM) + EPS);
            f32x4* op = (f32x4*)(args.out + (size_t)n * DM) + lane;
#pragma unroll
            for (int j = 0; j < 8; ++j) op[64 * j] = v[j] * rstd * ((const f32x4*)args.in[32])[64 * j + lane];
        }
    }
#undef IN
#undef SEAM
}

constexpr int N_PHASES = 20;
extern "C" void kernel_launch(void* const* d_in, const int* in_sizes, int n_in, void* d_out, int out_size, void* d_ws, size_t ws_size, hipStream_t stream) {
    static int grid = 0;
    if (grid == 0) {
        if (n_in != 33 || ws_size < WS_END) { fprintf(stderr, "kernel_launch: need 33 inputs and %zu bytes of workspace; got %d, %zu\n", (size_t)WS_END, n_in, ws_size); grid = -1; return; }
        int dev = 0, cus = 0, per_cu = 0;
        if (hipGetDevice(&dev) != hipSuccess || hipDeviceGetAttribute(&cus, hipDeviceAttributeMultiprocessorCount, dev) != hipSuccess) { grid = -1; return; }
        if (hipFuncSetAttribute((const void*)hybrid_fwd, hipFuncAttributeMaxDynamicSharedMemorySize, LDS_BYTES) != hipSuccess) { fprintf(stderr, "kernel_launch: hipFuncSetAttribute failed\n"); grid = -1; return; }
        if (hipOccupancyMaxActiveBlocksPerMultiprocessor(&per_cu, (const void*)hybrid_fwd, 512, LDS_BYTES) != hipSuccess || per_cu < 1)
            fprintf(stderr, "kernel_launch: occupancy query reports %d workgroups per CU\n", per_cu);
        (void)hipGetLastError();
        grid = cus;
    }
    if (grid < 0) return;
    (void)hipMemsetAsync((char*)d_ws + WS_CTL, 0, CTL_ZERO_BYTES, stream);
    Args a{};
    for (int i = 0; i < 33; ++i) a.in[i] = (const float*)d_in[i];
    a.out = (float*)d_out; a.ws = (unsigned char*)d_ws;
#if MK_PER_PHASE
    for (int p = 0; p < N_PHASES; ++p) { a.ph_lo = p; a.ph_hi = p + 1; hipLaunchKernelGGL(hybrid_fwd, dim3(grid), dim3(512), LDS_BYTES, stream, a); }
#else
    a.ph_lo = 0; a.ph_hi = N_PHASES;
    hipLaunchKernelGGL(hybrid_fwd, dim3(grid), dim3(512), LDS_BYTES, stream, a);
#endif
    const hipError_t le = hipPeekAtLastError();
    if (le != hipSuccess) fprintf(stderr, "kernel_launch: launch failed: %s\n", hipGetErrorName(le));
}
```

```cpp
#include <hip/hip_runtime.h>
#include <hip/hip_bf16.h>
#include <cstdio>
#include <cstdint>

#ifndef MK_PER_PHASE
#define MK_PER_PHASE 0
#endif

#ifndef PRESCALE
#define PRESCALE 1
#endif
#ifndef L1ATT_FP8
#define L1ATT_FP8 1
#endif
#ifndef FFN0_FP8
#define FFN0_FP8 1
#endif
#define GAS __attribute__((address_space(1)))
#define LAS __attribute__((address_space(3)))
typedef unsigned short bf16_t;
typedef short bf16x8 __attribute__((ext_vector_type(8)));
typedef short s16x4 __attribute__((ext_vector_type(4)));
typedef float f32x2 __attribute__((ext_vector_type(2)));
typedef float f32x4 __attribute__((ext_vector_type(4)));
typedef float f32x16 __attribute__((ext_vector_type(16)));
typedef unsigned u32x2 __attribute__((ext_vector_type(2)));
typedef unsigned u32x4 __attribute__((ext_vector_type(4)));
typedef GAS unsigned gu32;

constexpr int DM = 2048, NB = 4, SEQ = 4096, NCTX = 256, RPB = SEQ + NCTX, MROWS = NB * RPB;
constexpr int NTOK = NB * SEQ;
constexpr int PROJ = 4608, DFF = 5632, NE = 8, DEX = 7168;
constexpr int CAP_TILES = 136, CAP = CAP_TILES * 256;
constexpr float EPS = 1e-6f;
constexpr float LOG2E = 1.4426950408889634f;
constexpr float ATT_SCALE = 0.088388347648318440f;
constexpr float A_SCALE = 0.125f;
constexpr float LAMBDA_INIT = 0.2f;

constexpr size_t MiB = 1u << 20;
constexpr size_t WS_CTL = 0, CTL_ZERO_BYTES = 32 * 1024;
constexpr size_t WS_MODS = 1 * MiB;
constexpr size_t WS_ADAP = 2 * MiB;
constexpr size_t WS_ROPE = 18 * MiB;
constexpr size_t WS_ROUTE = 22 * MiB;
constexpr size_t WS_GATES = WS_ROUTE + 512 * 1024;
constexpr size_t WS_SLOT = WS_GATES + 256 * 1024;
constexpr size_t WS_CNT = WS_SLOT + 256 * 1024;
constexpr size_t WS_TILEE = WS_CNT + 64 * 1024;
constexpr size_t WS_WIN0 = 34 * MiB, WS_WOUT0 = 52 * MiB, WS_WGU0 = 60 * MiB, WS_WDN0 = 104 * MiB;
constexpr size_t WS_WIN1 = 126 * MiB, WS_WOUT1 = 144 * MiB, WS_WGU1 = 152 * MiB, WS_WDN1 = 600 * MiB;
constexpr size_t WS_XR = 824 * MiB;
constexpr size_t WS_H = 960 * MiB;
constexpr size_t WS_AO = 1028 * MiB;
constexpr size_t WS_Y = WS_H;
constexpr size_t WS_QKV = 1096 * MiB;
constexpr size_t WS_XG = WS_QKV;
constexpr size_t WS_MID = 1249 * MiB;
constexpr size_t WS_SLAB0 = 1500 * MiB;
constexpr size_t WS_SLAB1 = 1540 * MiB;
constexpr size_t WS_SLABW = 1600 * MiB;
constexpr size_t WS_END = 1725 * MiB;
constexpr int CW_TMO = 0, CW_BAR = 4096;
constexpr int NS0 = FFN0_FP8 ? 2 : 4;

constexpr int RING_BYTES = 131072;
constexpr int LDS_BYTES = 147456;
constexpr int MISC_OFF = LDS_BYTES - 256;

#define RLX_AGENT __ATOMIC_RELAXED, __HIP_MEMORY_SCOPE_AGENT
#define LDS_WAIT() asm volatile("s_waitcnt lgkmcnt(0)" ::: "memory")
#define VM_WAIT() asm volatile("s_waitcnt vmcnt(0)" ::: "memory")
__device__ __forceinline__ unsigned cvt_pk_bf16(float lo, float hi) { unsigned r; asm volatile("v_cvt_pk_bf16_f32 %0, %1, %2" : "=v"(r) : "v"(lo), "v"(hi)); return r; }
__device__ __forceinline__ float bf_lo(unsigned w) { return __uint_as_float(w << 16); }
__device__ __forceinline__ float bf_hi(unsigned w) { return __uint_as_float(w & 0xffff0000u); }
typedef int i32x8 __attribute__((ext_vector_type(8)));
constexpr float S_H8 = 16.0f, S_W8 = 1024.0f, S_M8 = 4.0f, S_A8 = 64.0f;
__device__ __forceinline__ float clamp8(float x) { return __builtin_amdgcn_fmed3f(x, -448.0f, 448.0f); }
__device__ __forceinline__ unsigned pk4_fp8(float a, float b, float c, float d) {
    int w = 0; w = __builtin_amdgcn_cvt_pk_fp8_f32(clamp8(a), clamp8(b), w, false); w = __builtin_amdgcn_cvt_pk_fp8_f32(clamp8(c), clamp8(d), w, true); return (unsigned)w; }
__device__ __forceinline__ float wave_sum(float v) {
#pragma unroll
    for (int o = 1; o < 64; o <<= 1) v += __shfl_xor(v, o);
    return v;
}
__device__ __forceinline__ int fresh_tid() { int t = threadIdx.x; asm volatile("" : "+v"(t)); return t; }
__device__ __forceinline__ float fast_silu(float x) { return x * __builtin_amdgcn_rcpf(1.0f + __builtin_amdgcn_exp2f(-x * LOG2E)); }

namespace pg8 {
constexpr int BM = 256, BK = 64, HALF = 128, HTB = HALF * BK * 2, STAGE_BYTES = 8 * HTB, NXCD = 8, WGM = 4;
__host__ __device__ __forceinline__ int lds_byte(int r, int c) { const int st = (r >> 4) * 2 + (c >> 5), rr = r & 15, cc = c & 31, ob = rr * 64 + cc * 2; return st * 1024 + (ob ^ (((ob >> 9) & 1) << 5)); }
__host__ __device__ __forceinline__ void stage_rc(int b, int& R, int& C) { const int st = b / 1024, sb = b % 1024, swz = sb ^ (((sb >> 9) & 1) << 5); R = (st >> 1) * 16 + swz / 64; C = (st & 1) * 32 + (swz % 64) / 2; }
__host__ __device__ __forceinline__ int perm32(int rho) { const int n = rho >> 4, i = rho & 15; return 8 * (i >> 2) + 4 * n + (i & 3); }

typedef int i32x4_t __attribute__((ext_vector_type(4)));
struct Unit { int pm, pn, kofs, nt, flag; };
struct Gemm { const bf16_t* A; const bf16_t* Bt; int K; };

struct MapId { __device__ __forceinline__ void operator()(int pm, int pn, Unit& u) const { u.pm = pm; u.pn = pn; } };
struct MapL0Split { __device__ __forceinline__ void operator()(int pm, int pn, Unit& u) const { u.pm = pm < 64 ? (pm >> 4) * 17 + (pm & 15) : (pm - 64) * 17 + 16; u.pn = pn; } };
struct MapLatent { __device__ __forceinline__ void operator()(int pm, int pn, Unit& u) const { u.pm = (pm >> 4) * 17 + (pm & 15); u.pn = pn; } };
struct MapMoe { const int* tile_e; int npe; __device__ __forceinline__ void operator()(int pm, int pn, Unit& u) const { u.pm = pm; u.pn = tile_e[pm] * npe + pn; } };
template <class Map> struct Order {
    int nM, nN, nwg, G, c, ntf, exn, S; Map map;
    __device__ __forceinline__ void init(int nM_, int nN_, int G_, int c_, Map m, int ntf_, int ex_nM = 0, int S_ = 1) { nM = nM_; nN = nN_; nwg = nM * nN; G = G_; c = c_; map = m; ntf = ntf_; S = S_; exn = ex_nM * nN_ * S_; }
    __device__ __forceinline__ bool next(int i, Unit& u) const {
        const long L = (long)i * G + c; u.kofs = 0; u.nt = ntf; u.flag = 0;
        if (L >= nwg) { const long sidx = L - nwg; if (sidx >= exn) return false; const int part = (int)(sidx % S), ux = (int)(sidx / S);
            map(nM + ux / nN, ux % nN, u); u.nt = ntf / S; u.kofs = part * u.nt * (BK * 2); u.flag = 1 + part; return true; }
        int wgid = (int)L; { const int q = nwg / NXCD, r = nwg % NXCD, xcd = wgid % NXCD, off = wgid / NXCD; wgid = (xcd < r ? xcd * (q + 1) : r * (q + 1) + (xcd - r) * q) + off; }
        const int nig = WGM * nN, gid = wgid / nig, fm = gid * WGM, gsz = (nM - fm) < WGM ? (nM - fm) : WGM;
        map(fm + ((wgid % nig) % gsz), (wgid % nig) / gsz, u); return true;
    }
    __device__ __forceinline__ void a_ready(const Unit&) const {}
    __device__ __forceinline__ void done(const Unit&) const {}
};

struct EpiBf16 {
    static constexpr bool PERM = true;
    bf16_t* O; int ldc; int npn; float sc; float* slab;
    __device__ __forceinline__ void operator()(const f32x4 (&acc)[2][2][4][2], const Unit& u, int wr, int wc, int fr, int fq) const {
        const int row0 = u.pm * BM + wr * 64 + fr, col0 = (u.pn % npn) * BM + wc * 32 + 8 * fq;
        if (u.flag) {
            float* sp = slab + ((size_t)(u.flag - 1) * (7 * 256) + (size_t)(u.pm - 128) * BM + wr * 64 + fr) * ldc + col0;
#pragma unroll
            for (int ai = 0; ai < 2; ++ai)
#pragma unroll
                for (int m = 0; m < 4; ++m)
#pragma unroll
                    for (int bj = 0; bj < 2; ++bj) { float* p = sp + (size_t)(ai * HALF + m * 16) * ldc + bj * HALF;
                        *(f32x4*)p = acc[ai][bj][m][0] * sc; *(f32x4*)(p + 4) = acc[ai][bj][m][1] * sc; }
            return;
        }
#pragma unroll
        for (int ai = 0; ai < 2; ++ai)
#pragma unroll
            for (int m = 0; m < 4; ++m) { bf16_t* rowp = O + (size_t)(row0 + ai * HALF + m * 16) * ldc + col0;
#pragma unroll
                for (int bj = 0; bj < 2; ++bj) { const f32x4 v0 = acc[ai][bj][m][0] * sc, v1 = acc[ai][bj][m][1] * sc;
                    u32x4 w; w.x = cvt_pk_bf16(v0[0], v0[1]); w.y = cvt_pk_bf16(v0[2], v0[3]); w.z = cvt_pk_bf16(v1[0], v1[1]); w.w = cvt_pk_bf16(v1[2], v1[3]);
                    *(u32x4*)(rowp + bj * HALF) = w; } }
    }
};
template <int LAYER> struct EpiQKV {
    static constexpr bool PERM = true;
    bf16_t* O; const float* cA; const float* sA; const float* cB; const float* sB; const float* qg; const float* kg; LAS float* scr; float asc;
    __device__ __forceinline__ void operator()(const f32x4 (&acc)[2][2][4][2], const Unit& u, int wr, int wc, int fr, int fq) const {
        const int tt = u.pm % 17, pn = u.pn; const bool latent = tt < 16;
        int kind0, kind1; bool norm = false;
        if constexpr (LAYER == 0) { const int k = (pn < 4 || (pn >= 8 && pn < 12)) ? 1 : ((pn >= 4 && pn < 8) || pn == 16) ? 2 : 0; kind0 = kind1 = k; norm = (k == 2); }
        else { kind0 = kind1 = (pn < 4 || pn == 8) ? 2 : 0; }
        const int row0 = u.pm * BM + wr * 64 + fr, col0 = pn * BM + wc * 32 + 8 * fq, ch = wc * 32 + 8 * fq;
        if (norm) {
#pragma unroll
            for (int ai = 0; ai < 2; ++ai)
#pragma unroll
                for (int m = 0; m < 4; ++m)
#pragma unroll
                    for (int bj = 0; bj < 2; ++bj) { const f32x4 a = acc[ai][bj][m][0], b = acc[ai][bj][m][1];
                        float q = (a[0] * a[0] + a[1] * a[1]) + (a[2] * a[2] + a[3] * a[3]) + (b[0] * b[0] + b[1] * b[1]) + (b[2] * b[2] + b[3] * b[3]);
                        q += __shfl_xor(q, 16); q += __shfl_xor(q, 32);
                        if (fq == 0) scr[((ai * HALF + wr * 64 + m * 16 + fr) * 2 + bj) * 4 + wc] = q; }
            asm volatile("s_waitcnt lgkmcnt(0)" ::: "memory"); __builtin_amdgcn_s_barrier(); asm volatile("" ::: "memory");
        }
        f32x4 g0 = {1.f, 1.f, 1.f, 1.f}, g1 = g0;
        if (norm) { const LAS float* gl = scr + 2048 + ((pn == 16) ? 128 : 0) + ch; g0 = *(const LAS f32x4*)gl; g1 = *(const LAS f32x4*)(gl + 4); }
        const int kmax = kind0 > kind1 ? kind0 : kind1;
        const int npair = (kmax == 1) ? 16 : 32, p0 = (kmax == 1) ? ((ch & 63) >> 1) : (ch >> 1), q0 = p0 & (npair - 1); const bool use_row = p0 < npair;
        f32x4 frq;
#pragma unroll
        for (int i = 0; i < 4; ++i) frq[i] = __builtin_amdgcn_exp2f(-(float)(q0 + i) * (13.287712379549449f / (float)npair)) * 0.15915494309189535f;
#pragma unroll
        for (int ai = 0; ai < 2; ++ai)
#pragma unroll
            for (int m = 0; m < 4; ++m) { const int r = ai * HALF + wr * 64 + m * 16 + fr, t = tt * 256 + r;
                bf16_t* rowp = O + (size_t)(row0 + ai * HALF + m * 16) * PROJ + col0;
                f32x4 cs = {1.f, 1.f, 1.f, 1.f}, sn = {0.f, 0.f, 0.f, 0.f};
                if (latent && kmax != 0) { const float pos = (float)(use_row ? (t >> 6) : (t & 63));
#pragma unroll
                    for (int i = 0; i < 4; ++i) { const float x = pos * frq[i]; cs[i] = __builtin_amdgcn_cosf(x); sn[i] = __builtin_amdgcn_sinf(x); } }
#pragma unroll
                for (int bj = 0; bj < 2; ++bj) { f32x4 v0 = acc[ai][bj][m][0] * asc, v1 = acc[ai][bj][m][1] * asc; const int kind = bj ? kind1 : kind0;
                    if (norm) { const f32x4 p = *(const LAS f32x4*)(scr + ((ai * HALF + wr * 64 + m * 16 + fr) * 2 + bj) * 4);
                        const float rsv = 1.0f / sqrtf(((p[0] + p[1]) + (p[2] + p[3])) * (1.0f / 128.0f) + EPS); v0 = v0 * rsv * g0; v1 = v1 * rsv * g1; }
                    if (latent && kind != 0) {
                        const f32x4 a = v0, b = v1;
                        v0[0] = a[0] * cs[0] - a[1] * sn[0]; v0[1] = a[0] * sn[0] + a[1] * cs[0]; v0[2] = a[2] * cs[1] - a[3] * sn[1]; v0[3] = a[2] * sn[1] + a[3] * cs[1];
                        v1[0] = b[0] * cs[2] - b[1] * sn[2]; v1[1] = b[0] * sn[2] + b[1] * cs[2]; v1[2] = b[2] * cs[3] - b[3] * sn[3]; v1[3] = b[2] * sn[3] + b[3] * cs[3]; }
                    if constexpr (LAYER == 0 && PRESCALE) { const float qs = pn < 4 ? A_SCALE * LOG2E : (pn < 8 ? ATT_SCALE * LOG2E : 1.0f); v0 = v0 * qs; v1 = v1 * qs; }
                    u32x4 w; w.x = cvt_pk_bf16(v0[0], v0[1]); w.y = cvt_pk_bf16(v0[2], v0[3]); w.z = cvt_pk_bf16(v1[0], v1[1]); w.w = cvt_pk_bf16(v1[2], v1[3]);
                    *(u32x4*)(rowp + bj * HALF) = w; } }
    }
};
struct EpiSwiGLU {
    static constexpr bool PERM = true;
    bf16_t* O; int ldc; int npn;
    __device__ __forceinline__ void operator()(const f32x4 (&acc)[2][2][4][2], const Unit& u, int wr, int wc, int fr, int fq) const {
        const int row0 = u.pm * BM + wr * 64 + fr, col0 = (u.pn % npn) * HALF + wc * 32 + 8 * fq;
#pragma unroll
        for (int ai = 0; ai < 2; ++ai)
#pragma unroll
            for (int m = 0; m < 4; ++m) { bf16_t* rowp = O + (size_t)(row0 + ai * HALF + m * 16) * ldc + col0;
                const f32x4 g0 = acc[ai][0][m][0], g1 = acc[ai][0][m][1], u0 = acc[ai][1][m][0], u1 = acc[ai][1][m][1];
                u32x4 w;
                w.x = cvt_pk_bf16(fast_silu(g0[0]) * u0[0], fast_silu(g0[1]) * u0[1]); w.y = cvt_pk_bf16(fast_silu(g0[2]) * u0[2], fast_silu(g0[3]) * u0[3]);
                w.z = cvt_pk_bf16(fast_silu(g1[0]) * u1[0], fast_silu(g1[1]) * u1[1]); w.w = cvt_pk_bf16(fast_silu(g1[2]) * u1[2], fast_silu(g1[3]) * u1[3]);
                *(u32x4*)rowp = w; }
    }
};
struct EpiSwiGLU8 {
    static constexpr bool PERM = true;
    unsigned char* O; int ldc; int npn; float si, so;
    __device__ __forceinline__ f32x2 two(f32x2 ag, f32x2 au, float kneg, float c0) const {
        const f32x2 t = ag * kneg; f32x2 e; e.x = __builtin_amdgcn_exp2f(t.x); e.y = __builtin_amdgcn_exp2f(t.y);
        const f32x2 d = e * c0 + c0; f32x2 r; r.x = __builtin_amdgcn_rcpf(d.x); r.y = __builtin_amdgcn_rcpf(d.y);
        return (ag * au) * r; }
    __device__ __forceinline__ void operator()(const f32x4 (&acc)[2][2][4][2], const Unit& u, int wr, int wc, int fr, int fq) const {
        const int row0 = u.pm * BM + wr * 64 + fr, col0 = (u.pn % npn) * HALF + wc * 32 + 8 * fq;
        const float kneg = -si * LOG2E, c0 = 1.0f / (si * so);
#pragma unroll
        for (int ai = 0; ai < 2; ++ai)
#pragma unroll
            for (int m = 0; m < 4; ++m) { unsigned char* rowp = O + (size_t)(row0 + ai * HALF + m * 16) * ldc + col0;
                const f32x4 g0 = acc[ai][0][m][0], g1 = acc[ai][0][m][1], u0 = acc[ai][1][m][0], u1 = acc[ai][1][m][1];
                u32x2 w;
                const f32x2 a = two((f32x2){g0[0], g0[1]}, (f32x2){u0[0], u0[1]}, kneg, c0), b = two((f32x2){g0[2], g0[3]}, (f32x2){u0[2], u0[3]}, kneg, c0);
                const f32x2 c = two((f32x2){g1[0], g1[1]}, (f32x2){u1[0], u1[1]}, kneg, c0), d = two((f32x2){g1[2], g1[3]}, (f32x2){u1[2], u1[3]}, kneg, c0);
                w.x = pk4_fp8(a.x, a.y, b.x, b.y); w.y = pk4_fp8(c.x, c.y, d.x, d.y);
                *(u32x2*)rowp = w; }
    }
};
struct EpiResid {
    static constexpr bool PERM = false;
    const float* x_in; const float* ctx_in; float* XR; const float* mods; int gate_chunk; int from_input; float* slab; float asc;
    __device__ __forceinline__ void operator()(const f32x4 (&acc)[2][2][4][2], const Unit& u, int wr, int wc, int fr, int fq) const {
        const int b = u.pm / 17, tt = u.pm % 17;
        float* outp = XR + (size_t)u.pm * BM * DM;
        const float* basep = from_input ? (tt < 16 ? x_in + ((size_t)b * SEQ + (size_t)tt * 256) * DM : ctx_in + (size_t)b * NCTX * DM) : outp;
        const float* gate = mods + (size_t)(tt < 16 ? b : 4) * 12288 + gate_chunk * DM;
        const int col0 = u.pn * BM + wc * 32 + 4 * fq;
        f32x4 gv[2][2];
#pragma unroll
        for (int bj = 0; bj < 2; ++bj)
#pragma unroll
            for (int n = 0; n < 2; ++n) gv[bj][n] = *(const f32x4*)(gate + col0 + bj * HALF + n * 16) * asc;
        if (u.flag) {
            float* sp = slab + ((size_t)(u.flag - 1) * (NB * NCTX) + (size_t)b * NCTX) * DM;
#pragma unroll
            for (int ai = 0; ai < 2; ++ai)
#pragma unroll
                for (int m = 0; m < 4; ++m) { const size_t off = (size_t)(ai * HALF + wr * 64 + m * 16 + fr) * DM + col0;
#pragma unroll
                    for (int bj = 0; bj < 2; ++bj)
#pragma unroll
                        for (int n = 0; n < 2; ++n) *(f32x4*)(sp + off + bj * HALF + n * 16) = gv[bj][n] * acc[ai][bj][m][n]; }
            return;
        }
#pragma unroll
        for (int ai = 0; ai < 2; ++ai)
#pragma unroll
            for (int m = 0; m < 4; ++m) { const size_t off = (size_t)(ai * HALF + wr * 64 + m * 16 + fr) * DM + col0;
#pragma unroll
                for (int bj = 0; bj < 2; ++bj)
#pragma unroll
                    for (int n = 0; n < 2; ++n) { const f32x4 bs = *(const f32x4*)(basep + off + bj * HALF + n * 16);
                        *(f32x4*)(outp + off + bj * HALF + n * 16) = bs + gv[bj][n] * acc[ai][bj][m][n]; }
                if (m & 1) asm volatile("" ::: "memory"); }
    }
};

template <class Epi, class Sched, bool FP8 = false, bool ALIGN_EPI = true, bool SP2 = true>
__device__ __forceinline__ void gemm_phase(LAS unsigned char* lds, const Gemm g, const Sched& S, const Epi& E) {
    const int tid = fresh_tid(), wid = __builtin_amdgcn_readfirstlane(tid >> 6), lane = tid & 63, wr = wid >> 2, wc = wid & 3, fr = lane & 15, fq = lane >> 4;
    const int K = g.K;
    unsigned voffA[2], voffB[2];
#pragma unroll
    for (int i = 0; i < 2; ++i) { int R, C; stage_rc(tid * 16 + i * 8192, R, C); const int Rb = Epi::PERM ? ((R & ~31) + perm32(R & 31)) : R;
        voffA[i] = (unsigned)(R * K + C) * 2u; voffB[i] = (unsigned)(Rb * K + C) * 2u; }
    const size_t kstep = (size_t)(BK * 2);
    const size_t hstep = (size_t)HALF * K * 2;
    const size_t tstep = 2 * hstep;
    const unsigned ldsw = (unsigned)wid * 1024u;
    const int aoff = FP8 ? lds_byte(wr * 64 + fr, fq * 16) : lds_byte(wr * 64 + fr, fq * 8), boff = FP8 ? lds_byte(wc * 32 + fr, fq * 16) : lds_byte(wc * 32 + fr, fq * 8);
#define PG8_SA(b, h) (((b) * 2 + (h)) * HTB)
#define PG8_SB(b, h) ((4 + (b) * 2 + (h)) * HTB)
#define PG8_STAGE(bufoff, gbase, voff) do { _Pragma("unroll") for (int _i = 0; _i < 2; ++_i) \
        __builtin_amdgcn_global_load_lds((const unsigned*)((const char*)(gbase) + (voff)[_i]), (LAS unsigned*)(lds + (bufoff) + ldsw + _i * 8192), 16, 0, 0); } while (0)
#define PG8_LD16(p) (*(const LAS i32x4_t*)(p))
#define PG8_LDA(dst, b, h) do { if constexpr (FP8) { _Pragma("unroll") for (int m = 0; m < 4; ++m) { const LAS unsigned char* _p = lds + PG8_SA(b, h) + aoff + m * 2048; \
            dst##8[m] = __builtin_shufflevector(PG8_LD16(_p), PG8_LD16(_p + 16), 0, 1, 2, 3, 4, 5, 6, 7); } } else { \
        _Pragma("unroll") for (int m = 0; m < 4; ++m) _Pragma("unroll") for (int k = 0; k < 2; ++k) dst[m][k] = *(const LAS bf16x8*)(lds + PG8_SA(b, h) + aoff + m * 2048 + k * 1024); } } while (0)
#define PG8_LDB(dst, b, h) do { if constexpr (FP8) { _Pragma("unroll") for (int n = 0; n < 2; ++n) { const LAS unsigned char* _p = lds + PG8_SB(b, h) + boff + n * 2048; \
            dst##8[n] = __builtin_shufflevector(PG8_LD16(_p), PG8_LD16(_p + 16), 0, 1, 2, 3, 4, 5, 6, 7); } } else { \
        _Pragma("unroll") for (int n = 0; n < 2; ++n) _Pragma("unroll") for (int k = 0; k < 2; ++k) dst[n][k] = *(const LAS bf16x8*)(lds + PG8_SB(b, h) + boff + n * 2048 + k * 1024); } } while (0)
#define PG8_MMA(ai, bj, At, Bt) do { __builtin_amdgcn_s_setprio(1); _Pragma("unroll") for (int m = 0; m < 4; ++m) _Pragma("unroll") for (int n = 0; n < 2; ++n) { if constexpr (FP8) \
        asm volatile("v_mfma_f32_16x16x128_f8f6f4 %0, %1, %2, %0" : "+v"(acc[ai][bj][m][n]) : "v"(Bt##8[n]), "v"(At##8[m])); else { _Pragma("unroll") for (int k = 0; k < 2; ++k) \
        acc[ai][bj][m][n] = __builtin_amdgcn_mfma_f32_16x16x32_bf16(Bt[n][k], At[m][k], acc[ai][bj][m][n], 0, 0, 0); } } __builtin_amdgcn_s_setprio(0); } while (0)
#define PG8_WAIT_V(n) asm volatile("s_waitcnt vmcnt(" #n ")" ::: "memory")
#define PG8_WAIT_L(n) asm volatile("s_waitcnt lgkmcnt(" #n ")" ::: "memory")
#define PG8_BAR __builtin_amdgcn_s_barrier()
#define PG8_SCHED __builtin_amdgcn_sched_barrier(0)
    Unit cur, nxt; int ui = 0;
    if (!S.next(0, cur)) return;
    f32x4 acc[2][2][4][2];
#pragma unroll
    for (int a = 0; a < 2; ++a)
#pragma unroll
        for (int b = 0; b < 2; ++b)
#pragma unroll
            for (int m = 0; m < 4; ++m)
#pragma unroll
                for (int n = 0; n < 2; ++n) acc[a][b][m][n] = (f32x4){0.f, 0.f, 0.f, 0.f};
    bf16x8 At[4][2], B0[2][2], B1[2][2]; i32x8 At8[4], B08[2], B18[2];
    const char* cA = (const char*)g.A + (size_t)cur.pm * tstep + cur.kofs; const char* cB = (const char*)g.Bt + (size_t)cur.pn * tstep + cur.kofs;
    S.a_ready(cur);
    if constexpr (SP2) {
        PG8_STAGE(PG8_SB(0, 0), cB, voffB); PG8_STAGE(PG8_SB(0, 1), cB + hstep, voffB); PG8_STAGE(PG8_SA(0, 0), cA, voffA); PG8_STAGE(PG8_SA(0, 1), cA + hstep, voffA);
        if (wr == 1) PG8_BAR;
        PG8_WAIT_V(2); PG8_BAR;
        PG8_STAGE(PG8_SB(1, 0), cB + kstep, voffB); PG8_STAGE(PG8_SA(1, 0), cA + kstep, voffA); PG8_STAGE(PG8_SB(1, 1), cB + hstep + kstep, voffB);
        PG8_WAIT_V(6); PG8_BAR;
    } else {
        PG8_STAGE(PG8_SB(0, 0), cB, voffB); PG8_STAGE(PG8_SA(0, 0), cA, voffA); PG8_STAGE(PG8_SB(0, 1), cB + hstep, voffB); PG8_STAGE(PG8_SA(0, 1), cA + hstep, voffA);
        if (wr == 1) PG8_BAR;
        PG8_WAIT_V(4); PG8_BAR;
        PG8_STAGE(PG8_SB(1, 0), cB + kstep, voffB); PG8_STAGE(PG8_SA(1, 0), cA + kstep, voffA); PG8_STAGE(PG8_SB(1, 1), cB + hstep + kstep, voffB);
        PG8_WAIT_V(6); PG8_BAR;
    }
    for (;;) {
        const bool has_next = S.next(ui + 1, nxt);
        const char* nA = has_next ? (const char*)g.A + (size_t)nxt.pm * tstep + nxt.kofs : cA; const char* nB = has_next ? (const char*)g.Bt + (size_t)nxt.pn * tstep + nxt.kofs : cB;
        const int nt = cur.nt;
        for (int t = 0; t < nt; t += 2) {
            const bool last = (t == nt - 2);
            const char* a1 = cA + (size_t)(t + 1) * kstep;
            const char* a2 = last ? nA : cA + (size_t)(t + 2) * kstep; const char* b2 = last ? nB : cB + (size_t)(t + 2) * kstep;
            const char* a3 = a2 + kstep; const char* b3 = b2 + kstep;
            if (last && has_next) S.a_ready(nxt);
            if constexpr (SP2) {
            PG8_LDB(B0, 0, 0); PG8_LDB(B1, 0, 1); PG8_SCHED; PG8_LDA(At, 0, 0); PG8_STAGE(PG8_SA(1, 1), a1 + hstep, voffA);
            PG8_WAIT_V(8); PG8_WAIT_L(0); PG8_BAR; PG8_MMA(0, 0, At, B0); PG8_MMA(0, 1, At, B1); PG8_BAR; PG8_SCHED;
            PG8_LDA(At, 0, 1); PG8_STAGE(PG8_SB(0, 0), b2, voffB); PG8_STAGE(PG8_SB(0, 1), b2 + hstep, voffB); PG8_STAGE(PG8_SA(0, 0), a2, voffA);
            PG8_WAIT_V(8); PG8_WAIT_L(0); PG8_BAR; PG8_MMA(1, 0, At, B0); PG8_MMA(1, 1, At, B1); PG8_BAR; PG8_SCHED;
            PG8_LDB(B0, 1, 0); PG8_LDB(B1, 1, 1); PG8_SCHED; PG8_LDA(At, 1, 0); PG8_STAGE(PG8_SA(0, 1), a2 + hstep, voffA);
            PG8_WAIT_V(8); PG8_WAIT_L(0); PG8_BAR; PG8_MMA(0, 0, At, B0); PG8_MMA(0, 1, At, B1); PG8_BAR; PG8_SCHED;
            PG8_LDA(At, 1, 1); PG8_STAGE(PG8_SB(1, 0), b3, voffB); PG8_STAGE(PG8_SB(1, 1), b3 + hstep, voffB); PG8_STAGE(PG8_SA(1, 0), a3, voffA);
            PG8_WAIT_V(8); PG8_WAIT_L(0); PG8_BAR; PG8_MMA(1, 0, At, B0); PG8_MMA(1, 1, At, B1); PG8_BAR; PG8_SCHED;
            } else {
            PG8_LDB(B0, 0, 0); PG8_SCHED; PG8_LDA(At, 0, 0); PG8_STAGE(PG8_SA(1, 1), a1 + hstep, voffA);
            PG8_WAIT_L(8); PG8_BAR; PG8_WAIT_L(0); PG8_MMA(0, 0, At, B0); PG8_BAR; PG8_SCHED;
            PG8_LDB(B1, 0, 1); PG8_STAGE(PG8_SB(0, 0), b2, voffB);
            PG8_BAR; PG8_WAIT_L(0); PG8_MMA(0, 1, At, B1); PG8_BAR;
            PG8_LDA(At, 0, 1); PG8_STAGE(PG8_SA(0, 0), a2, voffA);
            PG8_BAR; PG8_WAIT_L(0); PG8_MMA(1, 0, At, B0); PG8_BAR; PG8_SCHED;
            PG8_STAGE(PG8_SB(0, 1), b2 + hstep, voffB);
            PG8_WAIT_V(6); PG8_BAR; PG8_MMA(1, 1, At, B1); PG8_BAR;
            PG8_LDB(B0, 1, 0); PG8_SCHED; PG8_LDA(At, 1, 0); PG8_STAGE(PG8_SA(0, 1), a2 + hstep, voffA);
            PG8_WAIT_L(8); PG8_BAR; PG8_WAIT_L(0); PG8_MMA(0, 0, At, B0); PG8_BAR; PG8_SCHED;
            PG8_LDB(B1, 1, 1); PG8_STAGE(PG8_SB(1, 0), b3, voffB);
            PG8_BAR; PG8_WAIT_L(0); PG8_MMA(0, 1, At, B1); PG8_BAR;
            PG8_LDA(At, 1, 1); PG8_STAGE(PG8_SA(1, 0), a3, voffA);
            PG8_BAR; PG8_WAIT_L(0); PG8_MMA(1, 0, At, B0); PG8_BAR; PG8_SCHED;
            PG8_STAGE(PG8_SB(1, 1), b3 + hstep, voffB);
            PG8_WAIT_V(6); PG8_BAR; PG8_MMA(1, 1, At, B1); PG8_BAR;
            }
        }
        if constexpr (ALIGN_EPI) { if (wr == 0) PG8_BAR; }
        if constexpr (FP8) asm volatile("s_nop 15\n\ts_nop 15" ::: "memory");
        E(acc, cur, wr, wc, fr, fq); S.done(cur);
        if (!has_next) break;
#pragma unroll
        for (int a = 0; a < 2; ++a)
#pragma unroll
            for (int b = 0; b < 2; ++b)
#pragma unroll
                for (int m = 0; m < 4; ++m)
#pragma unroll
                    for (int n = 0; n < 2; ++n) acc[a][b][m][n] = (f32x4){0.f, 0.f, 0.f, 0.f};
        cur = nxt; cA = nA; cB = nB; ++ui;
        if constexpr (ALIGN_EPI) { if (wr == 1) PG8_BAR; }
    }
    PG8_WAIT_V(0);
    if constexpr (!ALIGN_EPI) { if (wr == 0) PG8_BAR; }
    PG8_BAR;
#undef PG8_SA
#undef PG8_SB
#undef PG8_STAGE
#undef PG8_LDA
#undef PG8_LDB
#undef PG8_MMA
#undef PG8_LD16
#undef PG8_WAIT_V
#undef PG8_WAIT_L
#undef PG8_BAR
#undef PG8_SCHED
}
}

namespace att {
constexpr int D = 128, NW = 8, QBLK = 32, KVBLK = 64;
constexpr int LDQK = PROJ, LDO = DM;
constexpr float THR = 8.f;
#ifndef DIFF_SD
#define DIFF_SD 2
#endif
#ifndef STD_SD
#define STD_SD 1
#endif
constexpr int SHM_V = KVBLK * D * 2, SHM_K = KVBLK * D * 2;
constexpr int OFF_WS = 2 * SHM_V + 2 * SHM_K, OFF_STASH = OFF_WS + NW * 64 * 4, OFF_BIAS = OFF_STASH + 65536, ATT_LDS = OFF_BIAS + 2048;
static_assert(ATT_LDS <= MISC_OFF, "attention LDS");
#define KSWZ(row, colB) ((row) * 256 + ((colB) ^ (((row) & 7) << 4)))
#define SBAR() __builtin_amdgcn_sched_barrier(0)
__device__ __forceinline__ int crow(int r, int hi) { return (r & 3) + 8 * (r >> 2) + 4 * hi; }
struct TileMap { int NC, cbase, lbase, NT; __device__ __forceinline__ int krow(int j) const { return j < NC ? cbase + 64 * j : lbase + 64 * (j - NC); } };
struct MaskInfo { int q0, r0, lo; };

template <int MODE>
__device__ __forceinline__ void apply_mask(f32x16& p0, f32x16& p1, int j, const TileMap& tm, const MaskInfo& mi, int wid, int r32, int hi, const float* btab) {
    if constexpr (MODE == 1) {
        if (j >= tm.NC) {
            const int kp0 = tm.lbase + 64 * (j - tm.NC), qw = mi.q0 + wid * 32;
            if (kp0 - (qw + 31) < -128 || kp0 + 63 - qw > 128) {
                const int dq = kp0 - (qw + r32) + 4 * hi;
#pragma unroll
                for (int r = 0; r < 16; ++r) { const int d = dq + (r & 3) + 8 * (r >> 2);
                    if (d > 128 || d < -128) p0[r] = -1e30f;
                    if (d + 32 > 128 || d + 32 < -128) p1[r] = -1e30f; }
            }
        }
    } else if constexpr (MODE == 2) {
        if (j >= tm.NC) {
            const int kr = mi.lo + (j - tm.NC), rq = mi.r0 + (wid >> 1);
            int rs = rq - 4; rs = rs < 0 ? 0 : (rs > 56 ? 56 : rs);
            if (kr >= rs && kr < rs + 8) {
                const int cq = (wid & 1) * 32 + r32; int cs = cq - 8; cs = cs < 0 ? 0 : (cs > 48 ? 48 : cs);
                const float* bt = btab + (kr - rq + 7) * 31 + (4 * hi - cq + 15);
                const int cb = 4 * hi - cs;
#pragma unroll
                for (int r = 0; r < 16; ++r) { const int ko = (r & 3) + 8 * (r >> 2);
                    p0[r] = ((unsigned)(ko + cb) < 16u) ? p0[r] + bt[ko] : -1e30f;
                    if ((r & 7) == 7) SBAR(); }
#pragma unroll
                for (int r = 0; r < 16; ++r) { const int ko = (r & 3) + 8 * (r >> 2);
                    p1[r] = ((unsigned)(ko + 32 + cb) < 16u) ? p1[r] + bt[ko + 32] : -1e30f;
                    if ((r & 7) == 7) SBAR(); }
            } else {
#pragma unroll
                for (int r = 0; r < 16; ++r) { p0[r] = -1e30f; p1[r] = -1e30f; }
            }
        }
    }
}
__device__ __forceinline__ void partialSM(f32x16& p0, f32x16& p1, float& m_reg, float& mn, float& alpha, const float C, const float thr_raw) {
    float pmax = p0[0];
#pragma unroll
    for (int r = 1; r < 16; ++r) pmax = fmaxf(pmax, p0[r]);
#pragma unroll
    for (int r = 0; r < 16; ++r) pmax = fmaxf(pmax, p1[r]);
    { auto rr = __builtin_amdgcn_permlane32_swap(__float_as_uint(pmax), __float_as_uint(pmax), false, false);
      pmax = fmaxf(__uint_as_float(rr[0]), __uint_as_float(rr[1])); }
    if (__builtin_expect(__all(pmax - m_reg <= thr_raw), 1)) { mn = m_reg; alpha = 1.f; }
    else { mn = fmaxf(m_reg, pmax); alpha = __builtin_amdgcn_exp2f((m_reg - mn) * C); m_reg = mn; }
    const float mnC = -mn * C;
#pragma unroll
    for (int r = 0; r < 16; ++r) p0[r] = fmaf(p0[r], C, mnC);
#pragma unroll
    for (int r = 0; r < 16; ++r) p1[r] = fmaf(p1[r], C, mnC);
#pragma unroll
    for (int r = 0; r < 16; ++r) p0[r] = __builtin_amdgcn_exp2f(p0[r]);
}
__device__ __forceinline__ void finishSM(f32x16& p0, f32x16& p1, float alpha, float& l_reg, bf16x8& pa0, bf16x8& pa1, bf16x8& pa2, bf16x8& pa3) {
#pragma unroll
    for (int r = 0; r < 16; ++r) p1[r] = __builtin_amdgcn_exp2f(p1[r]);
    float ps = 0;
#pragma unroll
    for (int r = 0; r < 16; ++r) ps += p0[r];
#pragma unroll
    for (int r = 0; r < 16; ++r) ps += p1[r];
    { auto rr = __builtin_amdgcn_permlane32_swap(__float_as_uint(ps), __float_as_uint(ps), false, false);
      ps = __uint_as_float(rr[0]) + __uint_as_float(rr[1]); }
    l_reg = l_reg * alpha + ps;
#define PK4(P, BASE, OUT) do { unsigned a0 = cvt_pk_bf16(P[BASE + 0], P[BASE + 1]), a1 = cvt_pk_bf16(P[BASE + 2], P[BASE + 3]);   \
    unsigned b0 = cvt_pk_bf16(P[BASE + 4], P[BASE + 5]), b1 = cvt_pk_bf16(P[BASE + 6], P[BASE + 7]);                              \
    auto r0 = __builtin_amdgcn_permlane32_swap(a0, b0, false, false); auto r1 = __builtin_amdgcn_permlane32_swap(a1, b1, false, false); \
    u32x4 w = {r0[0], r1[0], r0[1], r1[1]}; OUT = *reinterpret_cast<bf16x8*>(&w); } while (0)
    PK4(p0, 0, pa0); PK4(p0, 8, pa1); PK4(p1, 0, pa2); PK4(p1, 8, pa3);
#undef PK4
}
template <int DLO, int DHI, bool QLDS>
__device__ __forceinline__ void qkt(f32x16& p0, f32x16& p1, const char* Ks, const bf16x8* qr, const char* qlds, int r32, int hi, const f32x16& cinit = f32x16{}) {
#pragma unroll
    for (int d0 = DLO; d0 < DHI; ++d0) { const int cb = (d0 * 16 + hi * 8) * 2;
        bf16x8 q; if constexpr (QLDS) q = *(const volatile LAS bf16x8*)((const LAS char*)qlds + d0 * 8192); else q = qr[d0];
        const bf16x8 b0 = *reinterpret_cast<const bf16x8*>(Ks + KSWZ(r32, cb));
        const bf16x8 b1 = *reinterpret_cast<const bf16x8*>(Ks + KSWZ(32 + r32, cb));
        if (d0 == DLO) {
            if constexpr (PRESCALE && !QLDS) {
                asm("v_mfma_f32_32x32x16_bf16 %0, %1, %2, %3" : "=&v"(p0) : "v"(b0), "v"(q), "v"(cinit));
                asm("v_mfma_f32_32x32x16_bf16 %0, %1, %2, %3" : "=&v"(p1) : "v"(b1), "v"(q), "v"(cinit)); }
            else { p0 = __builtin_amdgcn_mfma_f32_32x32x16_bf16(b0, q, cinit, 0, 0, 0); p1 = __builtin_amdgcn_mfma_f32_32x32x16_bf16(b1, q, cinit, 0, 0, 0); } }
        else { p0 = __builtin_amdgcn_mfma_f32_32x32x16_bf16(b0, q, p0, 0, 0, 0); p1 = __builtin_amdgcn_mfma_f32_32x32x16_bf16(b1, q, p1, 0, 0, 0); } }
}
constexpr float THR_L2 = THR * LOG2E;
__device__ __forceinline__ void presm_decide(f32x16& p0, f32x16& p1, float pmax, float& m_hat, float& alpha, f32x16& negm, bool first) {
    { auto rr = __builtin_amdgcn_permlane32_swap(__float_as_uint(pmax), __float_as_uint(pmax), false, false);
      pmax = fmaxf(__uint_as_float(rr[0]), __uint_as_float(rr[1])); }
    if (!first && __builtin_expect(__all(pmax <= THR_L2), 1)) { alpha = 1.f; }
    else { const float dl = first ? pmax : fmaxf(pmax, 0.f); m_hat += dl; alpha = first ? 1.f : __builtin_amdgcn_exp2f(-dl);
#pragma unroll
        for (int r = 0; r < 16; ++r) { p0[r] -= dl; p1[r] -= dl; }
#pragma unroll
        for (int r = 0; r < 16; ++r) negm[r] = -m_hat; }
}
__device__ __forceinline__ int v_st(int k, int c) { const int kk = (k & ~0xC) | ((k & 4) << 1) | ((k & 8) >> 1); return ((kk >> 3) * 4 + (c >> 5)) * 512 + ((kk & 7) * 32 + (c & 31)) * 2; }
__device__ __forceinline__ int v_rd_base(int lane) { return ((lane & 3) << 3) | (((lane >> 2) & 3) << 6) | (((lane >> 4) & 1) << 5) | (((lane >> 5) & 1) << 8); }
constexpr int v_rd_off(int d0, int ks, int half) { return d0 * 512 + ks * 4096 + half * 2048; }
template <int OFF> __device__ __forceinline__ s16x4 tr_read(int vb) {
    s16x4 r; asm volatile("ds_read_b64_tr_b16 %0, %1 offset:%2" : "=&v"(r) : "v"(vb), "i"(OFF) : "memory"); return r;
}
template <int D0> __device__ __forceinline__ void pv_one(f32x16& od, int vb, bf16x8 pa0, bf16x8 pa1, bf16x8 pa2, bf16x8 pa3) {
    const s16x4 l0 = tr_read<v_rd_off(D0, 0, 0)>(vb), h0 = tr_read<v_rd_off(D0, 0, 1)>(vb), l1 = tr_read<v_rd_off(D0, 1, 0)>(vb), h1 = tr_read<v_rd_off(D0, 1, 1)>(vb);
    const s16x4 l2 = tr_read<v_rd_off(D0, 2, 0)>(vb), h2 = tr_read<v_rd_off(D0, 2, 1)>(vb), l3 = tr_read<v_rd_off(D0, 3, 0)>(vb), h3 = tr_read<v_rd_off(D0, 3, 1)>(vb);
    asm volatile("s_waitcnt lgkmcnt(0)" ::: "memory"); SBAR();
#define PK(L, H) (bf16x8){L[0], L[1], L[2], L[3], H[0], H[1], H[2], H[3]}
    od = __builtin_amdgcn_mfma_f32_32x32x16_bf16(pa0, PK(l0, h0), od, 0, 0, 0);
    od = __builtin_amdgcn_mfma_f32_32x32x16_bf16(pa1, PK(l1, h1), od, 0, 0, 0);
    od = __builtin_amdgcn_mfma_f32_32x32x16_bf16(pa2, PK(l2, h2), od, 0, 0, 0);
    od = __builtin_amdgcn_mfma_f32_32x32x16_bf16(pa3, PK(l3, h3), od, 0, 0, 0);
#undef PK
}
__device__ __forceinline__ void pv_d0(f32x16* o, int vb, bf16x8 pa0, bf16x8 pa1, bf16x8 pa2, bf16x8 pa3) {
    pv_one<0>(o[0], vb, pa0, pa1, pa2, pa3); pv_one<1>(o[1], vb, pa0, pa1, pa2, pa3); pv_one<2>(o[2], vb, pa0, pa1, pa2, pa3); pv_one<3>(o[3], vb, pa0, pa1, pa2, pa3);
}
template <int MODE, bool PRE = false>
__device__ __forceinline__ void pv_sm(f32x16* o, int vb, bf16x8 pa0, bf16x8 pa1, bf16x8 pa2, bf16x8 pa3, f32x16& p0, f32x16& p1, float& m_reg, float& mn, float& alpha, const float C, const float thr_raw,
                                      int j, const TileMap& tm, const MaskInfo& mi, int wid, int r32, int hi, const float* btab, f32x16* negm = nullptr) {
    if constexpr (PRE) {
        pv_one<0>(o[0], vb, pa0, pa1, pa2, pa3);
        float pmax = p0[0];
#pragma unroll
        for (int r = 1; r < 16; ++r) pmax = fmaxf(pmax, p0[r]);
        pv_one<1>(o[1], vb, pa0, pa1, pa2, pa3);
#pragma unroll
        for (int r = 0; r < 16; ++r) pmax = fmaxf(pmax, p1[r]);
        pv_one<2>(o[2], vb, pa0, pa1, pa2, pa3);
        presm_decide(p0, p1, pmax, m_reg, alpha, *negm, false);
        pv_one<3>(o[3], vb, pa0, pa1, pa2, pa3);
#pragma unroll
        for (int r = 0; r < 16; ++r) p0[r] = __builtin_amdgcn_exp2f(p0[r]);
        return;
    }
    pv_one<0>(o[0], vb, pa0, pa1, pa2, pa3);
    apply_mask<MODE>(p0, p1, j, tm, mi, wid, r32, hi, btab);
    float pmax = p0[0];
#pragma unroll
    for (int r = 1; r < 16; ++r) pmax = fmaxf(pmax, p0[r]);
    pv_one<1>(o[1], vb, pa0, pa1, pa2, pa3);
#pragma unroll
    for (int r = 0; r < 16; ++r) pmax = fmaxf(pmax, p1[r]);
    { auto rr = __builtin_amdgcn_permlane32_swap(__float_as_uint(pmax), __float_as_uint(pmax), false, false);
      pmax = fmaxf(__uint_as_float(rr[0]), __uint_as_float(rr[1])); }
    if (__builtin_expect(__all(pmax - m_reg <= thr_raw), 1)) { mn = m_reg; alpha = 1.f; }
    else { mn = fmaxf(m_reg, pmax); alpha = __builtin_amdgcn_exp2f((m_reg - mn) * C); m_reg = mn; }
    const float mnC = -mn * C;
    pv_one<2>(o[2], vb, pa0, pa1, pa2, pa3);
#pragma unroll
    for (int r = 0; r < 16; ++r) p0[r] = fmaf(p0[r], C, mnC);
#pragma unroll
    for (int r = 0; r < 16; ++r) p1[r] = fmaf(p1[r], C, mnC);
    pv_one<3>(o[3], vb, pa0, pa1, pa2, pa3);
#pragma unroll
    for (int r = 0; r < 16; ++r) p0[r] = __builtin_amdgcn_exp2f(p0[r]);
}

template <int MODE, int DLO, int DHI, int SD = 2, bool QLDS = false>
__device__ __forceinline__ void attn_core(const bf16_t* __restrict__ Qb, const bf16_t* __restrict__ Kh, const bf16_t* __restrict__ Vh, const TileMap tm, const MaskInfo mi,
                                          const float C, const float thr_raw, char* lds, f32x16 (&o)[4], float& l_out, float& m_out) {
    const int tid = fresh_tid(), wid = tid >> 6, lane = tid & 63, r32 = lane & 31, hi = lane >> 5;
    char* V_lds = lds; char* K_lds = lds + 2 * SHM_V;
    float* ws = (float*)(lds + OFF_WS) + wid * 64; float* al_l = ws + 32;
    const float* btab = (const float*)(lds + OFF_BIAS);
    constexpr bool PRE = (MODE == 0) && (PRESCALE != 0);
    float m_reg = PRE ? 0.f : -1e30f, l_reg = 0; f32x16 negm = f32x16{};
#pragma unroll
    for (int d = 0; d < 4; ++d) o[d] = f32x16{};
    bf16x8 qr[8];
    const unsigned qoff = (unsigned)((wid * QBLK + r32) * LDQK + hi * 8);
#pragma unroll
    for (int d0 = 0; d0 < 8; ++d0) { if (d0 >= DLO && d0 < DHI) qr[d0] = *reinterpret_cast<const bf16x8*>(Qb + qoff + d0 * 16); else qr[d0] = bf16x8{}; }
    const char* qlds = lds + OFF_STASH + tid * 16;
    if constexpr (QLDS) {
#pragma unroll
        for (int d0 = DLO; d0 < DHI; ++d0) *(bf16x8*)(lds + OFF_STASH + tid * 16 + d0 * 8192) = qr[d0];
        asm volatile("s_waitcnt lgkmcnt(0)" ::: "memory");
    }
    const int sr = tid >> 4, sc = (tid & 15) * 8, vst0 = v_st(sr, sc), vst1 = v_st(32 + sr, sc);
    const unsigned loff = (unsigned)(sr * LDQK + sc);
    const int vb0 = (int)(uintptr_t)V_lds + v_rd_base(lane);
    struct { bf16x8 vs0, vs1, ks0, ks1; } sr_[SD];
#define SLOAD(i, k0) do { const size_t _k0 = (size_t)(k0) * LDQK; const bf16_t* _kt = Kh + _k0; const bf16_t* _vt = Vh + _k0; \
    sr_[i].vs0 = *reinterpret_cast<const bf16x8*>(_vt + loff); sr_[i].vs1 = *reinterpret_cast<const bf16x8*>(_vt + 32 * LDQK + loff); \
    sr_[i].ks0 = *reinterpret_cast<const bf16x8*>(_kt + loff); sr_[i].ks1 = *reinterpret_cast<const bf16x8*>(_kt + 32 * LDQK + loff); } while (0)
#define SWRITE(b, i) do { *(bf16x8*)(V_lds + (b) * SHM_V + vst0) = sr_[i].vs0; *(bf16x8*)(V_lds + (b) * SHM_V + vst1) = sr_[i].vs1; const int kc = sc * 2; \
    *(bf16x8*)(K_lds + (b) * SHM_K + KSWZ(sr, kc)) = sr_[i].ks0; *(bf16x8*)(K_lds + (b) * SHM_K + KSWZ(32 + sr, kc)) = sr_[i].ks1; } while (0)
#define SWAIT() do { if constexpr (SD == 2) asm volatile("s_waitcnt vmcnt(4)" ::: "memory"); else asm volatile("s_waitcnt vmcnt(0)" ::: "memory"); } while (0)
#define RESC(a) do { if (__any((a) < 1.f)) { if (hi == 0) al_l[r32] = (a); asm volatile("s_waitcnt lgkmcnt(0)" ::: "memory"); \
    _Pragma("unroll") for (int d = 0; d < 4; ++d) _Pragma("unroll") for (int r = 0; r < 16; ++r) o[d][r] *= al_l[crow(r, hi)]; } } while (0)
    f32x16 pA0, pA1, pB0, pB1; float mnA, mnB, alA, alB; bf16x8 pa0, pa1, pa2, pa3; const int NT = tm.NT;
    constexpr int SE = 0, SO = SD - 1;
    SLOAD(SE, tm.krow(0)); asm volatile("s_waitcnt vmcnt(0)" ::: "memory"); SWRITE(0, SE); __syncthreads();
    qkt<DLO, DHI, QLDS>(pA0, pA1, K_lds, qr, qlds, r32, hi, negm); apply_mask<MODE>(pA0, pA1, 0, tm, mi, wid, r32, hi, btab);
    if constexpr (PRE) { float pmax = pA0[0];
#pragma unroll
        for (int r = 1; r < 16; ++r) pmax = fmaxf(pmax, pA0[r]);
#pragma unroll
        for (int r = 0; r < 16; ++r) pmax = fmaxf(pmax, pA1[r]);
        presm_decide(pA0, pA1, pmax, m_reg, alA, negm, true);
#pragma unroll
        for (int r = 0; r < 16; ++r) pA0[r] = __builtin_amdgcn_exp2f(pA0[r]); }
    else partialSM(pA0, pA1, m_reg, mnA, alA, C, thr_raw);
    SLOAD(SO, tm.krow(1)); if constexpr (SD == 2) { if (2 < NT) SLOAD(SE, tm.krow(2)); }
    SWAIT(); SWRITE(1, SO); __syncthreads();
    for (int j = 1; j + 1 < NT; j += 2) {
        SBAR(); qkt<DLO, DHI, QLDS>(pB0, pB1, K_lds + SHM_K, qr, qlds, r32, hi, negm);
        finishSM(pA0, pA1, alA, l_reg, pa0, pa1, pa2, pa3); SBAR();
        SLOAD(SO, tm.krow(j + SD)); SBAR();
        pv_sm<MODE, PRE>(o, vb0, pa0, pa1, pa2, pa3, pB0, pB1, m_reg, mnB, alB, C, thr_raw, j, tm, mi, wid, r32, hi, btab, &negm);
        __syncthreads(); SWAIT(); SWRITE(0, SE);
        RESC(alB); __syncthreads();
        SBAR(); qkt<DLO, DHI, QLDS>(pA0, pA1, K_lds, qr, qlds, r32, hi, negm);
        finishSM(pB0, pB1, alB, l_reg, pa0, pa1, pa2, pa3); SBAR();
        if (SD == 1 || j + 3 < NT) SLOAD(SE, tm.krow(j + 1 + SD)); SBAR();
        pv_sm<MODE, PRE>(o, vb0 + SHM_V, pa0, pa1, pa2, pa3, pA0, pA1, m_reg, mnA, alA, C, thr_raw, j + 1, tm, mi, wid, r32, hi, btab, &negm);
        __syncthreads(); SWAIT(); SWRITE(1, SO);
        RESC(alA); __syncthreads();
    }
    SBAR(); qkt<DLO, DHI, QLDS>(pB0, pB1, K_lds + SHM_K, qr, qlds, r32, hi, negm);
    finishSM(pA0, pA1, alA, l_reg, pa0, pa1, pa2, pa3); SBAR();
    pv_sm<MODE, PRE>(o, vb0, pa0, pa1, pa2, pa3, pB0, pB1, m_reg, mnB, alB, C, thr_raw, NT - 1, tm, mi, wid, r32, hi, btab, &negm);
    __syncthreads(); RESC(alB);
    finishSM(pB0, pB1, alB, l_reg, pa0, pa1, pa2, pa3); SBAR();
    pv_d0(o, vb0 + SHM_V, pa0, pa1, pa2, pa3);
    l_out = l_reg; m_out = m_reg;
#undef SLOAD
#undef SWRITE
#undef SWAIT
#undef RESC
}
__device__ __forceinline__ void normalise(f32x16 (&o)[4], float l_reg, char* lds) {
    const int tid = fresh_tid(), wid = tid >> 6, lane = tid & 63, r32 = lane & 31, hi = lane >> 5;
    float* li_l = (float*)(lds + OFF_WS) + wid * 64;
    if (hi == 0) li_l[r32] = l_reg; asm volatile("s_waitcnt lgkmcnt(0)" ::: "memory");
#pragma unroll
    for (int r = 0; r < 16; ++r) { const float rl = __builtin_amdgcn_rcpf(li_l[crow(r, hi)]);
#pragma unroll
        for (int d0 = 0; d0 < 4; ++d0) o[d0][r] *= rl; }
    asm volatile("s_waitcnt lgkmcnt(0)" ::: "memory");
}
__device__ __forceinline__ void store_o(const f32x16 (&o)[4], bf16_t* Ob) {
    const int tid = fresh_tid(), wid = tid >> 6, lane = tid & 63, r32 = lane & 31, hi = lane >> 5;
    __hip_bfloat16* Ow = (__hip_bfloat16*)Ob + (long)(wid * QBLK) * LDO;
#pragma unroll
    for (int r = 0; r < 16; ++r) { const int orow = crow(r, hi);
#pragma unroll
        for (int d0 = 0; d0 < 4; ++d0) Ow[(long)orow * LDO + d0 * 32 + r32] = __float2bfloat16(o[d0][r]); }
}
__device__ __forceinline__ void store_o8(const f32x16 (&o)[4], unsigned char* Ob8) {
    const int tid = fresh_tid(), wid = tid >> 6, lane = tid & 63, r32 = lane & 31, hi = lane >> 5;
    unsigned char* Ow = Ob8 + (long)(wid * QBLK) * LDO;
#pragma unroll
    for (int r = 0; r < 16; r += 2) { const int orow = crow(r, hi);
#pragma unroll
        for (int d0 = 0; d0 < 4; ++d0) { const int w = __builtin_amdgcn_cvt_pk_fp8_f32(clamp8(o[d0][r] * S_A8), clamp8(o[d0][r + 1] * S_A8), 0, false);
            Ow[(long)orow * LDO + d0 * 32 + r32] = (unsigned char)(w & 0xff); Ow[(long)(orow + 1) * LDO + d0 * 32 + r32] = (unsigned char)((w >> 8) & 0xff); } }
}
template <int MODE>
__device__ __forceinline__ void unit_std(const bf16_t* Qb, const bf16_t* Kh, const bf16_t* Vh, const TileMap tm, const MaskInfo mi, float sink, bf16_t* Ob, char* lds) {
    f32x16 o[4]; float l, m;
    const float C = ATT_SCALE * LOG2E;
    attn_core<MODE, 0, 8, (MODE == 0 ? STD_SD : 1), (MODE != 0)>(Qb, Kh, Vh, tm, mi, C, THR / ATT_SCALE, lds, o, l, m);
    if constexpr (MODE == 1) l += __builtin_amdgcn_exp2f(sink * LOG2E - m * C);
    normalise(o, l, lds);
    if constexpr (MODE != 0 && L1ATT_FP8) store_o8(o, (unsigned char*)Ob); else store_o(o, Ob);
    __syncthreads();
}
__device__ __forceinline__ void unit_diff(const bf16_t* Qb, const bf16_t* Kh, const bf16_t* Vh, const TileMap tm, float lam, const float* subln_g, bf16_t* Ob, char* lds) {
    const int tid = fresh_tid(), lane = tid & 63, r32 = lane & 31;
    f32x16 o[4]; float l, m; const MaskInfo mi{0, 0, 0};
    const float C = A_SCALE * LOG2E;
    unsigned* stash = (unsigned*)(lds + OFF_STASH);
    attn_core<0, 0, 4, DIFF_SD>(Qb, Kh, Vh, tm, mi, C, THR / A_SCALE, lds, o, l, m);
    normalise(o, l, lds);
#pragma unroll
    for (int d0 = 0; d0 < 4; ++d0)
#pragma unroll
        for (int r = 0; r < 16; r += 2) stash[(d0 * 8 + (r >> 1)) * 512 + tid] = cvt_pk_bf16(o[d0][r], o[d0][r + 1]);
    __syncthreads();
    attn_core<0, 4, 8, DIFF_SD>(Qb, Kh, Vh, tm, mi, C, THR / A_SCALE, lds, o, l, m);
    normalise(o, l, lds);
    float ss[16];
#pragma unroll
    for (int r = 0; r < 16; ++r) ss[r] = 0.f;
#pragma unroll
    for (int d0 = 0; d0 < 4; ++d0)
#pragma unroll
        for (int r = 0; r < 16; r += 2) { const unsigned w = stash[(d0 * 8 + (r >> 1)) * 512 + tid];
            const float a = bf_lo(w) - lam * o[d0][r], b = bf_hi(w) - lam * o[d0][r + 1];
            o[d0][r] = a; o[d0][r + 1] = b; ss[r] += a * a; ss[r + 1] += b * b; }
#pragma unroll
    for (int r = 0; r < 16; ++r) {
#pragma unroll
        for (int x = 1; x < 32; x <<= 1) ss[r] += __shfl_xor(ss[r], x);
        ss[r] = (1.0f - LAMBDA_INIT) / sqrtf(ss[r] * (1.0f / 128.0f) + EPS); }
    float gg[4];
#pragma unroll
    for (int d0 = 0; d0 < 4; ++d0) gg[d0] = subln_g[d0 * 32 + r32];
#pragma unroll
    for (int d0 = 0; d0 < 4; ++d0)
#pragma unroll
        for (int r = 0; r < 16; ++r) o[d0][r] *= ss[r] * gg[d0];
    store_o(o, Ob);
    __syncthreads();
}
#undef SBAR
}

#define XB_TMO      128
#define XB_XCNT(j)  (256  + 64 * (j))
#define XB_XSUB(j)  (1280 + 64 * (j))
#define XB_XGEN(j)  (2304 + 64 * (j))
#define XB_TOP      3328
#define XB_TOPGEN   3392
#define XCD_BAR_WORDS 3456
#define XB_SPIN_CAP (1u << 22)
__device__ __forceinline__ unsigned xb_ld(unsigned* p)              { return __hip_atomic_load(p, __ATOMIC_RELAXED, __HIP_MEMORY_SCOPE_AGENT); }
__device__ __forceinline__ unsigned xb_add(unsigned* p, unsigned v) { return __hip_atomic_fetch_add(p, v, __ATOMIC_RELAXED, __HIP_MEMORY_SCOPE_AGENT); }
__device__ __forceinline__ unsigned xb_xcc_id() { return (unsigned)__builtin_amdgcn_s_getreg((3 << 11) | 20) & 0xFu; }
#define XB_SPIN(cond, bar) do { unsigned _sp = 0; while (cond) { __builtin_amdgcn_s_sleep(1); \
    if ((++_sp & 255u) == 0u) { if (xb_ld(&(bar)[XB_TMO])) break; if (_sp > XB_SPIN_CAP) { atomicAdd(&(bar)[XB_TMO], 1u); break; } } } } while (0)
struct XcdBarrier { unsigned* bar; unsigned x; volatile LAS unsigned* st; };
__device__ __forceinline__ XcdBarrier xcd_barrier_post(unsigned* bar, volatile LAS unsigned* st) {
    XcdBarrier b; b.bar = bar; b.x = xb_xcc_id(); b.st = st;
    if (threadIdx.x == 0) (void)xb_add(&bar[XB_XCNT(b.x)], 1u);
    return b;
}
__device__ __forceinline__ void xcd_barrier_complete(unsigned* bar, unsigned x, unsigned& nloc, unsigned& nx) {
    const unsigned G = gridDim.x * gridDim.y * gridDim.z;
    unsigned sum, cnt, mine, sp = 0u;
    for (;;) {
        sum = 0u; cnt = 0u; mine = 0u;
#pragma unroll
        for (unsigned j = 0; j < 16; ++j) { const unsigned c = xb_ld(&bar[XB_XCNT(j)]); sum += c; cnt += (c > 0u) ? 1u : 0u; mine = (j == x) ? c : mine; }
        if (sum == G) break;
        __builtin_amdgcn_s_sleep(1);
        if ((++sp & 255u) == 0u) { if (xb_ld(&bar[XB_TMO])) break; if (sp > XB_SPIN_CAP) { atomicAdd(&bar[XB_TMO], 1u); break; } }
    }
    nloc = mine > 0u ? mine : 1u; nx = cnt > 0u ? cnt : 1u;
}
__device__ __forceinline__ void xcd_barrier(const XcdBarrier& b) {
    asm volatile("s_waitcnt vmcnt(0)" ::: "memory");
    __syncthreads();
    if (threadIdx.x == 0) {
        unsigned* bar = b.bar;
        __builtin_amdgcn_s_waitcnt(0);
        unsigned nloc = b.st[0], nx = b.st[1];
        if (nloc == 0u) { xcd_barrier_complete(bar, b.x, nloc, nx); b.st[0] = nloc; b.st[1] = nx; }
        const unsigned old = xb_add(&bar[XB_XSUB(b.x)], 1u);
        const unsigned gen = old / nloc;
        if (old + 1u == (gen + 1u) * nloc) {
            __builtin_amdgcn_fence(__ATOMIC_RELEASE, "agent");
            asm volatile("s_waitcnt vmcnt(0)" ::: "memory");
            const unsigned og = xb_add(&bar[XB_TOP], 1u);
            const unsigned tg = og / nx;
            if (og + 1u == (tg + 1u) * nx) xb_add(&bar[XB_TOPGEN], 1u);
            else XB_SPIN(xb_ld(&bar[XB_TOPGEN]) == tg, bar);
            __builtin_amdgcn_fence(__ATOMIC_ACQUIRE, "agent");
            xb_add(&bar[XB_XGEN(b.x)], 1u);
            asm volatile("s_waitcnt vmcnt(0)" ::: "memory");
        } else {
            XB_SPIN(xb_ld(&bar[XB_XGEN(b.x)]) == gen, bar);
            __builtin_amdgcn_fence(__ATOMIC_ACQUIRE, "agent");
            asm volatile("s_waitcnt vmcnt(0)" ::: "memory");
        }
    }
    __syncthreads();
}

struct Args { const float* in[33]; float* out; unsigned char* ws; int ph_lo, ph_hi; };
struct Frame {
    LAS unsigned char* lds; int vcu, G;
};

__device__ __forceinline__ void transpose_item(const float* W, int ldw, int K, bf16_t* WT, int k0, int n0, long dst_row0, LAS float* scr, int lane) {
    { float tv[32]; const float* wp = W + (size_t)(k0 + (lane >> 5)) * ldw + n0 + (lane & 31);
#pragma unroll
      for (int i = 0; i < 32; ++i) tv[i] = wp[(size_t)(2 * i) * ldw];
#pragma unroll
      for (int i = 0; i < 32; ++i) scr[(2 * i + (lane >> 5)) * 33 + (lane & 31)] = tv[i]; }
    LDS_WAIT(); asm volatile("" ::: "memory");
    const int c = lane & 7;
#pragma unroll
    for (int j = 0; j < 4; ++j) { const int n = (lane >> 3) + 8 * j; const LAS float* s = scr + (8 * c) * 33 + n;
        u32x4 o; o.x = cvt_pk_bf16(s[0 * 33], s[1 * 33]); o.y = cvt_pk_bf16(s[2 * 33], s[3 * 33]); o.z = cvt_pk_bf16(s[4 * 33], s[5 * 33]); o.w = cvt_pk_bf16(s[6 * 33], s[7 * 33]);
        *(GAS u32x4*)(WT + (size_t)(dst_row0 + n) * K + k0 + 8 * c) = o; }
    LDS_WAIT(); asm volatile("" ::: "memory");
}
__device__ __forceinline__ void transpose_item8(const float* W, int ldw, int K, unsigned char* WT, int k0, int n0, long dst_row0, LAS float* scr, int lane, float scale) {
#pragma unroll
    for (int hb = 0; hb < 2; ++hb) { float tv[32]; const float* wp = W + (size_t)(k0 + 64 * hb + (lane >> 5)) * ldw + n0 + (lane & 31);
#pragma unroll
        for (int i = 0; i < 32; ++i) tv[i] = wp[(size_t)(2 * i) * ldw];
#pragma unroll
        for (int i = 0; i < 32; ++i) { const int kk = 64 * hb + 2 * i + (lane >> 5); scr[kk * 32 + (((lane & 31) + 8 * (kk >> 4)) & 31)] = tv[i]; } }
    LDS_WAIT(); asm volatile("" ::: "memory");
    const int c = lane & 7;
#pragma unroll
    for (int j = 0; j < 4; ++j) { const int n = (lane >> 3) + 8 * j; const LAS float* s = scr + (16 * c) * 32 + ((n + 8 * c) & 31);
        u32x4 o;
        o.x = pk4_fp8(s[0 * 32] * scale, s[1 * 32] * scale, s[2 * 32] * scale, s[3 * 32] * scale); o.y = pk4_fp8(s[4 * 32] * scale, s[5 * 32] * scale, s[6 * 32] * scale, s[7 * 32] * scale);
        o.z = pk4_fp8(s[8 * 32] * scale, s[9 * 32] * scale, s[10 * 32] * scale, s[11 * 32] * scale); o.w = pk4_fp8(s[12 * 32] * scale, s[13 * 32] * scale, s[14 * 32] * scale, s[15 * 32] * scale);
        *(GAS u32x4*)(WT + (size_t)(dst_row0 + n) * K + k0 + 16 * c) = o; }
    LDS_WAIT(); asm volatile("" ::: "memory");
}
__device__ __forceinline__ void tr_plain8(const float* W, int K, int N, unsigned char* WT, long row_off, LAS float* scr, int item, int lane) {
    const int nblk = N / 32, kb = item / nblk, nb = item % nblk;
    transpose_item8(W, N, K, WT, 128 * kb, 32 * nb, row_off + 32 * nb, scr, lane, S_W8);
}
__device__ __forceinline__ void tr_gu8(const float* W, int K, int N, unsigned char* WT, long row_off, int up, LAS float* scr, int item, int lane) {
    const int nblk = N / 32, kb = item / nblk, nb = item % nblk, n0 = 32 * nb;
    transpose_item8(W, N, K, WT, 128 * kb, n0, row_off + (long)(n0 >> 7) * 256 + (n0 & 127) + up * 128, scr, lane, S_W8);
}
__device__ __forceinline__ void tr_plain(const float* W, int K, int N, bf16_t* WT, long row_off, LAS float* scr, int item, int lane) {
    const int nblk = N / 32, kb = item / nblk, nb = item % nblk;
    transpose_item(W, N, K, WT, 64 * kb, 32 * nb, row_off + 32 * nb, scr, lane);
}
__device__ __forceinline__ void tr_gu(const float* W, int K, int N, bf16_t* WT, long row_off, int up, LAS float* scr, int item, int lane) {
    const int nblk = N / 32, kb = item / nblk, nb = item % nblk, n0 = 32 * nb;
    transpose_item(W, N, K, WT, 64 * kb, n0, row_off + (long)(n0 >> 7) * 256 + (n0 & 127) + up * 128, scr, lane);
}

template <bool OUT8 = false>
__device__ __forceinline__ void mod_row(const float* xrow, const float* g, const float* sh, const float* sc, bf16_t* orow, int lane, f32x4 (&v)[8], const float* xs = nullptr, size_t xs_stride = 0, int nxs = 0, float* xout = nullptr) {
    const f32x4* xr = (const f32x4*)xrow + lane;
    float s = 0.f;
#pragma unroll
    for (int j = 0; j < 8; ++j) { v[j] = xr[64 * j];
        if (xs) {
#pragma unroll
            for (int p = 0; p < 8; ++p) if (p < nxs) v[j] += ((const f32x4*)(xs + p * xs_stride))[64 * j + lane];
            if (xout) ((f32x4*)xout)[64 * j + lane] = v[j]; }
        s += (v[j].x * v[j].x + v[j].y * v[j].y) + (v[j].z * v[j].z + v[j].w * v[j].w); }
    const float rstd = 1.0f / sqrtf(wave_sum(s) * (1.0f / DM) + EPS);
    u32x2* o8 = (u32x2*)orow + lane;
#pragma unroll
    for (int j = 0; j < 8; ++j) { const f32x4 gg = ((const f32x4*)g)[64 * j + lane], ss = ((const f32x4*)sc)[64 * j + lane], hh = ((const f32x4*)sh)[64 * j + lane];
        v[j] = v[j] * rstd * gg * (ss + 1.0f) + hh;
        if constexpr (OUT8) ((unsigned*)orow)[64 * j + lane] = pk4_fp8(v[j].x * S_H8, v[j].y * S_H8, v[j].z * S_H8, v[j].w * S_H8);
        else { u32x2 w; w.x = cvt_pk_bf16(v[j].x, v[j].y); w.y = cvt_pk_bf16(v[j].z, v[j].w); o8[64 * j] = w; } }
}
__device__ __forceinline__ const float* in_row(const float* x, const float* ctx, int row) {
    const int b = row / RPB, t = row % RPB;
    return t < SEQ ? x + ((size_t)b * SEQ + t) * DM : ctx + ((size_t)b * NCTX + (t - SEQ)) * DM;
}

__device__ __forceinline__ void rope8(float (&f)[8], const float* cs, const float* sn) {
    const f32x4 c = *(const f32x4*)cs, s = *(const f32x4*)sn;
#pragma unroll
    for (int p = 0; p < 4; ++p) { const float x0 = f[2 * p], x1 = f[2 * p + 1]; f[2 * p] = x0 * c[p] - x1 * s[p]; f[2 * p + 1] = x0 * s[p] + x1 * c[p]; }
}
__device__ __forceinline__ void unpack8(const u32x4 w, float (&f)[8]) { f[0] = bf_lo(w.x); f[1] = bf_hi(w.x); f[2] = bf_lo(w.y); f[3] = bf_hi(w.y); f[4] = bf_lo(w.z); f[5] = bf_hi(w.z); f[6] = bf_lo(w.w); f[7] = bf_hi(w.w); }
__device__ __forceinline__ u32x4 pack8(const float (&f)[8]) { u32x4 w; w.x = cvt_pk_bf16(f[0], f[1]); w.y = cvt_pk_bf16(f[2], f[3]); w.z = cvt_pk_bf16(f[4], f[5]); w.w = cvt_pk_bf16(f[6], f[7]); return w; }
template <bool NORM, int ROPE_DIM>
__device__ __forceinline__ void fix_span(bf16_t* rowp, int col0, int nvec, const float* g, const float* cosT, const float* sinT, int lane) {
    for (int v = lane; v < nvec; v += 64) {
        const int e0 = v * 8;
        u32x4 w = *(u32x4*)(rowp + col0 + e0); float f[8]; unpack8(w, f);
        if constexpr (NORM) {
            float s = 0.f;
#pragma unroll
            for (int i = 0; i < 8; ++i) s += f[i] * f[i];
            s += __shfl_xor(s, 1); s += __shfl_xor(s, 2); s += __shfl_xor(s, 4); s += __shfl_xor(s, 8);
            const float rstd = 1.0f / sqrtf(s * (1.0f / 128.0f) + EPS);
            const f32x4 g0 = *(const f32x4*)(g + (e0 & 127)), g1 = *(const f32x4*)(g + (e0 & 127) + 4);
#pragma unroll
            for (int i = 0; i < 4; ++i) { f[i] = f[i] * rstd * g0[i]; f[4 + i] = f[4 + i] * rstd * g1[i]; }
        }
        if constexpr (ROPE_DIM == 64) { const int p0 = (e0 & 63) >> 1; rope8(f, cosT + p0, sinT + p0); }
        if constexpr (ROPE_DIM == 128) { const int p0 = (e0 & 127) >> 1; rope8(f, cosT + p0, sinT + p0); }
        *(u32x4*)(rowp + col0 + e0) = pack8(f);
    }
}

__global__ void __launch_bounds__(512, 2) hybrid_fwd(Args args) {
    extern __shared__ __attribute__((aligned(16))) unsigned char lds[];
    Frame F;
    F.lds = (LAS unsigned char*)lds;
    F.G = gridDim.x; { const int bx = blockIdx.x; F.vcu = (F.G % 8 == 0) ? (bx % 8) * (F.G / 8) + bx / 8 : bx; }
    volatile LAS unsigned* MISC = (volatile LAS unsigned*)(F.lds + MISC_OFF);
    unsigned char* ws = args.ws;
    gu32* ctl = (gu32*)(ws + WS_CTL);
    for (int u = threadIdx.x; u < 64; u += 512) MISC[u] = 0u;
    __syncthreads();
    XcdBarrier bar; bar.bar = (unsigned*)(ctl + CW_BAR); bar.x = 0; bar.st = nullptr;
#if !MK_PER_PHASE
    bar = xcd_barrier_post((unsigned*)(ctl + CW_BAR), MISC + 8);
#define GRID_BAR() xcd_barrier(bar)
#else
#define GRID_BAR() do { } while (0)
#endif
    const int lo = args.ph_lo, hi = args.ph_hi;
#ifndef PH_MASK
#define PH_MASK 0xFFFFFu
#endif
#define IN(k) ((((PH_MASK) >> (k)) & 1u) && lo <= (k) && (k) < hi)
#ifndef DBL_MASK
#define DBL_MASK 0u
#endif
#define NREP(k) ((((DBL_MASK) >> (k)) & 1u) ? 2 : 1)
#define SEAM(k) do { if (IN(k) && IN((k) + 1)) GRID_BAR(); } while (0)

#define MODS ((float*)(ws + WS_MODS))
#define ADAP ((float*)(ws + WS_ADAP))
#define cosA ((float*)(ws + WS_ROPE))
#define sinA (cosA + 4096 * 32)
#define cosB (cosA + 2 * 4096 * 32)
#define sinB (cosA + 2 * 4096 * 32 + 4096 * 64)
#define ROUTE ((int*)(ws + WS_ROUTE))
#define GATES ((float*)(ws + WS_GATES))
#define SLOT ((int*)(ws + WS_SLOT))
#define CNT ((int*)(ws + WS_CNT))
#define TILEE ((int*)(ws + WS_TILEE))
#define W_IN0 ((bf16_t*)(ws + WS_WIN0))
#define W_OUT0 ((bf16_t*)(ws + WS_WOUT0))
#define W_GU0 ((bf16_t*)(ws + WS_WGU0))
#define W_DN0 ((bf16_t*)(ws + WS_WDN0))
#define W_IN1 ((bf16_t*)(ws + WS_WIN1))
#define W_OUT1 ((bf16_t*)(ws + WS_WOUT1))
#define W_GU1 ((bf16_t*)(ws + WS_WGU1))
#define W_DN1 ((bf16_t*)(ws + WS_WDN1))
#define XR ((float*)(ws + WS_XR))
#define H ((bf16_t*)(ws + WS_H))
#define AO ((bf16_t*)(ws + WS_AO))
#define Y ((bf16_t*)(ws + WS_Y))
#define QKV ((bf16_t*)(ws + WS_QKV))
#define XG ((bf16_t*)(ws + WS_XG))
#define MID ((bf16_t*)(ws + WS_MID))
#define MODS1 (MODS + 5 * 12288)
#define SLAB0 ((float*)(ws + WS_SLAB0))
#define SLAB1 ((float*)(ws + WS_SLAB1))
#define SLABW ((float*)(ws + WS_SLABW))
#define x_in (args.in[0])
#define c_in (args.in[1])
#define ctx_in (args.in[2])
#define cctx_in (args.in[3])
    const int NGW = F.G * 8;
#define PH_LOCALS const int tid = fresh_tid(), lane = tid & 63, wave = __builtin_amdgcn_readfirstlane(tid >> 6), gw = F.vcu * 8 + wave; (void)tid; (void)lane; (void)wave; (void)gw

    if (IN(0)) for (int rep_ = 0; rep_ < NREP(0); ++rep_) {
        PH_LOCALS;
        LAS float* scr = (LAS float*)(F.lds + wave * 16384);
        LAS float* sil = (LAS float*)(F.lds + 98304);
        __syncthreads();
        for (int i = tid; i < 5 * DM; i += 512) { const float v = (i < 4 * DM) ? c_in[i] : cctx_in[i - 4 * DM]; sil[i] = v / (1.0f + __expf(-v)); }
        __syncthreads();
        for (int it = gw; it < 2 * 48 * 32; it += NGW) {
            const int l = it / (48 * 32), r = it % (48 * 32), cg = r / 32, kc = r % 32;
            const float* W = args.in[l ? 22 : 6] + (size_t)(kc * 64) * 12288 + cg * 256 + lane * 4;
            f32x4 a[5];
#pragma unroll
            for (int b = 0; b < 5; ++b) a[b] = (f32x4){0.f, 0.f, 0.f, 0.f};
#pragma unroll 8
            for (int k = 0; k < 64; ++k) { const f32x4 w = *(const f32x4*)(W + (size_t)k * 12288);
#pragma unroll
                for (int b = 0; b < 5; ++b) a[b] += w * sil[b * DM + kc * 64 + k]; }
#pragma unroll
            for (int b = 0; b < 5; ++b) *(f32x4*)(ADAP + ((size_t)(l * 32 + kc) * 5 + b) * 12288 + cg * 256 + lane * 4) = a[b];
        }
        __syncthreads();
        {
            constexpr int I_IN = (DM / 64) * (PROJ / 32), I_OUT = (DM / 64) * (DM / 32);
            constexpr int I_GU = (FFN0_FP8 == 2) ? (DM / 128) * (DFF / 32) : (DM / 64) * (DFF / 32), I_DN = (FFN0_FP8 >= 1) ? (DFF / 128) * (DM / 32) : (DFF / 64) * (DM / 32);
            constexpr int I_EGU = (DM / 128) * (DEX / 32), I_EDN = (DEX / 128) * (DM / 32);
            constexpr int I_IN8 = (DM / 128) * (PROJ / 32), I_OUT8 = (DM / 128) * (DM / 32);
            constexpr int NIT = I_IN + (L1ATT_FP8 ? I_IN8 : I_IN) + I_OUT + (L1ATT_FP8 ? I_OUT8 : I_OUT) + 2 * I_GU + I_DN;
            for (int it = gw; it < NIT; it += NGW) {
                int r = it;
                if (r < I_IN) { tr_plain(args.in[8], DM, PROJ, W_IN0, 0, scr, r, lane); continue; } r -= I_IN;
#if L1ATT_FP8
                if (r < I_IN8) { tr_plain8(args.in[24], DM, PROJ, (unsigned char*)W_IN1, 0, scr, r, lane); continue; } r -= I_IN8;
#else
                if (r < I_IN) { tr_plain(args.in[24], DM, PROJ, W_IN1, 0, scr, r, lane); continue; } r -= I_IN;
#endif
                if (r < I_OUT) { tr_plain(args.in[9], DM, DM, W_OUT0, 0, scr, r, lane); continue; } r -= I_OUT;
#if L1ATT_FP8
                if (r < I_OUT8) { tr_plain8(args.in[25], DM, DM, (unsigned char*)W_OUT1, 0, scr, r, lane); continue; } r -= I_OUT8;
#else
                if (r < I_OUT) { tr_plain(args.in[25], DM, DM, W_OUT1, 0, scr, r, lane); continue; } r -= I_OUT;
#endif
#if FFN0_FP8 == 2
                if (r < I_GU) { tr_gu8(args.in[17], DM, DFF, (unsigned char*)W_GU0, 0, 0, scr, r, lane); continue; } r -= I_GU;
                if (r < I_GU) { tr_gu8(args.in[18], DM, DFF, (unsigned char*)W_GU0, 0, 1, scr, r, lane); continue; } r -= I_GU;
#else
                if (r < I_GU) { tr_gu(args.in[17], DM, DFF, W_GU0, 0, 0, scr, r, lane); continue; } r -= I_GU;
                if (r < I_GU) { tr_gu(args.in[18], DM, DFF, W_GU0, 0, 1, scr, r, lane); continue; } r -= I_GU;
#endif
#if FFN0_FP8 >= 1
                if (r < I_DN) { tr_plain8(args.in[19], DFF, DM, (unsigned char*)W_DN0, 0, scr, r, lane); continue; } r -= I_DN;
#else
                if (r < I_DN) { tr_plain(args.in[19], DFF, DM, W_DN0, 0, scr, r, lane); continue; } r -= I_DN;
#endif
            }
            constexpr int NITX = NE * (2 * I_EGU + I_EDN);
            const float* wp; int ldw; unsigned char* wt; int Kb;
#define XDECODE(IT, WP, LDW, WT, KB) do { int r_ = (IT); const int e_ = r_ / (2 * I_EGU + I_EDN); r_ -= e_ * (2 * I_EGU + I_EDN); \
                if (r_ < 2 * I_EGU) { const int up_ = r_ >= I_EGU; r_ -= up_ * I_EGU; const int nblk_ = DEX / 32, kb_ = r_ / nblk_, n0_ = 32 * (r_ % nblk_); \
                    WP = args.in[29 + up_] + (size_t)e_ * DM * DEX + (size_t)(128 * kb_ + (lane >> 5)) * DEX + n0_ + (lane & 31); LDW = DEX; KB = DM; \
                    WT = (unsigned char*)W_GU1 + ((size_t)e_ * 2 * DEX + (size_t)(n0_ >> 7) * 256 + (n0_ & 127) + up_ * 128) * DM + 128 * kb_; } \
                else { r_ -= 2 * I_EGU; const int nblk_ = DM / 32, kb_ = r_ / nblk_, n0_ = 32 * (r_ % nblk_); \
                    WP = args.in[31] + (size_t)e_ * DEX * DM + (size_t)(128 * kb_ + (lane >> 5)) * DM + n0_ + (lane & 31); LDW = DM; KB = DEX; \
                    WT = (unsigned char*)W_DN1 + ((size_t)e_ * DM + n0_) * DEX + 128 * kb_; } } while (0)
#define XLOAD(T, WP, LDW, HB) do { _Pragma("unroll") for (int i_ = 0; i_ < 32; ++i_) T[i_] = (WP)[(size_t)(64 * (HB) + 2 * i_) * (LDW)]; } while (0)
#define XWRITE(T, HB) do { _Pragma("unroll") for (int i_ = 0; i_ < 32; ++i_) { const int kk_ = 64 * (HB) + 2 * i_ + (lane >> 5); scr[kk_ * 32 + (((lane & 31) + 8 * (kk_ >> 4)) & 31)] = T[i_]; } } while (0)
            float ta[32], tb[32];
            int itx = gw;
            if (itx < NITX) { XDECODE(itx, wp, ldw, wt, Kb); XLOAD(ta, wp, ldw, 0); }
            while (itx < NITX) {
                XLOAD(tb, wp, ldw, 1);
                XWRITE(ta, 0);
                unsigned char* wt_c = wt; const int Kb_c = Kb;
                const int nxt = itx + NGW;
                if (nxt < NITX) { XDECODE(nxt, wp, ldw, wt, Kb); XLOAD(ta, wp, ldw, 0); }
                XWRITE(tb, 1);
                LDS_WAIT(); asm volatile("" ::: "memory");
                { const int c = lane & 7;
#pragma unroll
                  for (int j = 0; j < 4; ++j) { const int n = (lane >> 3) + 8 * j; const LAS float* sp = scr + (16 * c) * 32 + ((n + 8 * c) & 31);
                      u32x4 o;
                      o.x = pk4_fp8(sp[0 * 32] * S_W8, sp[1 * 32] * S_W8, sp[2 * 32] * S_W8, sp[3 * 32] * S_W8); o.y = pk4_fp8(sp[4 * 32] * S_W8, sp[5 * 32] * S_W8, sp[6 * 32] * S_W8, sp[7 * 32] * S_W8);
                      o.z = pk4_fp8(sp[8 * 32] * S_W8, sp[9 * 32] * S_W8, sp[10 * 32] * S_W8, sp[11 * 32] * S_W8); o.w = pk4_fp8(sp[12 * 32] * S_W8, sp[13 * 32] * S_W8, sp[14 * 32] * S_W8, sp[15 * 32] * S_W8);
                      *(GAS u32x4*)(wt_c + (size_t)n * Kb_c + 16 * c) = o; } }
                LDS_WAIT(); asm volatile("" ::: "memory");
                itx = nxt;
            }
#undef XDECODE
#undef XLOAD
#undef XWRITE
        }
    }
    SEAM(0);
    if (IN(1)) for (int rep_ = 0; rep_ < NREP(1); ++rep_) {
        PH_LOCALS;
        for (int i = blockIdx.x * 512 + tid; i < 2 * 5 * 12288; i += F.G * 512) {
            const int l = i / (5 * 12288), r = i % (5 * 12288), b = r / 12288, j = r % 12288;
            float s = args.in[l ? 23 : 7][j];
            for (int kc = 0; kc < 32; ++kc) s += ADAP[((size_t)(l * 32 + kc) * 5 + b) * 12288 + j];
            MODS[i] = s;
        }
        if (blockIdx.x == 0 && wave == 0) {
            const float a = wave_sum(args.in[10][lane] * args.in[11][lane]), b = wave_sum(args.in[12][lane] * args.in[13][lane]);
            if (lane == 0) MODS[2 * 5 * 12288] = expf(a) - expf(b) + LAMBDA_INIT;
        }
    }
    SEAM(1);
    if (IN(2)) for (int rep_ = 0; rep_ < NREP(2); ++rep_) {
        PH_LOCALS;
        for (int row = gw; row < MROWS; row += NGW) {
            const int b = row / RPB, t = row % RPB; const float* md = MODS + (size_t)(t < SEQ ? b : 4) * 12288;
            f32x4 v[8]; mod_row(in_row(x_in, ctx_in, row), args.in[4], md + 0 * DM, md + 1 * DM, H + (size_t)row * DM, lane, v);
        }
    }
    SEAM(2);
    if (IN(3)) for (int rep_ = 0; rep_ < NREP(3); ++rep_) {
        PH_LOCALS;
        pg8::Gemm g{H, W_IN0, DM}; pg8::Order<pg8::MapId> S; S.init(MROWS / 256, PROJ / 256, F.G, (int)blockIdx.x, pg8::MapId{}, DM / 64);
        { LAS float* gl = (LAS float*)(F.lds + RING_BYTES) + 2048; if (tid < 256) gl[tid] = tid < 128 ? args.in[15][tid] : args.in[16][tid - 128]; __syncthreads(); }
        pg8::EpiQKV<0> E{QKV, cosA, sinA, cosB, sinB, args.in[15], args.in[16], (LAS float*)(F.lds + RING_BYTES), 1.0f};
        pg8::gemm_phase(F.lds, g, S, E);
    }
    SEAM(3);
    if (IN(5)) for (int rep_ = 0; rep_ < NREP(5); ++rep_) {
        PH_LOCALS;
        const float lam = MODS[2 * 5 * 12288];
        for (int k = F.vcu; k < 256; k += F.G) {
            for (int i = 0; i < 3; ++i) {
                int b, h, qt;
                if (i < 2) { const int u = 2 * k + i; b = u >> 7; h = (u >> 4) & 7; qt = u & 15; } else { if (k >= 32) break; b = k >> 3; h = k & 7; qt = 16; }
                const size_t rb = (size_t)b * RPB;
                const att::TileMap tm = (qt < 16) ? att::TileMap{0, 0, 0, 68} : att::TileMap{0, 0, SEQ, 4};
#ifndef NO_DIFF
                att::unit_diff(QKV + (rb + qt * 256) * PROJ + h * 128, QKV + rb * PROJ + 2048 + h * 128, QKV + rb * PROJ + 3072 + h * 128, tm, lam, args.in[14],
                               AO + (rb + qt * 256) * DM + h * 128, (char*)lds);
#endif
            }
            for (int i = 0; i < 3; ++i) {
                int b, h, qt;
                if (i < 2) { const int u = 2 * k + i; b = u >> 7; h = (u >> 4) & 7; qt = u & 15; } else { if (k < 32 || k >= 64) break; b = (k - 32) >> 3; h = k & 7; qt = 16; }
                const size_t rb = (size_t)b * RPB; const int kv = h >> 2;
                const att::TileMap tm = (qt < 16) ? att::TileMap{0, 0, 0, 68} : att::TileMap{0, 0, SEQ, 4};
#ifndef NO_STD0
                att::unit_std<0>(QKV + (rb + qt * 256) * PROJ + 1024 + h * 128, QKV + rb * PROJ + 4096 + kv * 128, QKV + rb * PROJ + 4352 + kv * 128, tm, att::MaskInfo{0, 0, 0}, 0.f,
                                 AO + (rb + qt * 256) * DM + 1024 + h * 128, (char*)lds);
#endif
            }
        }
    }
    SEAM(5);
    if (IN(6)) for (int rep_ = 0; rep_ < NREP(6); ++rep_) {
        PH_LOCALS;
        pg8::Gemm g{AO, W_OUT0, DM}; pg8::Order<pg8::MapL0Split> S; S.init(NTOK / 256, DM / 256, F.G, (int)blockIdx.x, pg8::MapL0Split{}, DM / 64, 4, 8);
        pg8::EpiResid E{x_in, ctx_in, XR, MODS, 2, 1, SLABW, 1.0f};
        pg8::gemm_phase<pg8::EpiResid, pg8::Order<pg8::MapL0Split>>(F.lds, g, S, E);
    }
    SEAM(6);
    if (IN(7)) for (int rep_ = 0; rep_ < NREP(7); ++rep_) {
        PH_LOCALS;
        for (int row = gw; row < MROWS; row += NGW) {
            const int b = row / RPB, t = row % RPB; const float* md = MODS + (size_t)(t < SEQ ? b : 4) * 12288;
#if FFN0_FP8 == 2
            f32x4 v[8]; mod_row<true>(t < SEQ ? XR + (size_t)row * DM : in_row(x_in, ctx_in, row), args.in[5], md + 3 * DM, md + 4 * DM, (bf16_t*)((unsigned char*)H + (size_t)row * DM), lane, v,
                                      t < SEQ ? nullptr : SLABW + ((size_t)b * NCTX + (t - SEQ)) * DM, (size_t)NB * NCTX * DM, 8, XR + (size_t)row * DM);
#else
            f32x4 v[8]; mod_row(t < SEQ ? XR + (size_t)row * DM : in_row(x_in, ctx_in, row), args.in[5], md + 3 * DM, md + 4 * DM, H + (size_t)row * DM, lane, v,
                                t < SEQ ? nullptr : SLABW + ((size_t)b * NCTX + (t - SEQ)) * DM, (size_t)NB * NCTX * DM, 8, XR + (size_t)row * DM);
#endif
        }
    }
    SEAM(7);
    if (IN(8)) for (int rep_ = 0; rep_ < NREP(8); ++rep_) {
        PH_LOCALS;
#if FFN0_FP8 == 2
        pg8::Gemm g{H, W_GU0, DM / 2}; pg8::Order<pg8::MapId> S; S.init(MROWS / 256, 2 * DFF / 256, F.G, (int)blockIdx.x, pg8::MapId{}, DM / 128);
        pg8::EpiSwiGLU8 E{(unsigned char*)MID, DFF, 2 * DFF / 256, 1.0f / (S_H8 * S_W8), S_M8 / (S_H8 * S_W8)};
        pg8::gemm_phase<pg8::EpiSwiGLU8, pg8::Order<pg8::MapId>, true>(F.lds, g, S, E);
#elif FFN0_FP8 == 1
        pg8::Gemm g{H, W_GU0, DM}; pg8::Order<pg8::MapId> S; S.init(MROWS / 256, 2 * DFF / 256, F.G, (int)blockIdx.x, pg8::MapId{}, DM / 64);
        pg8::EpiSwiGLU8 E{(unsigned char*)MID, DFF, 2 * DFF / 256, 1.0f, S_M8};
        pg8::gemm_phase(F.lds, g, S, E);
#else
        pg8::Gemm g{H, W_GU0, DM}; pg8::Order<pg8::MapId> S; S.init(MROWS / 256, 2 * DFF / 256, F.G, (int)blockIdx.x, pg8::MapId{}, DM / 64);
        pg8::EpiSwiGLU E{MID, DFF, 2 * DFF / 256};
        pg8::gemm_phase(F.lds, g, S, E);
#endif
    }
    SEAM(8);
    if (IN(9)) for (int rep_ = 0; rep_ < NREP(9); ++rep_) {
        PH_LOCALS;
#if FFN0_FP8 >= 1
        pg8::Gemm g{MID, W_DN0, DFF / 2}; pg8::Order<pg8::MapL0Split> S; S.init(NTOK / 256, DM / 256, F.G, (int)blockIdx.x, pg8::MapL0Split{}, DFF / 128, 4, NS0);
        pg8::EpiResid E{x_in, ctx_in, XR, MODS, 5, 0, SLAB0, 1.0f / (S_M8 * S_W8)};
        pg8::gemm_phase<pg8::EpiResid, pg8::Order<pg8::MapL0Split>, true>(F.lds, g, S, E);
#else
        pg8::Gemm g{MID, W_DN0, DFF}; pg8::Order<pg8::MapL0Split> S; S.init(NTOK / 256, DM / 256, F.G, (int)blockIdx.x, pg8::MapL0Split{}, DFF / 64, 4, NS0);
        pg8::EpiResid E{x_in, ctx_in, XR, MODS, 5, 0, SLAB0, 1.0f};
        pg8::gemm_phase(F.lds, g, S, E);
#endif
    }
    SEAM(9);
    if (IN(10)) for (int rep_ = 0; rep_ < NREP(10); ++rep_) {
        PH_LOCALS;
        for (int row = gw; row < MROWS; row += NGW) {
            const int b = row / RPB, t = row % RPB; const float* md = MODS1 + (size_t)(t < SEQ ? b : 4) * 12288;
#if L1ATT_FP8
            f32x4 v[8]; mod_row<true>(XR + (size_t)row * DM, args.in[20], md + 0 * DM, md + 1 * DM, (bf16_t*)((unsigned char*)H + (size_t)row * DM), lane, v, t < SEQ ? nullptr : SLAB0 + ((size_t)b * NCTX + (t - SEQ)) * DM, (size_t)NB * NCTX * DM, NS0);
#else
            f32x4 v[8]; mod_row(XR + (size_t)row * DM, args.in[20], md + 0 * DM, md + 1 * DM, H + (size_t)row * DM, lane, v, t < SEQ ? nullptr : SLAB0 + ((size_t)b * NCTX + (t - SEQ)) * DM, (size_t)NB * NCTX * DM, NS0);
#endif
        }
    }
    SEAM(10);
    if (IN(11)) for (int rep_ = 0; rep_ < NREP(11); ++rep_) {
        PH_LOCALS;
        pg8::Gemm g{H, W_IN1, L1ATT_FP8 ? DM / 2 : DM}; pg8::Order<pg8::MapId> S; S.init(MROWS / 256, PROJ / 256, F.G, (int)blockIdx.x, pg8::MapId{}, L1ATT_FP8 ? DM / 128 : DM / 64);
#if L1ATT_FP8
        pg8::EpiQKV<1> E{QKV, cosA, sinA, cosB, sinB, nullptr, nullptr, (LAS float*)(F.lds + RING_BYTES), 1.0f / (S_H8 * S_W8)};
        pg8::gemm_phase<pg8::EpiQKV<1>, pg8::Order<pg8::MapId>, true>(F.lds, g, S, E);
#else
        pg8::EpiQKV<1> E{QKV, cosA, sinA, cosB, sinB, nullptr, nullptr, (LAS float*)(F.lds + RING_BYTES), 1.0f};
        pg8::gemm_phase(F.lds, g, S, E);
#endif
    }
    SEAM(11);
    if (IN(13)) for (int rep_ = 0; rep_ < NREP(13); ++rep_) {
        PH_LOCALS;
        float* btab = (float*)(lds + att::OFF_BIAS);
        for (int k = F.vcu; k < 256; k += F.G) {
            for (int i = 0; i < 2; ++i) {
                const int u = 2 * k + i, b = u >> 7, h = (u >> 4) & 7, qt = u & 15, kv = h >> 2; const size_t rb = (size_t)b * RPB;
                const int q0 = qt * 256, ks = (q0 - 128) < 0 ? 0 : (q0 - 128), ke = (q0 + 384) > SEQ ? SEQ : (q0 + 384);
                const att::TileMap tm{4, SEQ, ks, 4 + (ke - ks) / 64};
#ifndef NO_WIN
                att::unit_std<1>(QKV + (rb + q0) * PROJ + h * 128, QKV + rb * PROJ + 2048 + kv * 128, QKV + rb * PROJ + 2304 + kv * 128, tm, att::MaskInfo{q0, 0, 0}, args.in[26][h],
                                 L1ATT_FP8 ? (bf16_t*)((unsigned char*)AO + (rb + q0) * DM + h * 128) : AO + (rb + q0) * DM + h * 128, (char*)lds);
#endif
            }
            for (int i = 0; i < 2; ++i) {
                const int u = 2 * k + i, b = u >> 7, h = (u >> 4) & 7, qt = u & 15; const size_t rb = (size_t)b * RPB;
                const int r0 = qt * 4; int lo_ = r0 - 4; lo_ = lo_ < 0 ? 0 : (lo_ > 52 ? 52 : lo_);
                for (int j = tid; j < 15 * 31; j += 512) btab[j] = args.in[27][h * 465 + j] * (1.0f / ATT_SCALE);
                __syncthreads();
                const att::TileMap tm{4, SEQ, lo_ * 64, 16};
#ifndef NO_NA
                att::unit_std<2>(QKV + (rb + qt * 256) * PROJ + 1024 + h * 128, QKV + rb * PROJ + 2560 + h * 128, QKV + rb * PROJ + 3584 + h * 128, tm, att::MaskInfo{0, r0, lo_}, 0.f,
                                 L1ATT_FP8 ? (bf16_t*)((unsigned char*)AO + (rb + qt * 256) * DM + 1024 + h * 128) : AO + (rb + qt * 256) * DM + 1024 + h * 128, (char*)lds);
#endif
            }
        }
    }
    SEAM(13);
    if (IN(14)) for (int rep_ = 0; rep_ < NREP(14); ++rep_) {
        PH_LOCALS;
#if L1ATT_FP8
        pg8::Gemm g{AO, W_OUT1, DM / 2}; pg8::Order<pg8::MapLatent> S; S.init(NTOK / 256, DM / 256, F.G, (int)blockIdx.x, pg8::MapLatent{}, DM / 128);
        pg8::EpiResid E{x_in, ctx_in, XR, MODS1, 2, 0, nullptr, 1.0f / (S_A8 * S_W8)};
        pg8::gemm_phase<pg8::EpiResid, pg8::Order<pg8::MapLatent>, true>(F.lds, g, S, E);
#else
        pg8::Gemm g{AO, W_OUT1, DM}; pg8::Order<pg8::MapLatent> S; S.init(NTOK / 256, DM / 256, F.G, (int)blockIdx.x, pg8::MapLatent{}, DM / 64);
        pg8::EpiResid E{x_in, ctx_in, XR, MODS1, 2, 0, nullptr, 1.0f};
        pg8::gemm_phase(F.lds, g, S, E);
#endif
    }
    SEAM(14);
    if (IN(15)) for (int rep_ = 0; rep_ < NREP(15); ++rep_) {
        PH_LOCALS;
        LAS float* wt = (LAS float*)F.lds;
        LAS int* ce = (LAS int*)(F.lds + 65536);
        for (int i = tid; i < DM * NE; i += 512) { const int kk = i >> 3, e = i & 7; wt[e * DM + kk] = args.in[28][i]; }
        __syncthreads();
        for (int chunk = blockIdx.x; chunk < NTOK / 64; chunk += F.G) {
            for (int i = 0; i < 8; ++i) {
                const int tl = wave * 8 + i, n = chunk * 64 + tl, b = n >> 12, t = n & 4095, row = b * RPB + t;
                const float* md = MODS1 + (size_t)b * 12288;
                f32x4 v[8]; mod_row<true>(XR + (size_t)row * DM, args.in[21], md + 3 * DM, md + 4 * DM, (bf16_t*)((unsigned char*)H + (size_t)row * DM), lane, v);
                float lg[8];
#pragma unroll
                for (int e = 0; e < 8; ++e) { float s = 0.f;
#pragma unroll
                    for (int j = 0; j < 8; ++j) { const f32x4 w = *(const LAS f32x4*)(wt + e * DM + 256 * j + 4 * lane); s += (v[j].x * w.x + v[j].y * w.y) + (v[j].z * w.z + v[j].w * w.w); }
                    lg[e] = wave_sum(s); }
                int e0 = 0; float l0 = lg[0];
#pragma unroll
                for (int e = 1; e < 8; ++e) if (lg[e] > l0) { l0 = lg[e]; e0 = e; }
                int e1 = -1; float l1 = -3.4e38f;
#pragma unroll
                for (int e = 0; e < 8; ++e) if (e != e0 && lg[e] > l1) { l1 = lg[e]; e1 = e; }
                if (lane == 0) { ce[tl * 2] = e0; ce[tl * 2 + 1] = e1; const float g1 = 1.0f / (1.0f + expf(l0 - l1)); GATES[n * 2] = 1.0f - g1; GATES[n * 2 + 1] = g1; }
            }
            __syncthreads();
            if (wave == 0) {
                const int e0 = ce[lane * 2], e1 = ce[lane * 2 + 1]; int rk0 = 0, rk1 = 0;
                const unsigned long long below = (1ull << lane) - 1ull;
#pragma unroll
                for (int e = 0; e < 8; ++e) {
                    const unsigned long long m0 = __ballot(e0 == e), m1 = __ballot(e1 == e);
                    const int c0 = __popcll(m0);
                    if (e0 == e) rk0 = __popcll(m0 & below);
                    if (e1 == e) rk1 = c0 + __popcll(m1 & below);
                    if (lane == 0) CNT[chunk * 8 + e] = c0 + __popcll(m1);
                }
                const int n = chunk * 64 + lane;
                ROUTE[n * 4 + 0] = e0; ROUTE[n * 4 + 1] = e1; ROUTE[n * 4 + 2] = rk0; ROUTE[n * 4 + 3] = rk1;
            }
            __syncthreads();
        }
    }
    SEAM(15);
    if (IN(16)) for (int rep_ = 0; rep_ < NREP(16); ++rep_) {
        PH_LOCALS;
        LAS int* tot = (LAS int*)F.lds; LAS int* pre = tot + 8; LAS int* base = tot + 16;
        for (int chunk = blockIdx.x; chunk < NTOK / 64; chunk += F.G) {
            { const int e = wave; int a = 0, p = 0;
#pragma unroll
              for (int i = 0; i < 4; ++i) { const int c = 4 * lane + i; const int v = CNT[c * 8 + e]; a += v; p += (c < chunk) ? v : 0; }
              a = (int)wave_sum((float)a); p = (int)wave_sum((float)p);
              if (lane == 0) { tot[e] = a; pre[e] = p; } }
            __syncthreads();
            if (tid == 0) { int s = 0; for (int e = 0; e < 8; ++e) { base[e] = s; s += (tot[e] + 255) / 256 * 256; } base[8] = s; }
            __syncthreads();
            if (chunk == 0 && tid < CAP_TILES + 1) {
                const int ntile = base[8] / 256;
                if (tid == CAP_TILES) TILEE[CAP_TILES] = ntile;
                else { int e = 0; for (int q = 1; q < 8; ++q) if (tid * 256 >= base[q]) e = q; TILEE[tid] = e; }
            }
            for (int i = 0; i < 8; ++i) {
                const int tl = wave * 8 + i, n = chunk * 64 + tl, b = n >> 12, t = n & 4095, row = b * RPB + t;
                const int e0 = ROUTE[n * 4 + 0], e1 = ROUTE[n * 4 + 1], rk0 = ROUTE[n * 4 + 2], rk1 = ROUTE[n * 4 + 3];
                const int s0 = base[e0] + pre[e0] + rk0, s1 = base[e1] + pre[e1] + rk1;
                if (lane == 0) { SLOT[n * 2] = s0; SLOT[n * 2 + 1] = s1; }
                const u32x4* src = (const u32x4*)((const unsigned char*)H + (size_t)row * DM) + lane;
                u32x4* d0 = (u32x4*)((unsigned char*)XG + (size_t)s0 * DM) + lane; u32x4* d1 = (u32x4*)((unsigned char*)XG + (size_t)s1 * DM) + lane;
#pragma unroll
                for (int j = 0; j < 2; ++j) { const u32x4 w = src[64 * j]; d0[64 * j] = w; d1[64 * j] = w; }
            }
            __syncthreads();
        }
    }
    SEAM(16);
    if (IN(17)) for (int rep_ = 0; rep_ < NREP(17); ++rep_) {
        PH_LOCALS;
        const int ntile = TILEE[CAP_TILES];
        pg8::Gemm g{XG, W_GU1, DM / 2}; pg8::Order<pg8::MapMoe> S; S.init(ntile, 2 * DEX / 256, F.G, (int)blockIdx.x, pg8::MapMoe{TILEE, 2 * DEX / 256}, DM / 128);
        pg8::EpiSwiGLU8 E{(unsigned char*)MID, DEX, 2 * DEX / 256, 1.0f / (S_H8 * S_W8), S_M8 / (S_H8 * S_W8)};
        pg8::gemm_phase<pg8::EpiSwiGLU8, pg8::Order<pg8::MapMoe>, true>(F.lds, g, S, E);
    }
    SEAM(17);
    if (IN(18)) for (int rep_ = 0; rep_ < NREP(18); ++rep_) {
        PH_LOCALS;
        const int ntile = TILEE[CAP_TILES];
        pg8::Gemm g{MID, W_DN1, DEX / 2}; pg8::Order<pg8::MapMoe> S; S.init(ntile < 128 ? ntile : 128, DM / 256, F.G, (int)blockIdx.x, pg8::MapMoe{TILEE, DM / 256}, DEX / 128, ntile < 128 ? 0 : ntile - 128, 4);
        pg8::EpiBf16 E{Y, DM, DM / 256, 1.0f / (S_M8 * S_W8), SLAB1};
        pg8::gemm_phase<pg8::EpiBf16, pg8::Order<pg8::MapMoe>, true>(F.lds, g, S, E);
    }
    SEAM(18);
    if (IN(19)) for (int rep_ = 0; rep_ < NREP(19); ++rep_) {
        PH_LOCALS;
        for (int n = gw; n < NTOK; n += NGW) {
            const int b = n >> 12, t = n & 4095, row = b * RPB + t;
            const int s0 = SLOT[n * 2], s1 = SLOT[n * 2 + 1]; const float g0 = GATES[n * 2], g1 = GATES[n * 2 + 1];
            const float* gt = MODS1 + (size_t)b * 12288 + 5 * DM;
            const f32x4* xr = (const f32x4*)(XR + (size_t)row * DM) + lane;
            f32x4 v[8]; float s = 0.f;
#pragma unroll
            for (int j = 0; j < 8; ++j) { f32x4 ya, yb;
                if (s0 < 128 * 256) { const u32x2 a = ((const u32x2*)(Y + (size_t)s0 * DM))[64 * j + lane]; ya = (f32x4){bf_lo(a.x), bf_hi(a.x), bf_lo(a.y), bf_hi(a.y)}; }
                else { ya = (f32x4){0.f, 0.f, 0.f, 0.f};
#pragma unroll
                    for (int p = 0; p < 4; ++p) ya += ((const f32x4*)(SLAB1 + ((size_t)p * (7 * 256) + (s0 - 128 * 256)) * DM))[64 * j + lane]; }
                if (s1 < 128 * 256) { const u32x2 a = ((const u32x2*)(Y + (size_t)s1 * DM))[64 * j + lane]; yb = (f32x4){bf_lo(a.x), bf_hi(a.x), bf_lo(a.y), bf_hi(a.y)}; }
                else { yb = (f32x4){0.f, 0.f, 0.f, 0.f};
#pragma unroll
                    for (int p = 0; p < 4; ++p) yb += ((const f32x4*)(SLAB1 + ((size_t)p * (7 * 256) + (s1 - 128 * 256)) * DM))[64 * j + lane]; }
                const f32x4 gg = ((const f32x4*)gt)[64 * j + lane];
                v[j] = xr[64 * j] + gg * (ya * g0 + yb * g1); s += (v[j].x * v[j].x + v[j].y * v[j].y) + (v[j].z * v[j].z + v[j].w * v[j].w); }
            const float rstd = 1.0f / sqrtf(wave_sum(s) * (1.0f / DM) + EPS);
            f32x4* op = (f32x4*)(args.out + (size_t)n * DM) + lane;
#pragma unroll
            for (int j = 0; j < 8; ++j) op[64 * j] = v[j] * rstd * ((const f32x4*)args.in[32])[64 * j + lane];
        }
    }
#undef IN
#undef SEAM
}

constexpr int N_PHASES = 20;
extern "C" void kernel_launch(void* const* d_in, const int* in_sizes, int n_in, void* d_out, int out_size, void* d_ws, size_t ws_size, hipStream_t stream) {
    static int grid = 0;
    if (grid == 0) {
        if (n_in != 33 || ws_size < WS_END) { fprintf(stderr, "kernel_launch: need 33 inputs and %zu bytes of workspace; got %d, %zu\n", (size_t)WS_END, n_in, ws_size); grid = -1; return; }
        int dev = 0, cus = 0, per_cu = 0;
        if (hipGetDevice(&dev) != hipSuccess || hipDeviceGetAttribute(&cus, hipDeviceAttributeMultiprocessorCount, dev) != hipSuccess) { grid = -1; return; }
        if (hipFuncSetAttribute((const void*)hybrid_fwd, hipFuncAttributeMaxDynamicSharedMemorySize, LDS_BYTES) != hipSuccess) { fprintf(stderr, "kernel_launch: hipFuncSetAttribute failed\n"); grid = -1; return; }
        if (hipOccupancyMaxActiveBlocksPerMultiprocessor(&per_cu, (const void*)hybrid_fwd, 512, LDS_BYTES) != hipSuccess || per_cu < 1)
            fprintf(stderr, "kernel_launch: occupancy query reports %d workgroups per CU\n", per_cu);
        (void)hipGetLastError();
        grid = cus;
    }
    if (grid < 0) return;
    (void)hipMemsetAsync((char*)d_ws + WS_CTL, 0, CTL_ZERO_BYTES, stream);
    Args a{};
    for (int i = 0; i < 33; ++i) a.in[i] = (const float*)d_in[i];
    a.out = (float*)d_out; a.ws = (unsigned char*)d_ws;
#if MK_PER_PHASE
    for (int p = 0; p < N_PHASES; ++p) { a.ph_lo = p; a.ph_hi = p + 1; hipLaunchKernelGGL(hybrid_fwd, dim3(grid), dim3(512), LDS_BYTES, stream, a); }
#else
    a.ph_lo = 0; a.ph_hi = N_PHASES;
    hipLaunchKernelGGL(hybrid_fwd, dim3(grid), dim3(512), LDS_BYTES, stream, a);
#endif
    const hipError_t le = hipPeekAtLastError();
    if (le != hipSuccess) fprintf(stderr, "kernel_launch: launch failed: %s\n", hipGetErrorName(le));
}
```

```cpp
#include <hip/hip_runtime.h>
#include <hip/hip_bf16.h>
#include <cstdio>
#include <cstdint>

#ifndef MK_PER_PHASE
#define MK_PER_PHASE 0
#endif

#ifndef L1PRE
#define L1PRE 1
#endif
#ifndef ATT_DMA
#define ATT_DMA 1
#endif
#ifndef TSKIP
#define TSKIP 0
#endif
#ifndef PRESCALE
#define PRESCALE 1
#endif
#ifndef L1ATT_FP8
#define L1ATT_FP8 1
#endif
#ifndef FFN0_FP8
#define FFN0_FP8 1
#endif
#define GAS __attribute__((address_space(1)))
#define LAS __attribute__((address_space(3)))
typedef unsigned short bf16_t;
typedef short bf16x8 __attribute__((ext_vector_type(8)));
typedef short s16x4 __attribute__((ext_vector_type(4)));
typedef float f32x2 __attribute__((ext_vector_type(2)));
typedef float f32x4 __attribute__((ext_vector_type(4)));
typedef float f32x16 __attribute__((ext_vector_type(16)));
typedef unsigned u32x2 __attribute__((ext_vector_type(2)));
typedef unsigned u32x4 __attribute__((ext_vector_type(4)));
typedef GAS unsigned gu32;

constexpr int DM = 2048, NB = 4, SEQ = 4096, NCTX = 256, RPB = SEQ + NCTX, MROWS = NB * RPB;
constexpr int NTOK = NB * SEQ;
constexpr int PROJ = 4608, DFF = 5632, NE = 8, DEX = 7168;
constexpr int CAP_TILES = 136, CAP = CAP_TILES * 256;
constexpr float EPS = 1e-6f;
constexpr float LOG2E = 1.4426950408889634f;
constexpr float ATT_SCALE = 0.088388347648318440f;
constexpr float A_SCALE = 0.125f;
constexpr float LAMBDA_INIT = 0.2f;

constexpr size_t MiB = 1u << 20;
constexpr size_t WS_CTL = 0, CTL_ZERO_BYTES = 32 * 1024;
constexpr size_t WS_MODS = 1 * MiB;
constexpr size_t WS_ADAP = 2 * MiB;
constexpr size_t WS_ROPE = 18 * MiB;
constexpr size_t WS_ROUTE = 22 * MiB;
constexpr size_t WS_GATES = WS_ROUTE + 512 * 1024;
constexpr size_t WS_SLOT = WS_GATES + 256 * 1024;
constexpr size_t WS_CNT = WS_SLOT + 256 * 1024;
constexpr size_t WS_TILEE = WS_CNT + 64 * 1024;
constexpr size_t WS_WIN0 = 34 * MiB, WS_WOUT0 = 52 * MiB, WS_WGU0 = 60 * MiB, WS_WDN0 = 104 * MiB;
constexpr size_t WS_WIN1 = 126 * MiB, WS_WOUT1 = 144 * MiB, WS_WGU1 = 152 * MiB, WS_WDN1 = 600 * MiB;
constexpr size_t WS_XR = 824 * MiB;
constexpr size_t WS_H = 960 * MiB;
constexpr size_t WS_AO = 1028 * MiB;
constexpr size_t WS_Y = WS_H;
constexpr size_t WS_QKV = 1096 * MiB;
constexpr size_t WS_XG = WS_QKV;
constexpr size_t WS_MID = 1249 * MiB;
constexpr size_t WS_SLAB0 = 1500 * MiB;
constexpr size_t WS_SLAB1 = 1540 * MiB;
constexpr size_t WS_SLABW = 1600 * MiB;
constexpr size_t WS_END = 1725 * MiB;
constexpr int CW_TMO = 0, CW_BAR = 4096;
constexpr int NS0 = FFN0_FP8 ? 2 : 4;

constexpr int RING_BYTES = 131072;
constexpr int LDS_BYTES = 147456;
constexpr int MISC_OFF = LDS_BYTES - 256;

#define RLX_AGENT __ATOMIC_RELAXED, __HIP_MEMORY_SCOPE_AGENT
#define LDS_WAIT() asm volatile("s_waitcnt lgkmcnt(0)" ::: "memory")
#define VM_WAIT() asm volatile("s_waitcnt vmcnt(0)" ::: "memory")
__device__ __forceinline__ unsigned cvt_pk_bf16(float lo, float hi) { unsigned r; asm volatile("v_cvt_pk_bf16_f32 %0, %1, %2" : "=v"(r) : "v"(lo), "v"(hi)); return r; }
__device__ __forceinline__ float bf_lo(unsigned w) { return __uint_as_float(w << 16); }
__device__ __forceinline__ float bf_hi(unsigned w) { return __uint_as_float(w & 0xffff0000u); }
typedef int i32x8 __attribute__((ext_vector_type(8)));
constexpr float S_H8 = 16.0f, S_W8 = 1024.0f, S_M8 = 4.0f, S_A8 = 64.0f;
__device__ __forceinline__ float clamp8(float x) { return __builtin_amdgcn_fmed3f(x, -448.0f, 448.0f); }
__device__ __forceinline__ unsigned pk4_fp8(float a, float b, float c, float d) {
    int w = 0; w = __builtin_amdgcn_cvt_pk_fp8_f32(clamp8(a), clamp8(b), w, false); w = __builtin_amdgcn_cvt_pk_fp8_f32(clamp8(c), clamp8(d), w, true); return (unsigned)w; }
__device__ __forceinline__ float wave_sum(float v) {
#pragma unroll
    for (int o = 1; o < 64; o <<= 1) v += __shfl_xor(v, o);
    return v;
}
__device__ __forceinline__ int fresh_tid() { int t = threadIdx.x; asm volatile("" : "+v"(t)); return t; }
__device__ __forceinline__ float fast_silu(float x) { return x * __builtin_amdgcn_rcpf(1.0f + __builtin_amdgcn_exp2f(-x * LOG2E)); }

namespace pg8 {
constexpr int BM = 256, BK = 64, HALF = 128, HTB = HALF * BK * 2, STAGE_BYTES = 8 * HTB, NXCD = 8, WGM = 4;
__host__ __device__ __forceinline__ int lds_byte(int r, int c) { const int st = (r >> 4) * 2 + (c >> 5), rr = r & 15, cc = c & 31, ob = rr * 64 + cc * 2; return st * 1024 + (ob ^ (((ob >> 9) & 1) << 5)); }
__host__ __device__ __forceinline__ void stage_rc(int b, int& R, int& C) { const int st = b / 1024, sb = b % 1024, swz = sb ^ (((sb >> 9) & 1) << 5); R = (st >> 1) * 16 + swz / 64; C = (st & 1) * 32 + (swz % 64) / 2; }
__host__ __device__ __forceinline__ int perm32(int rho) { const int n = rho >> 4, i = rho & 15; return 8 * (i >> 2) + 4 * n + (i & 3); }

typedef int i32x4_t __attribute__((ext_vector_type(4)));
struct Unit { int pm, pn, kofs, nt, flag; };
struct Gemm { const bf16_t* A; const bf16_t* Bt; int K; };

struct MapId { __device__ __forceinline__ void operator()(int pm, int pn, Unit& u) const { u.pm = pm; u.pn = pn; } };
struct MapL0Split { __device__ __forceinline__ void operator()(int pm, int pn, Unit& u) const { u.pm = pm < 64 ? (pm >> 4) * 17 + (pm & 15) : (pm - 64) * 17 + 16; u.pn = pn; } };
struct MapLatent { __device__ __forceinline__ void operator()(int pm, int pn, Unit& u) const { u.pm = (pm >> 4) * 17 + (pm & 15); u.pn = pn; } };
struct MapMoe { const int* tile_e; int npe; __device__ __forceinline__ void operator()(int pm, int pn, Unit& u) const { u.pm = pm; u.pn = tile_e[pm] * npe + pn; } };
template <class Map> struct Order {
    int nM, nN, nwg, G, c, ntf, exn, S; Map map;
    __device__ __forceinline__ void init(int nM_, int nN_, int G_, int c_, Map m, int ntf_, int ex_nM = 0, int S_ = 1) { nM = nM_; nN = nN_; nwg = nM * nN; G = G_; c = c_; map = m; ntf = ntf_; S = S_; exn = ex_nM * nN_ * S_; }
    __device__ __forceinline__ bool next(int i, Unit& u) const {
        const long L = (long)i * G + c; u.kofs = 0; u.nt = ntf; u.flag = 0;
        if (L >= nwg) { const long sidx = L - nwg; if (sidx >= exn) return false; const int part = (int)(sidx % S), ux = (int)(sidx / S);
            map(nM + ux / nN, ux % nN, u); u.nt = ntf / S; u.kofs = part * u.nt * (BK * 2); u.flag = 1 + part; return true; }
        int wgid = (int)L; { const int q = nwg / NXCD, r = nwg % NXCD, xcd = wgid % NXCD, off = wgid / NXCD; wgid = (xcd < r ? xcd * (q + 1) : r * (q + 1) + (xcd - r) * q) + off; }
        const int nig = WGM * nN, gid = wgid / nig, fm = gid * WGM, gsz = (nM - fm) < WGM ? (nM - fm) : WGM;
        map(fm + ((wgid % nig) % gsz), (wgid % nig) / gsz, u); return true;
    }
    __device__ __forceinline__ void a_ready(const Unit&) const {}
    __device__ __forceinline__ void done(const Unit&) const {}
};

struct EpiBf16 {
    static constexpr bool PERM = true;
    bf16_t* O; int ldc; int npn; float sc; float* slab;
    __device__ __forceinline__ void operator()(const f32x4 (&acc)[2][2][4][2], const Unit& u, int wr, int wc, int fr, int fq) const {
        const int row0 = u.pm * BM + wr * 64 + fr, col0 = (u.pn % npn) * BM + wc * 32 + 8 * fq;
        if (u.flag) {
            float* sp = slab + ((size_t)(u.flag - 1) * (7 * 256) + (size_t)(u.pm - 128) * BM + wr * 64 + fr) * ldc + col0;
#pragma unroll
            for (int ai = 0; ai < 2; ++ai)
#pragma unroll
                for (int m = 0; m < 4; ++m)
#pragma unroll
                    for (int bj = 0; bj < 2; ++bj) { float* p = sp + (size_t)(ai * HALF + m * 16) * ldc + bj * HALF;
                        *(f32x4*)p = acc[ai][bj][m][0] * sc; *(f32x4*)(p + 4) = acc[ai][bj][m][1] * sc; }
            return;
        }
#pragma unroll
        for (int ai = 0; ai < 2; ++ai)
#pragma unroll
            for (int m = 0; m < 4; ++m) { bf16_t* rowp = O + (size_t)(row0 + ai * HALF + m * 16) * ldc + col0;
#pragma unroll
                for (int bj = 0; bj < 2; ++bj) { const f32x4 v0 = acc[ai][bj][m][0] * sc, v1 = acc[ai][bj][m][1] * sc;
                    u32x4 w; w.x = cvt_pk_bf16(v0[0], v0[1]); w.y = cvt_pk_bf16(v0[2], v0[3]); w.z = cvt_pk_bf16(v1[0], v1[1]); w.w = cvt_pk_bf16(v1[2], v1[3]);
                    *(u32x4*)(rowp + bj * HALF) = w; } }
    }
};
template <int LAYER> struct EpiQKV {
    static constexpr bool PERM = true;
    bf16_t* O; const float* cA; const float* sA; const float* cB; const float* sB; const float* qg; const float* kg; LAS float* scr; float asc;
    __device__ __forceinline__ void operator()(const f32x4 (&acc)[2][2][4][2], const Unit& u, int wr, int wc, int fr, int fq) const {
        const int tt = u.pm % 17, pn = u.pn; const bool latent = tt < 16;
        int kind0, kind1; bool norm = false;
        if constexpr (LAYER == 0) { const int k = (pn < 4 || (pn >= 8 && pn < 12)) ? 1 : ((pn >= 4 && pn < 8) || pn == 16) ? 2 : 0; kind0 = kind1 = k; norm = (k == 2); }
        else { kind0 = kind1 = (pn < 4 || pn == 8) ? 2 : 0; }
        const int row0 = u.pm * BM + wr * 64 + fr, col0 = pn * BM + wc * 32 + 8 * fq, ch = wc * 32 + 8 * fq;
        if (norm) {
#pragma unroll
            for (int ai = 0; ai < 2; ++ai)
#pragma unroll
                for (int m = 0; m < 4; ++m)
#pragma unroll
                    for (int bj = 0; bj < 2; ++bj) { const f32x4 a = acc[ai][bj][m][0], b = acc[ai][bj][m][1];
                        float q = (a[0] * a[0] + a[1] * a[1]) + (a[2] * a[2] + a[3] * a[3]) + (b[0] * b[0] + b[1] * b[1]) + (b[2] * b[2] + b[3] * b[3]);
                        q += __shfl_xor(q, 16); q += __shfl_xor(q, 32);
                        if (fq == 0) scr[((ai * HALF + wr * 64 + m * 16 + fr) * 2 + bj) * 4 + wc] = q; }
            asm volatile("s_waitcnt lgkmcnt(0)" ::: "memory"); __builtin_amdgcn_s_barrier(); asm volatile("" ::: "memory");
        }
        f32x4 g0 = {1.f, 1.f, 1.f, 1.f}, g1 = g0;
        if (norm) { const LAS float* gl = scr + 2048 + ((pn == 16) ? 128 : 0) + ch; g0 = *(const LAS f32x4*)gl; g1 = *(const LAS f32x4*)(gl + 4); }
        const int kmax = kind0 > kind1 ? kind0 : kind1;
        const int npair = (kmax == 1) ? 16 : 32, p0 = (kmax == 1) ? ((ch & 63) >> 1) : (ch >> 1), q0 = p0 & (npair - 1); const bool use_row = p0 < npair;
        f32x4 frq;
#pragma unroll
        for (int i = 0; i < 4; ++i) frq[i] = __builtin_amdgcn_exp2f(-(float)(q0 + i) * (13.287712379549449f / (float)npair)) * 0.15915494309189535f;
#pragma unroll
        for (int ai = 0; ai < 2; ++ai)
#pragma unroll
            for (int m = 0; m < 4; ++m) { const int r = ai * HALF + wr * 64 + m * 16 + fr, t = tt * 256 + r;
                bf16_t* rowp = O + (size_t)(row0 + ai * HALF + m * 16) * PROJ + col0;
                f32x4 cs = {1.f, 1.f, 1.f, 1.f}, sn = {0.f, 0.f, 0.f, 0.f};
                if (latent && kmax != 0) { const float pos = (float)(use_row ? (t >> 6) : (t & 63));
#pragma unroll
                    for (int i = 0; i < 4; ++i) { const float x = pos * frq[i]; cs[i] = __builtin_amdgcn_cosf(x); sn[i] = __builtin_amdgcn_sinf(x); } }
#pragma unroll
                for (int bj = 0; bj < 2; ++bj) { f32x4 v0 = acc[ai][bj][m][0] * asc, v1 = acc[ai][bj][m][1] * asc; const int kind = bj ? kind1 : kind0;
                    if (norm) { const f32x4 p = *(const LAS f32x4*)(scr + ((ai * HALF + wr * 64 + m * 16 + fr) * 2 + bj) * 4);
                        const float rsv = 1.0f / sqrtf(((p[0] + p[1]) + (p[2] + p[3])) * (1.0f / 128.0f) + EPS); v0 = v0 * rsv * g0; v1 = v1 * rsv * g1; }
                    if (latent && kind != 0) {
                        const f32x4 a = v0, b = v1;
                        v0[0] = a[0] * cs[0] - a[1] * sn[0]; v0[1] = a[0] * sn[0] + a[1] * cs[0]; v0[2] = a[2] * cs[1] - a[3] * sn[1]; v0[3] = a[2] * sn[1] + a[3] * cs[1];
                        v1[0] = b[0] * cs[2] - b[1] * sn[2]; v1[1] = b[0] * sn[2] + b[1] * cs[2]; v1[2] = b[2] * cs[3] - b[3] * sn[3]; v1[3] = b[2] * sn[3] + b[3] * cs[3]; }
                    if constexpr (LAYER == 0 && PRESCALE) { const float qs = pn < 4 ? A_SCALE * LOG2E : (pn < 8 ? ATT_SCALE * LOG2E : 1.0f); v0 = v0 * qs; v1 = v1 * qs; }
                    if constexpr (LAYER == 1 && PRESCALE && L1PRE) { const float qs = pn < 4 ? ATT_SCALE * LOG2E : 1.0f; v0 = v0 * qs; v1 = v1 * qs; }
                    u32x4 w; w.x = cvt_pk_bf16(v0[0], v0[1]); w.y = cvt_pk_bf16(v0[2], v0[3]); w.z = cvt_pk_bf16(v1[0], v1[1]); w.w = cvt_pk_bf16(v1[2], v1[3]);
                    *(u32x4*)(rowp + bj * HALF) = w; } }
    }
};
struct EpiSwiGLU {
    static constexpr bool PERM = true;
    bf16_t* O; int ldc; int npn;
    __device__ __forceinline__ void operator()(const f32x4 (&acc)[2][2][4][2], const Unit& u, int wr, int wc, int fr, int fq) const {
        const int row0 = u.pm * BM + wr * 64 + fr, col0 = (u.pn % npn) * HALF + wc * 32 + 8 * fq;
#pragma unroll
        for (int ai = 0; ai < 2; ++ai)
#pragma unroll
            for (int m = 0; m < 4; ++m) { bf16_t* rowp = O + (size_t)(row0 + ai * HALF + m * 16) * ldc + col0;
                const f32x4 g0 = acc[ai][0][m][0], g1 = acc[ai][0][m][1], u0 = acc[ai][1][m][0], u1 = acc[ai][1][m][1];
                u32x4 w;
                w.x = cvt_pk_bf16(fast_silu(g0[0]) * u0[0], fast_silu(g0[1]) * u0[1]); w.y = cvt_pk_bf16(fast_silu(g0[2]) * u0[2], fast_silu(g0[3]) * u0[3]);
                w.z = cvt_pk_bf16(fast_silu(g1[0]) * u1[0], fast_silu(g1[1]) * u1[1]); w.w = cvt_pk_bf16(fast_silu(g1[2]) * u1[2], fast_silu(g1[3]) * u1[3]);
                *(u32x4*)rowp = w; }
    }
};
struct EpiSwiGLU8 {
    static constexpr bool PERM = true;
    unsigned char* O; int ldc; int npn; float si, so;
    __device__ __forceinline__ f32x2 two(f32x2 ag, f32x2 au, float kneg, float c0) const {
        const f32x2 t = ag * kneg; f32x2 e; e.x = __builtin_amdgcn_exp2f(t.x); e.y = __builtin_amdgcn_exp2f(t.y);
        const f32x2 d = e * c0 + c0; f32x2 r; r.x = __builtin_amdgcn_rcpf(d.x); r.y = __builtin_amdgcn_rcpf(d.y);
        return (ag * au) * r; }
    __device__ __forceinline__ void operator()(const f32x4 (&acc)[2][2][4][2], const Unit& u, int wr, int wc, int fr, int fq) const {
        const int row0 = u.pm * BM + wr * 64 + fr, col0 = (u.pn % npn) * HALF + wc * 32 + 8 * fq;
        const float kneg = -si * LOG2E, c0 = 1.0f / (si * so);
#pragma unroll
        for (int ai = 0; ai < 2; ++ai)
#pragma unroll
            for (int m = 0; m < 4; ++m) { unsigned char* rowp = O + (size_t)(row0 + ai * HALF + m * 16) * ldc + col0;
                const f32x4 g0 = acc[ai][0][m][0], g1 = acc[ai][0][m][1], u0 = acc[ai][1][m][0], u1 = acc[ai][1][m][1];
                u32x2 w;
                const f32x2 a = two((f32x2){g0[0], g0[1]}, (f32x2){u0[0], u0[1]}, kneg, c0), b = two((f32x2){g0[2], g0[3]}, (f32x2){u0[2], u0[3]}, kneg, c0);
                const f32x2 c = two((f32x2){g1[0], g1[1]}, (f32x2){u1[0], u1[1]}, kneg, c0), d = two((f32x2){g1[2], g1[3]}, (f32x2){u1[2], u1[3]}, kneg, c0);
                w.x = pk4_fp8(a.x, a.y, b.x, b.y); w.y = pk4_fp8(c.x, c.y, d.x, d.y);
                *(u32x2*)rowp = w; }
    }
};
struct EpiResid {
    static constexpr bool PERM = false;
    const float* x_in; const float* ctx_in; float* XR; const float* mods; int gate_chunk; int from_input; float* slab; float asc;
    __device__ __forceinline__ void operator()(const f32x4 (&acc)[2][2][4][2], const Unit& u, int wr, int wc, int fr, int fq) const {
        const int b = u.pm / 17, tt = u.pm % 17;
        float* outp = XR + (size_t)u.pm * BM * DM;
        const float* basep = from_input ? (tt < 16 ? x_in + ((size_t)b * SEQ + (size_t)tt * 256) * DM : ctx_in + (size_t)b * NCTX * DM) : outp;
        const float* gate = mods + (size_t)(tt < 16 ? b : 4) * 12288 + gate_chunk * DM;
        const int col0 = u.pn * BM + wc * 32 + 4 * fq;
        f32x4 gv[2][2];
#pragma unroll
        for (int bj = 0; bj < 2; ++bj)
#pragma unroll
            for (int n = 0; n < 2; ++n) gv[bj][n] = *(const f32x4*)(gate + col0 + bj * HALF + n * 16) * asc;
        if (u.flag) {
            float* sp = slab + ((size_t)(u.flag - 1) * (NB * NCTX) + (size_t)b * NCTX) * DM;
#pragma unroll
            for (int ai = 0; ai < 2; ++ai)
#pragma unroll
                for (int m = 0; m < 4; ++m) { const size_t off = (size_t)(ai * HALF + wr * 64 + m * 16 + fr) * DM + col0;
#pragma unroll
                    for (int bj = 0; bj < 2; ++bj)
#pragma unroll
                        for (int n = 0; n < 2; ++n) *(f32x4*)(sp + off + bj * HALF + n * 16) = gv[bj][n] * acc[ai][bj][m][n]; }
            return;
        }
#pragma unroll
        for (int ai = 0; ai < 2; ++ai)
#pragma unroll
            for (int m = 0; m < 4; ++m) { const size_t off = (size_t)(ai * HALF + wr * 64 + m * 16 + fr) * DM + col0;
#pragma unroll
                for (int bj = 0; bj < 2; ++bj)
#pragma unroll
                    for (int n = 0; n < 2; ++n) { const f32x4 bs = *(const f32x4*)(basep + off + bj * HALF + n * 16);
                        *(f32x4*)(outp + off + bj * HALF + n * 16) = bs + gv[bj][n] * acc[ai][bj][m][n]; }
                if (m & 1) asm volatile("" ::: "memory"); }
    }
};

template <class Epi, class Sched, bool FP8 = false, bool ALIGN_EPI = true, bool SP2 = true>
__device__ __forceinline__ void gemm_phase(LAS unsigned char* lds, const Gemm g, const Sched& S, const Epi& E) {
    const int tid = fresh_tid(), wid = __builtin_amdgcn_readfirstlane(tid >> 6), lane = tid & 63, wr = wid >> 2, wc = wid & 3, fr = lane & 15, fq = lane >> 4;
    const int K = g.K;
    unsigned voffA[2], voffB[2];
#pragma unroll
    for (int i = 0; i < 2; ++i) { int R, C; stage_rc(tid * 16 + i * 8192, R, C); const int Rb = Epi::PERM ? ((R & ~31) + perm32(R & 31)) : R;
        voffA[i] = (unsigned)(R * K + C) * 2u; voffB[i] = (unsigned)(Rb * K + C) * 2u; }
    const size_t kstep = (size_t)(BK * 2);
    const size_t hstep = (size_t)HALF * K * 2;
    const size_t tstep = 2 * hstep;
    const unsigned ldsw = (unsigned)wid * 1024u;
    const int aoff = FP8 ? lds_byte(wr * 64 + fr, fq * 16) : lds_byte(wr * 64 + fr, fq * 8), boff = FP8 ? lds_byte(wc * 32 + fr, fq * 16) : lds_byte(wc * 32 + fr, fq * 8);
#define PG8_SA(b, h) (((b) * 2 + (h)) * HTB)
#define PG8_SB(b, h) ((4 + (b) * 2 + (h)) * HTB)
#define PG8_STAGE(bufoff, gbase, voff) do { _Pragma("unroll") for (int _i = 0; _i < 2; ++_i) \
        __builtin_amdgcn_global_load_lds((const unsigned*)((const char*)(gbase) + (voff)[_i]), (LAS unsigned*)(lds + (bufoff) + ldsw + _i * 8192), 16, 0, 0); } while (0)
#define PG8_LD16(p) (*(const LAS i32x4_t*)(p))
#define PG8_LDA(dst, b, h) do { if constexpr (FP8) { _Pragma("unroll") for (int m = 0; m < 4; ++m) { const LAS unsigned char* _p = lds + PG8_SA(b, h) + aoff + m * 2048; \
            dst##8[m] = __builtin_shufflevector(PG8_LD16(_p), PG8_LD16(_p + 16), 0, 1, 2, 3, 4, 5, 6, 7); } } else { \
        _Pragma("unroll") for (int m = 0; m < 4; ++m) _Pragma("unroll") for (int k = 0; k < 2; ++k) dst[m][k] = *(const LAS bf16x8*)(lds + PG8_SA(b, h) + aoff + m * 2048 + k * 1024); } } while (0)
#define PG8_LDB(dst, b, h) do { if constexpr (FP8) { _Pragma("unroll") for (int n = 0; n < 2; ++n) { const LAS unsigned char* _p = lds + PG8_SB(b, h) + boff + n * 2048; \
            dst##8[n] = __builtin_shufflevector(PG8_LD16(_p), PG8_LD16(_p + 16), 0, 1, 2, 3, 4, 5, 6, 7); } } else { \
        _Pragma("unroll") for (int n = 0; n < 2; ++n) _Pragma("unroll") for (int k = 0; k < 2; ++k) dst[n][k] = *(const LAS bf16x8*)(lds + PG8_SB(b, h) + boff + n * 2048 + k * 1024); } } while (0)
#define PG8_MMA(ai, bj, At, Bt) do { __builtin_amdgcn_s_setprio(1); _Pragma("unroll") for (int m = 0; m < 4; ++m) _Pragma("unroll") for (int n = 0; n < 2; ++n) { if constexpr (FP8) \
        asm volatile("v_mfma_f32_16x16x128_f8f6f4 %0, %1, %2, %0" : "+v"(acc[ai][bj][m][n]) : "v"(Bt##8[n]), "v"(At##8[m])); else { _Pragma("unroll") for (int k = 0; k < 2; ++k) \
        acc[ai][bj][m][n] = __builtin_amdgcn_mfma_f32_16x16x32_bf16(Bt[n][k], At[m][k], acc[ai][bj][m][n], 0, 0, 0); } } __builtin_amdgcn_s_setprio(0); } while (0)
#define PG8_WAIT_V(n) asm volatile("s_waitcnt vmcnt(" #n ")" ::: "memory")
#define PG8_WAIT_L(n) asm volatile("s_waitcnt lgkmcnt(" #n ")" ::: "memory")
#define PG8_BAR __builtin_amdgcn_s_barrier()
#define PG8_SCHED __builtin_amdgcn_sched_barrier(0)
    Unit cur, nxt; int ui = 0;
    if (!S.next(0, cur)) return;
    f32x4 acc[2][2][4][2];
#pragma unroll
    for (int a = 0; a < 2; ++a)
#pragma unroll
        for (int b = 0; b < 2; ++b)
#pragma unroll
            for (int m = 0; m < 4; ++m)
#pragma unroll
                for (int n = 0; n < 2; ++n) acc[a][b][m][n] = (f32x4){0.f, 0.f, 0.f, 0.f};
    bf16x8 At[4][2], B0[2][2], B1[2][2]; i32x8 At8[4], B08[2], B18[2];
    const char* cA = (const char*)g.A + (size_t)cur.pm * tstep + cur.kofs; const char* cB = (const char*)g.Bt + (size_t)cur.pn * tstep + cur.kofs;
    S.a_ready(cur);
    if constexpr (SP2) {
        PG8_STAGE(PG8_SB(0, 0), cB, voffB); PG8_STAGE(PG8_SB(0, 1), cB + hstep, voffB); PG8_STAGE(PG8_SA(0, 0), cA, voffA); PG8_STAGE(PG8_SA(0, 1), cA + hstep, voffA);
        if (wr == 1) PG8_BAR;
        PG8_WAIT_V(2); PG8_BAR;
        PG8_STAGE(PG8_SB(1, 0), cB + kstep, voffB); PG8_STAGE(PG8_SA(1, 0), cA + kstep, voffA); PG8_STAGE(PG8_SB(1, 1), cB + hstep + kstep, voffB);
        PG8_WAIT_V(6); PG8_BAR;
    } else {
        PG8_STAGE(PG8_SB(0, 0), cB, voffB); PG8_STAGE(PG8_SA(0, 0), cA, voffA); PG8_STAGE(PG8_SB(0, 1), cB + hstep, voffB); PG8_STAGE(PG8_SA(0, 1), cA + hstep, voffA);
        if (wr == 1) PG8_BAR;
        PG8_WAIT_V(4); PG8_BAR;
        PG8_STAGE(PG8_SB(1, 0), cB + kstep, voffB); PG8_STAGE(PG8_SA(1, 0), cA + kstep, voffA); PG8_STAGE(PG8_SB(1, 1), cB + hstep + kstep, voffB);
        PG8_WAIT_V(6); PG8_BAR;
    }
    for (;;) {
        const bool has_next = S.next(ui + 1, nxt);
        const char* nA = has_next ? (const char*)g.A + (size_t)nxt.pm * tstep + nxt.kofs : cA; const char* nB = has_next ? (const char*)g.Bt + (size_t)nxt.pn * tstep + nxt.kofs : cB;
        const int nt = cur.nt;
        for (int t = 0; t < nt; t += 2) {
            const bool last = (t == nt - 2);
            const char* a1 = cA + (size_t)(t + 1) * kstep;
            const char* a2 = last ? nA : cA + (size_t)(t + 2) * kstep; const char* b2 = last ? nB : cB + (size_t)(t + 2) * kstep;
            const char* a3 = a2 + kstep; const char* b3 = b2 + kstep;
            if (last && has_next) S.a_ready(nxt);
            if constexpr (SP2) {
            PG8_LDB(B0, 0, 0); PG8_LDB(B1, 0, 1); PG8_SCHED; PG8_LDA(At, 0, 0); PG8_STAGE(PG8_SA(1, 1), a1 + hstep, voffA);
            PG8_WAIT_V(8); PG8_WAIT_L(0); PG8_BAR; PG8_MMA(0, 0, At, B0); PG8_MMA(0, 1, At, B1); PG8_BAR; PG8_SCHED;
            PG8_LDA(At, 0, 1); PG8_STAGE(PG8_SB(0, 0), b2, voffB); PG8_STAGE(PG8_SB(0, 1), b2 + hstep, voffB); PG8_STAGE(PG8_SA(0, 0), a2, voffA);
            PG8_WAIT_V(8); PG8_WAIT_L(0); PG8_BAR; PG8_MMA(1, 0, At, B0); PG8_MMA(1, 1, At, B1); PG8_BAR; PG8_SCHED;
            PG8_LDB(B0, 1, 0); PG8_LDB(B1, 1, 1); PG8_SCHED; PG8_LDA(At, 1, 0); PG8_STAGE(PG8_SA(0, 1), a2 + hstep, voffA);
            PG8_WAIT_V(8); PG8_WAIT_L(0); PG8_BAR; PG8_MMA(0, 0, At, B0); PG8_MMA(0, 1, At, B1); PG8_BAR; PG8_SCHED;
            PG8_LDA(At, 1, 1); PG8_STAGE(PG8_SB(1, 0), b3, voffB); PG8_STAGE(PG8_SB(1, 1), b3 + hstep, voffB); PG8_STAGE(PG8_SA(1, 0), a3, voffA);
            PG8_WAIT_V(8); PG8_WAIT_L(0); PG8_BAR; PG8_MMA(1, 0, At, B0); PG8_MMA(1, 1, At, B1); PG8_BAR; PG8_SCHED;
            } else {
            PG8_LDB(B0, 0, 0); PG8_SCHED; PG8_LDA(At, 0, 0); PG8_STAGE(PG8_SA(1, 1), a1 + hstep, voffA);
            PG8_WAIT_L(8); PG8_BAR; PG8_WAIT_L(0); PG8_MMA(0, 0, At, B0); PG8_BAR; PG8_SCHED;
            PG8_LDB(B1, 0, 1); PG8_STAGE(PG8_SB(0, 0), b2, voffB);
            PG8_BAR; PG8_WAIT_L(0); PG8_MMA(0, 1, At, B1); PG8_BAR;
            PG8_LDA(At, 0, 1); PG8_STAGE(PG8_SA(0, 0), a2, voffA);
            PG8_BAR; PG8_WAIT_L(0); PG8_MMA(1, 0, At, B0); PG8_BAR; PG8_SCHED;
            PG8_STAGE(PG8_SB(0, 1), b2 + hstep, voffB);
            PG8_WAIT_V(6); PG8_BAR; PG8_MMA(1, 1, At, B1); PG8_BAR;
            PG8_LDB(B0, 1, 0); PG8_SCHED; PG8_LDA(At, 1, 0); PG8_STAGE(PG8_SA(0, 1), a2 + hstep, voffA);
            PG8_WAIT_L(8); PG8_BAR; PG8_WAIT_L(0); PG8_MMA(0, 0, At, B0); PG8_BAR; PG8_SCHED;
            PG8_LDB(B1, 1, 1); PG8_STAGE(PG8_SB(1, 0), b3, voffB);
            PG8_BAR; PG8_WAIT_L(0); PG8_MMA(0, 1, At, B1); PG8_BAR;
            PG8_LDA(At, 1, 1); PG8_STAGE(PG8_SA(1, 0), a3, voffA);
            PG8_BAR; PG8_WAIT_L(0); PG8_MMA(1, 0, At, B0); PG8_BAR; PG8_SCHED;
            PG8_STAGE(PG8_SB(1, 1), b3 + hstep, voffB);
            PG8_WAIT_V(6); PG8_BAR; PG8_MMA(1, 1, At, B1); PG8_BAR;
            }
        }
        if constexpr (ALIGN_EPI) { if (wr == 0) PG8_BAR; }
        if constexpr (FP8) asm volatile("s_nop 15\n\ts_nop 15" ::: "memory");
        E(acc, cur, wr, wc, fr, fq); S.done(cur);
        if (!has_next) break;
#pragma unroll
        for (int a = 0; a < 2; ++a)
#pragma unroll
            for (int b = 0; b < 2; ++b)
#pragma unroll
                for (int m = 0; m < 4; ++m)
#pragma unroll
                    for (int n = 0; n < 2; ++n) acc[a][b][m][n] = (f32x4){0.f, 0.f, 0.f, 0.f};
        cur = nxt; cA = nA; cB = nB; ++ui;
        if constexpr (ALIGN_EPI) { if (wr == 1) PG8_BAR; }
    }
    PG8_WAIT_V(0);
    if constexpr (!ALIGN_EPI) { if (wr == 0) PG8_BAR; }
    PG8_BAR;
#undef PG8_SA
#undef PG8_SB
#undef PG8_STAGE
#undef PG8_LDA
#undef PG8_LDB
#undef PG8_MMA
#undef PG8_LD16
#undef PG8_WAIT_V
#undef PG8_WAIT_L
#undef PG8_BAR
#undef PG8_SCHED
}
}

namespace att {
constexpr int D = 128, NW = 8, QBLK = 32, KVBLK = 64;
constexpr int LDQK = PROJ, LDO = DM;
constexpr float THR = 8.f;
#ifndef DIFF_SD
#define DIFF_SD 2
#endif
#ifndef STD_SD
#define STD_SD 1
#endif
constexpr int SHM_V = KVBLK * D * 2, SHM_K = KVBLK * D * 2;
constexpr int OFF_WS = 2 * SHM_V + 2 * SHM_K, OFF_STASH = OFF_WS + NW * 64 * 4, OFF_BIAS = OFF_STASH + 65536, ATT_LDS = OFF_BIAS + 2048;
static_assert(ATT_LDS <= MISC_OFF, "attention LDS");
#define KSWZ(row, colB) ((row) * 256 + ((colB) ^ (((row) & 7) << 4)))
#define SBAR() __builtin_amdgcn_sched_barrier(0)
__device__ __forceinline__ int crow(int r, int hi) { return (r & 3) + 8 * (r >> 2) + 4 * hi; }
struct TileMap { int NC, cbase, lbase, NT; __device__ __forceinline__ int krow(int j) const { return j < NC ? cbase + 64 * j : lbase + 64 * (j - NC); } };
struct MaskInfo { int q0, r0, lo; };

template <int MODE>
__device__ __forceinline__ void apply_mask(f32x16& p0, f32x16& p1, int j, const TileMap& tm, const MaskInfo& mi, int wid, int r32, int hi, const float* btab) {
    if constexpr (MODE == 1) {
        if (j >= tm.NC) {
            const int kp0 = tm.lbase + 64 * (j - tm.NC), qw = mi.q0 + wid * 32;
            if (kp0 - (qw + 31) < -128 || kp0 + 63 - qw > 128) {
                const int dq = kp0 - (qw + r32) + 4 * hi;
#pragma unroll
                for (int r = 0; r < 16; ++r) { const int d = dq + (r & 3) + 8 * (r >> 2);
                    if (d > 128 || d < -128) p0[r] = -1e30f;
                    if (d + 32 > 128 || d + 32 < -128) p1[r] = -1e30f; }
            }
        }
    } else if constexpr (MODE == 2) {
        if (j >= tm.NC) {
            const int kr = mi.lo + (j - tm.NC), rq = mi.r0 + (wid >> 1);
            int rs = rq - 4; rs = rs < 0 ? 0 : (rs > 56 ? 56 : rs);
            if (kr >= rs && kr < rs + 8) {
                const int cq = (wid & 1) * 32 + r32; int cs = cq - 8; cs = cs < 0 ? 0 : (cs > 48 ? 48 : cs);
                const float* bt = btab + (kr - rq + 7) * 31 + (4 * hi - cq + 15);
                const int cb = 4 * hi - cs;
#pragma unroll
                for (int r = 0; r < 16; ++r) { const int ko = (r & 3) + 8 * (r >> 2);
                    p0[r] = ((unsigned)(ko + cb) < 16u) ? p0[r] + bt[ko] : -1e30f;
                    if ((r & 7) == 7) SBAR(); }
#pragma unroll
                for (int r = 0; r < 16; ++r) { const int ko = (r & 3) + 8 * (r >> 2);
                    p1[r] = ((unsigned)(ko + 32 + cb) < 16u) ? p1[r] + bt[ko + 32] : -1e30f;
                    if ((r & 7) == 7) SBAR(); }
            } else {
#pragma unroll
                for (int r = 0; r < 16; ++r) { p0[r] = -1e30f; p1[r] = -1e30f; }
            }
        }
    }
}
__device__ __forceinline__ void partialSM(f32x16& p0, f32x16& p1, float& m_reg, float& mn, float& alpha, const float C, const float thr_raw) {
    float pmax = p0[0];
#pragma unroll
    for (int r = 1; r < 16; ++r) pmax = fmaxf(pmax, p0[r]);
#pragma unroll
    for (int r = 0; r < 16; ++r) pmax = fmaxf(pmax, p1[r]);
    { auto rr = __builtin_amdgcn_permlane32_swap(__float_as_uint(pmax), __float_as_uint(pmax), false, false);
      pmax = fmaxf(__uint_as_float(rr[0]), __uint_as_float(rr[1])); }
    if (__builtin_expect(__all(pmax - m_reg <= thr_raw), 1)) { mn = m_reg; alpha = 1.f; }
    else { mn = fmaxf(m_reg, pmax); alpha = __builtin_amdgcn_exp2f((m_reg - mn) * C); m_reg = mn; }
    const float mnC = -mn * C;
#pragma unroll
    for (int r = 0; r < 16; ++r) p0[r] = fmaf(p0[r], C, mnC);
#pragma unroll
    for (int r = 0; r < 16; ++r) p1[r] = fmaf(p1[r], C, mnC);
#pragma unroll
    for (int r = 0; r < 16; ++r) p0[r] = __builtin_amdgcn_exp2f(p0[r]);
}
__device__ __forceinline__ void finishSM(f32x16& p0, f32x16& p1, float alpha, float& l_reg, bf16x8& pa0, bf16x8& pa1, bf16x8& pa2, bf16x8& pa3) {
#pragma unroll
    for (int r = 0; r < 16; ++r) p1[r] = __builtin_amdgcn_exp2f(p1[r]);
    float ps = 0;
#pragma unroll
    for (int r = 0; r < 16; ++r) ps += p0[r];
#pragma unroll
    for (int r = 0; r < 16; ++r) ps += p1[r];
    { auto rr = __builtin_amdgcn_permlane32_swap(__float_as_uint(ps), __float_as_uint(ps), false, false);
      ps = __uint_as_float(rr[0]) + __uint_as_float(rr[1]); }
    l_reg = l_reg * alpha + ps;
#define PK4(P, BASE, OUT) do { unsigned a0 = cvt_pk_bf16(P[BASE + 0], P[BASE + 1]), a1 = cvt_pk_bf16(P[BASE + 2], P[BASE + 3]);   \
    unsigned b0 = cvt_pk_bf16(P[BASE + 4], P[BASE + 5]), b1 = cvt_pk_bf16(P[BASE + 6], P[BASE + 7]);                              \
    auto r0 = __builtin_amdgcn_permlane32_swap(a0, b0, false, false); auto r1 = __builtin_amdgcn_permlane32_swap(a1, b1, false, false); \
    u32x4 w = {r0[0], r1[0], r0[1], r1[1]}; OUT = *reinterpret_cast<bf16x8*>(&w); } while (0)
    PK4(p0, 0, pa0); PK4(p0, 8, pa1); PK4(p1, 0, pa2); PK4(p1, 8, pa3);
#undef PK4
}
template <int DLO, int DHI, bool QLDS, bool PREQ = false>
__device__ __forceinline__ void qkt(f32x16& p0, f32x16& p1, const char* Ks, const bf16x8* qr, const char* qlds, int r32, int hi, const f32x16& cinit = f32x16{}) {
#pragma unroll
    for (int d0 = DLO; d0 < DHI; ++d0) { const int cb = (d0 * 16 + hi * 8) * 2;
        bf16x8 q; if constexpr (QLDS) q = *(const volatile LAS bf16x8*)((const LAS char*)qlds + d0 * 8192); else q = qr[d0];
        const bf16x8 b0 = *reinterpret_cast<const bf16x8*>(Ks + KSWZ(r32, cb));
        const bf16x8 b1 = *reinterpret_cast<const bf16x8*>(Ks + KSWZ(32 + r32, cb));
        if (d0 == DLO) {
            if constexpr (PRESCALE && (!QLDS || (L1PRE && PREQ))) {
                asm("v_mfma_f32_32x32x16_bf16 %0, %1, %2, %3" : "=&v"(p0) : "v"(b0), "v"(q), "v"(cinit));
                asm("v_mfma_f32_32x32x16_bf16 %0, %1, %2, %3" : "=&v"(p1) : "v"(b1), "v"(q), "v"(cinit)); }
            else { p0 = __builtin_amdgcn_mfma_f32_32x32x16_bf16(b0, q, cinit, 0, 0, 0); p1 = __builtin_amdgcn_mfma_f32_32x32x16_bf16(b1, q, cinit, 0, 0, 0); } }
        else { p0 = __builtin_amdgcn_mfma_f32_32x32x16_bf16(b0, q, p0, 0, 0, 0); p1 = __builtin_amdgcn_mfma_f32_32x32x16_bf16(b1, q, p1, 0, 0, 0); } }
}
constexpr float THR_L2 = THR * LOG2E;
__device__ __forceinline__ void presm_decide(f32x16& p0, f32x16& p1, float pmax, float& m_hat, float& alpha, f32x16& negm, bool first) {
    { auto rr = __builtin_amdgcn_permlane32_swap(__float_as_uint(pmax), __float_as_uint(pmax), false, false);
      pmax = fmaxf(__uint_as_float(rr[0]), __uint_as_float(rr[1])); }
    if (!first && __builtin_expect(__all(pmax <= THR_L2), 1)) { alpha = 1.f; }
    else { const float dl = first ? pmax : fmaxf(pmax, 0.f); m_hat += dl; alpha = first ? 1.f : __builtin_amdgcn_exp2f(-dl);
#pragma unroll
        for (int r = 0; r < 16; ++r) { p0[r] -= dl; p1[r] -= dl; }
#pragma unroll
        for (int r = 0; r < 16; ++r) negm[r] = -m_hat; }
}
__device__ __forceinline__ int v_st(int k, int c) { const int kk = (k & ~0xC) | ((k & 4) << 1) | ((k & 8) >> 1); return ((kk >> 3) * 4 + (c >> 5)) * 512 + ((kk & 7) * 32 + (c & 31)) * 2; }
__device__ __forceinline__ int v_rd_base(int lane) { return ((lane & 3) << 3) | (((lane >> 2) & 3) << 6) | (((lane >> 4) & 1) << 5) | (((lane >> 5) & 1) << 8); }
constexpr int v_rd_off(int d0, int ks, int half) { return d0 * 512 + ks * 4096 + half * 2048; }
template <int OFF> __device__ __forceinline__ s16x4 tr_read(int vb) {
    s16x4 r; asm volatile("ds_read_b64_tr_b16 %0, %1 offset:%2" : "=&v"(r) : "v"(vb), "i"(OFF) : "memory"); return r;
}
template <int D0> __device__ __forceinline__ void pv_one(f32x16& od, int vb, bf16x8 pa0, bf16x8 pa1, bf16x8 pa2, bf16x8 pa3) {
    const s16x4 l0 = tr_read<v_rd_off(D0, 0, 0)>(vb), h0 = tr_read<v_rd_off(D0, 0, 1)>(vb), l1 = tr_read<v_rd_off(D0, 1, 0)>(vb), h1 = tr_read<v_rd_off(D0, 1, 1)>(vb);
    const s16x4 l2 = tr_read<v_rd_off(D0, 2, 0)>(vb), h2 = tr_read<v_rd_off(D0, 2, 1)>(vb), l3 = tr_read<v_rd_off(D0, 3, 0)>(vb), h3 = tr_read<v_rd_off(D0, 3, 1)>(vb);
    asm volatile("s_waitcnt lgkmcnt(0)" ::: "memory"); SBAR();
#define PK(L, H) (bf16x8){L[0], L[1], L[2], L[3], H[0], H[1], H[2], H[3]}
    od = __builtin_amdgcn_mfma_f32_32x32x16_bf16(pa0, PK(l0, h0), od, 0, 0, 0);
    od = __builtin_amdgcn_mfma_f32_32x32x16_bf16(pa1, PK(l1, h1), od, 0, 0, 0);
    od = __builtin_amdgcn_mfma_f32_32x32x16_bf16(pa2, PK(l2, h2), od, 0, 0, 0);
    od = __builtin_amdgcn_mfma_f32_32x32x16_bf16(pa3, PK(l3, h3), od, 0, 0, 0);
#undef PK
}
__device__ __forceinline__ void pv_d0(f32x16* o, int vb, bf16x8 pa0, bf16x8 pa1, bf16x8 pa2, bf16x8 pa3) {
    pv_one<0>(o[0], vb, pa0, pa1, pa2, pa3); pv_one<1>(o[1], vb, pa0, pa1, pa2, pa3); pv_one<2>(o[2], vb, pa0, pa1, pa2, pa3); pv_one<3>(o[3], vb, pa0, pa1, pa2, pa3);
}
template <int MODE, bool PRE = false>
__device__ __forceinline__ void pv_sm(f32x16* o, int vb, bf16x8 pa0, bf16x8 pa1, bf16x8 pa2, bf16x8 pa3, f32x16& p0, f32x16& p1, float& m_reg, float& mn, float& alpha, const float C, const float thr_raw,
                                      int j, const TileMap& tm, const MaskInfo& mi, int wid, int r32, int hi, const float* btab, f32x16* negm = nullptr) {
    if constexpr (PRE) {
        pv_one<0>(o[0], vb, pa0, pa1, pa2, pa3);
        apply_mask<MODE>(p0, p1, j, tm, mi, wid, r32, hi, btab);
        float pmax = p0[0];
#pragma unroll
        for (int r = 1; r < 16; ++r) pmax = fmaxf(pmax, p0[r]);
        pv_one<1>(o[1], vb, pa0, pa1, pa2, pa3);
#pragma unroll
        for (int r = 0; r < 16; ++r) pmax = fmaxf(pmax, p1[r]);
        pv_one<2>(o[2], vb, pa0, pa1, pa2, pa3);
        presm_decide(p0, p1, pmax, m_reg, alpha, *negm, false);
        pv_one<3>(o[3], vb, pa0, pa1, pa2, pa3);
#pragma unroll
        for (int r = 0; r < 16; ++r) p0[r] = __builtin_amdgcn_exp2f(p0[r]);
        return;
    }
    pv_one<0>(o[0], vb, pa0, pa1, pa2, pa3);
    apply_mask<MODE>(p0, p1, j, tm, mi, wid, r32, hi, btab);
    float pmax = p0[0];
#pragma unroll
    for (int r = 1; r < 16; ++r) pmax = fmaxf(pmax, p0[r]);
    pv_one<1>(o[1], vb, pa0, pa1, pa2, pa3);
#pragma unroll
    for (int r = 0; r < 16; ++r) pmax = fmaxf(pmax, p1[r]);
    { auto rr = __builtin_amdgcn_permlane32_swap(__float_as_uint(pmax), __float_as_uint(pmax), false, false);
      pmax = fmaxf(__uint_as_float(rr[0]), __uint_as_float(rr[1])); }
    if (__builtin_expect(__all(pmax - m_reg <= thr_raw), 1)) { mn = m_reg; alpha = 1.f; }
    else { mn = fmaxf(m_reg, pmax); alpha = __builtin_amdgcn_exp2f((m_reg - mn) * C); m_reg = mn; }
    const float mnC = -mn * C;
    pv_one<2>(o[2], vb, pa0, pa1, pa2, pa3);
#pragma unroll
    for (int r = 0; r < 16; ++r) p0[r] = fmaf(p0[r], C, mnC);
#pragma unroll
    for (int r = 0; r < 16; ++r) p1[r] = fmaf(p1[r], C, mnC);
    pv_one<3>(o[3], vb, pa0, pa1, pa2, pa3);
#pragma unroll
    for (int r = 0; r < 16; ++r) p0[r] = __builtin_amdgcn_exp2f(p0[r]);
}

template <int MODE, bool PRE>
__device__ __forceinline__ void sm_alone(f32x16& p0, f32x16& p1, float& m_reg, float& mn, float& alpha, const float C, const float thr_raw,
                                         int j, const TileMap& tm, const MaskInfo& mi, int wid, int r32, int hi, const float* btab, f32x16& negm) {
    apply_mask<MODE>(p0, p1, j, tm, mi, wid, r32, hi, btab);
    if constexpr (PRE) { float pmax = p0[0];
#pragma unroll
        for (int r = 1; r < 16; ++r) pmax = fmaxf(pmax, p0[r]);
#pragma unroll
        for (int r = 0; r < 16; ++r) pmax = fmaxf(pmax, p1[r]);
        presm_decide(p0, p1, pmax, m_reg, alpha, negm, false);
#pragma unroll
        for (int r = 0; r < 16; ++r) p0[r] = __builtin_amdgcn_exp2f(p0[r]); }
    else partialSM(p0, p1, m_reg, mn, alpha, C, thr_raw);
}
template <int MODE, int DLO, int DHI, int SD = 2, bool QLDS = false>
__device__ __forceinline__ void attn_core(const bf16_t* __restrict__ Qb, const bf16_t* __restrict__ Kh, const bf16_t* __restrict__ Vh, const TileMap tm, const MaskInfo mi,
                                          const float C, const float thr_raw, char* lds, f32x16 (&o)[4], float& l_out, float& m_out) {
    const int tid = fresh_tid(), wid = tid >> 6, lane = tid & 63, r32 = lane & 31, hi = lane >> 5;
    char* V_lds = lds; char* K_lds = lds + 2 * SHM_V;
    float* ws = (float*)(lds + OFF_WS) + wid * 64; float* al_l = ws + 32;
    const float* btab = (const float*)(lds + OFF_BIAS);
    constexpr bool PRE = (PRESCALE != 0) && (MODE == 0 || (MODE == 1 && L1PRE));
    float m_reg = PRE ? 0.f : -1e30f, l_reg = 0; f32x16 negm = f32x16{};
#pragma unroll
    for (int d = 0; d < 4; ++d) o[d] = f32x16{};
    bf16x8 qr[8];
    const unsigned qoff = (unsigned)((wid * QBLK + r32) * LDQK + hi * 8);
#pragma unroll
    for (int d0 = 0; d0 < 8; ++d0) { if (d0 >= DLO && d0 < DHI) qr[d0] = *reinterpret_cast<const bf16x8*>(Qb + qoff + d0 * 16); else qr[d0] = bf16x8{}; }
    const char* qlds = lds + OFF_STASH + tid * 16;
    if constexpr (QLDS) {
#pragma unroll
        for (int d0 = DLO; d0 < DHI; ++d0) *(bf16x8*)(lds + OFF_STASH + tid * 16 + d0 * 8192) = qr[d0];
        asm volatile("s_waitcnt lgkmcnt(0)" ::: "memory");
    }
    const int sr = tid >> 4, sc = (tid & 15) * 8, vst0 = v_st(sr, sc), vst1 = v_st(32 + sr, sc);
    const unsigned loff = (unsigned)(sr * LDQK + sc);
    const int vb0 = (int)(uintptr_t)V_lds + v_rd_base(lane);
    struct { bf16x8 vs0, vs1, ks0, ks1; } sr_[SD];
#define SLOAD(i, k0) do { const size_t _k0 = (size_t)(k0) * LDQK; const bf16_t* _kt = Kh + _k0; const bf16_t* _vt = Vh + _k0; \
    sr_[i].vs0 = *reinterpret_cast<const bf16x8*>(_vt + loff); sr_[i].vs1 = *reinterpret_cast<const bf16x8*>(_vt + 32 * LDQK + loff); \
    sr_[i].ks0 = *reinterpret_cast<const bf16x8*>(_kt + loff); sr_[i].ks1 = *reinterpret_cast<const bf16x8*>(_kt + 32 * LDQK + loff); } while (0)
#define SWRITE(b, i) do { *(bf16x8*)(V_lds + (b) * SHM_V + vst0) = sr_[i].vs0; *(bf16x8*)(V_lds + (b) * SHM_V + vst1) = sr_[i].vs1; const int kc = sc * 2; \
    *(bf16x8*)(K_lds + (b) * SHM_K + KSWZ(sr, kc)) = sr_[i].ks0; *(bf16x8*)(K_lds + (b) * SHM_K + KSWZ(32 + sr, kc)) = sr_[i].ks1; } while (0)
#define SWAIT() do { if constexpr (SD == 2) asm volatile("s_waitcnt vmcnt(4)" ::: "memory"); else asm volatile("s_waitcnt vmcnt(0)" ::: "memory"); } while (0)
#define RESC(a) do { if (__any((a) < 1.f)) { if (hi == 0) al_l[r32] = (a); asm volatile("s_waitcnt lgkmcnt(0)" ::: "memory"); \
    _Pragma("unroll") for (int d = 0; d < 4; ++d) _Pragma("unroll") for (int r = 0; r < 16; ++r) o[d][r] *= al_l[crow(r, hi)]; } } while (0)
    f32x16 pA0, pA1, pB0, pB1; float mnA, mnB, alA, alB; bf16x8 pa0, pa1, pa2, pa3; const int NT = tm.NT;
    constexpr int SE = 0, SO = SD - 1;
    SLOAD(SE, tm.krow(0)); asm volatile("s_waitcnt vmcnt(0)" ::: "memory"); SWRITE(0, SE); __syncthreads();
    qkt<DLO, DHI, QLDS, PRE>(pA0, pA1, K_lds, qr, qlds, r32, hi, negm); apply_mask<MODE>(pA0, pA1, 0, tm, mi, wid, r32, hi, btab);
    if constexpr (PRE) { float pmax = pA0[0];
#pragma unroll
        for (int r = 1; r < 16; ++r) pmax = fmaxf(pmax, pA0[r]);
#pragma unroll
        for (int r = 0; r < 16; ++r) pmax = fmaxf(pmax, pA1[r]);
        presm_decide(pA0, pA1, pmax, m_reg, alA, negm, true);
#pragma unroll
        for (int r = 0; r < 16; ++r) pA0[r] = __builtin_amdgcn_exp2f(pA0[r]); }
    else partialSM(pA0, pA1, m_reg, mnA, alA, C, thr_raw);
    SLOAD(SO, tm.krow(1)); if constexpr (SD == 2) { if (2 < NT) SLOAD(SE, tm.krow(2)); }
    SWAIT(); SWRITE(1, SO); __syncthreads();
    if constexpr (true) {
        for (int j = 1; j + 1 < NT; j += 2) {
            SBAR(); qkt<DLO, DHI, QLDS, PRE>(pB0, pB1, K_lds + SHM_K, qr, qlds, r32, hi, negm);
            finishSM(pA0, pA1, alA, l_reg, pa0, pa1, pa2, pa3); SBAR();
            SLOAD(SO, tm.krow(j + SD)); SBAR();
            pv_sm<MODE, PRE>(o, vb0, pa0, pa1, pa2, pa3, pB0, pB1, m_reg, mnB, alB, C, thr_raw, j, tm, mi, wid, r32, hi, btab, &negm);
            __syncthreads(); SWAIT(); SWRITE(0, SE);
            RESC(alB); __syncthreads();
            SBAR(); qkt<DLO, DHI, QLDS, PRE>(pA0, pA1, K_lds, qr, qlds, r32, hi, negm);
            finishSM(pB0, pB1, alB, l_reg, pa0, pa1, pa2, pa3); SBAR();
            if (SD == 1 || j + 3 < NT) SLOAD(SE, tm.krow(j + 1 + SD)); SBAR();
            pv_sm<MODE, PRE>(o, vb0 + SHM_V, pa0, pa1, pa2, pa3, pA0, pA1, m_reg, mnA, alA, C, thr_raw, j + 1, tm, mi, wid, r32, hi, btab, &negm);
            __syncthreads(); SWAIT(); SWRITE(1, SO);
            RESC(alA); __syncthreads();
        }
        SBAR(); qkt<DLO, DHI, QLDS, PRE>(pB0, pB1, K_lds + SHM_K, qr, qlds, r32, hi, negm);
        finishSM(pA0, pA1, alA, l_reg, pa0, pa1, pa2, pa3); SBAR();
        pv_sm<MODE, PRE>(o, vb0, pa0, pa1, pa2, pa3, pB0, pB1, m_reg, mnB, alB, C, thr_raw, NT - 1, tm, mi, wid, r32, hi, btab, &negm);
        __syncthreads(); RESC(alB);
        finishSM(pB0, pB1, alB, l_reg, pa0, pa1, pa2, pa3); SBAR();
        pv_d0(o, vb0 + SHM_V, pa0, pa1, pa2, pa3);
    } else {
        const int widu = __builtin_amdgcn_readfirstlane(wid);
        auto ACT = [&](int j) -> bool {
            if (j < tm.NC) return true;
            if constexpr (MODE == 1) { const int kp0 = tm.lbase + 64 * (j - tm.NC), qw = mi.q0 + widu * 32; return !(kp0 + 63 - qw < -128 || kp0 - (qw + 31) > 128); }
            else { const int kr = mi.lo + (j - tm.NC), rq = mi.r0 + (widu >> 1); int rs = rq - 4; rs = rs < 0 ? 0 : (rs > 56 ? 56 : rs); return kr >= rs && kr < rs + 8; } };
#define TSTEP(PC0, PC1, ALC, MNC, PP0, PP1, ALP, KOFF, VOFF, JC, AP, AC) do { \
        SBAR(); if (AC) qkt<DLO, DHI, QLDS, PRE>(PC0, PC1, K_lds + (KOFF), qr, qlds, r32, hi, negm); else { asm("" : "=v"(PC0)); asm("" : "=v"(PC1)); }    \
        if (AP) finishSM(PP0, PP1, ALP, l_reg, pa0, pa1, pa2, pa3); else { asm("" : "=v"(pa0)); asm("" : "=v"(pa1)); asm("" : "=v"(pa2)); asm("" : "=v"(pa3)); } SBAR(); } while (0)
#define TPV(PC0, PC1, ALC, MNC, VOFF, JC, AP, AC) do { \
        if ((AP) && (AC)) pv_sm<MODE, PRE>(o, vb0 + (VOFF), pa0, pa1, pa2, pa3, PC0, PC1, m_reg, MNC, ALC, C, thr_raw, JC, tm, mi, wid, r32, hi, btab, &negm); \
        else if (AP) pv_d0(o, vb0 + (VOFF), pa0, pa1, pa2, pa3); \
        else if (AC) sm_alone<MODE, PRE>(PC0, PC1, m_reg, MNC, ALC, C, thr_raw, JC, tm, mi, wid, r32, hi, btab, negm); } while (0)
        bool aA = true, aB;
        for (int j = 1; j + 1 < NT; j += 2) {
            aB = ACT(j);
            TSTEP(pB0, pB1, alB, mnB, pA0, pA1, alA, SHM_K, 0, j, aA, aB);
            SLOAD(SO, tm.krow(j + SD)); SBAR();
            TPV(pB0, pB1, alB, mnB, 0, j, aA, aB);
            __syncthreads(); SWAIT(); SWRITE(0, SE);
            if (aB) RESC(alB); __syncthreads();
            aA = ACT(j + 1);
            TSTEP(pA0, pA1, alA, mnA, pB0, pB1, alB, 0, SHM_V, j + 1, aB, aA);
            if (SD == 1 || j + 3 < NT) SLOAD(SE, tm.krow(j + 1 + SD)); SBAR();
            TPV(pA0, pA1, alA, mnA, SHM_V, j + 1, aB, aA);
            __syncthreads(); SWAIT(); SWRITE(1, SO);
            if (aA) RESC(alA); __syncthreads();
        }
        aB = ACT(NT - 1);
        TSTEP(pB0, pB1, alB, mnB, pA0, pA1, alA, SHM_K, 0, NT - 1, aA, aB);
        TPV(pB0, pB1, alB, mnB, 0, NT - 1, aA, aB);
        __syncthreads(); if (aB) RESC(alB);
        if (aB) { finishSM(pB0, pB1, alB, l_reg, pa0, pa1, pa2, pa3); SBAR();
            pv_d0(o, vb0 + SHM_V, pa0, pa1, pa2, pa3); }
#undef TSTEP
#undef TPV
    }
    l_out = l_reg; m_out = m_reg;
#undef SLOAD
#undef SWRITE
#undef SWAIT
#undef RESC
}

template <int MODE, int DLO, int DHI, bool QLDS>
__device__ __forceinline__ void attn_core_dma(const bf16_t* __restrict__ Qb, const bf16_t* __restrict__ Kh, const bf16_t* __restrict__ Vh, const TileMap tm, const MaskInfo mi,
                                              const float C, const float thr_raw, char* lds, f32x16 (&o)[4], float& l_out, float& m_out) {
    const int tid = fresh_tid(), wid = tid >> 6, lane = tid & 63, r32 = lane & 31, hi = lane >> 5;
    const int widu = __builtin_amdgcn_readfirstlane(wid);
    char* V_lds = lds; char* K_lds = lds + 2 * SHM_V;
    float* ws = (float*)(lds + OFF_WS) + wid * 64; float* al_l = ws + 32;
    const float* btab = (const float*)(lds + OFF_BIAS);
    constexpr bool PRE = (PRESCALE != 0) && (MODE == 0 || (MODE == 1 && L1PRE));
    float m_reg = PRE ? 0.f : -1e30f, l_reg = 0; f32x16 negm = f32x16{};
#pragma unroll
    for (int d = 0; d < 4; ++d) o[d] = f32x16{};
    bf16x8 qr[8];
    const unsigned qoff = (unsigned)((wid * QBLK + r32) * LDQK + hi * 8);
#pragma unroll
    for (int d0 = 0; d0 < 8; ++d0) { if (d0 >= DLO && d0 < DHI) qr[d0] = *reinterpret_cast<const bf16x8*>(Qb + qoff + d0 * 16); else qr[d0] = bf16x8{}; }
    const char* qlds = lds + OFF_STASH + tid * 16;
    if constexpr (QLDS) {
#pragma unroll
        for (int d0 = DLO; d0 < DHI; ++d0) *(bf16x8*)(lds + OFF_STASH + tid * 16 + d0 * 8192) = qr[d0];
        asm volatile("s_waitcnt lgkmcnt(0)" ::: "memory");
    }
    unsigned kso[2], vso[2];
#pragma unroll
    for (int i = 0; i < 2; ++i) { const int row = (i * 8 + wid) * 4 + (lane >> 4), col = ((lane & 15) ^ (row & 7)) * 8; kso[i] = (unsigned)(row * LDQK + col) * 2u;
        const int st = (i * 8 + wid) * 2 + (lane >> 5), kk = (st >> 2) * 8 + ((lane & 31) >> 2), k = (kk & ~0xC) | ((kk & 4) << 1) | ((kk & 8) >> 1), c = (st & 3) * 32 + (lane & 3) * 8;
        vso[i] = (unsigned)(k * LDQK + c) * 2u; }
    LAS unsigned char* Vd = (LAS unsigned char*)V_lds + widu * 1024; LAS unsigned char* Kd = (LAS unsigned char*)K_lds + widu * 1024;
    const int vb0 = (int)(uintptr_t)V_lds + v_rd_base(lane);
#define DMAK(b, k0) do { const char* _g = (const char*)(Kh + (size_t)(k0) * LDQK); _Pragma("unroll") for (int _i = 0; _i < 2; ++_i) \
        __builtin_amdgcn_global_load_lds((const unsigned*)(_g + kso[_i]), (LAS unsigned*)(Kd + (b) * SHM_K + _i * 8192), 16, 0, 0); } while (0)
#define DMAV(b, k0) do { const char* _g = (const char*)(Vh + (size_t)(k0) * LDQK); _Pragma("unroll") for (int _i = 0; _i < 2; ++_i) \
        __builtin_amdgcn_global_load_lds((const unsigned*)(_g + vso[_i]), (LAS unsigned*)(Vd + (b) * SHM_V + _i * 8192), 16, 0, 0); } while (0)
#define LANDED() do { asm volatile("s_waitcnt vmcnt(0)" ::: "memory"); __builtin_amdgcn_s_barrier(); asm volatile("" ::: "memory"); } while (0)
#define RESC(a) do { if (__any((a) < 1.f)) { if (hi == 0) al_l[r32] = (a); asm volatile("s_waitcnt lgkmcnt(0)" ::: "memory"); \
    _Pragma("unroll") for (int d = 0; d < 4; ++d) _Pragma("unroll") for (int r = 0; r < 16; ++r) o[d][r] *= al_l[crow(r, hi)]; } } while (0)
    f32x16 pA0, pA1, pB0, pB1; float mnA, mnB, alA, alB; bf16x8 pa0, pa1, pa2, pa3; const int NT = tm.NT;
    DMAK(0, tm.krow(0)); DMAV(0, tm.krow(0)); DMAK(1, tm.krow(1)); LANDED();
    qkt<DLO, DHI, QLDS, PRE>(pA0, pA1, K_lds, qr, qlds, r32, hi, negm); apply_mask<MODE>(pA0, pA1, 0, tm, mi, wid, r32, hi, btab);
    if constexpr (PRE) { float pmax = pA0[0];
#pragma unroll
        for (int r = 1; r < 16; ++r) pmax = fmaxf(pmax, pA0[r]);
#pragma unroll
        for (int r = 0; r < 16; ++r) pmax = fmaxf(pmax, pA1[r]);
        presm_decide(pA0, pA1, pmax, m_reg, alA, negm, true);
#pragma unroll
        for (int r = 0; r < 16; ++r) pA0[r] = __builtin_amdgcn_exp2f(pA0[r]); }
    else partialSM(pA0, pA1, m_reg, mnA, alA, C, thr_raw);
    asm volatile("s_waitcnt lgkmcnt(0)" ::: "memory"); __builtin_amdgcn_s_barrier(); asm volatile("" ::: "memory");
    auto ACT = [&](int j) -> bool {
        if constexpr (MODE == 0 || !TSKIP) return true;
        else { if (j < tm.NC) return true;
            if constexpr (MODE == 1) { const int kp0 = tm.lbase + 64 * (j - tm.NC), qw = mi.q0 + widu * 32; return !(kp0 + 63 - qw < -128 || kp0 - (qw + 31) > 128); }
            else { const int kr = mi.lo + (j - tm.NC), rq = mi.r0 + (widu >> 1); int rs = rq - 4; rs = rs < 0 ? 0 : (rs > 56 ? 56 : rs); return kr >= rs && kr < rs + 8; } } };
#define TQS(PC0, PC1, PP0, PP1, ALP, KOFF, AP, AC) do { \
        SBAR(); if (AC) qkt<DLO, DHI, QLDS, PRE>(PC0, PC1, K_lds + (KOFF), qr, qlds, r32, hi, negm); else { asm("" : "=v"(PC0)); asm("" : "=v"(PC1)); }    \
        if (AP) finishSM(PP0, PP1, ALP, l_reg, pa0, pa1, pa2, pa3); else { asm("" : "=v"(pa0)); asm("" : "=v"(pa1)); asm("" : "=v"(pa2)); asm("" : "=v"(pa3)); } SBAR(); } while (0)
#define TPV(PC0, PC1, ALC, MNC, VOFF, JC, AP, AC) do { \
        if ((AP) && (AC)) pv_sm<MODE, PRE>(o, vb0 + (VOFF), pa0, pa1, pa2, pa3, PC0, PC1, m_reg, MNC, ALC, C, thr_raw, JC, tm, mi, wid, r32, hi, btab, &negm); \
        else if (AP) pv_d0(o, vb0 + (VOFF), pa0, pa1, pa2, pa3); \
        else if (AC) sm_alone<MODE, PRE>(PC0, PC1, m_reg, MNC, ALC, C, thr_raw, JC, tm, mi, wid, r32, hi, btab, negm); \
        if (AC) RESC(ALC); } while (0)
    bool aA = true, aB;
    for (int j = 1; j + 1 < NT; j += 2) {
        DMAK(0, tm.krow(j + 1)); DMAV(1, tm.krow(j)); aB = ACT(j);
        TQS(pB0, pB1, pA0, pA1, alA, SHM_K, aA, aB);
        TPV(pB0, pB1, alB, mnB, 0, j, aA, aB);
        LANDED();
        DMAK(1, tm.krow(j + 2)); DMAV(0, tm.krow(j + 1)); aA = ACT(j + 1);
        TQS(pA0, pA1, pB0, pB1, alB, 0, aB, aA);
        TPV(pA0, pA1, alA, mnA, SHM_V, j + 1, aB, aA);
        LANDED();
    }
    DMAV(1, tm.krow(NT - 1)); aB = ACT(NT - 1);
    TQS(pB0, pB1, pA0, pA1, alA, SHM_K, aA, aB);
    TPV(pB0, pB1, alB, mnB, 0, NT - 1, aA, aB);
    LANDED();
    if (aB) { finishSM(pB0, pB1, alB, l_reg, pa0, pa1, pa2, pa3); SBAR();
        pv_d0(o, vb0 + SHM_V, pa0, pa1, pa2, pa3); }
    l_out = l_reg; m_out = m_reg;
#undef DMAK
#undef DMAV
#undef LANDED
#undef RESC
#undef TQS
#undef TPV
}
__device__ __forceinline__ void normalise(f32x16 (&o)[4], float l_reg, char* lds) {
    const int tid = fresh_tid(), wid = tid >> 6, lane = tid & 63, r32 = lane & 31, hi = lane >> 5;
    float* li_l = (float*)(lds + OFF_WS) + wid * 64;
    if (hi == 0) li_l[r32] = l_reg; asm volatile("s_waitcnt lgkmcnt(0)" ::: "memory");
#pragma unroll
    for (int r = 0; r < 16; ++r) { const float rl = __builtin_amdgcn_rcpf(li_l[crow(r, hi)]);
#pragma unroll
        for (int d0 = 0; d0 < 4; ++d0) o[d0][r] *= rl; }
    asm volatile("s_waitcnt lgkmcnt(0)" ::: "memory");
}
__device__ __forceinline__ void store_o(const f32x16 (&o)[4], bf16_t* Ob) {
    const int tid = fresh_tid(), wid = tid >> 6, lane = tid & 63, r32 = lane & 31, hi = lane >> 5;
    __hip_bfloat16* Ow = (__hip_bfloat16*)Ob + (long)(wid * QBLK) * LDO;
#pragma unroll
    for (int r = 0; r < 16; ++r) { const int orow = crow(r, hi);
#pragma unroll
        for (int d0 = 0; d0 < 4; ++d0) Ow[(long)orow * LDO + d0 * 32 + r32] = __float2bfloat16(o[d0][r]); }
}
__device__ __forceinline__ void store_o8(const f32x16 (&o)[4], unsigned char* Ob8) {
    const int tid = fresh_tid(), wid = tid >> 6, lane = tid & 63, r32 = lane & 31, hi = lane >> 5;
    unsigned char* Ow = Ob8 + (long)(wid * QBLK) * LDO;
#pragma unroll
    for (int r = 0; r < 16; r += 2) { const int orow = crow(r, hi);
#pragma unroll
        for (int d0 = 0; d0 < 4; ++d0) { const int w = __builtin_amdgcn_cvt_pk_fp8_f32(clamp8(o[d0][r] * S_A8), clamp8(o[d0][r + 1] * S_A8), 0, false);
            Ow[(long)orow * LDO + d0 * 32 + r32] = (unsigned char)(w & 0xff); Ow[(long)(orow + 1) * LDO + d0 * 32 + r32] = (unsigned char)((w >> 8) & 0xff); } }
}
template <int MODE>
__device__ __forceinline__ void unit_std(const bf16_t* Qb, const bf16_t* Kh, const bf16_t* Vh, const TileMap tm, const MaskInfo mi, float sink, bf16_t* Ob, char* lds) {
    f32x16 o[4]; float l, m;
    const float C = ATT_SCALE * LOG2E;
    if constexpr (ATT_DMA) attn_core_dma<MODE, 0, 8, (MODE != 0)>(Qb, Kh, Vh, tm, mi, C, THR / ATT_SCALE, lds, o, l, m);
    else attn_core<MODE, 0, 8, (MODE == 0 ? STD_SD : 1), (MODE != 0)>(Qb, Kh, Vh, tm, mi, C, THR / ATT_SCALE, lds, o, l, m);
    if constexpr (MODE == 1) l += __builtin_amdgcn_exp2f(sink * LOG2E - ((PRESCALE && L1PRE) ? m : m * C));
    normalise(o, l, lds);
    if constexpr (MODE != 0 && L1ATT_FP8) store_o8(o, (unsigned char*)Ob); else store_o(o, Ob);
    __syncthreads();
}
__device__ __forceinline__ void unit_diff(const bf16_t* Qb, const bf16_t* Kh, const bf16_t* Vh, const TileMap tm, float lam, const float* subln_g, bf16_t* Ob, char* lds) {
    const int tid = fresh_tid(), lane = tid & 63, r32 = lane & 31;
    f32x16 o[4]; float l, m; const MaskInfo mi{0, 0, 0};
    const float C = A_SCALE * LOG2E;
    unsigned* stash = (unsigned*)(lds + OFF_STASH);
    if constexpr (ATT_DMA) attn_core_dma<0, 0, 4, false>(Qb, Kh, Vh, tm, mi, C, THR / A_SCALE, lds, o, l, m); else attn_core<0, 0, 4, DIFF_SD>(Qb, Kh, Vh, tm, mi, C, THR / A_SCALE, lds, o, l, m);
    normalise(o, l, lds);
#pragma unroll
    for (int d0 = 0; d0 < 4; ++d0)
#pragma unroll
        for (int r = 0; r < 16; r += 2) stash[(d0 * 8 + (r >> 1)) * 512 + tid] = cvt_pk_bf16(o[d0][r], o[d0][r + 1]);
    __syncthreads();
    if constexpr (ATT_DMA) attn_core_dma<0, 4, 8, false>(Qb, Kh, Vh, tm, mi, C, THR / A_SCALE, lds, o, l, m); else attn_core<0, 4, 8, DIFF_SD>(Qb, Kh, Vh, tm, mi, C, THR / A_SCALE, lds, o, l, m);
    normalise(o, l, lds);
    float ss[16];
#pragma unroll
    for (int r = 0; r < 16; ++r) ss[r] = 0.f;
#pragma unroll
    for (int d0 = 0; d0 < 4; ++d0)
#pragma unroll
        for (int r = 0; r < 16; r += 2) { const unsigned w = stash[(d0 * 8 + (r >> 1)) * 512 + tid];
            const float a = bf_lo(w) - lam * o[d0][r], b = bf_hi(w) - lam * o[d0][r + 1];
            o[d0][r] = a; o[d0][r + 1] = b; ss[r] += a * a; ss[r + 1] += b * b; }
#pragma unroll
    for (int r = 0; r < 16; ++r) {
#pragma unroll
        for (int x = 1; x < 32; x <<= 1) ss[r] += __shfl_xor(ss[r], x);
        ss[r] = (1.0f - LAMBDA_INIT) / sqrtf(ss[r] * (1.0f / 128.0f) + EPS); }
    float gg[4];
#pragma unroll
    for (int d0 = 0; d0 < 4; ++d0) gg[d0] = subln_g[d0 * 32 + r32];
#pragma unroll
    for (int d0 = 0; d0 < 4; ++d0)
#pragma unroll
        for (int r = 0; r < 16; ++r) o[d0][r] *= ss[r] * gg[d0];
    store_o(o, Ob);
    __syncthreads();
}
#undef SBAR
}

#define XB_TMO      128
#define XB_XCNT(j)  (256  + 64 * (j))
#define XB_XSUB(j)  (1280 + 64 * (j))
#define XB_XGEN(j)  (2304 + 64 * (j))
#define XB_TOP      3328
#define XB_TOPGEN   3392
#define XCD_BAR_WORDS 3456
#define XB_SPIN_CAP (1u << 22)
__device__ __forceinline__ unsigned xb_ld(unsigned* p)              { return __hip_atomic_load(p, __ATOMIC_RELAXED, __HIP_MEMORY_SCOPE_AGENT); }
__device__ __forceinline__ unsigned xb_add(unsigned* p, unsigned v) { return __hip_atomic_fetch_add(p, v, __ATOMIC_RELAXED, __HIP_MEMORY_SCOPE_AGENT); }
__device__ __forceinline__ unsigned xb_xcc_id() { return (unsigned)__builtin_amdgcn_s_getreg((3 << 11) | 20) & 0xFu; }
#define XB_SPIN(cond, bar) do { unsigned _sp = 0; while (cond) { __builtin_amdgcn_s_sleep(1); \
    if ((++_sp & 255u) == 0u) { if (xb_ld(&(bar)[XB_TMO])) break; if (_sp > XB_SPIN_CAP) { atomicAdd(&(bar)[XB_TMO], 1u); break; } } } } while (0)
struct XcdBarrier { unsigned* bar; unsigned x; volatile LAS unsigned* st; };
__device__ __forceinline__ XcdBarrier xcd_barrier_post(unsigned* bar, volatile LAS unsigned* st) {
    XcdBarrier b; b.bar = bar; b.x = xb_xcc_id(); b.st = st;
    if (threadIdx.x == 0) (void)xb_add(&bar[XB_XCNT(b.x)], 1u);
    return b;
}
__device__ __forceinline__ void xcd_barrier_complete(unsigned* bar, unsigned x, unsigned& nloc, unsigned& nx) {
    const unsigned G = gridDim.x * gridDim.y * gridDim.z;
    unsigned sum, cnt, mine, sp = 0u;
    for (;;) {
        sum = 0u; cnt = 0u; mine = 0u;
#pragma unroll
        for (unsigned j = 0; j < 16; ++j) { const unsigned c = xb_ld(&bar[XB_XCNT(j)]); sum += c; cnt += (c > 0u) ? 1u : 0u; mine = (j == x) ? c : mine; }
        if (sum == G) break;
        __builtin_amdgcn_s_sleep(1);
        if ((++sp & 255u) == 0u) { if (xb_ld(&bar[XB_TMO])) break; if (sp > XB_SPIN_CAP) { atomicAdd(&bar[XB_TMO], 1u); break; } }
    }
    nloc = mine > 0u ? mine : 1u; nx = cnt > 0u ? cnt : 1u;
}
__device__ __forceinline__ void xcd_barrier(const XcdBarrier& b) {
    asm volatile("s_waitcnt vmcnt(0)" ::: "memory");
    __syncthreads();
    if (threadIdx.x == 0) {
        unsigned* bar = b.bar;
        __builtin_amdgcn_s_waitcnt(0);
        unsigned nloc = b.st[0], nx = b.st[1];
        if (nloc == 0u) { xcd_barrier_complete(bar, b.x, nloc, nx); b.st[0] = nloc; b.st[1] = nx; }
        const unsigned old = xb_add(&bar[XB_XSUB(b.x)], 1u);
        const unsigned gen = old / nloc;
        if (old + 1u == (gen + 1u) * nloc) {
            __builtin_amdgcn_fence(__ATOMIC_RELEASE, "agent");
            asm volatile("s_waitcnt vmcnt(0)" ::: "memory");
            const unsigned og = xb_add(&bar[XB_TOP], 1u);
            const unsigned tg = og / nx;
            if (og + 1u == (tg + 1u) * nx) xb_add(&bar[XB_TOPGEN], 1u);
            else XB_SPIN(xb_ld(&bar[XB_TOPGEN]) == tg, bar);
            __builtin_amdgcn_fence(__ATOMIC_ACQUIRE, "agent");
            xb_add(&bar[XB_XGEN(b.x)], 1u);
            asm volatile("s_waitcnt vmcnt(0)" ::: "memory");
        } else {
            XB_SPIN(xb_ld(&bar[XB_XGEN(b.x)]) == gen, bar);
            __builtin_amdgcn_fence(__ATOMIC_ACQUIRE, "agent");
            asm volatile("s_waitcnt vmcnt(0)" ::: "memory");
        }
    }
    __syncthreads();
}

struct Args { const float* in[33]; float* out; unsigned char* ws; int ph_lo, ph_hi; };
struct Frame {
    LAS unsigned char* lds; int vcu, G;
};

__device__ __forceinline__ void transpose_item(const float* W, int ldw, int K, bf16_t* WT, int k0, int n0, long dst_row0, LAS float* scr, int lane) {
    { float tv[32]; const float* wp = W + (size_t)(k0 + (lane >> 5)) * ldw + n0 + (lane & 31);
#pragma unroll
      for (int i = 0; i < 32; ++i) tv[i] = wp[(size_t)(2 * i) * ldw];
#pragma unroll
      for (int i = 0; i < 32; ++i) scr[(2 * i + (lane >> 5)) * 33 + (lane & 31)] = tv[i]; }
    LDS_WAIT(); asm volatile("" ::: "memory");
    const int c = lane & 7;
#pragma unroll
    for (int j = 0; j < 4; ++j) { const int n = (lane >> 3) + 8 * j; const LAS float* s = scr + (8 * c) * 33 + n;
        u32x4 o; o.x = cvt_pk_bf16(s[0 * 33], s[1 * 33]); o.y = cvt_pk_bf16(s[2 * 33], s[3 * 33]); o.z = cvt_pk_bf16(s[4 * 33], s[5 * 33]); o.w = cvt_pk_bf16(s[6 * 33], s[7 * 33]);
        *(GAS u32x4*)(WT + (size_t)(dst_row0 + n) * K + k0 + 8 * c) = o; }
    LDS_WAIT(); asm volatile("" ::: "memory");
}
__device__ __forceinline__ void transpose_item8(const float* W, int ldw, int K, unsigned char* WT, int k0, int n0, long dst_row0, LAS float* scr, int lane, float scale) {
#pragma unroll
    for (int hb = 0; hb < 2; ++hb) { float tv[32]; const float* wp = W + (size_t)(k0 + 64 * hb + (lane >> 5)) * ldw + n0 + (lane & 31);
#pragma unroll
        for (int i = 0; i < 32; ++i) tv[i] = wp[(size_t)(2 * i) * ldw];
#pragma unroll
        for (int i = 0; i < 32; ++i) { const int kk = 64 * hb + 2 * i + (lane >> 5); scr[kk * 32 + (((lane & 31) + 8 * (kk >> 4)) & 31)] = tv[i]; } }
    LDS_WAIT(); asm volatile("" ::: "memory");
    const int c = lane & 7;
#pragma unroll
    for (int j = 0; j < 4; ++j) { const int n = (lane >> 3) + 8 * j; const LAS float* s = scr + (16 * c) * 32 + ((n + 8 * c) & 31);
        u32x4 o;
        o.x = pk4_fp8(s[0 * 32] * scale, s[1 * 32] * scale, s[2 * 32] * scale, s[3 * 32] * scale); o.y = pk4_fp8(s[4 * 32] * scale, s[5 * 32] * scale, s[6 * 32] * scale, s[7 * 32] * scale);
        o.z = pk4_fp8(s[8 * 32] * scale, s[9 * 32] * scale, s[10 * 32] * scale, s[11 * 32] * scale); o.w = pk4_fp8(s[12 * 32] * scale, s[13 * 32] * scale, s[14 * 32] * scale, s[15 * 32] * scale);
        *(GAS u32x4*)(WT + (size_t)(dst_row0 + n) * K + k0 + 16 * c) = o; }
    LDS_WAIT(); asm volatile("" ::: "memory");
}
__device__ __forceinline__ void tr_plain8(const float* W, int K, int N, unsigned char* WT, long row_off, LAS float* scr, int item, int lane) {
    const int nblk = N / 32, kb = item / nblk, nb = item % nblk;
    transpose_item8(W, N, K, WT, 128 * kb, 32 * nb, row_off + 32 * nb, scr, lane, S_W8);
}
__device__ __forceinline__ void tr_gu8(const float* W, int K, int N, unsigned char* WT, long row_off, int up, LAS float* scr, int item, int lane) {
    const int nblk = N / 32, kb = item / nblk, nb = item % nblk, n0 = 32 * nb;
    transpose_item8(W, N, K, WT, 128 * kb, n0, row_off + (long)(n0 >> 7) * 256 + (n0 & 127) + up * 128, scr, lane, S_W8);
}
__device__ __forceinline__ void tr_plain(const float* W, int K, int N, bf16_t* WT, long row_off, LAS float* scr, int item, int lane) {
    const int nblk = N / 32, kb = item / nblk, nb = item % nblk;
    transpose_item(W, N, K, WT, 64 * kb, 32 * nb, row_off + 32 * nb, scr, lane);
}
__device__ __forceinline__ void tr_gu(const float* W, int K, int N, bf16_t* WT, long row_off, int up, LAS float* scr, int item, int lane) {
    const int nblk = N / 32, kb = item / nblk, nb = item % nblk, n0 = 32 * nb;
    transpose_item(W, N, K, WT, 64 * kb, n0, row_off + (long)(n0 >> 7) * 256 + (n0 & 127) + up * 128, scr, lane);
}

template <bool OUT8 = false>
__device__ __forceinline__ void mod_row(const float* xrow, const float* g, const float* sh, const float* sc, bf16_t* orow, int lane, f32x4 (&v)[8], const float* xs = nullptr, size_t xs_stride = 0, int nxs = 0, float* xout = nullptr) {
    const f32x4* xr = (const f32x4*)xrow + lane;
    float s = 0.f;
#pragma unroll
    for (int j = 0; j < 8; ++j) { v[j] = xr[64 * j];
        if (xs) {
#pragma unroll
            for (int p = 0; p < 8; ++p) if (p < nxs) v[j] += ((const f32x4*)(xs + p * xs_stride))[64 * j + lane];
            if (xout) ((f32x4*)xout)[64 * j + lane] = v[j]; }
        s += (v[j].x * v[j].x + v[j].y * v[j].y) + (v[j].z * v[j].z + v[j].w * v[j].w); }
    const float rstd = 1.0f / sqrtf(wave_sum(s) * (1.0f / DM) + EPS);
    u32x2* o8 = (u32x2*)orow + lane;
#pragma unroll
    for (int j = 0; j < 8; ++j) { const f32x4 gg = ((const f32x4*)g)[64 * j + lane], ss = ((const f32x4*)sc)[64 * j + lane], hh = ((const f32x4*)sh)[64 * j + lane];
        v[j] = v[j] * rstd * gg * (ss + 1.0f) + hh;
        if constexpr (OUT8) ((unsigned*)orow)[64 * j + lane] = pk4_fp8(v[j].x * S_H8, v[j].y * S_H8, v[j].z * S_H8, v[j].w * S_H8);
        else { u32x2 w; w.x = cvt_pk_bf16(v[j].x, v[j].y); w.y = cvt_pk_bf16(v[j].z, v[j].w); o8[64 * j] = w; } }
}
__device__ __forceinline__ const float* in_row(const float* x, const float* ctx, int row) {
    const int b = row / RPB, t = row % RPB;
    return t < SEQ ? x + ((size_t)b * SEQ + t) * DM : ctx + ((size_t)b * NCTX + (t - SEQ)) * DM;
}

__device__ __forceinline__ void rope8(float (&f)[8], const float* cs, const float* sn) {
    const f32x4 c = *(const f32x4*)cs, s = *(const f32x4*)sn;
#pragma unroll
    for (int p = 0; p < 4; ++p) { const float x0 = f[2 * p], x1 = f[2 * p + 1]; f[2 * p] = x0 * c[p] - x1 * s[p]; f[2 * p + 1] = x0 * s[p] + x1 * c[p]; }
}
__device__ __forceinline__ void unpack8(const u32x4 w, float (&f)[8]) { f[0] = bf_lo(w.x); f[1] = bf_hi(w.x); f[2] = bf_lo(w.y); f[3] = bf_hi(w.y); f[4] = bf_lo(w.z); f[5] = bf_hi(w.z); f[6] = bf_lo(w.w); f[7] = bf_hi(w.w); }
__device__ __forceinline__ u32x4 pack8(const float (&f)[8]) { u32x4 w; w.x = cvt_pk_bf16(f[0], f[1]); w.y = cvt_pk_bf16(f[2], f[3]); w.z = cvt_pk_bf16(f[4], f[5]); w.w = cvt_pk_bf16(f[6], f[7]); return w; }
template <bool NORM, int ROPE_DIM>
__device__ __forceinline__ void fix_span(bf16_t* rowp, int col0, int nvec, const float* g, const float* cosT, const float* sinT, int lane) {
    for (int v = lane; v < nvec; v += 64) {
        const int e0 = v * 8;
        u32x4 w = *(u32x4*)(rowp + col0 + e0); float f[8]; unpack8(w, f);
        if constexpr (NORM) {
            float s = 0.f;
#pragma unroll
            for (int i = 0; i < 8; ++i) s += f[i] * f[i];
            s += __shfl_xor(s, 1); s += __shfl_xor(s, 2); s += __shfl_xor(s, 4); s += __shfl_xor(s, 8);
            const float rstd = 1.0f / sqrtf(s * (1.0f / 128.0f) + EPS);
            const f32x4 g0 = *(const f32x4*)(g + (e0 & 127)), g1 = *(const f32x4*)(g + (e0 & 127) + 4);
#pragma unroll
            for (int i = 0; i < 4; ++i) { f[i] = f[i] * rstd * g0[i]; f[4 + i] = f[4 + i] * rstd * g1[i]; }
        }
        if constexpr (ROPE_DIM == 64) { const int p0 = (e0 & 63) >> 1; rope8(f, cosT + p0, sinT + p0); }
        if constexpr (ROPE_DIM == 128) { const int p0 = (e0 & 127) >> 1; rope8(f, cosT + p0, sinT + p0); }
        *(u32x4*)(rowp + col0 + e0) = pack8(f);
    }
}

__global__ void __launch_bounds__(512, 2) hybrid_fwd(Args args) {
    extern __shared__ __attribute__((aligned(16))) unsigned char lds[];
    Frame F;
    F.lds = (LAS unsigned char*)lds;
    F.G = gridDim.x; { const int bx = blockIdx.x; F.vcu = (F.G % 8 == 0) ? (bx % 8) * (F.G / 8) + bx / 8 : bx; }
    volatile LAS unsigned* MISC = (volatile LAS unsigned*)(F.lds + MISC_OFF);
    unsigned char* ws = args.ws;
    gu32* ctl = (gu32*)(ws + WS_CTL);
    for (int u = threadIdx.x; u < 64; u += 512) MISC[u] = 0u;
    __syncthreads();
    XcdBarrier bar; bar.bar = (unsigned*)(ctl + CW_BAR); bar.x = 0; bar.st = nullptr;
#if !MK_PER_PHASE
    bar = xcd_barrier_post((unsigned*)(ctl + CW_BAR), MISC + 8);
#define GRID_BAR() xcd_barrier(bar)
#else
#define GRID_BAR() do { } while (0)
#endif
    const int lo = args.ph_lo, hi = args.ph_hi;
#ifndef PH_MASK
#define PH_MASK 0xFFFFFu
#endif
#define IN(k) ((((PH_MASK) >> (k)) & 1u) && lo <= (k) && (k) < hi)
#ifndef DBL_MASK
#define DBL_MASK 0u
#endif
#define NREP(k) ((((DBL_MASK) >> (k)) & 1u) ? 2 : 1)
#define SEAM(k) do { if (IN(k) && IN((k) + 1)) GRID_BAR(); } while (0)

#define MODS ((float*)(ws + WS_MODS))
#define ADAP ((float*)(ws + WS_ADAP))
#define cosA ((float*)(ws + WS_ROPE))
#define sinA (cosA + 4096 * 32)
#define cosB (cosA + 2 * 4096 * 32)
#define sinB (cosA + 2 * 4096 * 32 + 4096 * 64)
#define ROUTE ((int*)(ws + WS_ROUTE))
#define GATES ((float*)(ws + WS_GATES))
#define SLOT ((int*)(ws + WS_SLOT))
#define CNT ((int*)(ws + WS_CNT))
#define TILEE ((int*)(ws + WS_TILEE))
#define W_IN0 ((bf16_t*)(ws + WS_WIN0))
#define W_OUT0 ((bf16_t*)(ws + WS_WOUT0))
#define W_GU0 ((bf16_t*)(ws + WS_WGU0))
#define W_DN0 ((bf16_t*)(ws + WS_WDN0))
#define W_IN1 ((bf16_t*)(ws + WS_WIN1))
#define W_OUT1 ((bf16_t*)(ws + WS_WOUT1))
#define W_GU1 ((bf16_t*)(ws + WS_WGU1))
#define W_DN1 ((bf16_t*)(ws + WS_WDN1))
#define XR ((float*)(ws + WS_XR))
#define H ((bf16_t*)(ws + WS_H))
#define AO ((bf16_t*)(ws + WS_AO))
#define Y ((bf16_t*)(ws + WS_Y))
#define QKV ((bf16_t*)(ws + WS_QKV))
#define XG ((bf16_t*)(ws + WS_XG))
#define MID ((bf16_t*)(ws + WS_MID))
#define MODS1 (MODS + 5 * 12288)
#define SLAB0 ((float*)(ws + WS_SLAB0))
#define SLAB1 ((float*)(ws + WS_SLAB1))
#define SLABW ((float*)(ws + WS_SLABW))
#define x_in (args.in[0])
#define c_in (args.in[1])
#define ctx_in (args.in[2])
#define cctx_in (args.in[3])
    const int NGW = F.G * 8;
#define PH_LOCALS const int tid = fresh_tid(), lane = tid & 63, wave = __builtin_amdgcn_readfirstlane(tid >> 6), gw = F.vcu * 8 + wave; (void)tid; (void)lane; (void)wave; (void)gw

    if (IN(0)) for (int rep_ = 0; rep_ < NREP(0); ++rep_) {
        PH_LOCALS;
        LAS float* scr = (LAS float*)(F.lds + wave * 16384);
        LAS float* sil = (LAS float*)(F.lds + 98304);
        __syncthreads();
        for (int i = tid; i < 5 * DM; i += 512) { const float v = (i < 4 * DM) ? c_in[i] : cctx_in[i - 4 * DM]; sil[i] = v / (1.0f + __expf(-v)); }
        __syncthreads();
        for (int it = gw; it < 2 * 48 * 32; it += NGW) {
            const int l = it / (48 * 32), r = it % (48 * 32), cg = r / 32, kc = r % 32;
            const float* W = args.in[l ? 22 : 6] + (size_t)(kc * 64) * 12288 + cg * 256 + lane * 4;
            f32x4 a[5];
#pragma unroll
            for (int b = 0; b < 5; ++b) a[b] = (f32x4){0.f, 0.f, 0.f, 0.f};
#pragma unroll 8
            for (int k = 0; k < 64; ++k) { const f32x4 w = *(const f32x4*)(W + (size_t)k * 12288);
#pragma unroll
                for (int b = 0; b < 5; ++b) a[b] += w * sil[b * DM + kc * 64 + k]; }
#pragma unroll
            for (int b = 0; b < 5; ++b) *(f32x4*)(ADAP + ((size_t)(l * 32 + kc) * 5 + b) * 12288 + cg * 256 + lane * 4) = a[b];
        }
        __syncthreads();
        {
            constexpr int I_IN = (DM / 64) * (PROJ / 32), I_OUT = (DM / 64) * (DM / 32);
            constexpr int I_GU = (FFN0_FP8 == 2) ? (DM / 128) * (DFF / 32) : (DM / 64) * (DFF / 32), I_DN = (FFN0_FP8 >= 1) ? (DFF / 128) * (DM / 32) : (DFF / 64) * (DM / 32);
            constexpr int I_EGU = (DM / 128) * (DEX / 32), I_EDN = (DEX / 128) * (DM / 32);
            constexpr int I_IN8 = (DM / 128) * (PROJ / 32), I_OUT8 = (DM / 128) * (DM / 32);
            constexpr int NIT = I_IN + (L1ATT_FP8 ? I_IN8 : I_IN) + I_OUT + (L1ATT_FP8 ? I_OUT8 : I_OUT) + 2 * I_GU + I_DN;
            for (int it = gw; it < NIT; it += NGW) {
                int r = it;
                if (r < I_IN) { tr_plain(args.in[8], DM, PROJ, W_IN0, 0, scr, r, lane); continue; } r -= I_IN;
#if L1ATT_FP8
                if (r < I_IN8) { tr_plain8(args.in[24], DM, PROJ, (unsigned char*)W_IN1, 0, scr, r, lane); continue; } r -= I_IN8;
#else
                if (r < I_IN) { tr_plain(args.in[24], DM, PROJ, W_IN1, 0, scr, r, lane); continue; } r -= I_IN;
#endif
                if (r < I_OUT) { tr_plain(args.in[9], DM, DM, W_OUT0, 0, scr, r, lane); continue; } r -= I_OUT;
#if L1ATT_FP8
                if (r < I_OUT8) { tr_plain8(args.in[25], DM, DM, (unsigned char*)W_OUT1, 0, scr, r, lane); continue; } r -= I_OUT8;
#else
                if (r < I_OUT) { tr_plain(args.in[25], DM, DM, W_OUT1, 0, scr, r, lane); continue; } r -= I_OUT;
#endif
#if FFN0_FP8 == 2
                if (r < I_GU) { tr_gu8(args.in[17], DM, DFF, (unsigned char*)W_GU0, 0, 0, scr, r, lane); continue; } r -= I_GU;
                if (r < I_GU) { tr_gu8(args.in[18], DM, DFF, (unsigned char*)W_GU0, 0, 1, scr, r, lane); continue; } r -= I_GU;
#else
                if (r < I_GU) { tr_gu(args.in[17], DM, DFF, W_GU0, 0, 0, scr, r, lane); continue; } r -= I_GU;
                if (r < I_GU) { tr_gu(args.in[18], DM, DFF, W_GU0, 0, 1, scr, r, lane); continue; } r -= I_GU;
#endif
#if FFN0_FP8 >= 1
                if (r < I_DN) { tr_plain8(args.in[19], DFF, DM, (unsigned char*)W_DN0, 0, scr, r, lane); continue; } r -= I_DN;
#else
                if (r < I_DN) { tr_plain(args.in[19], DFF, DM, W_DN0, 0, scr, r, lane); continue; } r -= I_DN;
#endif
            }
            constexpr int NITX = NE * (2 * I_EGU + I_EDN);
            const float* wp; int ldw; unsigned char* wt; int Kb;
#define XDECODE(IT, WP, LDW, WT, KB) do { int r_ = (IT); const int e_ = r_ / (2 * I_EGU + I_EDN); r_ -= e_ * (2 * I_EGU + I_EDN); \
                if (r_ < 2 * I_EGU) { const int up_ = r_ >= I_EGU; r_ -= up_ * I_EGU; const int nblk_ = DEX / 32, kb_ = r_ / nblk_, n0_ = 32 * (r_ % nblk_); \
                    WP = args.in[29 + up_] + (size_t)e_ * DM * DEX + (size_t)(128 * kb_ + (lane >> 5)) * DEX + n0_ + (lane & 31); LDW = DEX; KB = DM; \
                    WT = (unsigned char*)W_GU1 + ((size_t)e_ * 2 * DEX + (size_t)(n0_ >> 7) * 256 + (n0_ & 127) + up_ * 128) * DM + 128 * kb_; } \
                else { r_ -= 2 * I_EGU; const int nblk_ = DM / 32, kb_ = r_ / nblk_, n0_ = 32 * (r_ % nblk_); \
                    WP = args.in[31] + (size_t)e_ * DEX * DM + (size_t)(128 * kb_ + (lane >> 5)) * DM + n0_ + (lane & 31); LDW = DM; KB = DEX; \
                    WT = (unsigned char*)W_DN1 + ((size_t)e_ * DM + n0_) * DEX + 128 * kb_; } } while (0)
#define XLOAD(T, WP, LDW, HB) do { _Pragma("unroll") for (int i_ = 0; i_ < 32; ++i_) T[i_] = (WP)[(size_t)(64 * (HB) + 2 * i_) * (LDW)]; } while (0)
#define XWRITE(T, HB) do { _Pragma("unroll") for (int i_ = 0; i_ < 32; ++i_) { const int kk_ = 64 * (HB) + 2 * i_ + (lane >> 5); scr[kk_ * 32 + (((lane & 31) + 8 * (kk_ >> 4)) & 31)] = T[i_]; } } while (0)
            float ta[32], tb[32];
            int itx = gw;
            if (itx < NITX) { XDECODE(itx, wp, ldw, wt, Kb); XLOAD(ta, wp, ldw, 0); }
            while (itx < NITX) {
                XLOAD(tb, wp, ldw, 1);
                XWRITE(ta, 0);
                unsigned char* wt_c = wt; const int Kb_c = Kb;
                const int nxt = itx + NGW;
                if (nxt < NITX) { XDECODE(nxt, wp, ldw, wt, Kb); XLOAD(ta, wp, ldw, 0); }
                XWRITE(tb, 1);
                LDS_WAIT(); asm volatile("" ::: "memory");
                { const int c = lane & 7;
#pragma unroll
                  for (int j = 0; j < 4; ++j) { const int n = (lane >> 3) + 8 * j; const LAS float* sp = scr + (16 * c) * 32 + ((n + 8 * c) & 31);
                      u32x4 o;
                      o.x = pk4_fp8(sp[0 * 32] * S_W8, sp[1 * 32] * S_W8, sp[2 * 32] * S_W8, sp[3 * 32] * S_W8); o.y = pk4_fp8(sp[4 * 32] * S_W8, sp[5 * 32] * S_W8, sp[6 * 32] * S_W8, sp[7 * 32] * S_W8);
                      o.z = pk4_fp8(sp[8 * 32] * S_W8, sp[9 * 32] * S_W8, sp[10 * 32] * S_W8, sp[11 * 32] * S_W8); o.w = pk4_fp8(sp[12 * 32] * S_W8, sp[13 * 32] * S_W8, sp[14 * 32] * S_W8, sp[15 * 32] * S_W8);
                      *(GAS u32x4*)(wt_c + (size_t)n * Kb_c + 16 * c) = o; } }
                LDS_WAIT(); asm volatile("" ::: "memory");
                itx = nxt;
            }
#undef XDECODE
#undef XLOAD
#undef XWRITE
        }
    }
    SEAM(0);
    if (IN(1)) for (int rep_ = 0; rep_ < NREP(1); ++rep_) {
        PH_LOCALS;
        for (int i = blockIdx.x * 512 + tid; i < 2 * 5 * 12288; i += F.G * 512) {
            const int l = i / (5 * 12288), r = i % (5 * 12288), b = r / 12288, j = r % 12288;
            float s = args.in[l ? 23 : 7][j];
            for (int kc = 0; kc < 32; ++kc) s += ADAP[((size_t)(l * 32 + kc) * 5 + b) * 12288 + j];
            MODS[i] = s;
        }
        if (blockIdx.x == 0 && wave == 0) {
            const float a = wave_sum(args.in[10][lane] * args.in[11][lane]), b = wave_sum(args.in[12][lane] * args.in[13][lane]);
            if (lane == 0) MODS[2 * 5 * 12288] = expf(a) - expf(b) + LAMBDA_INIT;
        }
    }
    SEAM(1);
    if (IN(2)) for (int rep_ = 0; rep_ < NREP(2); ++rep_) {
        PH_LOCALS;
        for (int row = gw; row < MROWS; row += NGW) {
            const int b = row / RPB, t = row % RPB; const float* md = MODS + (size_t)(t < SEQ ? b : 4) * 12288;
            f32x4 v[8]; mod_row(in_row(x_in, ctx_in, row), args.in[4], md + 0 * DM, md + 1 * DM, H + (size_t)row * DM, lane, v);
        }
    }
    SEAM(2);
    if (IN(3)) for (int rep_ = 0; rep_ < NREP(3); ++rep_) {
        PH_LOCALS;
        pg8::Gemm g{H, W_IN0, DM}; pg8::Order<pg8::MapId> S; S.init(MROWS / 256, PROJ / 256, F.G, (int)blockIdx.x, pg8::MapId{}, DM / 64);
        { LAS float* gl = (LAS float*)(F.lds + RING_BYTES) + 2048; if (tid < 256) gl[tid] = tid < 128 ? args.in[15][tid] : args.in[16][tid - 128]; __syncthreads(); }
        pg8::EpiQKV<0> E{QKV, cosA, sinA, cosB, sinB, args.in[15], args.in[16], (LAS float*)(F.lds + RING_BYTES), 1.0f};
        pg8::gemm_phase(F.lds, g, S, E);
    }
    SEAM(3);
    if (IN(5)) for (int rep_ = 0; rep_ < NREP(5); ++rep_) {
        PH_LOCALS;
        const float lam = MODS[2 * 5 * 12288];
        for (int k = F.vcu; k < 256; k += F.G) {
            for (int i = 0; i < 3; ++i) {
                int b, h, qt;
                if (i < 2) { const int u = 2 * k + i; b = u >> 7; h = (u >> 4) & 7; qt = u & 15; } else { if (k >= 32) break; b = k >> 3; h = k & 7; qt = 16; }
                const size_t rb = (size_t)b * RPB;
                const att::TileMap tm = (qt < 16) ? att::TileMap{0, 0, 0, 68} : att::TileMap{0, 0, SEQ, 4};
#ifndef NO_DIFF
                att::unit_diff(QKV + (rb + qt * 256) * PROJ + h * 128, QKV + rb * PROJ + 2048 + h * 128, QKV + rb * PROJ + 3072 + h * 128, tm, lam, args.in[14],
                               AO + (rb + qt * 256) * DM + h * 128, (char*)lds);
#endif
            }
            for (int i = 0; i < 3; ++i) {
                int b, h, qt;
                if (i < 2) { const int u = 2 * k + i; b = u >> 7; h = (u >> 4) & 7; qt = u & 15; } else { if (k < 32 || k >= 64) break; b = (k - 32) >> 3; h = k & 7; qt = 16; }
                const size_t rb = (size_t)b * RPB; const int kv = h >> 2;
                const att::TileMap tm = (qt < 16) ? att::TileMap{0, 0, 0, 68} : att::TileMap{0, 0, SEQ, 4};
#ifndef NO_STD0
                att::unit_std<0>(QKV + (rb + qt * 256) * PROJ + 1024 + h * 128, QKV + rb * PROJ + 4096 + kv * 128, QKV + rb * PROJ + 4352 + kv * 128, tm, att::MaskInfo{0, 0, 0}, 0.f,
                                 AO + (rb + qt * 256) * DM + 1024 + h * 128, (char*)lds);
#endif
            }
        }
    }
    SEAM(5);
    if (IN(6)) for (int rep_ = 0; rep_ < NREP(6); ++rep_) {
        PH_LOCALS;
        pg8::Gemm g{AO, W_OUT0, DM}; pg8::Order<pg8::MapL0Split> S; S.init(NTOK / 256, DM / 256, F.G, (int)blockIdx.x, pg8::MapL0Split{}, DM / 64, 4, 8);
        pg8::EpiResid E{x_in, ctx_in, XR, MODS, 2, 1, SLABW, 1.0f};
        pg8::gemm_phase<pg8::EpiResid, pg8::Order<pg8::MapL0Split>>(F.lds, g, S, E);
    }
    SEAM(6);
    if (IN(7)) for (int rep_ = 0; rep_ < NREP(7); ++rep_) {
        PH_LOCALS;
        for (int row = gw; row < MROWS; row += NGW) {
            const int b = row / RPB, t = row % RPB; const float* md = MODS + (size_t)(t < SEQ ? b : 4) * 12288;
#if FFN0_FP8 == 2
            f32x4 v[8]; mod_row<true>(t < SEQ ? XR + (size_t)row * DM : in_row(x_in, ctx_in, row), args.in[5], md + 3 * DM, md + 4 * DM, (bf16_t*)((unsigned char*)H + (size_t)row * DM), lane, v,
                                      t < SEQ ? nullptr : SLABW + ((size_t)b * NCTX + (t - SEQ)) * DM, (size_t)NB * NCTX * DM, 8, XR + (size_t)row * DM);
#else
            f32x4 v[8]; mod_row(t < SEQ ? XR + (size_t)row * DM : in_row(x_in, ctx_in, row), args.in[5], md + 3 * DM, md + 4 * DM, H + (size_t)row * DM, lane, v,
                                t < SEQ ? nullptr : SLABW + ((size_t)b * NCTX + (t - SEQ)) * DM, (size_t)NB * NCTX * DM, 8, XR + (size_t)row * DM);
#endif
        }
    }
    SEAM(7);
    if (IN(8)) for (int rep_ = 0; rep_ < NREP(8); ++rep_) {
        PH_LOCALS;
#if FFN0_FP8 == 2
        pg8::Gemm g{H, W_GU0, DM / 2}; pg8::Order<pg8::MapId> S; S.init(MROWS / 256, 2 * DFF / 256, F.G, (int)blockIdx.x, pg8::MapId{}, DM / 128);
        pg8::EpiSwiGLU8 E{(unsigned char*)MID, DFF, 2 * DFF / 256, 1.0f / (S_H8 * S_W8), S_M8 / (S_H8 * S_W8)};
        pg8::gemm_phase<pg8::EpiSwiGLU8, pg8::Order<pg8::MapId>, true>(F.lds, g, S, E);
#elif FFN0_FP8 == 1
        pg8::Gemm g{H, W_GU0, DM}; pg8::Order<pg8::MapId> S; S.init(MROWS / 256, 2 * DFF / 256, F.G, (int)blockIdx.x, pg8::MapId{}, DM / 64);
        pg8::EpiSwiGLU8 E{(unsigned char*)MID, DFF, 2 * DFF / 256, 1.0f, S_M8};
        pg8::gemm_phase(F.lds, g, S, E);
#else
        pg8::Gemm g{H, W_GU0, DM}; pg8::Order<pg8::MapId> S; S.init(MROWS / 256, 2 * DFF / 256, F.G, (int)blockIdx.x, pg8::MapId{}, DM / 64);
        pg8::EpiSwiGLU E{MID, DFF, 2 * DFF / 256};
        pg8::gemm_phase(F.lds, g, S, E);
#endif
    }
    SEAM(8);
    if (IN(9)) for (int rep_ = 0; rep_ < NREP(9); ++rep_) {
        PH_LOCALS;
#if FFN0_FP8 >= 1
        pg8::Gemm g{MID, W_DN0, DFF / 2}; pg8::Order<pg8::MapL0Split> S; S.init(NTOK / 256, DM / 256, F.G, (int)blockIdx.x, pg8::MapL0Split{}, DFF / 128, 4, NS0);
        pg8::EpiResid E{x_in, ctx_in, XR, MODS, 5, 0, SLAB0, 1.0f / (S_M8 * S_W8)};
        pg8::gemm_phase<pg8::EpiResid, pg8::Order<pg8::MapL0Split>, true>(F.lds, g, S, E);
#else
        pg8::Gemm g{MID, W_DN0, DFF}; pg8::Order<pg8::MapL0Split> S; S.init(NTOK / 256, DM / 256, F.G, (int)blockIdx.x, pg8::MapL0Split{}, DFF / 64, 4, NS0);
        pg8::EpiResid E{x_in, ctx_in, XR, MODS, 5, 0, SLAB0, 1.0f};
        pg8::gemm_phase(F.lds, g, S, E);
#endif
    }
    SEAM(9);
    if (IN(10)) for (int rep_ = 0; rep_ < NREP(10); ++rep_) {
        PH_LOCALS;
        for (int row = gw; row < MROWS; row += NGW) {
            const int b = row / RPB, t = row % RPB; const float* md = MODS1 + (size_t)(t < SEQ ? b : 4) * 12288;
#if L1ATT_FP8
            f32x4 v[8]; mod_row<true>(XR + (size_t)row * DM, args.in[20], md + 0 * DM, md + 1 * DM, (bf16_t*)((unsigned char*)H + (size_t)row * DM), lane, v, t < SEQ ? nullptr : SLAB0 + ((size_t)b * NCTX + (t - SEQ)) * DM, (size_t)NB * NCTX * DM, NS0);
#else
            f32x4 v[8]; mod_row(XR + (size_t)row * DM, args.in[20], md + 0 * DM, md + 1 * DM, H + (size_t)row * DM, lane, v, t < SEQ ? nullptr : SLAB0 + ((size_t)b * NCTX + (t - SEQ)) * DM, (size_t)NB * NCTX * DM, NS0);
#endif
        }
    }
    SEAM(10);
    if (IN(11)) for (int rep_ = 0; rep_ < NREP(11); ++rep_) {
        PH_LOCALS;
        pg8::Gemm g{H, W_IN1, L1ATT_FP8 ? DM / 2 : DM}; pg8::Order<pg8::MapId> S; S.init(MROWS / 256, PROJ / 256, F.G, (int)blockIdx.x, pg8::MapId{}, L1ATT_FP8 ? DM / 128 : DM / 64);
#if L1ATT_FP8
        pg8::EpiQKV<1> E{QKV, cosA, sinA, cosB, sinB, nullptr, nullptr, (LAS float*)(F.lds + RING_BYTES), 1.0f / (S_H8 * S_W8)};
        pg8::gemm_phase<pg8::EpiQKV<1>, pg8::Order<pg8::MapId>, true>(F.lds, g, S, E);
#else
        pg8::EpiQKV<1> E{QKV, cosA, sinA, cosB, sinB, nullptr, nullptr, (LAS float*)(F.lds + RING_BYTES), 1.0f};
        pg8::gemm_phase(F.lds, g, S, E);
#endif
    }
    SEAM(11);
    if (IN(13)) for (int rep_ = 0; rep_ < NREP(13); ++rep_) {
        PH_LOCALS;
        float* btab = (float*)(lds + att::OFF_BIAS);
        for (int k = F.vcu; k < 256; k += F.G) {
            for (int i = 0; i < 2; ++i) {
                const int u = 2 * k + i, b = u >> 7, h = (u >> 4) & 7, qt = u & 15, kv = h >> 2; const size_t rb = (size_t)b * RPB;
                const int q0 = qt * 256, ks = (q0 - 128) < 0 ? 0 : (q0 - 128), ke = (q0 + 384) > SEQ ? SEQ : (q0 + 384);
                const att::TileMap tm{4, SEQ, ks, 4 + (ke - ks) / 64};
#ifndef NO_WIN
                att::unit_std<1>(QKV + (rb + q0) * PROJ + h * 128, QKV + rb * PROJ + 2048 + kv * 128, QKV + rb * PROJ + 2304 + kv * 128, tm, att::MaskInfo{q0, 0, 0}, args.in[26][h],
                                 L1ATT_FP8 ? (bf16_t*)((unsigned char*)AO + (rb + q0) * DM + h * 128) : AO + (rb + q0) * DM + h * 128, (char*)lds);
#endif
            }
            for (int i = 0; i < 2; ++i) {
                const int u = 2 * k + i, b = u >> 7, h = (u >> 4) & 7, qt = u & 15; const size_t rb = (size_t)b * RPB;
                const int r0 = qt * 4; int lo_ = r0 - 4; lo_ = lo_ < 0 ? 0 : (lo_ > 52 ? 52 : lo_);
                for (int j = tid; j < 15 * 31; j += 512) btab[j] = args.in[27][h * 465 + j] * (1.0f / ATT_SCALE);
                __syncthreads();
                const att::TileMap tm{4, SEQ, lo_ * 64, 16};
#ifndef NO_NA
                att::unit_std<2>(QKV + (rb + qt * 256) * PROJ + 1024 + h * 128, QKV + rb * PROJ + 2560 + h * 128, QKV + rb * PROJ + 3584 + h * 128, tm, att::MaskInfo{0, r0, lo_}, 0.f,
                                 L1ATT_FP8 ? (bf16_t*)((unsigned char*)AO + (rb + qt * 256) * DM + 1024 + h * 128) : AO + (rb + qt * 256) * DM + 1024 + h * 128, (char*)lds);
#endif
            }
        }
    }
    SEAM(13);
    if (IN(14)) for (int rep_ = 0; rep_ < NREP(14); ++rep_) {
        PH_LOCALS;
#if L1ATT_FP8
        pg8::Gemm g{AO, W_OUT1, DM / 2}; pg8::Order<pg8::MapLatent> S; S.init(NTOK / 256, DM / 256, F.G, (int)blockIdx.x, pg8::MapLatent{}, DM / 128);
        pg8::EpiResid E{x_in, ctx_in, XR, MODS1, 2, 0, nullptr, 1.0f / (S_A8 * S_W8)};
        pg8::gemm_phase<pg8::EpiResid, pg8::Order<pg8::MapLatent>, true>(F.lds, g, S, E);
#else
        pg8::Gemm g{AO, W_OUT1, DM}; pg8::Order<pg8::MapLatent> S; S.init(NTOK / 256, DM / 256, F.G, (int)blockIdx.x, pg8::MapLatent{}, DM / 64);
        pg8::EpiResid E{x_in, ctx_in, XR, MODS1, 2, 0, nullptr, 1.0f};
        pg8::gemm_phase(F.lds, g, S, E);
#endif
    }
    SEAM(14);
    if (IN(15)) for (int rep_ = 0; rep_ < NREP(15); ++rep_) {
        PH_LOCALS;
        LAS float* wt = (LAS float*)F.lds;
        LAS int* ce = (LAS int*)(F.lds + 65536);
        for (int i = tid; i < DM * NE; i += 512) { const int kk = i >> 3, e = i & 7; wt[e * DM + kk] = args.in[28][i]; }
        __syncthreads();
        for (int chunk = blockIdx.x; chunk < NTOK / 64; chunk += F.G) {
            for (int i = 0; i < 8; ++i) {
                const int tl = wave * 8 + i, n = chunk * 64 + tl, b = n >> 12, t = n & 4095, row = b * RPB + t;
                const float* md = MODS1 + (size_t)b * 12288;
                f32x4 v[8]; mod_row<true>(XR + (size_t)row * DM, args.in[21], md + 3 * DM, md + 4 * DM, (bf16_t*)((unsigned char*)H + (size_t)row * DM), lane, v);
                float lg[8];
#pragma unroll
                for (int e = 0; e < 8; ++e) { float s = 0.f;
#pragma unroll
                    for (int j = 0; j < 8; ++j) { const f32x4 w = *(const LAS f32x4*)(wt + e * DM + 256 * j + 4 * lane); s += (v[j].x * w.x + v[j].y * w.y) + (v[j].z * w.z + v[j].w * w.w); }
                    lg[e] = wave_sum(s); }
                int e0 = 0; float l0 = lg[0];
#pragma unroll
                for (int e = 1; e < 8; ++e) if (lg[e] > l0) { l0 = lg[e]; e0 = e; }
                int e1 = -1; float l1 = -3.4e38f;
#pragma unroll
                for (int e = 0; e < 8; ++e) if (e != e0 && lg[e] > l1) { l1 = lg[e]; e1 = e; }
                if (lane == 0) { ce[tl * 2] = e0; ce[tl * 2 + 1] = e1; const float g1 = 1.0f / (1.0f + expf(l0 - l1)); GATES[n * 2] = 1.0f - g1; GATES[n * 2 + 1] = g1; }
            }
            __syncthreads();
            if (wave == 0) {
                const int e0 = ce[lane * 2], e1 = ce[lane * 2 + 1]; int rk0 = 0, rk1 = 0;
                const unsigned long long below = (1ull << lane) - 1ull;
#pragma unroll
                for (int e = 0; e < 8; ++e) {
                    const unsigned long long m0 = __ballot(e0 == e), m1 = __ballot(e1 == e);
                    const int c0 = __popcll(m0);
                    if (e0 == e) rk0 = __popcll(m0 & below);
                    if (e1 == e) rk1 = c0 + __popcll(m1 & below);
                    if (lane == 0) CNT[chunk * 8 + e] = c0 + __popcll(m1);
                }
                const int n = chunk * 64 + lane;
                ROUTE[n * 4 + 0] = e0; ROUTE[n * 4 + 1] = e1; ROUTE[n * 4 + 2] = rk0; ROUTE[n * 4 + 3] = rk1;
            }
            __syncthreads();
        }
    }
    SEAM(15);
    if (IN(16)) for (int rep_ = 0; rep_ < NREP(16); ++rep_) {
        PH_LOCALS;
        LAS int* tot = (LAS int*)F.lds; LAS int* pre = tot + 8; LAS int* base = tot + 16;
        for (int chunk = blockIdx.x; chunk < NTOK / 64; chunk += F.G) {
            { const int e = wave; int a = 0, p = 0;
#pragma unroll
              for (int i = 0; i < 4; ++i) { const int c = 4 * lane + i; const int v = CNT[c * 8 + e]; a += v; p += (c < chunk) ? v : 0; }
              a = (int)wave_sum((float)a); p = (int)wave_sum((float)p);
              if (lane == 0) { tot[e] = a; pre[e] = p; } }
            __syncthreads();
            if (tid == 0) { int s = 0; for (int e = 0; e < 8; ++e) { base[e] = s; s += (tot[e] + 255) / 256 * 256; } base[8] = s; }
            __syncthreads();
            if (chunk == 0 && tid < CAP_TILES + 1) {
                const int ntile = base[8] / 256;
                if (tid == CAP_TILES) TILEE[CAP_TILES] = ntile;
                else { int e = 0; for (int q = 1; q < 8; ++q) if (tid * 256 >= base[q]) e = q; TILEE[tid] = e; }
            }
            for (int i = 0; i < 8; ++i) {
                const int tl = wave * 8 + i, n = chunk * 64 + tl, b = n >> 12, t = n & 4095, row = b * RPB + t;
                const int e0 = ROUTE[n * 4 + 0], e1 = ROUTE[n * 4 + 1], rk0 = ROUTE[n * 4 + 2], rk1 = ROUTE[n * 4 + 3];
                const int s0 = base[e0] + pre[e0] + rk0, s1 = base[e1] + pre[e1] + rk1;
                if (lane == 0) { SLOT[n * 2] = s0; SLOT[n * 2 + 1] = s1; }
                const u32x4* src = (const u32x4*)((const unsigned char*)H + (size_t)row * DM) + lane;
                u32x4* d0 = (u32x4*)((unsigned char*)XG + (size_t)s0 * DM) + lane; u32x4* d1 = (u32x4*)((unsigned char*)XG + (size_t)s1 * DM) + lane;
#pragma unroll
                for (int j = 0; j < 2; ++j) { const u32x4 w = src[64 * j]; d0[64 * j] = w; d1[64 * j] = w; }
            }
            __syncthreads();
        }
    }
    SEAM(16);
    if (IN(17)) for (int rep_ = 0; rep_ < NREP(17); ++rep_) {
        PH_LOCALS;
        const int ntile = TILEE[CAP_TILES];
        pg8::Gemm g{XG, W_GU1, DM / 2}; pg8::Order<pg8::MapMoe> S; S.init(ntile, 2 * DEX / 256, F.G, (int)blockIdx.x, pg8::MapMoe{TILEE, 2 * DEX / 256}, DM / 128);
        pg8::EpiSwiGLU8 E{(unsigned char*)MID, DEX, 2 * DEX / 256, 1.0f / (S_H8 * S_W8), S_M8 / (S_H8 * S_W8)};
        pg8::gemm_phase<pg8::EpiSwiGLU8, pg8::Order<pg8::MapMoe>, true>(F.lds, g, S, E);
    }
    SEAM(17);
    if (IN(18)) for (int rep_ = 0; rep_ < NREP(18); ++rep_) {
        PH_LOCALS;
        const int ntile = TILEE[CAP_TILES];
        pg8::Gemm g{MID, W_DN1, DEX / 2}; pg8::Order<pg8::MapMoe> S; S.init(ntile < 128 ? ntile : 128, DM / 256, F.G, (int)blockIdx.x, pg8::MapMoe{TILEE, DM / 256}, DEX / 128, ntile < 128 ? 0 : ntile - 128, 4);
        pg8::EpiBf16 E{Y, DM, DM / 256, 1.0f / (S_M8 * S_W8), SLAB1};
        pg8::gemm_phase<pg8::EpiBf16, pg8::Order<pg8::MapMoe>, true>(F.lds, g, S, E);
    }
    SEAM(18);
    if (IN(19)) for (int rep_ = 0; rep_ < NREP(19); ++rep_) {
        PH_LOCALS;
        for (int n = gw; n < NTOK; n += NGW) {
            const int b = n >> 12, t = n & 4095, row = b * RPB + t;
            const int s0 = SLOT[n * 2], s1 = SLOT[n * 2 + 1]; const float g0 = GATES[n * 2], g1 = GATES[n * 2 + 1];
            const float* gt = MODS1 + (size_t)b * 12288 + 5 * DM;
            const f32x4* xr = (const f32x4*)(XR + (size_t)row * DM) + lane;
            f32x4 v[8]; float s = 0.f;
#pragma unroll
            for (int j = 0; j < 8; ++j) { f32x4 ya, yb;
                if (s0 < 128 * 256) { const u32x2 a = ((const u32x2*)(Y + (size_t)s0 * DM))[64 * j + lane]; ya = (f32x4){bf_lo(a.x), bf_hi(a.x), bf_lo(a.y), bf_hi(a.y)}; }
                else { ya = (f32x4){0.f, 0.f, 0.f, 0.f};
#pragma unroll
                    for (int p = 0; p < 4; ++p) ya += ((const f32x4*)(SLAB1 + ((size_t)p * (7 * 256) + (s0 - 128 * 256)) * DM))[64 * j + lane]; }
                if (s1 < 128 * 256) { const u32x2 a = ((const u32x2*)(Y + (size_t)s1 * DM))[64 * j + lane]; yb = (f32x4){bf_lo(a.x), bf_hi(a.x), bf_lo(a.y), bf_hi(a.y)}; }
                else { yb = (f32x4){0.f, 0.f, 0.f, 0.f};
#pragma unroll
                    for (int p = 0; p < 4; ++p) yb += ((const f32x4*)(SLAB1 + ((size_t)p * (7 * 256) + (s1 - 128 * 256)) * DM))[64 * j + lane]; }
                const f32x4 gg = ((const f32x4*)gt)[64 * j + lane];
                v[j] = xr[64 * j] + gg * (ya * g0 + yb * g1); s += (v[j].x * v[j].x + v[j].y * v[j].y) + (v[j].z * v[j].z + v[j].w * v[j].w); }
            const float rstd = 1.0f / sqrtf(wave_sum(s) * (1.0f / DM) + EPS);
            f32x4* op = (f32x4*)(args.out + (size_t)n * DM) + lane;
#pragma unroll
            for (int j = 0; j < 8; ++j) op[64 * j] = v[j] * rstd * ((const f32x4*)args.in[32])[64 * j + lane];
        }
    }
#undef IN
#undef SEAM
}

constexpr int N_PHASES = 20;
extern "C" void kernel_launch(void* const* d_in, const int* in_sizes, int n_in, void* d_out, int out_size, void* d_ws, size_t ws_size, hipStream_t stream) {
    static int grid = 0;
    if (grid == 0) {
        if (n_in != 33 || ws_size < WS_END) { fprintf(stderr, "kernel_launch: need 33 inputs and %zu bytes of workspace; got %d, %zu\n", (size_t)WS_END, n_in, ws_size); grid = -1; return; }
        int dev = 0, cus = 0, per_cu = 0;
        if (hipGetDevice(&dev) != hipSuccess || hipDeviceGetAttribute(&cus, hipDeviceAttributeMultiprocessorCount, dev) != hipSuccess) { grid = -1; return; }
        if (hipFuncSetAttribute((const void*)hybrid_fwd, hipFuncAttributeMaxDynamicSharedMemorySize, LDS_BYTES) != hipSuccess) { fprintf(stderr, "kernel_launch: hipFuncSetAttribute failed\n"); grid = -1; return; }
        if (hipOccupancyMaxActiveBlocksPerMultiprocessor(&per_cu, (const void*)hybrid_fwd, 512, LDS_BYTES) != hipSuccess || per_cu < 1)
            fprintf(stderr, "kernel_launch: occupancy query reports %d workgroups per CU\n", per_cu);
        (void)hipGetLastError();
        grid = cus;
    }
    if (grid < 0) return;
    (void)hipMemsetAsync((char*)d_ws + WS_CTL, 0, CTL_ZERO_BYTES, stream);
    Args a{};
    for (int i = 0; i < 33; ++i) a.in[i] = (const float*)d_in[i];
    a.out = (float*)d_out; a.ws = (unsigned char*)d_ws;
#if MK_PER_PHASE
    for (int p = 0; p < N_PHASES; ++p) { a.ph_lo = p; a.ph_hi = p + 1; hipLaunchKernelGGL(hybrid_fwd, dim3(grid), dim3(512), LDS_BYTES, stream, a); }
#else
    a.ph_lo = 0; a.ph_hi = N_PHASES;
    hipLaunchKernelGGL(hybrid_fwd, dim3(grid), dim3(512), LDS_BYTES, stream, a);
#endif
    const hipError_t le = hipPeekAtLastError();
    if (le != hipSuccess) fprintf(stderr, "kernel_launch: launch failed: %s\n", hipGetErrorName(le));
}
```

```cpp
#include <hip/hip_runtime.h>
#include <hip/hip_bf16.h>
#include <cstdio>
#include <cstdint>

#ifndef MK_PER_PHASE
#define MK_PER_PHASE 0
#endif

#ifndef L1PRE
#define L1PRE 1
#endif
#ifndef ATT_DMA
#define ATT_DMA 1
#endif
#ifndef TSKIP
#define TSKIP 1
#endif
#ifndef PRESCALE
#define PRESCALE 1
#endif
#ifndef L1ATT_FP8
#define L1ATT_FP8 1
#endif
#ifndef FFN0_FP8
#define FFN0_FP8 1
#endif
#define GAS __attribute__((address_space(1)))
#define LAS __attribute__((address_space(3)))
typedef unsigned short bf16_t;
typedef short bf16x8 __attribute__((ext_vector_type(8)));
typedef short s16x4 __attribute__((ext_vector_type(4)));
typedef float f32x2 __attribute__((ext_vector_type(2)));
typedef float f32x4 __attribute__((ext_vector_type(4)));
typedef float f32x16 __attribute__((ext_vector_type(16)));
typedef unsigned u32x2 __attribute__((ext_vector_type(2)));
typedef unsigned u32x4 __attribute__((ext_vector_type(4)));
typedef GAS unsigned gu32;

constexpr int DM = 2048, NB = 4, SEQ = 4096, NCTX = 256, RPB = SEQ + NCTX, MROWS = NB * RPB;
constexpr int NTOK = NB * SEQ;
constexpr int PROJ = 4608, DFF = 5632, NE = 8, DEX = 7168;
constexpr int CAP_TILES = 136, CAP = CAP_TILES * 256;
constexpr float EPS = 1e-6f;
constexpr float LOG2E = 1.4426950408889634f;
constexpr float ATT_SCALE = 0.088388347648318440f;
constexpr float A_SCALE = 0.125f;
constexpr float LAMBDA_INIT = 0.2f;

constexpr size_t MiB = 1u << 20;
constexpr size_t WS_CTL = 0, CTL_ZERO_BYTES = 32 * 1024;
constexpr size_t WS_MODS = 1 * MiB;
constexpr size_t WS_ADAP = 2 * MiB;
constexpr size_t WS_ROPE = 18 * MiB;
constexpr size_t WS_ROUTE = 22 * MiB;
constexpr size_t WS_GATES = WS_ROUTE + 512 * 1024;
constexpr size_t WS_SLOT = WS_GATES + 256 * 1024;
constexpr size_t WS_CNT = WS_SLOT + 256 * 1024;
constexpr size_t WS_TILEE = WS_CNT + 64 * 1024;
constexpr size_t WS_WIN0 = 34 * MiB, WS_WOUT0 = 52 * MiB, WS_WGU0 = 60 * MiB, WS_WDN0 = 104 * MiB;
constexpr size_t WS_WIN1 = 126 * MiB, WS_WOUT1 = 144 * MiB, WS_WGU1 = 152 * MiB, WS_WDN1 = 600 * MiB;
constexpr size_t WS_XR = 824 * MiB;
constexpr size_t WS_H = 960 * MiB;
constexpr size_t WS_AO = 1028 * MiB;
constexpr size_t WS_Y = WS_H;
constexpr size_t WS_QKV = 1096 * MiB;
constexpr size_t WS_XG = WS_QKV;
constexpr size_t WS_MID = 1249 * MiB;
constexpr size_t WS_SLAB0 = 1500 * MiB;
constexpr size_t WS_SLAB1 = 1540 * MiB;
constexpr size_t WS_SLABW = 1600 * MiB;
constexpr size_t WS_END = 1725 * MiB;
constexpr int CW_TMO = 0, CW_BAR = 4096;
constexpr int NS0 = FFN0_FP8 ? 2 : 4;

constexpr int RING_BYTES = 131072;
constexpr int LDS_BYTES = 147456;
constexpr int MISC_OFF = LDS_BYTES - 256;

#define RLX_AGENT __ATOMIC_RELAXED, __HIP_MEMORY_SCOPE_AGENT
#define LDS_WAIT() asm volatile("s_waitcnt lgkmcnt(0)" ::: "memory")
#define VM_WAIT() asm volatile("s_waitcnt vmcnt(0)" ::: "memory")
__device__ __forceinline__ unsigned cvt_pk_bf16(float lo, float hi) { unsigned r; asm volatile("v_cvt_pk_bf16_f32 %0, %1, %2" : "=v"(r) : "v"(lo), "v"(hi)); return r; }
__device__ __forceinline__ float bf_lo(unsigned w) { return __uint_as_float(w << 16); }
__device__ __forceinline__ float bf_hi(unsigned w) { return __uint_as_float(w & 0xffff0000u); }
typedef int i32x8 __attribute__((ext_vector_type(8)));
constexpr float S_H8 = 16.0f, S_W8 = 1024.0f, S_M8 = 4.0f, S_A8 = 64.0f;
__device__ __forceinline__ float clamp8(float x) { return __builtin_amdgcn_fmed3f(x, -448.0f, 448.0f); }
__device__ __forceinline__ unsigned pk4_fp8(float a, float b, float c, float d) {
    int w = 0; w = __builtin_amdgcn_cvt_pk_fp8_f32(clamp8(a), clamp8(b), w, false); w = __builtin_amdgcn_cvt_pk_fp8_f32(clamp8(c), clamp8(d), w, true); return (unsigned)w; }
__device__ __forceinline__ float wave_sum(float v) {
#pragma unroll
    for (int o = 1; o < 64; o <<= 1) v += __shfl_xor(v, o);
    return v;
}
__device__ __forceinline__ int fresh_tid() { int t = threadIdx.x; asm volatile("" : "+v"(t)); return t; }
__device__ __forceinline__ float fast_silu(float x) { return x * __builtin_amdgcn_rcpf(1.0f + __builtin_amdgcn_exp2f(-x * LOG2E)); }

namespace pg8 {
constexpr int BM = 256, BK = 64, HALF = 128, HTB = HALF * BK * 2, STAGE_BYTES = 8 * HTB, NXCD = 8, WGM = 4;
__host__ __device__ __forceinline__ int lds_byte(int r, int c) { const int st = (r >> 4) * 2 + (c >> 5), rr = r & 15, cc = c & 31, ob = rr * 64 + cc * 2; return st * 1024 + (ob ^ (((ob >> 9) & 1) << 5)); }
__host__ __device__ __forceinline__ void stage_rc(int b, int& R, int& C) { const int st = b / 1024, sb = b % 1024, swz = sb ^ (((sb >> 9) & 1) << 5); R = (st >> 1) * 16 + swz / 64; C = (st & 1) * 32 + (swz % 64) / 2; }
__host__ __device__ __forceinline__ int perm32(int rho) { const int n = rho >> 4, i = rho & 15; return 8 * (i >> 2) + 4 * n + (i & 3); }

typedef int i32x4_t __attribute__((ext_vector_type(4)));
struct Unit { int pm, pn, kofs, nt, flag; };
struct Gemm { const bf16_t* A; const bf16_t* Bt; int K; };

struct MapId { __device__ __forceinline__ void operator()(int pm, int pn, Unit& u) const { u.pm = pm; u.pn = pn; } };
struct MapL0Split { __device__ __forceinline__ void operator()(int pm, int pn, Unit& u) const { u.pm = pm < 64 ? (pm >> 4) * 17 + (pm & 15) : (pm - 64) * 17 + 16; u.pn = pn; } };
struct MapLatent { __device__ __forceinline__ void operator()(int pm, int pn, Unit& u) const { u.pm = (pm >> 4) * 17 + (pm & 15); u.pn = pn; } };
struct MapMoe { const int* tile_e; int npe; __device__ __forceinline__ void operator()(int pm, int pn, Unit& u) const { u.pm = pm; u.pn = tile_e[pm] * npe + pn; } };
template <class Map> struct Order {
    int nM, nN, nwg, G, c, ntf, exn, S; Map map;
    __device__ __forceinline__ void init(int nM_, int nN_, int G_, int c_, Map m, int ntf_, int ex_nM = 0, int S_ = 1) { nM = nM_; nN = nN_; nwg = nM * nN; G = G_; c = c_; map = m; ntf = ntf_; S = S_; exn = ex_nM * nN_ * S_; }
    __device__ __forceinline__ bool next(int i, Unit& u) const {
        const long L = (long)i * G + c; u.kofs = 0; u.nt = ntf; u.flag = 0;
        if (L >= nwg) { const long sidx = L - nwg; if (sidx >= exn) return false; const int part = (int)(sidx % S), ux = (int)(sidx / S);
            map(nM + ux / nN, ux % nN, u); u.nt = ntf / S; u.kofs = part * u.nt * (BK * 2); u.flag = 1 + part; return true; }
        int wgid = (int)L; { const int q = nwg / NXCD, r = nwg % NXCD, xcd = wgid % NXCD, off = wgid / NXCD; wgid = (xcd < r ? xcd * (q + 1) : r * (q + 1) + (xcd - r) * q) + off; }
        const int nig = WGM * nN, gid = wgid / nig, fm = gid * WGM, gsz = (nM - fm) < WGM ? (nM - fm) : WGM;
        map(fm + ((wgid % nig) % gsz), (wgid % nig) / gsz, u); return true;
    }
    __device__ __forceinline__ void a_ready(const Unit&) const {}
    __device__ __forceinline__ void done(const Unit&) const {}
};

struct EpiBf16 {
    static constexpr bool PERM = true;
    bf16_t* O; int ldc; int npn; float sc; float* slab;
    __device__ __forceinline__ void operator()(const f32x4 (&acc)[2][2][4][2], const Unit& u, int wr, int wc, int fr, int fq) const {
        const int row0 = u.pm * BM + wr * 64 + fr, col0 = (u.pn % npn) * BM + wc * 32 + 8 * fq;
        if (u.flag) {
            float* sp = slab + ((size_t)(u.flag - 1) * (7 * 256) + (size_t)(u.pm - 128) * BM + wr * 64 + fr) * ldc + col0;
#pragma unroll
            for (int ai = 0; ai < 2; ++ai)
#pragma unroll
                for (int m = 0; m < 4; ++m)
#pragma unroll
                    for (int bj = 0; bj < 2; ++bj) { float* p = sp + (size_t)(ai * HALF + m * 16) * ldc + bj * HALF;
                        *(f32x4*)p = acc[ai][bj][m][0] * sc; *(f32x4*)(p + 4) = acc[ai][bj][m][1] * sc; }
            return;
        }
#pragma unroll
        for (int ai = 0; ai < 2; ++ai)
#pragma unroll
            for (int m = 0; m < 4; ++m) { bf16_t* rowp = O + (size_t)(row0 + ai * HALF + m * 16) * ldc + col0;
#pragma unroll
                for (int bj = 0; bj < 2; ++bj) { const f32x4 v0 = acc[ai][bj][m][0] * sc, v1 = acc[ai][bj][m][1] * sc;
                    u32x4 w; w.x = cvt_pk_bf16(v0[0], v0[1]); w.y = cvt_pk_bf16(v0[2], v0[3]); w.z = cvt_pk_bf16(v1[0], v1[1]); w.w = cvt_pk_bf16(v1[2], v1[3]);
                    *(u32x4*)(rowp + bj * HALF) = w; } }
    }
};
template <int LAYER> struct EpiQKV {
    static constexpr bool PERM = true;
    bf16_t* O; const float* cA; const float* sA; const float* cB; const float* sB; const float* qg; const float* kg; LAS float* scr; float asc;
    __device__ __forceinline__ void operator()(const f32x4 (&acc)[2][2][4][2], const Unit& u, int wr, int wc, int fr, int fq) const {
        const int tt = u.pm % 17, pn = u.pn; const bool latent = tt < 16;
        int kind0, kind1; bool norm = false;
        if constexpr (LAYER == 0) { const int k = (pn < 4 || (pn >= 8 && pn < 12)) ? 1 : ((pn >= 4 && pn < 8) || pn == 16) ? 2 : 0; kind0 = kind1 = k; norm = (k == 2); }
        else { kind0 = kind1 = (pn < 4 || pn == 8) ? 2 : 0; }
        const int row0 = u.pm * BM + wr * 64 + fr, col0 = pn * BM + wc * 32 + 8 * fq, ch = wc * 32 + 8 * fq;
        if (norm) {
#pragma unroll
            for (int ai = 0; ai < 2; ++ai)
#pragma unroll
                for (int m = 0; m < 4; ++m)
#pragma unroll
                    for (int bj = 0; bj < 2; ++bj) { const f32x4 a = acc[ai][bj][m][0], b = acc[ai][bj][m][1];
                        float q = (a[0] * a[0] + a[1] * a[1]) + (a[2] * a[2] + a[3] * a[3]) + (b[0] * b[0] + b[1] * b[1]) + (b[2] * b[2] + b[3] * b[3]);
                        q += __shfl_xor(q, 16); q += __shfl_xor(q, 32);
                        if (fq == 0) scr[((ai * HALF + wr * 64 + m * 16 + fr) * 2 + bj) * 4 + wc] = q; }
            asm volatile("s_waitcnt lgkmcnt(0)" ::: "memory"); __builtin_amdgcn_s_barrier(); asm volatile("" ::: "memory");
        }
        f32x4 g0 = {1.f, 1.f, 1.f, 1.f}, g1 = g0;
        if (norm) { const LAS float* gl = scr + 2048 + ((pn == 16) ? 128 : 0) + ch; g0 = *(const LAS f32x4*)gl; g1 = *(const LAS f32x4*)(gl + 4); }
        const int kmax = kind0 > kind1 ? kind0 : kind1;
        const int npair = (kmax == 1) ? 16 : 32, p0 = (kmax == 1) ? ((ch & 63) >> 1) : (ch >> 1), q0 = p0 & (npair - 1); const bool use_row = p0 < npair;
        f32x4 frq;
#pragma unroll
        for (int i = 0; i < 4; ++i) frq[i] = __builtin_amdgcn_exp2f(-(float)(q0 + i) * (13.287712379549449f / (float)npair)) * 0.15915494309189535f;
#pragma unroll
        for (int ai = 0; ai < 2; ++ai)
#pragma unroll
            for (int m = 0; m < 4; ++m) { const int r = ai * HALF + wr * 64 + m * 16 + fr, t = tt * 256 + r;
                bf16_t* rowp = O + (size_t)(row0 + ai * HALF + m * 16) * PROJ + col0;
                f32x4 cs = {1.f, 1.f, 1.f, 1.f}, sn = {0.f, 0.f, 0.f, 0.f};
                if (latent && kmax != 0) { const float pos = (float)(use_row ? (t >> 6) : (t & 63));
#pragma unroll
                    for (int i = 0; i < 4; ++i) { const float x = pos * frq[i]; cs[i] = __builtin_amdgcn_cosf(x); sn[i] = __builtin_amdgcn_sinf(x); } }
#pragma unroll
                for (int bj = 0; bj < 2; ++bj) { f32x4 v0 = acc[ai][bj][m][0] * asc, v1 = acc[ai][bj][m][1] * asc; const int kind = bj ? kind1 : kind0;
                    if (norm) { const f32x4 p = *(const LAS f32x4*)(scr + ((ai * HALF + wr * 64 + m * 16 + fr) * 2 + bj) * 4);
                        const float rsv = 1.0f / sqrtf(((p[0] + p[1]) + (p[2] + p[3])) * (1.0f / 128.0f) + EPS); v0 = v0 * rsv * g0; v1 = v1 * rsv * g1; }
                    if (latent && kind != 0) {
                        const f32x4 a = v0, b = v1;
                        v0[0] = a[0] * cs[0] - a[1] * sn[0]; v0[1] = a[0] * sn[0] + a[1] * cs[0]; v0[2] = a[2] * cs[1] - a[3] * sn[1]; v0[3] = a[2] * sn[1] + a[3] * cs[1];
                        v1[0] = b[0] * cs[2] - b[1] * sn[2]; v1[1] = b[0] * sn[2] + b[1] * cs[2]; v1[2] = b[2] * cs[3] - b[3] * sn[3]; v1[3] = b[2] * sn[3] + b[3] * cs[3]; }
                    if constexpr (LAYER == 0 && PRESCALE) { const float qs = pn < 4 ? A_SCALE * LOG2E : (pn < 8 ? ATT_SCALE * LOG2E : 1.0f); v0 = v0 * qs; v1 = v1 * qs; }
                    if constexpr (LAYER == 1 && PRESCALE && L1PRE) { const float qs = pn < (ATT_DMA ? 8 : 4) ? ATT_SCALE * LOG2E : 1.0f; v0 = v0 * qs; v1 = v1 * qs; }
                    u32x4 w; w.x = cvt_pk_bf16(v0[0], v0[1]); w.y = cvt_pk_bf16(v0[2], v0[3]); w.z = cvt_pk_bf16(v1[0], v1[1]); w.w = cvt_pk_bf16(v1[2], v1[3]);
                    *(u32x4*)(rowp + bj * HALF) = w; } }
    }
};
struct EpiSwiGLU {
    static constexpr bool PERM = true;
    bf16_t* O; int ldc; int npn;
    __device__ __forceinline__ void operator()(const f32x4 (&acc)[2][2][4][2], const Unit& u, int wr, int wc, int fr, int fq) const {
        const int row0 = u.pm * BM + wr * 64 + fr, col0 = (u.pn % npn) * HALF + wc * 32 + 8 * fq;
#pragma unroll
        for (int ai = 0; ai < 2; ++ai)
#pragma unroll
            for (int m = 0; m < 4; ++m) { bf16_t* rowp = O + (size_t)(row0 + ai * HALF + m * 16) * ldc + col0;
                const f32x4 g0 = acc[ai][0][m][0], g1 = acc[ai][0][m][1], u0 = acc[ai][1][m][0], u1 = acc[ai][1][m][1];
                u32x4 w;
                w.x = cvt_pk_bf16(fast_silu(g0[0]) * u0[0], fast_silu(g0[1]) * u0[1]); w.y = cvt_pk_bf16(fast_silu(g0[2]) * u0[2], fast_silu(g0[3]) * u0[3]);
                w.z = cvt_pk_bf16(fast_silu(g1[0]) * u1[0], fast_silu(g1[1]) * u1[1]); w.w = cvt_pk_bf16(fast_silu(g1[2]) * u1[2], fast_silu(g1[3]) * u1[3]);
                *(u32x4*)rowp = w; }
    }
};
struct EpiSwiGLU8 {
    static constexpr bool PERM = true;
    unsigned char* O; int ldc; int npn; float si, so;
    __device__ __forceinline__ f32x2 two(f32x2 ag, f32x2 au, float kneg, float c0) const {
        const f32x2 t = ag * kneg; f32x2 e; e.x = __builtin_amdgcn_exp2f(t.x); e.y = __builtin_amdgcn_exp2f(t.y);
        const f32x2 d = e * c0 + c0; f32x2 r; r.x = __builtin_amdgcn_rcpf(d.x); r.y = __builtin_amdgcn_rcpf(d.y);
        return (ag * au) * r; }
    __device__ __forceinline__ void operator()(const f32x4 (&acc)[2][2][4][2], const Unit& u, int wr, int wc, int fr, int fq) const {
        const int row0 = u.pm * BM + wr * 64 + fr, col0 = (u.pn % npn) * HALF + wc * 32 + 8 * fq;
        const float kneg = -si * LOG2E, c0 = 1.0f / (si * so);
#pragma unroll
        for (int ai = 0; ai < 2; ++ai)
#pragma unroll
            for (int m = 0; m < 4; ++m) { unsigned char* rowp = O + (size_t)(row0 + ai * HALF + m * 16) * ldc + col0;
                const f32x4 g0 = acc[ai][0][m][0], g1 = acc[ai][0][m][1], u0 = acc[ai][1][m][0], u1 = acc[ai][1][m][1];
                u32x2 w;
                const f32x2 a = two((f32x2){g0[0], g0[1]}, (f32x2){u0[0], u0[1]}, kneg, c0), b = two((f32x2){g0[2], g0[3]}, (f32x2){u0[2], u0[3]}, kneg, c0);
                const f32x2 c = two((f32x2){g1[0], g1[1]}, (f32x2){u1[0], u1[1]}, kneg, c0), d = two((f32x2){g1[2], g1[3]}, (f32x2){u1[2], u1[3]}, kneg, c0);
                w.x = pk4_fp8(a.x, a.y, b.x, b.y); w.y = pk4_fp8(c.x, c.y, d.x, d.y);
                *(u32x2*)rowp = w; }
    }
};
struct EpiResid {
    static constexpr bool PERM = false;
    const float* x_in; const float* ctx_in; float* XR; const float* mods; int gate_chunk; int from_input; float* slab; float asc;
    __device__ __forceinline__ void operator()(const f32x4 (&acc)[2][2][4][2], const Unit& u, int wr, int wc, int fr, int fq) const {
        const int b = u.pm / 17, tt = u.pm % 17;
        float* outp = XR + (size_t)u.pm * BM * DM;
        const float* basep = from_input ? (tt < 16 ? x_in + ((size_t)b * SEQ + (size_t)tt * 256) * DM : ctx_in + (size_t)b * NCTX * DM) : outp;
        const float* gate = mods + (size_t)(tt < 16 ? b : 4) * 12288 + gate_chunk * DM;
        const int col0 = u.pn * BM + wc * 32 + 4 * fq;
        f32x4 gv[2][2];
#pragma unroll
        for (int bj = 0; bj < 2; ++bj)
#pragma unroll
            for (int n = 0; n < 2; ++n) gv[bj][n] = *(const f32x4*)(gate + col0 + bj * HALF + n * 16) * asc;
        if (u.flag) {
            float* sp = slab + ((size_t)(u.flag - 1) * (NB * NCTX) + (size_t)b * NCTX) * DM;
#pragma unroll
            for (int ai = 0; ai < 2; ++ai)
#pragma unroll
                for (int m = 0; m < 4; ++m) { const size_t off = (size_t)(ai * HALF + wr * 64 + m * 16 + fr) * DM + col0;
#pragma unroll
                    for (int bj = 0; bj < 2; ++bj)
#pragma unroll
                        for (int n = 0; n < 2; ++n) *(f32x4*)(sp + off + bj * HALF + n * 16) = gv[bj][n] * acc[ai][bj][m][n]; }
            return;
        }
#pragma unroll
        for (int ai = 0; ai < 2; ++ai)
#pragma unroll
            for (int m = 0; m < 4; ++m) { const size_t off = (size_t)(ai * HALF + wr * 64 + m * 16 + fr) * DM + col0;
#pragma unroll
                for (int bj = 0; bj < 2; ++bj)
#pragma unroll
                    for (int n = 0; n < 2; ++n) { const f32x4 bs = *(const f32x4*)(basep + off + bj * HALF + n * 16);
                        *(f32x4*)(outp + off + bj * HALF + n * 16) = bs + gv[bj][n] * acc[ai][bj][m][n]; }
                if (m & 1) asm volatile("" ::: "memory"); }
    }
};

template <class Epi, class Sched, bool FP8 = false, bool ALIGN_EPI = true, bool SP2 = true>
__device__ __forceinline__ void gemm_phase(LAS unsigned char* lds, const Gemm g, const Sched& S, const Epi& E) {
    const int tid = fresh_tid(), wid = __builtin_amdgcn_readfirstlane(tid >> 6), lane = tid & 63, wr = wid >> 2, wc = wid & 3, fr = lane & 15, fq = lane >> 4;
    const int K = g.K;
    unsigned voffA[2], voffB[2];
#pragma unroll
    for (int i = 0; i < 2; ++i) { int R, C; stage_rc(tid * 16 + i * 8192, R, C); const int Rb = Epi::PERM ? ((R & ~31) + perm32(R & 31)) : R;
        voffA[i] = (unsigned)(R * K + C) * 2u; voffB[i] = (unsigned)(Rb * K + C) * 2u; }
    const size_t kstep = (size_t)(BK * 2);
    const size_t hstep = (size_t)HALF * K * 2;
    const size_t tstep = 2 * hstep;
    const unsigned ldsw = (unsigned)wid * 1024u;
    const int aoff = FP8 ? lds_byte(wr * 64 + fr, fq * 16) : lds_byte(wr * 64 + fr, fq * 8), boff = FP8 ? lds_byte(wc * 32 + fr, fq * 16) : lds_byte(wc * 32 + fr, fq * 8);
#define PG8_SA(b, h) (((b) * 2 + (h)) * HTB)
#define PG8_SB(b, h) ((4 + (b) * 2 + (h)) * HTB)
#define PG8_STAGE(bufoff, gbase, voff) do { _Pragma("unroll") for (int _i = 0; _i < 2; ++_i) \
        __builtin_amdgcn_global_load_lds((const unsigned*)((const char*)(gbase) + (voff)[_i]), (LAS unsigned*)(lds + (bufoff) + ldsw + _i * 8192), 16, 0, 0); } while (0)
#define PG8_LD16(p) (*(const LAS i32x4_t*)(p))
#define PG8_LDA(dst, b, h) do { if constexpr (FP8) { _Pragma("unroll") for (int m = 0; m < 4; ++m) { const LAS unsigned char* _p = lds + PG8_SA(b, h) + aoff + m * 2048; \
            dst##8[m] = __builtin_shufflevector(PG8_LD16(_p), PG8_LD16(_p + 16), 0, 1, 2, 3, 4, 5, 6, 7); } } else { \
        _Pragma("unroll") for (int m = 0; m < 4; ++m) _Pragma("unroll") for (int k = 0; k < 2; ++k) dst[m][k] = *(const LAS bf16x8*)(lds + PG8_SA(b, h) + aoff + m * 2048 + k * 1024); } } while (0)
#define PG8_LDB(dst, b, h) do { if constexpr (FP8) { _Pragma("unroll") for (int n = 0; n < 2; ++n) { const LAS unsigned char* _p = lds + PG8_SB(b, h) + boff + n * 2048; \
            dst##8[n] = __builtin_shufflevector(PG8_LD16(_p), PG8_LD16(_p + 16), 0, 1, 2, 3, 4, 5, 6, 7); } } else { \
        _Pragma("unroll") for (int n = 0; n < 2; ++n) _Pragma("unroll") for (int k = 0; k < 2; ++k) dst[n][k] = *(const LAS bf16x8*)(lds + PG8_SB(b, h) + boff + n * 2048 + k * 1024); } } while (0)
#define PG8_MMA(ai, bj, At, Bt) do { __builtin_amdgcn_s_setprio(1); _Pragma("unroll") for (int m = 0; m < 4; ++m) _Pragma("unroll") for (int n = 0; n < 2; ++n) { if constexpr (FP8) \
        asm volatile("v_mfma_f32_16x16x128_f8f6f4 %0, %1, %2, %0" : "+v"(acc[ai][bj][m][n]) : "v"(Bt##8[n]), "v"(At##8[m])); else { _Pragma("unroll") for (int k = 0; k < 2; ++k) \
        acc[ai][bj][m][n] = __builtin_amdgcn_mfma_f32_16x16x32_bf16(Bt[n][k], At[m][k], acc[ai][bj][m][n], 0, 0, 0); } } __builtin_amdgcn_s_setprio(0); } while (0)
#define PG8_WAIT_V(n) asm volatile("s_waitcnt vmcnt(" #n ")" ::: "memory")
#define PG8_WAIT_L(n) asm volatile("s_waitcnt lgkmcnt(" #n ")" ::: "memory")
#define PG8_BAR __builtin_amdgcn_s_barrier()
#define PG8_SCHED __builtin_amdgcn_sched_barrier(0)
    Unit cur, nxt; int ui = 0;
    if (!S.next(0, cur)) return;
    f32x4 acc[2][2][4][2];
#pragma unroll
    for (int a = 0; a < 2; ++a)
#pragma unroll
        for (int b = 0; b < 2; ++b)
#pragma unroll
            for (int m = 0; m < 4; ++m)
#pragma unroll
                for (int n = 0; n < 2; ++n) acc[a][b][m][n] = (f32x4){0.f, 0.f, 0.f, 0.f};
    bf16x8 At[4][2], B0[2][2], B1[2][2]; i32x8 At8[4], B08[2], B18[2];
    const char* cA = (const char*)g.A + (size_t)cur.pm * tstep + cur.kofs; const char* cB = (const char*)g.Bt + (size_t)cur.pn * tstep + cur.kofs;
    S.a_ready(cur);
    if constexpr (SP2) {
        PG8_STAGE(PG8_SB(0, 0), cB, voffB); PG8_STAGE(PG8_SB(0, 1), cB + hstep, voffB); PG8_STAGE(PG8_SA(0, 0), cA, voffA); PG8_STAGE(PG8_SA(0, 1), cA + hstep, voffA);
        if (wr == 1) PG8_BAR;
        PG8_WAIT_V(2); PG8_BAR;
        PG8_STAGE(PG8_SB(1, 0), cB + kstep, voffB); PG8_STAGE(PG8_SA(1, 0), cA + kstep, voffA); PG8_STAGE(PG8_SB(1, 1), cB + hstep + kstep, voffB);
        PG8_WAIT_V(6); PG8_BAR;
    } else {
        PG8_STAGE(PG8_SB(0, 0), cB, voffB); PG8_STAGE(PG8_SA(0, 0), cA, voffA); PG8_STAGE(PG8_SB(0, 1), cB + hstep, voffB); PG8_STAGE(PG8_SA(0, 1), cA + hstep, voffA);
        if (wr == 1) PG8_BAR;
        PG8_WAIT_V(4); PG8_BAR;
        PG8_STAGE(PG8_SB(1, 0), cB + kstep, voffB); PG8_STAGE(PG8_SA(1, 0), cA + kstep, voffA); PG8_STAGE(PG8_SB(1, 1), cB + hstep + kstep, voffB);
        PG8_WAIT_V(6); PG8_BAR;
    }
    for (;;) {
        const bool has_next = S.next(ui + 1, nxt);
        const char* nA = has_next ? (const char*)g.A + (size_t)nxt.pm * tstep + nxt.kofs : cA; const char* nB = has_next ? (const char*)g.Bt + (size_t)nxt.pn * tstep + nxt.kofs : cB;
        const int nt = cur.nt;
        for (int t = 0; t < nt; t += 2) {
            const bool last = (t == nt - 2);
            const char* a1 = cA + (size_t)(t + 1) * kstep;
            const char* a2 = last ? nA : cA + (size_t)(t + 2) * kstep; const char* b2 = last ? nB : cB + (size_t)(t + 2) * kstep;
            const char* a3 = a2 + kstep; const char* b3 = b2 + kstep;
            if (last && has_next) S.a_ready(nxt);
            if constexpr (SP2) {
            PG8_LDB(B0, 0, 0); PG8_LDB(B1, 0, 1); PG8_SCHED; PG8_LDA(At, 0, 0); PG8_STAGE(PG8_SA(1, 1), a1 + hstep, voffA);
            PG8_WAIT_V(8); PG8_WAIT_L(0); PG8_BAR; PG8_MMA(0, 0, At, B0); PG8_MMA(0, 1, At, B1); PG8_BAR; PG8_SCHED;
            PG8_LDA(At, 0, 1); PG8_STAGE(PG8_SB(0, 0), b2, voffB); PG8_STAGE(PG8_SB(0, 1), b2 + hstep, voffB); PG8_STAGE(PG8_SA(0, 0), a2, voffA);
            PG8_WAIT_V(8); PG8_WAIT_L(0); PG8_BAR; PG8_MMA(1, 0, At, B0); PG8_MMA(1, 1, At, B1); PG8_BAR; PG8_SCHED;
            PG8_LDB(B0, 1, 0); PG8_LDB(B1, 1, 1); PG8_SCHED; PG8_LDA(At, 1, 0); PG8_STAGE(PG8_SA(0, 1), a2 + hstep, voffA);
            PG8_WAIT_V(8); PG8_WAIT_L(0); PG8_BAR; PG8_MMA(0, 0, At, B0); PG8_MMA(0, 1, At, B1); PG8_BAR; PG8_SCHED;
            PG8_LDA(At, 1, 1); PG8_STAGE(PG8_SB(1, 0), b3, voffB); PG8_STAGE(PG8_SB(1, 1), b3 + hstep, voffB); PG8_STAGE(PG8_SA(1, 0), a3, voffA);
            PG8_WAIT_V(8); PG8_WAIT_L(0); PG8_BAR; PG8_MMA(1, 0, At, B0); PG8_MMA(1, 1, At, B1); PG8_BAR; PG8_SCHED;
            } else {
            PG8_LDB(B0, 0, 0); PG8_SCHED; PG8_LDA(At, 0, 0); PG8_STAGE(PG8_SA(1, 1), a1 + hstep, voffA);
            PG8_WAIT_L(8); PG8_BAR; PG8_WAIT_L(0); PG8_MMA(0, 0, At, B0); PG8_BAR; PG8_SCHED;
            PG8_LDB(B1, 0, 1); PG8_STAGE(PG8_SB(0, 0), b2, voffB);
            PG8_BAR; PG8_WAIT_L(0); PG8_MMA(0, 1, At, B1); PG8_BAR;
            PG8_LDA(At, 0, 1); PG8_STAGE(PG8_SA(0, 0), a2, voffA);
            PG8_BAR; PG8_WAIT_L(0); PG8_MMA(1, 0, At, B0); PG8_BAR; PG8_SCHED;
            PG8_STAGE(PG8_SB(0, 1), b2 + hstep, voffB);
            PG8_WAIT_V(6); PG8_BAR; PG8_MMA(1, 1, At, B1); PG8_BAR;
            PG8_LDB(B0, 1, 0); PG8_SCHED; PG8_LDA(At, 1, 0); PG8_STAGE(PG8_SA(0, 1), a2 + hstep, voffA);
            PG8_WAIT_L(8); PG8_BAR; PG8_WAIT_L(0); PG8_MMA(0, 0, At, B0); PG8_BAR; PG8_SCHED;
            PG8_LDB(B1, 1, 1); PG8_STAGE(PG8_SB(1, 0), b3, voffB);
            PG8_BAR; PG8_WAIT_L(0); PG8_MMA(0, 1, At, B1); PG8_BAR;
            PG8_LDA(At, 1, 1); PG8_STAGE(PG8_SA(1, 0), a3, voffA);
            PG8_BAR; PG8_WAIT_L(0); PG8_MMA(1, 0, At, B0); PG8_BAR; PG8_SCHED;
            PG8_STAGE(PG8_SB(1, 1), b3 + hstep, voffB);
            PG8_WAIT_V(6); PG8_BAR; PG8_MMA(1, 1, At, B1); PG8_BAR;
            }
        }
        if constexpr (ALIGN_EPI) { if (wr == 0) PG8_BAR; }
        if constexpr (FP8) asm volatile("s_nop 15\n\ts_nop 15" ::: "memory");
        E(acc, cur, wr, wc, fr, fq); S.done(cur);
        if (!has_next) break;
#pragma unroll
        for (int a = 0; a < 2; ++a)
#pragma unroll
            for (int b = 0; b < 2; ++b)
#pragma unroll
                for (int m = 0; m < 4; ++m)
#pragma unroll
                    for (int n = 0; n < 2; ++n) acc[a][b][m][n] = (f32x4){0.f, 0.f, 0.f, 0.f};
        cur = nxt; cA = nA; cB = nB; ++ui;
        if constexpr (ALIGN_EPI) { if (wr == 1) PG8_BAR; }
    }
    PG8_WAIT_V(0);
    if constexpr (!ALIGN_EPI) { if (wr == 0) PG8_BAR; }
    PG8_BAR;
#undef PG8_SA
#undef PG8_SB
#undef PG8_STAGE
#undef PG8_LDA
#undef PG8_LDB
#undef PG8_MMA
#undef PG8_LD16
#undef PG8_WAIT_V
#undef PG8_WAIT_L
#undef PG8_BAR
#undef PG8_SCHED
}
}

namespace att {
constexpr int D = 128, NW = 8, QBLK = 32, KVBLK = 64;
constexpr int LDQK = PROJ, LDO = DM;
constexpr float THR = 8.f;
#ifndef DIFF_SD
#define DIFF_SD 2
#endif
#ifndef STD_SD
#define STD_SD 1
#endif
constexpr int SHM_V = KVBLK * D * 2, SHM_K = KVBLK * D * 2;
constexpr int OFF_WS = 2 * SHM_V + 2 * SHM_K, OFF_STASH = OFF_WS + NW * 64 * 4, OFF_BIAS = OFF_STASH + 65536, ATT_LDS = OFF_BIAS + 2048;
static_assert(ATT_LDS <= MISC_OFF, "attention LDS");
#define KSWZ(row, colB) ((row) * 256 + ((colB) ^ (((row) & 7) << 4)))
#define SBAR() __builtin_amdgcn_sched_barrier(0)
__device__ __forceinline__ int crow(int r, int hi) { return (r & 3) + 8 * (r >> 2) + 4 * hi; }
struct TileMap { int NC, cbase, lbase, NT; __device__ __forceinline__ int krow(int j) const { return j < NC ? cbase + 64 * j : lbase + 64 * (j - NC); } };
struct MaskInfo { int q0, r0, lo; };

template <int MODE>
__device__ __forceinline__ void apply_mask(f32x16& p0, f32x16& p1, int j, const TileMap& tm, const MaskInfo& mi, int wid, int r32, int hi, const float* btab) {
    if constexpr (MODE == 1) {
        if (j >= tm.NC) {
            const int kp0 = tm.lbase + 64 * (j - tm.NC), qw = mi.q0 + wid * 32;
            if (kp0 - (qw + 31) < -128 || kp0 + 63 - qw > 128) {
                const int dq = kp0 - (qw + r32) + 4 * hi;
#pragma unroll
                for (int r = 0; r < 16; ++r) { const int d = dq + (r & 3) + 8 * (r >> 2);
                    if (d > 128 || d < -128) p0[r] = -1e30f;
                    if (d + 32 > 128 || d + 32 < -128) p1[r] = -1e30f; }
            }
        }
    } else if constexpr (MODE == 2) {
        if (j >= tm.NC) {
            const int kr = mi.lo + (j - tm.NC), rq = mi.r0 + (wid >> 1);
            int rs = rq - 4; rs = rs < 0 ? 0 : (rs > 56 ? 56 : rs);
            if (kr >= rs && kr < rs + 8) {
                const int cq = (wid & 1) * 32 + r32; int cs = cq - 8; cs = cs < 0 ? 0 : (cs > 48 ? 48 : cs);
                const float* bt = btab + (kr - rq + 7) * 31 + (4 * hi - cq + 15);
                const int cb = 4 * hi - cs;
#pragma unroll
                for (int r = 0; r < 16; ++r) { const int ko = (r & 3) + 8 * (r >> 2);
                    p0[r] = ((unsigned)(ko + cb) < 16u) ? p0[r] + bt[ko] : -1e30f;
                    if ((r & 7) == 7) SBAR(); }
#pragma unroll
                for (int r = 0; r < 16; ++r) { const int ko = (r & 3) + 8 * (r >> 2);
                    p1[r] = ((unsigned)(ko + 32 + cb) < 16u) ? p1[r] + bt[ko + 32] : -1e30f;
                    if ((r & 7) == 7) SBAR(); }
            } else {
#pragma unroll
                for (int r = 0; r < 16; ++r) { p0[r] = -1e30f; p1[r] = -1e30f; }
            }
        }
    }
}
__device__ __forceinline__ void partialSM(f32x16& p0, f32x16& p1, float& m_reg, float& mn, float& alpha, const float C, const float thr_raw) {
    float pmax = p0[0];
#pragma unroll
    for (int r = 1; r < 16; ++r) pmax = fmaxf(pmax, p0[r]);
#pragma unroll
    for (int r = 0; r < 16; ++r) pmax = fmaxf(pmax, p1[r]);
    { auto rr = __builtin_amdgcn_permlane32_swap(__float_as_uint(pmax), __float_as_uint(pmax), false, false);
      pmax = fmaxf(__uint_as_float(rr[0]), __uint_as_float(rr[1])); }
    if (__builtin_expect(__all(pmax - m_reg <= thr_raw), 1)) { mn = m_reg; alpha = 1.f; }
    else { mn = fmaxf(m_reg, pmax); alpha = __builtin_amdgcn_exp2f((m_reg - mn) * C); m_reg = mn; }
    const float mnC = -mn * C;
#pragma unroll
    for (int r = 0; r < 16; ++r) p0[r] = fmaf(p0[r], C, mnC);
#pragma unroll
    for (int r = 0; r < 16; ++r) p1[r] = fmaf(p1[r], C, mnC);
#pragma unroll
    for (int r = 0; r < 16; ++r) p0[r] = __builtin_amdgcn_exp2f(p0[r]);
}
__device__ __forceinline__ void finishSM(f32x16& p0, f32x16& p1, float alpha, float& l_reg, bf16x8& pa0, bf16x8& pa1, bf16x8& pa2, bf16x8& pa3) {
#pragma unroll
    for (int r = 0; r < 16; ++r) p1[r] = __builtin_amdgcn_exp2f(p1[r]);
    float ps = 0;
#pragma unroll
    for (int r = 0; r < 16; ++r) ps += p0[r];
#pragma unroll
    for (int r = 0; r < 16; ++r) ps += p1[r];
    { auto rr = __builtin_amdgcn_permlane32_swap(__float_as_uint(ps), __float_as_uint(ps), false, false);
      ps = __uint_as_float(rr[0]) + __uint_as_float(rr[1]); }
    l_reg = l_reg * alpha + ps;
#define PK4(P, BASE, OUT) do { unsigned a0 = cvt_pk_bf16(P[BASE + 0], P[BASE + 1]), a1 = cvt_pk_bf16(P[BASE + 2], P[BASE + 3]);   \
    unsigned b0 = cvt_pk_bf16(P[BASE + 4], P[BASE + 5]), b1 = cvt_pk_bf16(P[BASE + 6], P[BASE + 7]);                              \
    auto r0 = __builtin_amdgcn_permlane32_swap(a0, b0, false, false); auto r1 = __builtin_amdgcn_permlane32_swap(a1, b1, false, false); \
    u32x4 w = {r0[0], r1[0], r0[1], r1[1]}; OUT = *reinterpret_cast<bf16x8*>(&w); } while (0)
    PK4(p0, 0, pa0); PK4(p0, 8, pa1); PK4(p1, 0, pa2); PK4(p1, 8, pa3);
#undef PK4
}
template <int DLO, int DHI, bool QLDS, bool PREQ = false>
__device__ __forceinline__ void qkt(f32x16& p0, f32x16& p1, const char* Ks, const bf16x8* qr, const char* qlds, int r32, int hi, const f32x16& cinit = f32x16{}) {
#pragma unroll
    for (int d0 = DLO; d0 < DHI; ++d0) { const int cb = (d0 * 16 + hi * 8) * 2;
        bf16x8 q; if constexpr (QLDS) q = *(const volatile LAS bf16x8*)((const LAS char*)qlds + d0 * 8192); else q = qr[d0];
        const bf16x8 b0 = *reinterpret_cast<const bf16x8*>(Ks + KSWZ(r32, cb));
        const bf16x8 b1 = *reinterpret_cast<const bf16x8*>(Ks + KSWZ(32 + r32, cb));
        if (d0 == DLO) {
            if constexpr (PRESCALE && (!QLDS || (L1PRE && PREQ))) {
                asm("v_mfma_f32_32x32x16_bf16 %0, %1, %2, %3" : "=&v"(p0) : "v"(b0), "v"(q), "v"(cinit));
                asm("v_mfma_f32_32x32x16_bf16 %0, %1, %2, %3" : "=&v"(p1) : "v"(b1), "v"(q), "v"(cinit)); }
            else { p0 = __builtin_amdgcn_mfma_f32_32x32x16_bf16(b0, q, cinit, 0, 0, 0); p1 = __builtin_amdgcn_mfma_f32_32x32x16_bf16(b1, q, cinit, 0, 0, 0); } }
        else { p0 = __builtin_amdgcn_mfma_f32_32x32x16_bf16(b0, q, p0, 0, 0, 0); p1 = __builtin_amdgcn_mfma_f32_32x32x16_bf16(b1, q, p1, 0, 0, 0); } }
}
constexpr float THR_L2 = THR * LOG2E;
__device__ __forceinline__ void presm_decide(f32x16& p0, f32x16& p1, float pmax, float& m_hat, float& alpha, f32x16& negm, bool first) {
    { auto rr = __builtin_amdgcn_permlane32_swap(__float_as_uint(pmax), __float_as_uint(pmax), false, false);
      pmax = fmaxf(__uint_as_float(rr[0]), __uint_as_float(rr[1])); }
    if (!first && __builtin_expect(__all(pmax <= THR_L2), 1)) { alpha = 1.f; }
    else { const float dl = first ? pmax : fmaxf(pmax, 0.f); m_hat += dl; alpha = first ? 1.f : __builtin_amdgcn_exp2f(-dl);
#pragma unroll
        for (int r = 0; r < 16; ++r) { p0[r] -= dl; p1[r] -= dl; }
#pragma unroll
        for (int r = 0; r < 16; ++r) negm[r] = -m_hat; }
}
__device__ __forceinline__ int v_st(int k, int c) { const int kk = (k & ~0xC) | ((k & 4) << 1) | ((k & 8) >> 1); return ((kk >> 3) * 4 + (c >> 5)) * 512 + ((kk & 7) * 32 + (c & 31)) * 2; }
__device__ __forceinline__ int v_rd_base(int lane) { return ((lane & 3) << 3) | (((lane >> 2) & 3) << 6) | (((lane >> 4) & 1) << 5) | (((lane >> 5) & 1) << 8); }
constexpr int v_rd_off(int d0, int ks, int half) { return d0 * 512 + ks * 4096 + half * 2048; }
template <int OFF> __device__ __forceinline__ s16x4 tr_read(int vb) {
    s16x4 r; asm volatile("ds_read_b64_tr_b16 %0, %1 offset:%2" : "=&v"(r) : "v"(vb), "i"(OFF) : "memory"); return r;
}
template <int D0> __device__ __forceinline__ void pv_one(f32x16& od, int vb, bf16x8 pa0, bf16x8 pa1, bf16x8 pa2, bf16x8 pa3) {
    const s16x4 l0 = tr_read<v_rd_off(D0, 0, 0)>(vb), h0 = tr_read<v_rd_off(D0, 0, 1)>(vb), l1 = tr_read<v_rd_off(D0, 1, 0)>(vb), h1 = tr_read<v_rd_off(D0, 1, 1)>(vb);
    const s16x4 l2 = tr_read<v_rd_off(D0, 2, 0)>(vb), h2 = tr_read<v_rd_off(D0, 2, 1)>(vb), l3 = tr_read<v_rd_off(D0, 3, 0)>(vb), h3 = tr_read<v_rd_off(D0, 3, 1)>(vb);
    asm volatile("s_waitcnt lgkmcnt(0)" ::: "memory"); SBAR();
#define PK(L, H) (bf16x8){L[0], L[1], L[2], L[3], H[0], H[1], H[2], H[3]}
    od = __builtin_amdgcn_mfma_f32_32x32x16_bf16(pa0, PK(l0, h0), od, 0, 0, 0);
    od = __builtin_amdgcn_mfma_f32_32x32x16_bf16(pa1, PK(l1, h1), od, 0, 0, 0);
    od = __builtin_amdgcn_mfma_f32_32x32x16_bf16(pa2, PK(l2, h2), od, 0, 0, 0);
    od = __builtin_amdgcn_mfma_f32_32x32x16_bf16(pa3, PK(l3, h3), od, 0, 0, 0);
#undef PK
}
__device__ __forceinline__ void pv_d0(f32x16* o, int vb, bf16x8 pa0, bf16x8 pa1, bf16x8 pa2, bf16x8 pa3) {
    pv_one<0>(o[0], vb, pa0, pa1, pa2, pa3); pv_one<1>(o[1], vb, pa0, pa1, pa2, pa3); pv_one<2>(o[2], vb, pa0, pa1, pa2, pa3); pv_one<3>(o[3], vb, pa0, pa1, pa2, pa3);
}
template <int MODE, bool PRE = false>
__device__ __forceinline__ void pv_sm(f32x16* o, int vb, bf16x8 pa0, bf16x8 pa1, bf16x8 pa2, bf16x8 pa3, f32x16& p0, f32x16& p1, float& m_reg, float& mn, float& alpha, const float C, const float thr_raw,
                                      int j, const TileMap& tm, const MaskInfo& mi, int wid, int r32, int hi, const float* btab, f32x16* negm = nullptr) {
    if constexpr (PRE) {
        pv_one<0>(o[0], vb, pa0, pa1, pa2, pa3);
        apply_mask<MODE>(p0, p1, j, tm, mi, wid, r32, hi, btab);
        float pmax = p0[0];
#pragma unroll
        for (int r = 1; r < 16; ++r) pmax = fmaxf(pmax, p0[r]);
        pv_one<1>(o[1], vb, pa0, pa1, pa2, pa3);
#pragma unroll
        for (int r = 0; r < 16; ++r) pmax = fmaxf(pmax, p1[r]);
        pv_one<2>(o[2], vb, pa0, pa1, pa2, pa3);
        presm_decide(p0, p1, pmax, m_reg, alpha, *negm, false);
        pv_one<3>(o[3], vb, pa0, pa1, pa2, pa3);
#pragma unroll
        for (int r = 0; r < 16; ++r) p0[r] = __builtin_amdgcn_exp2f(p0[r]);
        return;
    }
    pv_one<0>(o[0], vb, pa0, pa1, pa2, pa3);
    apply_mask<MODE>(p0, p1, j, tm, mi, wid, r32, hi, btab);
    float pmax = p0[0];
#pragma unroll
    for (int r = 1; r < 16; ++r) pmax = fmaxf(pmax, p0[r]);
    pv_one<1>(o[1], vb, pa0, pa1, pa2, pa3);
#pragma unroll
    for (int r = 0; r < 16; ++r) pmax = fmaxf(pmax, p1[r]);
    { auto rr = __builtin_amdgcn_permlane32_swap(__float_as_uint(pmax), __float_as_uint(pmax), false, false);
      pmax = fmaxf(__uint_as_float(rr[0]), __uint_as_float(rr[1])); }
    if (__builtin_expect(__all(pmax - m_reg <= thr_raw), 1)) { mn = m_reg; alpha = 1.f; }
    else { mn = fmaxf(m_reg, pmax); alpha = __builtin_amdgcn_exp2f((m_reg - mn) * C); m_reg = mn; }
    const float mnC = -mn * C;
    pv_one<2>(o[2], vb, pa0, pa1, pa2, pa3);
#pragma unroll
    for (int r = 0; r < 16; ++r) p0[r] = fmaf(p0[r], C, mnC);
#pragma unroll
    for (int r = 0; r < 16; ++r) p1[r] = fmaf(p1[r], C, mnC);
    pv_one<3>(o[3], vb, pa0, pa1, pa2, pa3);
#pragma unroll
    for (int r = 0; r < 16; ++r) p0[r] = __builtin_amdgcn_exp2f(p0[r]);
}

template <int MODE, bool PRE>
__device__ __forceinline__ void sm_alone(f32x16& p0, f32x16& p1, float& m_reg, float& mn, float& alpha, const float C, const float thr_raw,
                                         int j, const TileMap& tm, const MaskInfo& mi, int wid, int r32, int hi, const float* btab, f32x16& negm) {
    apply_mask<MODE>(p0, p1, j, tm, mi, wid, r32, hi, btab);
    if constexpr (PRE) { float pmax = p0[0];
#pragma unroll
        for (int r = 1; r < 16; ++r) pmax = fmaxf(pmax, p0[r]);
#pragma unroll
        for (int r = 0; r < 16; ++r) pmax = fmaxf(pmax, p1[r]);
        presm_decide(p0, p1, pmax, m_reg, alpha, negm, false);
#pragma unroll
        for (int r = 0; r < 16; ++r) p0[r] = __builtin_amdgcn_exp2f(p0[r]); }
    else partialSM(p0, p1, m_reg, mn, alpha, C, thr_raw);
}
template <int MODE, int DLO, int DHI, int SD = 2, bool QLDS = false>
__device__ __forceinline__ void attn_core(const bf16_t* __restrict__ Qb, const bf16_t* __restrict__ Kh, const bf16_t* __restrict__ Vh, const TileMap tm, const MaskInfo mi,
                                          const float C, const float thr_raw, char* lds, f32x16 (&o)[4], float& l_out, float& m_out) {
    const int tid = fresh_tid(), wid = tid >> 6, lane = tid & 63, r32 = lane & 31, hi = lane >> 5;
    char* V_lds = lds; char* K_lds = lds + 2 * SHM_V;
    float* ws = (float*)(lds + OFF_WS) + wid * 64; float* al_l = ws + 32;
    const float* btab = (const float*)(lds + OFF_BIAS);
    constexpr bool PRE = (PRESCALE != 0) && (MODE == 0 || (MODE == 1 && L1PRE));
    float m_reg = PRE ? 0.f : -1e30f, l_reg = 0; f32x16 negm = f32x16{};
#pragma unroll
    for (int d = 0; d < 4; ++d) o[d] = f32x16{};
    bf16x8 qr[8];
    const unsigned qoff = (unsigned)((wid * QBLK + r32) * LDQK + hi * 8);
#pragma unroll
    for (int d0 = 0; d0 < 8; ++d0) { if (d0 >= DLO && d0 < DHI) qr[d0] = *reinterpret_cast<const bf16x8*>(Qb + qoff + d0 * 16); else qr[d0] = bf16x8{}; }
    const char* qlds = lds + OFF_STASH + tid * 16;
    if constexpr (QLDS) {
#pragma unroll
        for (int d0 = DLO; d0 < DHI; ++d0) *(bf16x8*)(lds + OFF_STASH + tid * 16 + d0 * 8192) = qr[d0];
        asm volatile("s_waitcnt lgkmcnt(0)" ::: "memory");
    }
    const int sr = tid >> 4, sc = (tid & 15) * 8, vst0 = v_st(sr, sc), vst1 = v_st(32 + sr, sc);
    const unsigned loff = (unsigned)(sr * LDQK + sc);
    const int vb0 = (int)(uintptr_t)V_lds + v_rd_base(lane);
    struct { bf16x8 vs0, vs1, ks0, ks1; } sr_[SD];
#define SLOAD(i, k0) do { const size_t _k0 = (size_t)(k0) * LDQK; const bf16_t* _kt = Kh + _k0; const bf16_t* _vt = Vh + _k0; \
    sr_[i].vs0 = *reinterpret_cast<const bf16x8*>(_vt + loff); sr_[i].vs1 = *reinterpret_cast<const bf16x8*>(_vt + 32 * LDQK + loff); \
    sr_[i].ks0 = *reinterpret_cast<const bf16x8*>(_kt + loff); sr_[i].ks1 = *reinterpret_cast<const bf16x8*>(_kt + 32 * LDQK + loff); } while (0)
#define SWRITE(b, i) do { *(bf16x8*)(V_lds + (b) * SHM_V + vst0) = sr_[i].vs0; *(bf16x8*)(V_lds + (b) * SHM_V + vst1) = sr_[i].vs1; const int kc = sc * 2; \
    *(bf16x8*)(K_lds + (b) * SHM_K + KSWZ(sr, kc)) = sr_[i].ks0; *(bf16x8*)(K_lds + (b) * SHM_K + KSWZ(32 + sr, kc)) = sr_[i].ks1; } while (0)
#define SWAIT() do { if constexpr (SD == 2) asm volatile("s_waitcnt vmcnt(4)" ::: "memory"); else asm volatile("s_waitcnt vmcnt(0)" ::: "memory"); } while (0)
#define RESC(a) do { if (__any((a) < 1.f)) { if (hi == 0) al_l[r32] = (a); asm volatile("s_waitcnt lgkmcnt(0)" ::: "memory"); \
    _Pragma("unroll") for (int d = 0; d < 4; ++d) _Pragma("unroll") for (int r = 0; r < 16; ++r) o[d][r] *= al_l[crow(r, hi)]; } } while (0)
    f32x16 pA0, pA1, pB0, pB1; float mnA, mnB, alA, alB; bf16x8 pa0, pa1, pa2, pa3; const int NT = tm.NT;
    constexpr int SE = 0, SO = SD - 1;
    SLOAD(SE, tm.krow(0)); asm volatile("s_waitcnt vmcnt(0)" ::: "memory"); SWRITE(0, SE); __syncthreads();
    qkt<DLO, DHI, QLDS, PRE>(pA0, pA1, K_lds, qr, qlds, r32, hi, negm); apply_mask<MODE>(pA0, pA1, 0, tm, mi, wid, r32, hi, btab);
    if constexpr (PRE) { float pmax = pA0[0];
#pragma unroll
        for (int r = 1; r < 16; ++r) pmax = fmaxf(pmax, pA0[r]);
#pragma unroll
        for (int r = 0; r < 16; ++r) pmax = fmaxf(pmax, pA1[r]);
        presm_decide(pA0, pA1, pmax, m_reg, alA, negm, true);
#pragma unroll
        for (int r = 0; r < 16; ++r) pA0[r] = __builtin_amdgcn_exp2f(pA0[r]); }
    else partialSM(pA0, pA1, m_reg, mnA, alA, C, thr_raw);
    SLOAD(SO, tm.krow(1)); if constexpr (SD == 2) { if (2 < NT) SLOAD(SE, tm.krow(2)); }
    SWAIT(); SWRITE(1, SO); __syncthreads();
    if constexpr (true) {
        for (int j = 1; j + 1 < NT; j += 2) {
            SBAR(); qkt<DLO, DHI, QLDS, PRE>(pB0, pB1, K_lds + SHM_K, qr, qlds, r32, hi, negm);
            finishSM(pA0, pA1, alA, l_reg, pa0, pa1, pa2, pa3); SBAR();
            SLOAD(SO, tm.krow(j + SD)); SBAR();
            pv_sm<MODE, PRE>(o, vb0, pa0, pa1, pa2, pa3, pB0, pB1, m_reg, mnB, alB, C, thr_raw, j, tm, mi, wid, r32, hi, btab, &negm);
            __syncthreads(); SWAIT(); SWRITE(0, SE);
            RESC(alB); __syncthreads();
            SBAR(); qkt<DLO, DHI, QLDS, PRE>(pA0, pA1, K_lds, qr, qlds, r32, hi, negm);
            finishSM(pB0, pB1, alB, l_reg, pa0, pa1, pa2, pa3); SBAR();
            if (SD == 1 || j + 3 < NT) SLOAD(SE, tm.krow(j + 1 + SD)); SBAR();
            pv_sm<MODE, PRE>(o, vb0 + SHM_V, pa0, pa1, pa2, pa3, pA0, pA1, m_reg, mnA, alA, C, thr_raw, j + 1, tm, mi, wid, r32, hi, btab, &negm);
            __syncthreads(); SWAIT(); SWRITE(1, SO);
            RESC(alA); __syncthreads();
        }
        SBAR(); qkt<DLO, DHI, QLDS, PRE>(pB0, pB1, K_lds + SHM_K, qr, qlds, r32, hi, negm);
        finishSM(pA0, pA1, alA, l_reg, pa0, pa1, pa2, pa3); SBAR();
        pv_sm<MODE, PRE>(o, vb0, pa0, pa1, pa2, pa3, pB0, pB1, m_reg, mnB, alB, C, thr_raw, NT - 1, tm, mi, wid, r32, hi, btab, &negm);
        __syncthreads(); RESC(alB);
        finishSM(pB0, pB1, alB, l_reg, pa0, pa1, pa2, pa3); SBAR();
        pv_d0(o, vb0 + SHM_V, pa0, pa1, pa2, pa3);
    } else {
        const int widu = __builtin_amdgcn_readfirstlane(wid);
        auto ACT = [&](int j) -> bool {
            if (j < tm.NC) return true;
            if constexpr (MODE == 1) { const int kp0 = tm.lbase + 64 * (j - tm.NC), qw = mi.q0 + widu * 32; return !(kp0 + 63 - qw < -128 || kp0 - (qw + 31) > 128); }
            else { const int kr = mi.lo + (j - tm.NC), rq = mi.r0 + (widu >> 1); int rs = rq - 4; rs = rs < 0 ? 0 : (rs > 56 ? 56 : rs); return kr >= rs && kr < rs + 8; } };
#define TSTEP(PC0, PC1, ALC, MNC, PP0, PP1, ALP, KOFF, VOFF, JC, AP, AC) do { \
        SBAR(); if (AC) qkt<DLO, DHI, QLDS, PRE>(PC0, PC1, K_lds + (KOFF), qr, qlds, r32, hi, negm); else { asm("" : "=v"(PC0)); asm("" : "=v"(PC1)); }    \
        if (AP) finishSM(PP0, PP1, ALP, l_reg, pa0, pa1, pa2, pa3); else { asm("" : "=v"(pa0)); asm("" : "=v"(pa1)); asm("" : "=v"(pa2)); asm("" : "=v"(pa3)); } SBAR(); } while (0)
#define TPV(PC0, PC1, ALC, MNC, VOFF, JC, AP, AC) do { \
        if ((AP) && (AC)) pv_sm<MODE, PRE>(o, vb0 + (VOFF), pa0, pa1, pa2, pa3, PC0, PC1, m_reg, MNC, ALC, C, thr_raw, JC, tm, mi, wid, r32, hi, btab, &negm); \
        else if (AP) pv_d0(o, vb0 + (VOFF), pa0, pa1, pa2, pa3); \
        else if (AC) sm_alone<MODE, PRE>(PC0, PC1, m_reg, MNC, ALC, C, thr_raw, JC, tm, mi, wid, r32, hi, btab, negm); } while (0)
        bool aA = true, aB;
        for (int j = 1; j + 1 < NT; j += 2) {
            aB = ACT(j);
            TSTEP(pB0, pB1, alB, mnB, pA0, pA1, alA, SHM_K, 0, j, aA, aB);
            SLOAD(SO, tm.krow(j + SD)); SBAR();
            TPV(pB0, pB1, alB, mnB, 0, j, aA, aB);
            __syncthreads(); SWAIT(); SWRITE(0, SE);
            if (aB) RESC(alB); __syncthreads();
            aA = ACT(j + 1);
            TSTEP(pA0, pA1, alA, mnA, pB0, pB1, alB, 0, SHM_V, j + 1, aB, aA);
            if (SD == 1 || j + 3 < NT) SLOAD(SE, tm.krow(j + 1 + SD)); SBAR();
            TPV(pA0, pA1, alA, mnA, SHM_V, j + 1, aB, aA);
            __syncthreads(); SWAIT(); SWRITE(1, SO);
            if (aA) RESC(alA); __syncthreads();
        }
        aB = ACT(NT - 1);
        TSTEP(pB0, pB1, alB, mnB, pA0, pA1, alA, SHM_K, 0, NT - 1, aA, aB);
        TPV(pB0, pB1, alB, mnB, 0, NT - 1, aA, aB);
        __syncthreads(); if (aB) RESC(alB);
        if (aB) { finishSM(pB0, pB1, alB, l_reg, pa0, pa1, pa2, pa3); SBAR();
            pv_d0(o, vb0 + SHM_V, pa0, pa1, pa2, pa3); }
#undef TSTEP
#undef TPV
    }
    l_out = l_reg; m_out = m_reg;
#undef SLOAD
#undef SWRITE
#undef SWAIT
#undef RESC
}

template <int MODE, int DLO, int DHI, bool QLDS>
__device__ __forceinline__ void attn_core_dma(const bf16_t* __restrict__ Qb, const bf16_t* __restrict__ Kh, const bf16_t* __restrict__ Vh, const TileMap tm, const MaskInfo mi,
                                              const float C, const float thr_raw, char* lds, f32x16 (&o)[4], float& l_out, float& m_out) {
    const int tid = fresh_tid(), wid = tid >> 6, lane = tid & 63, r32 = lane & 31, hi = lane >> 5;
    const int widu = __builtin_amdgcn_readfirstlane(wid);
    char* V_lds = lds; char* K_lds = lds + 2 * SHM_V;
    float* ws = (float*)(lds + OFF_WS) + wid * 64; float* al_l = ws + 32;
    const float* btab = (const float*)(lds + OFF_BIAS);
    constexpr bool PRE = (PRESCALE != 0) && (MODE == 0 || L1PRE);
    float m_reg = PRE ? 0.f : -1e30f, l_reg = 0; f32x16 negm = f32x16{};
#pragma unroll
    for (int d = 0; d < 4; ++d) o[d] = f32x16{};
    bf16x8 qr[8];
    const unsigned qoff = (unsigned)((wid * QBLK + r32) * LDQK + hi * 8);
#pragma unroll
    for (int d0 = 0; d0 < 8; ++d0) { if (d0 >= DLO && d0 < DHI) qr[d0] = *reinterpret_cast<const bf16x8*>(Qb + qoff + d0 * 16); else qr[d0] = bf16x8{}; }
    const char* qlds = lds + OFF_STASH + tid * 16;
    if constexpr (QLDS) {
#pragma unroll
        for (int d0 = DLO; d0 < DHI; ++d0) *(bf16x8*)(lds + OFF_STASH + tid * 16 + d0 * 8192) = qr[d0];
        asm volatile("s_waitcnt lgkmcnt(0)" ::: "memory");
    }
    unsigned kso[2], vso[2];
#pragma unroll
    for (int i = 0; i < 2; ++i) { const int row = (i * 8 + wid) * 4 + (lane >> 4), col = ((lane & 15) ^ (row & 7)) * 8; kso[i] = (unsigned)(row * LDQK + col) * 2u;
        const int st = (i * 8 + wid) * 2 + (lane >> 5), kk = (st >> 2) * 8 + ((lane & 31) >> 2), k = (kk & ~0xC) | ((kk & 4) << 1) | ((kk & 8) >> 1), c = (st & 3) * 32 + (lane & 3) * 8;
        vso[i] = (unsigned)(k * LDQK + c) * 2u; }
    LAS unsigned char* Vd = (LAS unsigned char*)V_lds + widu * 1024; LAS unsigned char* Kd = (LAS unsigned char*)K_lds + widu * 1024;
    const int vb0 = (int)(uintptr_t)V_lds + v_rd_base(lane);
#define DMAK(b, k0) do { const char* _g = (const char*)(Kh + (size_t)(k0) * LDQK); _Pragma("unroll") for (int _i = 0; _i < 2; ++_i) \
        __builtin_amdgcn_global_load_lds((const unsigned*)(_g + kso[_i]), (LAS unsigned*)(Kd + (b) * SHM_K + _i * 8192), 16, 0, 0); } while (0)
#define DMAV(b, k0) do { const char* _g = (const char*)(Vh + (size_t)(k0) * LDQK); _Pragma("unroll") for (int _i = 0; _i < 2; ++_i) \
        __builtin_amdgcn_global_load_lds((const unsigned*)(_g + vso[_i]), (LAS unsigned*)(Vd + (b) * SHM_V + _i * 8192), 16, 0, 0); } while (0)
#define LANDED() do { asm volatile("s_waitcnt vmcnt(0)" ::: "memory"); __builtin_amdgcn_s_barrier(); asm volatile("" ::: "memory"); } while (0)
#define RESC(a) do { if (__any((a) < 1.f)) { if (hi == 0) al_l[r32] = (a); asm volatile("s_waitcnt lgkmcnt(0)" ::: "memory"); \
    _Pragma("unroll") for (int d = 0; d < 4; ++d) _Pragma("unroll") for (int r = 0; r < 16; ++r) o[d][r] *= al_l[crow(r, hi)]; } } while (0)
    f32x16 pA0, pA1, pB0, pB1; float mnA, mnB, alA, alB; bf16x8 pa0, pa1, pa2, pa3; const int NT = tm.NT;
    DMAK(0, tm.krow(0)); DMAV(0, tm.krow(0)); DMAK(1, tm.krow(1)); LANDED();
    qkt<DLO, DHI, QLDS, PRE>(pA0, pA1, K_lds, qr, qlds, r32, hi, negm); apply_mask<MODE>(pA0, pA1, 0, tm, mi, wid, r32, hi, btab);
    if constexpr (PRE) { float pmax = pA0[0];
#pragma unroll
        for (int r = 1; r < 16; ++r) pmax = fmaxf(pmax, pA0[r]);
#pragma unroll
        for (int r = 0; r < 16; ++r) pmax = fmaxf(pmax, pA1[r]);
        presm_decide(pA0, pA1, pmax, m_reg, alA, negm, true);
#pragma unroll
        for (int r = 0; r < 16; ++r) pA0[r] = __builtin_amdgcn_exp2f(pA0[r]); }
    else partialSM(pA0, pA1, m_reg, mnA, alA, C, thr_raw);
    asm volatile("s_waitcnt lgkmcnt(0)" ::: "memory"); __builtin_amdgcn_s_barrier(); asm volatile("" ::: "memory");
    auto ACT = [&](int j) -> bool {
        if constexpr (MODE == 0 || !TSKIP) return true;
        else { if (j < tm.NC) return true;
            if constexpr (MODE == 1) { const int kp0 = tm.lbase + 64 * (j - tm.NC), qw = mi.q0 + widu * 32; return !(kp0 + 63 - qw < -128 || kp0 - (qw + 31) > 128); }
            else { const int kr = mi.lo + (j - tm.NC), rq = mi.r0 + (widu >> 1); int rs = rq - 4; rs = rs < 0 ? 0 : (rs > 56 ? 56 : rs); return kr >= rs && kr < rs + 8; } } };
#define STEPX(PC0, PC1, ALC, MNC, PP0, PP1, ALP, KOFF, VOFF, JC, LIVE) do { \
        if (LIVE) { SBAR(); qkt<DLO, DHI, QLDS, PRE>(PC0, PC1, K_lds + (KOFF), qr, qlds, r32, hi, negm); \
            finishSM(PP0, PP1, ALP, l_reg, pa0, pa1, pa2, pa3); SBAR(); \
            pv_sm<MODE, PRE>(o, vb0 + (VOFF), pa0, pa1, pa2, pa3, PC0, PC1, m_reg, MNC, ALC, C, thr_raw, JC, tm, mi, wid, r32, hi, btab, &negm); \
            RESC(ALC); } \
        else { _Pragma("unroll") for (int r_ = 0; r_ < 16; ++r_) { PC0[r_] = 0.f; PC1[r_] = -1e30f; } ALC = 1.f; } } while (0)
    bool aA = true, aB;
    for (int j = 1; j + 1 < NT; j += 2) {
        DMAK(0, tm.krow(j + 1)); DMAV(1, tm.krow(j)); aB = ACT(j);
        STEPX(pB0, pB1, alB, mnB, pA0, pA1, alA, SHM_K, 0, j, (aA || aB));
        LANDED();
        DMAK(1, tm.krow(j + 2)); DMAV(0, tm.krow(j + 1)); aA = ACT(j + 1);
        STEPX(pA0, pA1, alA, mnA, pB0, pB1, alB, 0, SHM_V, j + 1, (aB || aA));
        LANDED();
    }
    DMAV(1, tm.krow(NT - 1)); aB = ACT(NT - 1);
    STEPX(pB0, pB1, alB, mnB, pA0, pA1, alA, SHM_K, 0, NT - 1, (aA || aB));
    LANDED();
    if (aB) { finishSM(pB0, pB1, alB, l_reg, pa0, pa1, pa2, pa3); SBAR();
        pv_d0(o, vb0 + SHM_V, pa0, pa1, pa2, pa3); }
    l_out = l_reg; m_out = m_reg;
#undef DMAK
#undef DMAV
#undef LANDED
#undef RESC
#undef STEPX
}
__device__ __forceinline__ void normalise(f32x16 (&o)[4], float l_reg, char* lds) {
    const int tid = fresh_tid(), wid = tid >> 6, lane = tid & 63, r32 = lane & 31, hi = lane >> 5;
    float* li_l = (float*)(lds + OFF_WS) + wid * 64;
    if (hi == 0) li_l[r32] = l_reg; asm volatile("s_waitcnt lgkmcnt(0)" ::: "memory");
#pragma unroll
    for (int r = 0; r < 16; ++r) { const float rl = __builtin_amdgcn_rcpf(li_l[crow(r, hi)]);
#pragma unroll
        for (int d0 = 0; d0 < 4; ++d0) o[d0][r] *= rl; }
    asm volatile("s_waitcnt lgkmcnt(0)" ::: "memory");
}
__device__ __forceinline__ void store_o(const f32x16 (&o)[4], bf16_t* Ob) {
    const int tid = fresh_tid(), wid = tid >> 6, lane = tid & 63, r32 = lane & 31, hi = lane >> 5;
    __hip_bfloat16* Ow = (__hip_bfloat16*)Ob + (long)(wid * QBLK) * LDO;
#pragma unroll
    for (int r = 0; r < 16; ++r) { const int orow = crow(r, hi);
#pragma unroll
        for (int d0 = 0; d0 < 4; ++d0) Ow[(long)orow * LDO + d0 * 32 + r32] = __float2bfloat16(o[d0][r]); }
}
__device__ __forceinline__ void store_o8(const f32x16 (&o)[4], unsigned char* Ob8) {
    const int tid = fresh_tid(), wid = tid >> 6, lane = tid & 63, r32 = lane & 31, hi = lane >> 5;
    unsigned char* Ow = Ob8 + (long)(wid * QBLK) * LDO;
#pragma unroll
    for (int r = 0; r < 16; r += 2) { const int orow = crow(r, hi);
#pragma unroll
        for (int d0 = 0; d0 < 4; ++d0) { const int w = __builtin_amdgcn_cvt_pk_fp8_f32(clamp8(o[d0][r] * S_A8), clamp8(o[d0][r + 1] * S_A8), 0, false);
            Ow[(long)orow * LDO + d0 * 32 + r32] = (unsigned char)(w & 0xff); Ow[(long)(orow + 1) * LDO + d0 * 32 + r32] = (unsigned char)((w >> 8) & 0xff); } }
}
template <int MODE>
__device__ __forceinline__ void unit_std(const bf16_t* Qb, const bf16_t* Kh, const bf16_t* Vh, const TileMap tm, const MaskInfo mi, float sink, bf16_t* Ob, char* lds) {
    f32x16 o[4]; float l, m;
    const float C = ATT_SCALE * LOG2E;
    if constexpr (ATT_DMA) attn_core_dma<MODE, 0, 8, (MODE != 0)>(Qb, Kh, Vh, tm, mi, C, THR / ATT_SCALE, lds, o, l, m);
    else attn_core<MODE, 0, 8, (MODE == 0 ? STD_SD : 1), (MODE != 0)>(Qb, Kh, Vh, tm, mi, C, THR / ATT_SCALE, lds, o, l, m);
    if constexpr (MODE == 1) l += __builtin_amdgcn_exp2f(sink * LOG2E - ((PRESCALE && L1PRE) ? m : m * C));
    normalise(o, l, lds);
    if constexpr (MODE != 0 && L1ATT_FP8) store_o8(o, (unsigned char*)Ob); else store_o(o, Ob);
    __syncthreads();
}
__device__ __forceinline__ void unit_diff(const bf16_t* Qb, const bf16_t* Kh, const bf16_t* Vh, const TileMap tm, float lam, const float* subln_g, bf16_t* Ob, char* lds) {
    const int tid = fresh_tid(), lane = tid & 63, r32 = lane & 31;
    f32x16 o[4]; float l, m; const MaskInfo mi{0, 0, 0};
    const float C = A_SCALE * LOG2E;
    unsigned* stash = (unsigned*)(lds + OFF_STASH);
    if constexpr (ATT_DMA) attn_core_dma<0, 0, 4, false>(Qb, Kh, Vh, tm, mi, C, THR / A_SCALE, lds, o, l, m); else attn_core<0, 0, 4, DIFF_SD>(Qb, Kh, Vh, tm, mi, C, THR / A_SCALE, lds, o, l, m);
    normalise(o, l, lds);
#pragma unroll
    for (int d0 = 0; d0 < 4; ++d0)
#pragma unroll
        for (int r = 0; r < 16; r += 2) stash[(d0 * 8 + (r >> 1)) * 512 + tid] = cvt_pk_bf16(o[d0][r], o[d0][r + 1]);
    __syncthreads();
    if constexpr (ATT_DMA) attn_core_dma<0, 4, 8, false>(Qb, Kh, Vh, tm, mi, C, THR / A_SCALE, lds, o, l, m); else attn_core<0, 4, 8, DIFF_SD>(Qb, Kh, Vh, tm, mi, C, THR / A_SCALE, lds, o, l, m);
    normalise(o, l, lds);
    float ss[16];
#pragma unroll
    for (int r = 0; r < 16; ++r) ss[r] = 0.f;
#pragma unroll
    for (int d0 = 0; d0 < 4; ++d0)
#pragma unroll
        for (int r = 0; r < 16; r += 2) { const unsigned w = stash[(d0 * 8 + (r >> 1)) * 512 + tid];
            const float a = bf_lo(w) - lam * o[d0][r], b = bf_hi(w) - lam * o[d0][r + 1];
            o[d0][r] = a; o[d0][r + 1] = b; ss[r] += a * a; ss[r + 1] += b * b; }
#pragma unroll
    for (int r = 0; r < 16; ++r) {
#pragma unroll
        for (int x = 1; x < 32; x <<= 1) ss[r] += __shfl_xor(ss[r], x);
        ss[r] = (1.0f - LAMBDA_INIT) / sqrtf(ss[r] * (1.0f / 128.0f) + EPS); }
    float gg[4];
#pragma unroll
    for (int d0 = 0; d0 < 4; ++d0) gg[d0] = subln_g[d0 * 32 + r32];
#pragma unroll
    for (int d0 = 0; d0 < 4; ++d0)
#pragma unroll
        for (int r = 0; r < 16; ++r) o[d0][r] *= ss[r] * gg[d0];
    store_o(o, Ob);
    __syncthreads();
}
#undef SBAR
}

#define XB_TMO      128
#define XB_XCNT(j)  (256  + 64 * (j))
#define XB_XSUB(j)  (1280 + 64 * (j))
#define XB_XGEN(j)  (2304 + 64 * (j))
#define XB_TOP      3328
#define XB_TOPGEN   3392
#define XCD_BAR_WORDS 3456
#define XB_SPIN_CAP (1u << 22)
__device__ __forceinline__ unsigned xb_ld(unsigned* p)              { return __hip_atomic_load(p, __ATOMIC_RELAXED, __HIP_MEMORY_SCOPE_AGENT); }
__device__ __forceinline__ unsigned xb_add(unsigned* p, unsigned v) { return __hip_atomic_fetch_add(p, v, __ATOMIC_RELAXED, __HIP_MEMORY_SCOPE_AGENT); }
__device__ __forceinline__ unsigned xb_xcc_id() { return (unsigned)__builtin_amdgcn_s_getreg((3 << 11) | 20) & 0xFu; }
#define XB_SPIN(cond, bar) do { unsigned _sp = 0; while (cond) { __builtin_amdgcn_s_sleep(1); \
    if ((++_sp & 255u) == 0u) { if (xb_ld(&(bar)[XB_TMO])) break; if (_sp > XB_SPIN_CAP) { atomicAdd(&(bar)[XB_TMO], 1u); break; } } } } while (0)
struct XcdBarrier { unsigned* bar; unsigned x; volatile LAS unsigned* st; };
__device__ __forceinline__ XcdBarrier xcd_barrier_post(unsigned* bar, volatile LAS unsigned* st) {
    XcdBarrier b; b.bar = bar; b.x = xb_xcc_id(); b.st = st;
    if (threadIdx.x == 0) (void)xb_add(&bar[XB_XCNT(b.x)], 1u);
    return b;
}
__device__ __forceinline__ void xcd_barrier_complete(unsigned* bar, unsigned x, unsigned& nloc, unsigned& nx) {
    const unsigned G = gridDim.x * gridDim.y * gridDim.z;
    unsigned sum, cnt, mine, sp = 0u;
    for (;;) {
        sum = 0u; cnt = 0u; mine = 0u;
#pragma unroll
        for (unsigned j = 0; j < 16; ++j) { const unsigned c = xb_ld(&bar[XB_XCNT(j)]); sum += c; cnt += (c > 0u) ? 1u : 0u; mine = (j == x) ? c : mine; }
        if (sum == G) break;
        __builtin_amdgcn_s_sleep(1);
        if ((++sp & 255u) == 0u) { if (xb_ld(&bar[XB_TMO])) break; if (sp > XB_SPIN_CAP) { atomicAdd(&bar[XB_TMO], 1u); break; } }
    }
    nloc = mine > 0u ? mine : 1u; nx = cnt > 0u ? cnt : 1u;
}
__device__ __forceinline__ void xcd_barrier(const XcdBarrier& b) {
    asm volatile("s_waitcnt vmcnt(0)" ::: "memory");
    __syncthreads();
    if (threadIdx.x == 0) {
        unsigned* bar = b.bar;
        __builtin_amdgcn_s_waitcnt(0);
        unsigned nloc = b.st[0], nx = b.st[1];
        if (nloc == 0u) { xcd_barrier_complete(bar, b.x, nloc, nx); b.st[0] = nloc; b.st[1] = nx; }
        const unsigned old = xb_add(&bar[XB_XSUB(b.x)], 1u);
        const unsigned gen = old / nloc;
        if (old + 1u == (gen + 1u) * nloc) {
            __builtin_amdgcn_fence(__ATOMIC_RELEASE, "agent");
            asm volatile("s_waitcnt vmcnt(0)" ::: "memory");
            const unsigned og = xb_add(&bar[XB_TOP], 1u);
            const unsigned tg = og / nx;
            if (og + 1u == (tg + 1u) * nx) xb_add(&bar[XB_TOPGEN], 1u);
            else XB_SPIN(xb_ld(&bar[XB_TOPGEN]) == tg, bar);
            __builtin_amdgcn_fence(__ATOMIC_ACQUIRE, "agent");
            xb_add(&bar[XB_XGEN(b.x)], 1u);
            asm volatile("s_waitcnt vmcnt(0)" ::: "memory");
        } else {
            XB_SPIN(xb_ld(&bar[XB_XGEN(b.x)]) == gen, bar);
            __builtin_amdgcn_fence(__ATOMIC_ACQUIRE, "agent");
            asm volatile("s_waitcnt vmcnt(0)" ::: "memory");
        }
    }
    __syncthreads();
}

struct Args { const float* in[33]; float* out; unsigned char* ws; int ph_lo, ph_hi; };
struct Frame {
    LAS unsigned char* lds; int vcu, G;
};

__device__ __forceinline__ void transpose_item(const float* W, int ldw, int K, bf16_t* WT, int k0, int n0, long dst_row0, LAS float* scr, int lane) {
    { float tv[32]; const float* wp = W + (size_t)(k0 + (lane >> 5)) * ldw + n0 + (lane & 31);
#pragma unroll
      for (int i = 0; i < 32; ++i) tv[i] = wp[(size_t)(2 * i) * ldw];
#pragma unroll
      for (int i = 0; i < 32; ++i) scr[(2 * i + (lane >> 5)) * 33 + (lane & 31)] = tv[i]; }
    LDS_WAIT(); asm volatile("" ::: "memory");
    const int c = lane & 7;
#pragma unroll
    for (int j = 0; j < 4; ++j) { const int n = (lane >> 3) + 8 * j; const LAS float* s = scr + (8 * c) * 33 + n;
        u32x4 o; o.x = cvt_pk_bf16(s[0 * 33], s[1 * 33]); o.y = cvt_pk_bf16(s[2 * 33], s[3 * 33]); o.z = cvt_pk_bf16(s[4 * 33], s[5 * 33]); o.w = cvt_pk_bf16(s[6 * 33], s[7 * 33]);
        *(GAS u32x4*)(WT + (size_t)(dst_row0 + n) * K + k0 + 8 * c) = o; }
    LDS_WAIT(); asm volatile("" ::: "memory");
}
__device__ __forceinline__ void transpose_item8(const float* W, int ldw, int K, unsigned char* WT, int k0, int n0, long dst_row0, LAS float* scr, int lane, float scale) {
#pragma unroll
    for (int hb = 0; hb < 2; ++hb) { float tv[32]; const float* wp = W + (size_t)(k0 + 64 * hb + (lane >> 5)) * ldw + n0 + (lane & 31);
#pragma unroll
        for (int i = 0; i < 32; ++i) tv[i] = wp[(size_t)(2 * i) * ldw];
#pragma unroll
        for (int i = 0; i < 32; ++i) { const int kk = 64 * hb + 2 * i + (lane >> 5); scr[kk * 32 + (((lane & 31) + 8 * (kk >> 4)) & 31)] = tv[i]; } }
    LDS_WAIT(); asm volatile("" ::: "memory");
    const int c = lane & 7;
#pragma unroll
    for (int j = 0; j < 4; ++j) { const int n = (lane >> 3) + 8 * j; const LAS float* s = scr + (16 * c) * 32 + ((n + 8 * c) & 31);
        u32x4 o;
        o.x = pk4_fp8(s[0 * 32] * scale, s[1 * 32] * scale, s[2 * 32] * scale, s[3 * 32] * scale); o.y = pk4_fp8(s[4 * 32] * scale, s[5 * 32] * scale, s[6 * 32] * scale, s[7 * 32] * scale);
        o.z = pk4_fp8(s[8 * 32] * scale, s[9 * 32] * scale, s[10 * 32] * scale, s[11 * 32] * scale); o.w = pk4_fp8(s[12 * 32] * scale, s[13 * 32] * scale, s[14 * 32] * scale, s[15 * 32] * scale);
        *(GAS u32x4*)(WT + (size_t)(dst_row0 + n) * K + k0 + 16 * c) = o; }
    LDS_WAIT(); asm volatile("" ::: "memory");
}
__device__ __forceinline__ void tr_plain8(const float* W, int K, int N, unsigned char* WT, long row_off, LAS float* scr, int item, int lane) {
    const int nblk = N / 32, kb = item / nblk, nb = item % nblk;
    transpose_item8(W, N, K, WT, 128 * kb, 32 * nb, row_off + 32 * nb, scr, lane, S_W8);
}
__device__ __forceinline__ void tr_gu8(const float* W, int K, int N, unsigned char* WT, long row_off, int up, LAS float* scr, int item, int lane) {
    const int nblk = N / 32, kb = item / nblk, nb = item % nblk, n0 = 32 * nb;
    transpose_item8(W, N, K, WT, 128 * kb, n0, row_off + (long)(n0 >> 7) * 256 + (n0 & 127) + up * 128, scr, lane, S_W8);
}
__device__ __forceinline__ void tr_plain(const float* W, int K, int N, bf16_t* WT, long row_off, LAS float* scr, int item, int lane) {
    const int nblk = N / 32, kb = item / nblk, nb = item % nblk;
    transpose_item(W, N, K, WT, 64 * kb, 32 * nb, row_off + 32 * nb, scr, lane);
}
__device__ __forceinline__ void tr_gu(const float* W, int K, int N, bf16_t* WT, long row_off, int up, LAS float* scr, int item, int lane) {
    const int nblk = N / 32, kb = item / nblk, nb = item % nblk, n0 = 32 * nb;
    transpose_item(W, N, K, WT, 64 * kb, n0, row_off + (long)(n0 >> 7) * 256 + (n0 & 127) + up * 128, scr, lane);
}

template <bool OUT8 = false>
__device__ __forceinline__ void mod_row(const float* xrow, const float* g, const float* sh, const float* sc, bf16_t* orow, int lane, f32x4 (&v)[8], const float* xs = nullptr, size_t xs_stride = 0, int nxs = 0, float* xout = nullptr) {
    const f32x4* xr = (const f32x4*)xrow + lane;
    float s = 0.f;
#pragma unroll
    for (int j = 0; j < 8; ++j) { v[j] = xr[64 * j];
        if (xs) {
#pragma unroll
            for (int p = 0; p < 8; ++p) if (p < nxs) v[j] += ((const f32x4*)(xs + p * xs_stride))[64 * j + lane];
            if (xout) ((f32x4*)xout)[64 * j + lane] = v[j]; }
        s += (v[j].x * v[j].x + v[j].y * v[j].y) + (v[j].z * v[j].z + v[j].w * v[j].w); }
    const float rstd = 1.0f / sqrtf(wave_sum(s) * (1.0f / DM) + EPS);
    u32x2* o8 = (u32x2*)orow + lane;
#pragma unroll
    for (int j = 0; j < 8; ++j) { const f32x4 gg = ((const f32x4*)g)[64 * j + lane], ss = ((const f32x4*)sc)[64 * j + lane], hh = ((const f32x4*)sh)[64 * j + lane];
        v[j] = v[j] * rstd * gg * (ss + 1.0f) + hh;
        if constexpr (OUT8) ((unsigned*)orow)[64 * j + lane] = pk4_fp8(v[j].x * S_H8, v[j].y * S_H8, v[j].z * S_H8, v[j].w * S_H8);
        else { u32x2 w; w.x = cvt_pk_bf16(v[j].x, v[j].y); w.y = cvt_pk_bf16(v[j].z, v[j].w); o8[64 * j] = w; } }
}
__device__ __forceinline__ const float* in_row(const float* x, const float* ctx, int row) {
    const int b = row / RPB, t = row % RPB;
    return t < SEQ ? x + ((size_t)b * SEQ + t) * DM : ctx + ((size_t)b * NCTX + (t - SEQ)) * DM;
}

__device__ __forceinline__ void rope8(float (&f)[8], const float* cs, const float* sn) {
    const f32x4 c = *(const f32x4*)cs, s = *(const f32x4*)sn;
#pragma unroll
    for (int p = 0; p < 4; ++p) { const float x0 = f[2 * p], x1 = f[2 * p + 1]; f[2 * p] = x0 * c[p] - x1 * s[p]; f[2 * p + 1] = x0 * s[p] + x1 * c[p]; }
}
__device__ __forceinline__ void unpack8(const u32x4 w, float (&f)[8]) { f[0] = bf_lo(w.x); f[1] = bf_hi(w.x); f[2] = bf_lo(w.y); f[3] = bf_hi(w.y); f[4] = bf_lo(w.z); f[5] = bf_hi(w.z); f[6] = bf_lo(w.w); f[7] = bf_hi(w.w); }
__device__ __forceinline__ u32x4 pack8(const float (&f)[8]) { u32x4 w; w.x = cvt_pk_bf16(f[0], f[1]); w.y = cvt_pk_bf16(f[2], f[3]); w.z = cvt_pk_bf16(f[4], f[5]); w.w = cvt_pk_bf16(f[6], f[7]); return w; }
template <bool NORM, int ROPE_DIM>
__device__ __forceinline__ void fix_span(bf16_t* rowp, int col0, int nvec, const float* g, const float* cosT, const float* sinT, int lane) {
    for (int v = lane; v < nvec; v += 64) {
        const int e0 = v * 8;
        u32x4 w = *(u32x4*)(rowp + col0 + e0); float f[8]; unpack8(w, f);
        if constexpr (NORM) {
            float s = 0.f;
#pragma unroll
            for (int i = 0; i < 8; ++i) s += f[i] * f[i];
            s += __shfl_xor(s, 1); s += __shfl_xor(s, 2); s += __shfl_xor(s, 4); s += __shfl_xor(s, 8);
            const float rstd = 1.0f / sqrtf(s * (1.0f / 128.0f) + EPS);
            const f32x4 g0 = *(const f32x4*)(g + (e0 & 127)), g1 = *(const f32x4*)(g + (e0 & 127) + 4);
#pragma unroll
            for (int i = 0; i < 4; ++i) { f[i] = f[i] * rstd * g0[i]; f[4 + i] = f[4 + i] * rstd * g1[i]; }
        }
        if constexpr (ROPE_DIM == 64) { const int p0 = (e0 & 63) >> 1; rope8(f, cosT + p0, sinT + p0); }
        if constexpr (ROPE_DIM == 128) { const int p0 = (e0 & 127) >> 1; rope8(f, cosT + p0, sinT + p0); }
        *(u32x4*)(rowp + col0 + e0) = pack8(f);
    }
}

__global__ void __launch_bounds__(512, 2) hybrid_fwd(Args args) {
    extern __shared__ __attribute__((aligned(16))) unsigned char lds[];
    Frame F;
    F.lds = (LAS unsigned char*)lds;
    F.G = gridDim.x; { const int bx = blockIdx.x; F.vcu = (F.G % 8 == 0) ? (bx % 8) * (F.G / 8) + bx / 8 : bx; }
    volatile LAS unsigned* MISC = (volatile LAS unsigned*)(F.lds + MISC_OFF);
    unsigned char* ws = args.ws;
    gu32* ctl = (gu32*)(ws + WS_CTL);
    for (int u = threadIdx.x; u < 64; u += 512) MISC[u] = 0u;
    __syncthreads();
    XcdBarrier bar; bar.bar = (unsigned*)(ctl + CW_BAR); bar.x = 0; bar.st = nullptr;
#if !MK_PER_PHASE
    bar = xcd_barrier_post((unsigned*)(ctl + CW_BAR), MISC + 8);
#define GRID_BAR() xcd_barrier(bar)
#else
#define GRID_BAR() do { } while (0)
#endif
    const int lo = args.ph_lo, hi = args.ph_hi;
#ifndef PH_MASK
#define PH_MASK 0xFFFFFu
#endif
#define IN(k) ((((PH_MASK) >> (k)) & 1u) && lo <= (k) && (k) < hi)
#ifndef DBL_MASK
#define DBL_MASK 0u
#endif
#define NREP(k) ((((DBL_MASK) >> (k)) & 1u) ? 2 : 1)
#define SEAM(k) do { if (IN(k) && IN((k) + 1)) GRID_BAR(); } while (0)

#define MODS ((float*)(ws + WS_MODS))
#define ADAP ((float*)(ws + WS_ADAP))
#define cosA ((float*)(ws + WS_ROPE))
#define sinA (cosA + 4096 * 32)
#define cosB (cosA + 2 * 4096 * 32)
#define sinB (cosA + 2 * 4096 * 32 + 4096 * 64)
#define ROUTE ((int*)(ws + WS_ROUTE))
#define GATES ((float*)(ws + WS_GATES))
#define SLOT ((int*)(ws + WS_SLOT))
#define CNT ((int*)(ws + WS_CNT))
#define TILEE ((int*)(ws + WS_TILEE))
#define W_IN0 ((bf16_t*)(ws + WS_WIN0))
#define W_OUT0 ((bf16_t*)(ws + WS_WOUT0))
#define W_GU0 ((bf16_t*)(ws + WS_WGU0))
#define W_DN0 ((bf16_t*)(ws + WS_WDN0))
#define W_IN1 ((bf16_t*)(ws + WS_WIN1))
#define W_OUT1 ((bf16_t*)(ws + WS_WOUT1))
#define W_GU1 ((bf16_t*)(ws + WS_WGU1))
#define W_DN1 ((bf16_t*)(ws + WS_WDN1))
#define XR ((float*)(ws + WS_XR))
#define H ((bf16_t*)(ws + WS_H))
#define AO ((bf16_t*)(ws + WS_AO))
#define Y ((bf16_t*)(ws + WS_Y))
#define QKV ((bf16_t*)(ws + WS_QKV))
#define XG ((bf16_t*)(ws + WS_XG))
#define MID ((bf16_t*)(ws + WS_MID))
#define MODS1 (MODS + 5 * 12288)
#define SLAB0 ((float*)(ws + WS_SLAB0))
#define SLAB1 ((float*)(ws + WS_SLAB1))
#define SLABW ((float*)(ws + WS_SLABW))
#define x_in (args.in[0])
#define c_in (args.in[1])
#define ctx_in (args.in[2])
#define cctx_in (args.in[3])
    const int NGW = F.G * 8;
#define PH_LOCALS const int tid = fresh_tid(), lane = tid & 63, wave = __builtin_amdgcn_readfirstlane(tid >> 6), gw = F.vcu * 8 + wave; (void)tid; (void)lane; (void)wave; (void)gw

    if (IN(0)) for (int rep_ = 0; rep_ < NREP(0); ++rep_) {
        PH_LOCALS;
        LAS float* scr = (LAS float*)(F.lds + wave * 16384);
        LAS float* sil = (LAS float*)(F.lds + 98304);
        __syncthreads();
        for (int i = tid; i < 5 * DM; i += 512) { const float v = (i < 4 * DM) ? c_in[i] : cctx_in[i - 4 * DM]; sil[i] = v / (1.0f + __expf(-v)); }
        __syncthreads();
        for (int it = gw; it < 2 * 48 * 32; it += NGW) {
            const int l = it / (48 * 32), r = it % (48 * 32), cg = r / 32, kc = r % 32;
            const float* W = args.in[l ? 22 : 6] + (size_t)(kc * 64) * 12288 + cg * 256 + lane * 4;
            f32x4 a[5];
#pragma unroll
            for (int b = 0; b < 5; ++b) a[b] = (f32x4){0.f, 0.f, 0.f, 0.f};
#pragma unroll 8
            for (int k = 0; k < 64; ++k) { const f32x4 w = *(const f32x4*)(W + (size_t)k * 12288);
#pragma unroll
                for (int b = 0; b < 5; ++b) a[b] += w * sil[b * DM + kc * 64 + k]; }
#pragma unroll
            for (int b = 0; b < 5; ++b) *(f32x4*)(ADAP + ((size_t)(l * 32 + kc) * 5 + b) * 12288 + cg * 256 + lane * 4) = a[b];
        }
        __syncthreads();
        {
            constexpr int I_IN = (DM / 64) * (PROJ / 32), I_OUT = (DM / 64) * (DM / 32);
            constexpr int I_GU = (FFN0_FP8 == 2) ? (DM / 128) * (DFF / 32) : (DM / 64) * (DFF / 32), I_DN = (FFN0_FP8 >= 1) ? (DFF / 128) * (DM / 32) : (DFF / 64) * (DM / 32);
            constexpr int I_EGU = (DM / 128) * (DEX / 32), I_EDN = (DEX / 128) * (DM / 32);
            constexpr int I_IN8 = (DM / 128) * (PROJ / 32), I_OUT8 = (DM / 128) * (DM / 32);
            constexpr int NIT = I_IN + (L1ATT_FP8 ? I_IN8 : I_IN) + I_OUT + (L1ATT_FP8 ? I_OUT8 : I_OUT) + 2 * I_GU + I_DN;
            for (int it = gw; it < NIT; it += NGW) {
                int r = it;
                if (r < I_IN) { tr_plain(args.in[8], DM, PROJ, W_IN0, 0, scr, r, lane); continue; } r -= I_IN;
#if L1ATT_FP8
                if (r < I_IN8) { tr_plain8(args.in[24], DM, PROJ, (unsigned char*)W_IN1, 0, scr, r, lane); continue; } r -= I_IN8;
#else
                if (r < I_IN) { tr_plain(args.in[24], DM, PROJ, W_IN1, 0, scr, r, lane); continue; } r -= I_IN;
#endif
                if (r < I_OUT) { tr_plain(args.in[9], DM, DM, W_OUT0, 0, scr, r, lane); continue; } r -= I_OUT;
#if L1ATT_FP8
                if (r < I_OUT8) { tr_plain8(args.in[25], DM, DM, (unsigned char*)W_OUT1, 0, scr, r, lane); continue; } r -= I_OUT8;
#else
                if (r < I_OUT) { tr_plain(args.in[25], DM, DM, W_OUT1, 0, scr, r, lane); continue; } r -= I_OUT;
#endif
#if FFN0_FP8 == 2
                if (r < I_GU) { tr_gu8(args.in[17], DM, DFF, (unsigned char*)W_GU0, 0, 0, scr, r, lane); continue; } r -= I_GU;
                if (r < I_GU) { tr_gu8(args.in[18], DM, DFF, (unsigned char*)W_GU0, 0, 1, scr, r, lane); continue; } r -= I_GU;
#else
                if (r < I_GU) { tr_gu(args.in[17], DM, DFF, W_GU0, 0, 0, scr, r, lane); continue; } r -= I_GU;
                if (r < I_GU) { tr_gu(args.in[18], DM, DFF, W_GU0, 0, 1, scr, r, lane); continue; } r -= I_GU;
#endif
#if FFN0_FP8 >= 1
                if (r < I_DN) { tr_plain8(args.in[19], DFF, DM, (unsigned char*)W_DN0, 0, scr, r, lane); continue; } r -= I_DN;
#else
                if (r < I_DN) { tr_plain(args.in[19], DFF, DM, W_DN0, 0, scr, r, lane); continue; } r -= I_DN;
#endif
            }
            constexpr int NITX = NE * (2 * I_EGU + I_EDN);
            const float* wp; int ldw; unsigned char* wt; int Kb;
#define XDECODE(IT, WP, LDW, WT, KB) do { int r_ = (IT); const int e_ = r_ / (2 * I_EGU + I_EDN); r_ -= e_ * (2 * I_EGU + I_EDN); \
                if (r_ < 2 * I_EGU) { const int up_ = r_ >= I_EGU; r_ -= up_ * I_EGU; const int nblk_ = DEX / 32, kb_ = r_ / nblk_, n0_ = 32 * (r_ % nblk_); \
                    WP = args.in[29 + up_] + (size_t)e_ * DM * DEX + (size_t)(128 * kb_ + (lane >> 5)) * DEX + n0_ + (lane & 31); LDW = DEX; KB = DM; \
                    WT = (unsigned char*)W_GU1 + ((size_t)e_ * 2 * DEX + (size_t)(n0_ >> 7) * 256 + (n0_ & 127) + up_ * 128) * DM + 128 * kb_; } \
                else { r_ -= 2 * I_EGU; const int nblk_ = DM / 32, kb_ = r_ / nblk_, n0_ = 32 * (r_ % nblk_); \
                    WP = args.in[31] + (size_t)e_ * DEX * DM + (size_t)(128 * kb_ + (lane >> 5)) * DM + n0_ + (lane & 31); LDW = DM; KB = DEX; \
                    WT = (unsigned char*)W_DN1 + ((size_t)e_ * DM + n0_) * DEX + 128 * kb_; } } while (0)
#define XLOAD(T, WP, LDW, HB) do { _Pragma("unroll") for (int i_ = 0; i_ < 32; ++i_) T[i_] = (WP)[(size_t)(64 * (HB) + 2 * i_) * (LDW)]; } while (0)
#define XWRITE(T, HB) do { _Pragma("unroll") for (int i_ = 0; i_ < 32; ++i_) { const int kk_ = 64 * (HB) + 2 * i_ + (lane >> 5); scr[kk_ * 32 + (((lane & 31) + 8 * (kk_ >> 4)) & 31)] = T[i_]; } } while (0)
            float ta[32], tb[32];
            int itx = gw;
            if (itx < NITX) { XDECODE(itx, wp, ldw, wt, Kb); XLOAD(ta, wp, ldw, 0); }
            while (itx < NITX) {
                XLOAD(tb, wp, ldw, 1);
                XWRITE(ta, 0);
                unsigned char* wt_c = wt; const int Kb_c = Kb;
                const int nxt = itx + NGW;
                if (nxt < NITX) { XDECODE(nxt, wp, ldw, wt, Kb); XLOAD(ta, wp, ldw, 0); }
                XWRITE(tb, 1);
                LDS_WAIT(); asm volatile("" ::: "memory");
                { const int c = lane & 7;
#pragma unroll
                  for (int j = 0; j < 4; ++j) { const int n = (lane >> 3) + 8 * j; const LAS float* sp = scr + (16 * c) * 32 + ((n + 8 * c) & 31);
                      u32x4 o;
                      o.x = pk4_fp8(sp[0 * 32] * S_W8, sp[1 * 32] * S_W8, sp[2 * 32] * S_W8, sp[3 * 32] * S_W8); o.y = pk4_fp8(sp[4 * 32] * S_W8, sp[5 * 32] * S_W8, sp[6 * 32] * S_W8, sp[7 * 32] * S_W8);
                      o.z = pk4_fp8(sp[8 * 32] * S_W8, sp[9 * 32] * S_W8, sp[10 * 32] * S_W8, sp[11 * 32] * S_W8); o.w = pk4_fp8(sp[12 * 32] * S_W8, sp[13 * 32] * S_W8, sp[14 * 32] * S_W8, sp[15 * 32] * S_W8);
                      *(GAS u32x4*)(wt_c + (size_t)n * Kb_c + 16 * c) = o; } }
                LDS_WAIT(); asm volatile("" ::: "memory");
                itx = nxt;
            }
#undef XDECODE
#undef XLOAD
#undef XWRITE
        }
    }
    SEAM(0);
    if (IN(1)) for (int rep_ = 0; rep_ < NREP(1); ++rep_) {
        PH_LOCALS;
        for (int i = blockIdx.x * 512 + tid; i < 2 * 5 * 12288; i += F.G * 512) {
            const int l = i / (5 * 12288), r = i % (5 * 12288), b = r / 12288, j = r % 12288;
            float s = args.in[l ? 23 : 7][j];
            for (int kc = 0; kc < 32; ++kc) s += ADAP[((size_t)(l * 32 + kc) * 5 + b) * 12288 + j];
            MODS[i] = s;
        }
        if (blockIdx.x == 0 && wave == 0) {
            const float a = wave_sum(args.in[10][lane] * args.in[11][lane]), b = wave_sum(args.in[12][lane] * args.in[13][lane]);
            if (lane == 0) MODS[2 * 5 * 12288] = expf(a) - expf(b) + LAMBDA_INIT;
        }
    }
    SEAM(1);
    if (IN(2)) for (int rep_ = 0; rep_ < NREP(2); ++rep_) {
        PH_LOCALS;
        for (int row = gw; row < MROWS; row += NGW) {
            const int b = row / RPB, t = row % RPB; const float* md = MODS + (size_t)(t < SEQ ? b : 4) * 12288;
            f32x4 v[8]; mod_row(in_row(x_in, ctx_in, row), args.in[4], md + 0 * DM, md + 1 * DM, H + (size_t)row * DM, lane, v);
        }
    }
    SEAM(2);
    if (IN(3)) for (int rep_ = 0; rep_ < NREP(3); ++rep_) {
        PH_LOCALS;
        pg8::Gemm g{H, W_IN0, DM}; pg8::Order<pg8::MapId> S; S.init(MROWS / 256, PROJ / 256, F.G, (int)blockIdx.x, pg8::MapId{}, DM / 64);
        { LAS float* gl = (LAS float*)(F.lds + RING_BYTES) + 2048; if (tid < 256) gl[tid] = tid < 128 ? args.in[15][tid] : args.in[16][tid - 128]; __syncthreads(); }
        pg8::EpiQKV<0> E{QKV, cosA, sinA, cosB, sinB, args.in[15], args.in[16], (LAS float*)(F.lds + RING_BYTES), 1.0f};
        pg8::gemm_phase(F.lds, g, S, E);
    }
    SEAM(3);
    if (IN(5)) for (int rep_ = 0; rep_ < NREP(5); ++rep_) {
        PH_LOCALS;
        const float lam = MODS[2 * 5 * 12288];
        for (int k = F.vcu; k < 256; k += F.G) {
            for (int i = 0; i < 3; ++i) {
                int b, h, qt;
                if (i < 2) { const int u = 2 * k + i; b = u >> 7; h = (u >> 4) & 7; qt = u & 15; } else { if (k >= 32) break; b = k >> 3; h = k & 7; qt = 16; }
                const size_t rb = (size_t)b * RPB;
                const att::TileMap tm = (qt < 16) ? att::TileMap{0, 0, 0, 68} : att::TileMap{0, 0, SEQ, 4};
#ifndef NO_DIFF
                att::unit_diff(QKV + (rb + qt * 256) * PROJ + h * 128, QKV + rb * PROJ + 2048 + h * 128, QKV + rb * PROJ + 3072 + h * 128, tm, lam, args.in[14],
                               AO + (rb + qt * 256) * DM + h * 128, (char*)lds);
#endif
            }
            for (int i = 0; i < 3; ++i) {
                int b, h, qt;
                if (i < 2) { const int u = 2 * k + i; b = u >> 7; h = (u >> 4) & 7; qt = u & 15; } else { if (k < 32 || k >= 64) break; b = (k - 32) >> 3; h = k & 7; qt = 16; }
                const size_t rb = (size_t)b * RPB; const int kv = h >> 2;
                const att::TileMap tm = (qt < 16) ? att::TileMap{0, 0, 0, 68} : att::TileMap{0, 0, SEQ, 4};
#ifndef NO_STD0
                att::unit_std<0>(QKV + (rb + qt * 256) * PROJ + 1024 + h * 128, QKV + rb * PROJ + 4096 + kv * 128, QKV + rb * PROJ + 4352 + kv * 128, tm, att::MaskInfo{0, 0, 0}, 0.f,
                                 AO + (rb + qt * 256) * DM + 1024 + h * 128, (char*)lds);
#endif
            }
        }
    }
    SEAM(5);
    if (IN(6)) for (int rep_ = 0; rep_ < NREP(6); ++rep_) {
        PH_LOCALS;
        pg8::Gemm g{AO, W_OUT0, DM}; pg8::Order<pg8::MapL0Split> S; S.init(NTOK / 256, DM / 256, F.G, (int)blockIdx.x, pg8::MapL0Split{}, DM / 64, 4, 8);
        pg8::EpiResid E{x_in, ctx_in, XR, MODS, 2, 1, SLABW, 1.0f};
        pg8::gemm_phase<pg8::EpiResid, pg8::Order<pg8::MapL0Split>>(F.lds, g, S, E);
    }
    SEAM(6);
    if (IN(7)) for (int rep_ = 0; rep_ < NREP(7); ++rep_) {
        PH_LOCALS;
        for (int row = gw; row < MROWS; row += NGW) {
            const int b = row / RPB, t = row % RPB; const float* md = MODS + (size_t)(t < SEQ ? b : 4) * 12288;
#if FFN0_FP8 == 2
            f32x4 v[8]; mod_row<true>(t < SEQ ? XR + (size_t)row * DM : in_row(x_in, ctx_in, row), args.in[5], md + 3 * DM, md + 4 * DM, (bf16_t*)((unsigned char*)H + (size_t)row * DM), lane, v,
                                      t < SEQ ? nullptr : SLABW + ((size_t)b * NCTX + (t - SEQ)) * DM, (size_t)NB * NCTX * DM, 8, XR + (size_t)row * DM);
#else
            f32x4 v[8]; mod_row(t < SEQ ? XR + (size_t)row * DM : in_row(x_in, ctx_in, row), args.in[5], md + 3 * DM, md + 4 * DM, H + (size_t)row * DM, lane, v,
                                t < SEQ ? nullptr : SLABW + ((size_t)b * NCTX + (t - SEQ)) * DM, (size_t)NB * NCTX * DM, 8, XR + (size_t)row * DM);
#endif
        }
    }
    SEAM(7);
    if (IN(8)) for (int rep_ = 0; rep_ < NREP(8); ++rep_) {
        PH_LOCALS;
#if FFN0_FP8 == 2
        pg8::Gemm g{H, W_GU0, DM / 2}; pg8::Order<pg8::MapId> S; S.init(MROWS / 256, 2 * DFF / 256, F.G, (int)blockIdx.x, pg8::MapId{}, DM / 128);
        pg8::EpiSwiGLU8 E{(unsigned char*)MID, DFF, 2 * DFF / 256, 1.0f / (S_H8 * S_W8), S_M8 / (S_H8 * S_W8)};
        pg8::gemm_phase<pg8::EpiSwiGLU8, pg8::Order<pg8::MapId>, true>(F.lds, g, S, E);
#elif FFN0_FP8 == 1
        pg8::Gemm g{H, W_GU0, DM}; pg8::Order<pg8::MapId> S; S.init(MROWS / 256, 2 * DFF / 256, F.G, (int)blockIdx.x, pg8::MapId{}, DM / 64);
        pg8::EpiSwiGLU8 E{(unsigned char*)MID, DFF, 2 * DFF / 256, 1.0f, S_M8};
        pg8::gemm_phase(F.lds, g, S, E);
#else
        pg8::Gemm g{H, W_GU0, DM}; pg8::Order<pg8::MapId> S; S.init(MROWS / 256, 2 * DFF / 256, F.G, (int)blockIdx.x, pg8::MapId{}, DM / 64);
        pg8::EpiSwiGLU E{MID, DFF, 2 * DFF / 256};
        pg8::gemm_phase(F.lds, g, S, E);
#endif
    }
    SEAM(8);
    if (IN(9)) for (int rep_ = 0; rep_ < NREP(9); ++rep_) {
        PH_LOCALS;
#if FFN0_FP8 >= 1
        pg8::Gemm g{MID, W_DN0, DFF / 2}; pg8::Order<pg8::MapL0Split> S; S.init(NTOK / 256, DM / 256, F.G, (int)blockIdx.x, pg8::MapL0Split{}, DFF / 128, 4, NS0);
        pg8::EpiResid E{x_in, ctx_in, XR, MODS, 5, 0, SLAB0, 1.0f / (S_M8 * S_W8)};
        pg8::gemm_phase<pg8::EpiResid, pg8::Order<pg8::MapL0Split>, true>(F.lds, g, S, E);
#else
        pg8::Gemm g{MID, W_DN0, DFF}; pg8::Order<pg8::MapL0Split> S; S.init(NTOK / 256, DM / 256, F.G, (int)blockIdx.x, pg8::MapL0Split{}, DFF / 64, 4, NS0);
        pg8::EpiResid E{x_in, ctx_in, XR, MODS, 5, 0, SLAB0, 1.0f};
        pg8::gemm_phase(F.lds, g, S, E);
#endif
    }
    SEAM(9);
    if (IN(10)) for (int rep_ = 0; rep_ < NREP(10); ++rep_) {
        PH_LOCALS;
        for (int row = gw; row < MROWS; row += NGW) {
            const int b = row / RPB, t = row % RPB; const float* md = MODS1 + (size_t)(t < SEQ ? b : 4) * 12288;
#if L1ATT_FP8
            f32x4 v[8]; mod_row<true>(XR + (size_t)row * DM, args.in[20], md + 0 * DM, md + 1 * DM, (bf16_t*)((unsigned char*)H + (size_t)row * DM), lane, v, t < SEQ ? nullptr : SLAB0 + ((size_t)b * NCTX + (t - SEQ)) * DM, (size_t)NB * NCTX * DM, NS0);
#else
            f32x4 v[8]; mod_row(XR + (size_t)row * DM, args.in[20], md + 0 * DM, md + 1 * DM, H + (size_t)row * DM, lane, v, t < SEQ ? nullptr : SLAB0 + ((size_t)b * NCTX + (t - SEQ)) * DM, (size_t)NB * NCTX * DM, NS0);
#endif
        }
    }
    SEAM(10);
    if (IN(11)) for (int rep_ = 0; rep_ < NREP(11); ++rep_) {
        PH_LOCALS;
        pg8::Gemm g{H, W_IN1, L1ATT_FP8 ? DM / 2 : DM}; pg8::Order<pg8::MapId> S; S.init(MROWS / 256, PROJ / 256, F.G, (int)blockIdx.x, pg8::MapId{}, L1ATT_FP8 ? DM / 128 : DM / 64);
#if L1ATT_FP8
        pg8::EpiQKV<1> E{QKV, cosA, sinA, cosB, sinB, nullptr, nullptr, (LAS float*)(F.lds + RING_BYTES), 1.0f / (S_H8 * S_W8)};
        pg8::gemm_phase<pg8::EpiQKV<1>, pg8::Order<pg8::MapId>, true>(F.lds, g, S, E);
#else
        pg8::EpiQKV<1> E{QKV, cosA, sinA, cosB, sinB, nullptr, nullptr, (LAS float*)(F.lds + RING_BYTES), 1.0f};
        pg8::gemm_phase(F.lds, g, S, E);
#endif
    }
    SEAM(11);
    if (IN(13)) for (int rep_ = 0; rep_ < NREP(13); ++rep_) {
        PH_LOCALS;
        float* btab = (float*)(lds + att::OFF_BIAS);
        for (int k = F.vcu; k < 256; k += F.G) {
            for (int i = 0; i < 2; ++i) {
                const int u = 2 * k + i, b = u >> 7, h = (u >> 4) & 7, qt = u & 15, kv = h >> 2; const size_t rb = (size_t)b * RPB;
                const int q0 = qt * 256, ks = (q0 - 128) < 0 ? 0 : (q0 - 128), ke = (q0 + 384) > SEQ ? SEQ : (q0 + 384);
                const att::TileMap tm{4, SEQ, ks, 4 + (ke - ks) / 64};
#ifndef NO_WIN
                att::unit_std<1>(QKV + (rb + q0) * PROJ + h * 128, QKV + rb * PROJ + 2048 + kv * 128, QKV + rb * PROJ + 2304 + kv * 128, tm, att::MaskInfo{q0, 0, 0}, args.in[26][h],
                                 L1ATT_FP8 ? (bf16_t*)((unsigned char*)AO + (rb + q0) * DM + h * 128) : AO + (rb + q0) * DM + h * 128, (char*)lds);
#endif
            }
            for (int i = 0; i < 2; ++i) {
                const int u = 2 * k + i, b = u >> 7, h = (u >> 4) & 7, qt = u & 15; const size_t rb = (size_t)b * RPB;
                const int r0 = qt * 4; int lo_ = r0 - 4; lo_ = lo_ < 0 ? 0 : (lo_ > 52 ? 52 : lo_);
                for (int j = tid; j < 15 * 31; j += 512) btab[j] = args.in[27][h * 465 + j] * ((PRESCALE && L1PRE && ATT_DMA) ? LOG2E : (1.0f / ATT_SCALE));
                __syncthreads();
                const att::TileMap tm{4, SEQ, lo_ * 64, 16};
#ifndef NO_NA
                att::unit_std<2>(QKV + (rb + qt * 256) * PROJ + 1024 + h * 128, QKV + rb * PROJ + 2560 + h * 128, QKV + rb * PROJ + 3584 + h * 128, tm, att::MaskInfo{0, r0, lo_}, 0.f,
                                 L1ATT_FP8 ? (bf16_t*)((unsigned char*)AO + (rb + qt * 256) * DM + 1024 + h * 128) : AO + (rb + qt * 256) * DM + 1024 + h * 128, (char*)lds);
#endif
            }
        }
    }
    SEAM(13);
    if (IN(14)) for (int rep_ = 0; rep_ < NREP(14); ++rep_) {
        PH_LOCALS;
#if L1ATT_FP8
        pg8::Gemm g{AO, W_OUT1, DM / 2}; pg8::Order<pg8::MapLatent> S; S.init(NTOK / 256, DM / 256, F.G, (int)blockIdx.x, pg8::MapLatent{}, DM / 128);
        pg8::EpiResid E{x_in, ctx_in, XR, MODS1, 2, 0, nullptr, 1.0f / (S_A8 * S_W8)};
        pg8::gemm_phase<pg8::EpiResid, pg8::Order<pg8::MapLatent>, true>(F.lds, g, S, E);
#else
        pg8::Gemm g{AO, W_OUT1, DM}; pg8::Order<pg8::MapLatent> S; S.init(NTOK / 256, DM / 256, F.G, (int)blockIdx.x, pg8::MapLatent{}, DM / 64);
        pg8::EpiResid E{x_in, ctx_in, XR, MODS1, 2, 0, nullptr, 1.0f};
        pg8::gemm_phase(F.lds, g, S, E);
#endif
    }
    SEAM(14);
    if (IN(15)) for (int rep_ = 0; rep_ < NREP(15); ++rep_) {
        PH_LOCALS;
        LAS float* wt = (LAS float*)F.lds;
        LAS int* ce = (LAS int*)(F.lds + 65536);
        for (int i = tid; i < DM * NE; i += 512) { const int kk = i >> 3, e = i & 7; wt[e * DM + kk] = args.in[28][i]; }
        __syncthreads();
        for (int chunk = blockIdx.x; chunk < NTOK / 64; chunk += F.G) {
            for (int i = 0; i < 8; ++i) {
                const int tl = wave * 8 + i, n = chunk * 64 + tl, b = n >> 12, t = n & 4095, row = b * RPB + t;
                const float* md = MODS1 + (size_t)b * 12288;
                f32x4 v[8]; mod_row<true>(XR + (size_t)row * DM, args.in[21], md + 3 * DM, md + 4 * DM, (bf16_t*)((unsigned char*)H + (size_t)row * DM), lane, v);
                float lg[8];
#pragma unroll
                for (int e = 0; e < 8; ++e) { float s = 0.f;
#pragma unroll
                    for (int j = 0; j < 8; ++j) { const f32x4 w = *(const LAS f32x4*)(wt + e * DM + 256 * j + 4 * lane); s += (v[j].x * w.x + v[j].y * w.y) + (v[j].z * w.z + v[j].w * w.w); }
                    lg[e] = wave_sum(s); }
                int e0 = 0; float l0 = lg[0];
#pragma unroll
                for (int e = 1; e < 8; ++e) if (lg[e] > l0) { l0 = lg[e]; e0 = e; }
                int e1 = -1; float l1 = -3.4e38f;
#pragma unroll
                for (int e = 0; e < 8; ++e) if (e != e0 && lg[e] > l1) { l1 = lg[e]; e1 = e; }
                if (lane == 0) { ce[tl * 2] = e0; ce[tl * 2 + 1] = e1; const float g1 = 1.0f / (1.0f + expf(l0 - l1)); GATES[n * 2] = 1.0f - g1; GATES[n * 2 + 1] = g1; }
            }
            __syncthreads();
            if (wave == 0) {
                const int e0 = ce[lane * 2], e1 = ce[lane * 2 + 1]; int rk0 = 0, rk1 = 0;
                const unsigned long long below = (1ull << lane) - 1ull;
#pragma unroll
                for (int e = 0; e < 8; ++e) {
                    const unsigned long long m0 = __ballot(e0 == e), m1 = __ballot(e1 == e);
                    const int c0 = __popcll(m0);
                    if (e0 == e) rk0 = __popcll(m0 & below);
                    if (e1 == e) rk1 = c0 + __popcll(m1 & below);
                    if (lane == 0) CNT[chunk * 8 + e] = c0 + __popcll(m1);
                }
                const int n = chunk * 64 + lane;
                ROUTE[n * 4 + 0] = e0; ROUTE[n * 4 + 1] = e1; ROUTE[n * 4 + 2] = rk0; ROUTE[n * 4 + 3] = rk1;
            }
            __syncthreads();
        }
    }
    SEAM(15);
    if (IN(16)) for (int rep_ = 0; rep_ < NREP(16); ++rep_) {
        PH_LOCALS;
        LAS int* tot = (LAS int*)F.lds; LAS int* pre = tot + 8; LAS int* base = tot + 16;
        for (int chunk = blockIdx.x; chunk < NTOK / 64; chunk += F.G) {
            { const int e = wave; int a = 0, p = 0;
#pragma unroll
              for (int i = 0; i < 4; ++i) { const int c = 4 * lane + i; const int v = CNT[c * 8 + e]; a += v; p += (c < chunk) ? v : 0; }
              a = (int)wave_sum((float)a); p = (int)wave_sum((float)p);
              if (lane == 0) { tot[e] = a; pre[e] = p; } }
            __syncthreads();
            if (tid == 0) { int s = 0; for (int e = 0; e < 8; ++e) { base[e] = s; s += (tot[e] + 255) / 256 * 256; } base[8] = s; }
            __syncthreads();
            if (chunk == 0 && tid < CAP_TILES + 1) {
                const int ntile = base[8] / 256;
                if (tid == CAP_TILES) TILEE[CAP_TILES] = ntile;
                else { int e = 0; for (int q = 1; q < 8; ++q) if (tid * 256 >= base[q]) e = q; TILEE[tid] = e; }
            }
            for (int i = 0; i < 8; ++i) {
                const int tl = wave * 8 + i, n = chunk * 64 + tl, b = n >> 12, t = n & 4095, row = b * RPB + t;
                const int e0 = ROUTE[n * 4 + 0], e1 = ROUTE[n * 4 + 1], rk0 = ROUTE[n * 4 + 2], rk1 = ROUTE[n * 4 + 3];
                const int s0 = base[e0] + pre[e0] + rk0, s1 = base[e1] + pre[e1] + rk1;
                if (lane == 0) { SLOT[n * 2] = s0; SLOT[n * 2 + 1] = s1; }
                const u32x4* src = (const u32x4*)((const unsigned char*)H + (size_t)row * DM) + lane;
                u32x4* d0 = (u32x4*)((unsigned char*)XG + (size_t)s0 * DM) + lane; u32x4* d1 = (u32x4*)((unsigned char*)XG + (size_t)s1 * DM) + lane;
#pragma unroll
                for (int j = 0; j < 2; ++j) { const u32x4 w = src[64 * j]; d0[64 * j] = w; d1[64 * j] = w; }
            }
            __syncthreads();
        }
    }
    SEAM(16);
    if (IN(17)) for (int rep_ = 0; rep_ < NREP(17); ++rep_) {
        PH_LOCALS;
        const int ntile = TILEE[CAP_TILES];
        pg8::Gemm g{XG, W_GU1, DM / 2}; pg8::Order<pg8::MapMoe> S; S.init(ntile, 2 * DEX / 256, F.G, (int)blockIdx.x, pg8::MapMoe{TILEE, 2 * DEX / 256}, DM / 128);
        pg8::EpiSwiGLU8 E{(unsigned char*)MID, DEX, 2 * DEX / 256, 1.0f / (S_H8 * S_W8), S_M8 / (S_H8 * S_W8)};
        pg8::gemm_phase<pg8::EpiSwiGLU8, pg8::Order<pg8::MapMoe>, true>(F.lds, g, S, E);
    }
    SEAM(17);
    if (IN(18)) for (int rep_ = 0; rep_ < NREP(18); ++rep_) {
        PH_LOCALS;
        const int ntile = TILEE[CAP_TILES];
        pg8::Gemm g{MID, W_DN1, DEX / 2}; pg8::Order<pg8::MapMoe> S; S.init(ntile < 128 ? ntile : 128, DM / 256, F.G, (int)blockIdx.x, pg8::MapMoe{TILEE, DM / 256}, DEX / 128, ntile < 128 ? 0 : ntile - 128, 4);
        pg8::EpiBf16 E{Y, DM, DM / 256, 1.0f / (S_M8 * S_W8), SLAB1};
        pg8::gemm_phase<pg8::EpiBf16, pg8::Order<pg8::MapMoe>, true>(F.lds, g, S, E);
    }
    SEAM(18);
    if (IN(19)) for (int rep_ = 0; rep_ < NREP(19); ++rep_) {
        PH_LOCALS;
        for (int n = gw; n < NTOK; n += NGW) {
            const int b = n >> 12, t = n & 4095, row = b * RPB + t;
            const int s0 = SLOT[n * 2], s1 = SLOT[n * 2 + 1]; const float g0 = GATES[n * 2], g1 = GATES[n * 2 + 1];
            const float* gt = MODS1 + (size_t)b * 12288 + 5 * DM;
            const f32x4* xr = (const f32x4*)(XR + (size_t)row * DM) + lane;
            f32x4 v[8]; float s = 0.f;
#pragma unroll
            for (int j = 0; j < 8; ++j) { f32x4 ya, yb;
                if (s0 < 128 * 256) { const u32x2 a = ((const u32x2*)(Y + (size_t)s0 * DM))[64 * j + lane]; ya = (f32x4){bf_lo(a.x), bf_hi(a.x), bf_lo(a.y), bf_hi(a.y)}; }
                else { ya = (f32x4){0.f, 0.f, 0.f, 0.f};
#pragma unroll
                    for (int p = 0; p < 4; ++p) ya += ((const f32x4*)(SLAB1 + ((size_t)p * (7 * 256) + (s0 - 128 * 256)) * DM))[64 * j + lane]; }
                if (s1 < 128 * 256) { const u32x2 a = ((const u32x2*)(Y + (size_t)s1 * DM))[64 * j + lane]; yb = (f32x4){bf_lo(a.x), bf_hi(a.x), bf_lo(a.y), bf_hi(a.y)}; }
                else { yb = (f32x4){0.f, 0.f, 0.f, 0.f};
#pragma unroll
                    for (int p = 0; p < 4; ++p) yb += ((const f32x4*)(SLAB1 + ((size_t)p * (7 * 256) + (s1 - 128 * 256)) * DM))[64 * j + lane]; }
                const f32x4 gg = ((const f32x4*)gt)[64 * j + lane];
                v[j] = xr[64 * j] + gg * (ya * g0 + yb * g1); s += (v[j].x * v[j].x + v[j].y * v[j].y) + (v[j].z * v[j].z + v[j].w * v[j].w); }
            const float rstd = 1.0f / sqrtf(wave_sum(s) * (1.0f / DM) + EPS);
            f32x4* op = (f32x4*)(args.out + (size_t)n * DM) + lane;
#pragma unroll
            for (int j = 0; j < 8; ++j) op[64 * j] = v[j] * rstd * ((const f32x4*)args.in[32])[64 * j + lane];
        }
    }
#undef IN
#undef SEAM
}

constexpr int N_PHASES = 20;
extern "C" void kernel_launch(void* const* d_in, const int* in_sizes, int n_in, void* d_out, int out_size, void* d_ws, size_t ws_size, hipStream_t stream) {
    static int grid = 0;
    if (grid == 0) {
        if (n_in != 33 || ws_size < WS_END) { fprintf(stderr, "kernel_launch: need 33 inputs and %zu bytes of workspace; got %d, %zu\n", (size_t)WS_END, n_in, ws_size); grid = -1; return; }
        int dev = 0, cus = 0, per_cu = 0;
        if (hipGetDevice(&dev) != hipSuccess || hipDeviceGetAttribute(&cus, hipDeviceAttributeMultiprocessorCount, dev) != hipSuccess) { grid = -1; return; }
        if (hipFuncSetAttribute((const void*)hybrid_fwd, hipFuncAttributeMaxDynamicSharedMemorySize, LDS_BYTES) != hipSuccess) { fprintf(stderr, "kernel_launch: hipFuncSetAttribute failed\n"); grid = -1; return; }
        if (hipOccupancyMaxActiveBlocksPerMultiprocessor(&per_cu, (const void*)hybrid_fwd, 512, LDS_BYTES) != hipSuccess || per_cu < 1)
            fprintf(stderr, "kernel_launch: occupancy query reports %d workgroups per CU\n", per_cu);
        (void)hipGetLastError();
        grid = cus;
    }
    if (grid < 0) return;
    (void)hipMemsetAsync((char*)d_ws + WS_CTL, 0, CTL_ZERO_BYTES, stream);
    Args a{};
    for (int i = 0; i < 33; ++i) a.in[i] = (const float*)d_in[i];
    a.out = (float*)d_out; a.ws = (unsigned char*)d_ws;
#if MK_PER_PHASE
    for (int p = 0; p < N_PHASES; ++p) { a.ph_lo = p; a.ph_hi = p + 1; hipLaunchKernelGGL(hybrid_fwd, dim3(grid), dim3(512), LDS_BYTES, stream, a); }
#else
    a.ph_lo = 0; a.ph_hi = N_PHASES;
    hipLaunchKernelGGL(hybrid_fwd, dim3(grid), dim3(512), LDS_BYTES, stream, a);
#endif
    const hipError_t le = hipPeekAtLastError();
    if (le != hipSuccess) fprintf(stderr, "kernel_launch: launch failed: %s\n", hipGetErrorName(le));
}
```

```cpp
#include <hip/hip_runtime.h>
#include <hip/hip_bf16.h>
#include <cstdio>
#include <cstdint>

#ifndef MK_PER_PHASE
#define MK_PER_PHASE 0
#endif

#ifndef L1PRE
#define L1PRE 1
#endif
#define ATT_DMA 1
#ifndef TSKIP
#define TSKIP 1
#endif
#ifndef PRESCALE
#define PRESCALE 1
#endif
#ifndef L1ATT_FP8
#define L1ATT_FP8 1
#endif
#ifndef FFN0_FP8
#define FFN0_FP8 1
#endif
#define GAS __attribute__((address_space(1)))
#define LAS __attribute__((address_space(3)))
typedef unsigned short bf16_t;
typedef short bf16x8 __attribute__((ext_vector_type(8)));
typedef short s16x4 __attribute__((ext_vector_type(4)));
typedef float f32x2 __attribute__((ext_vector_type(2)));
typedef float f32x4 __attribute__((ext_vector_type(4)));
typedef float f32x16 __attribute__((ext_vector_type(16)));
typedef unsigned u32x2 __attribute__((ext_vector_type(2)));
typedef unsigned u32x4 __attribute__((ext_vector_type(4)));
typedef GAS unsigned gu32;

constexpr int DM = 2048, NB = 4, SEQ = 4096, NCTX = 256, RPB = SEQ + NCTX, MROWS = NB * RPB;
constexpr int NTOK = NB * SEQ;
constexpr int PROJ = 4608, DFF = 5632, NE = 8, DEX = 7168;
constexpr int CAP_TILES = 136, CAP = CAP_TILES * 256;
constexpr float EPS = 1e-6f;
constexpr float LOG2E = 1.4426950408889634f;
constexpr float ATT_SCALE = 0.088388347648318440f;
constexpr float A_SCALE = 0.125f;
constexpr float LAMBDA_INIT = 0.2f;

constexpr size_t MiB = 1u << 20;
constexpr size_t WS_CTL = 0, CTL_ZERO_BYTES = 32 * 1024;
constexpr size_t WS_MODS = 1 * MiB;
constexpr size_t WS_ADAP = 2 * MiB;
constexpr size_t WS_ROPE = 18 * MiB;
constexpr size_t WS_ROUTE = 22 * MiB;
constexpr size_t WS_GATES = WS_ROUTE + 512 * 1024;
constexpr size_t WS_SLOT = WS_GATES + 256 * 1024;
constexpr size_t WS_CNT = WS_SLOT + 256 * 1024;
constexpr size_t WS_TILEE = WS_CNT + 64 * 1024;
constexpr size_t WS_WIN0 = 34 * MiB, WS_WOUT0 = 52 * MiB, WS_WGU0 = 60 * MiB, WS_WDN0 = 104 * MiB;
constexpr size_t WS_WIN1 = 126 * MiB, WS_WOUT1 = 144 * MiB, WS_WGU1 = 152 * MiB, WS_WDN1 = 600 * MiB;
constexpr size_t WS_XR = 824 * MiB;
constexpr size_t WS_H = 960 * MiB;
constexpr size_t WS_AO = 1028 * MiB;
constexpr size_t WS_Y = WS_H;
constexpr size_t WS_QKV = 1096 * MiB;
constexpr size_t WS_XG = WS_QKV;
constexpr size_t WS_MID = 1249 * MiB;
constexpr size_t WS_SLAB0 = 1500 * MiB;
constexpr size_t WS_SLAB1 = 1540 * MiB;
constexpr size_t WS_SLABW = 1600 * MiB;
constexpr size_t WS_VT = 1725 * MiB;
constexpr size_t WS_END = 1789 * MiB;
constexpr int CW_TMO = 0, CW_BAR = 4096;
constexpr int NS0 = FFN0_FP8 ? 2 : 4;

constexpr int RING_BYTES = 131072;
constexpr int LDS_BYTES = 147456;
constexpr int MISC_OFF = LDS_BYTES - 256;

#define RLX_AGENT __ATOMIC_RELAXED, __HIP_MEMORY_SCOPE_AGENT
#define LDS_WAIT() asm volatile("s_waitcnt lgkmcnt(0)" ::: "memory")
#define VM_WAIT() asm volatile("s_waitcnt vmcnt(0)" ::: "memory")
__device__ __forceinline__ unsigned cvt_pk_bf16(float lo, float hi) { unsigned r; asm volatile("v_cvt_pk_bf16_f32 %0, %1, %2" : "=v"(r) : "v"(lo), "v"(hi)); return r; }
__device__ __forceinline__ float bf_lo(unsigned w) { return __uint_as_float(w << 16); }
__device__ __forceinline__ float bf_hi(unsigned w) { return __uint_as_float(w & 0xffff0000u); }
typedef int i32x8 __attribute__((ext_vector_type(8)));
constexpr float S_H8 = 16.0f, S_W8 = 1024.0f, S_M8 = 4.0f, S_A8 = 64.0f;
__device__ __forceinline__ float clamp8(float x) { return __builtin_amdgcn_fmed3f(x, -448.0f, 448.0f); }
__device__ __forceinline__ unsigned pk4_fp8(float a, float b, float c, float d) {
    int w = 0; w = __builtin_amdgcn_cvt_pk_fp8_f32(clamp8(a), clamp8(b), w, false); w = __builtin_amdgcn_cvt_pk_fp8_f32(clamp8(c), clamp8(d), w, true); return (unsigned)w; }
__device__ __forceinline__ float wave_sum(float v) {
#pragma unroll
    for (int o = 1; o < 64; o <<= 1) v += __shfl_xor(v, o);
    return v;
}
__device__ __forceinline__ int fresh_tid() { int t = threadIdx.x; asm volatile("" : "+v"(t)); return t; }
__device__ __forceinline__ float fast_silu(float x) { return x * __builtin_amdgcn_rcpf(1.0f + __builtin_amdgcn_exp2f(-x * LOG2E)); }

namespace pg8 {
constexpr int BM = 256, BK = 64, HALF = 128, HTB = HALF * BK * 2, STAGE_BYTES = 8 * HTB, NXCD = 8, WGM = 4;
__host__ __device__ __forceinline__ int lds_byte(int r, int c) { const int st = (r >> 4) * 2 + (c >> 5), rr = r & 15, cc = c & 31, ob = rr * 64 + cc * 2; return st * 1024 + (ob ^ (((ob >> 9) & 1) << 5)); }
__host__ __device__ __forceinline__ void stage_rc(int b, int& R, int& C) { const int st = b / 1024, sb = b % 1024, swz = sb ^ (((sb >> 9) & 1) << 5); R = (st >> 1) * 16 + swz / 64; C = (st & 1) * 32 + (swz % 64) / 2; }
__host__ __device__ __forceinline__ int perm32(int rho) { const int n = rho >> 4, i = rho & 15; return 8 * (i >> 2) + 4 * n + (i & 3); }

typedef int i32x4_t __attribute__((ext_vector_type(4)));
struct Unit { int pm, pn, kofs, nt, flag; };
struct Gemm { const bf16_t* A; const bf16_t* Bt; int K; };

struct MapId { __device__ __forceinline__ void operator()(int pm, int pn, Unit& u) const { u.pm = pm; u.pn = pn; } };
struct MapL0Split { __device__ __forceinline__ void operator()(int pm, int pn, Unit& u) const { u.pm = pm < 64 ? (pm >> 4) * 17 + (pm & 15) : (pm - 64) * 17 + 16; u.pn = pn; } };
struct MapLatent { __device__ __forceinline__ void operator()(int pm, int pn, Unit& u) const { u.pm = (pm >> 4) * 17 + (pm & 15); u.pn = pn; } };
struct MapMoe { const int* tile_e; int npe; __device__ __forceinline__ void operator()(int pm, int pn, Unit& u) const { u.pm = pm; u.pn = tile_e[pm] * npe + pn; } };
template <class Map> struct Order {
    int nM, nN, nwg, G, c, ntf, exn, S; Map map;
    __device__ __forceinline__ void init(int nM_, int nN_, int G_, int c_, Map m, int ntf_, int ex_nM = 0, int S_ = 1) { nM = nM_; nN = nN_; nwg = nM * nN; G = G_; c = c_; map = m; ntf = ntf_; S = S_; exn = ex_nM * nN_ * S_; }
    __device__ __forceinline__ bool next(int i, Unit& u) const {
        const long L = (long)i * G + c; u.kofs = 0; u.nt = ntf; u.flag = 0;
        if (L >= nwg) { const long sidx = L - nwg; if (sidx >= exn) return false; const int part = (int)(sidx % S), ux = (int)(sidx / S);
            map(nM + ux / nN, ux % nN, u); u.nt = ntf / S; u.kofs = part * u.nt * (BK * 2); u.flag = 1 + part; return true; }
        int wgid = (int)L; { const int q = nwg / NXCD, r = nwg % NXCD, xcd = wgid % NXCD, off = wgid / NXCD; wgid = (xcd < r ? xcd * (q + 1) : r * (q + 1) + (xcd - r) * q) + off; }
        const int nig = WGM * nN, gid = wgid / nig, fm = gid * WGM, gsz = (nM - fm) < WGM ? (nM - fm) : WGM;
        map(fm + ((wgid % nig) % gsz), (wgid % nig) / gsz, u); return true;
    }
    __device__ __forceinline__ void a_ready(const Unit&) const {}
    __device__ __forceinline__ void done(const Unit&) const {}
};

struct EpiBf16 {
    static constexpr bool PERM = true;
    bf16_t* O; int ldc; int npn; float sc; float* slab;
    __device__ __forceinline__ void operator()(const f32x4 (&acc)[2][2][4][2], const Unit& u, int wr, int wc, int fr, int fq) const {
        const int row0 = u.pm * BM + wr * 64 + fr, col0 = (u.pn % npn) * BM + wc * 32 + 8 * fq;
        if (u.flag) {
            float* sp = slab + ((size_t)(u.flag - 1) * (7 * 256) + (size_t)(u.pm - 128) * BM + wr * 64 + fr) * ldc + col0;
#pragma unroll
            for (int ai = 0; ai < 2; ++ai)
#pragma unroll
                for (int m = 0; m < 4; ++m)
#pragma unroll
                    for (int bj = 0; bj < 2; ++bj) { float* p = sp + (size_t)(ai * HALF + m * 16) * ldc + bj * HALF;
                        *(f32x4*)p = acc[ai][bj][m][0] * sc; *(f32x4*)(p + 4) = acc[ai][bj][m][1] * sc; }
            return;
        }
#pragma unroll
        for (int ai = 0; ai < 2; ++ai)
#pragma unroll
            for (int m = 0; m < 4; ++m) { bf16_t* rowp = O + (size_t)(row0 + ai * HALF + m * 16) * ldc + col0;
#pragma unroll
                for (int bj = 0; bj < 2; ++bj) { const f32x4 v0 = acc[ai][bj][m][0] * sc, v1 = acc[ai][bj][m][1] * sc;
                    u32x4 w; w.x = cvt_pk_bf16(v0[0], v0[1]); w.y = cvt_pk_bf16(v0[2], v0[3]); w.z = cvt_pk_bf16(v1[0], v1[1]); w.w = cvt_pk_bf16(v1[2], v1[3]);
                    *(u32x4*)(rowp + bj * HALF) = w; } }
    }
};
template <int LAYER> struct EpiQKV {
    static constexpr bool PERM = true;
    bf16_t* O; const float* cA; const float* sA; const float* cB; const float* sB; const float* qg; const float* kg; LAS float* scr; float asc; bf16_t* VTp;
    static __device__ __forceinline__ bool swapped(int pn) { if constexpr (LAYER == 0) return (pn >= 12 && pn < 16) || pn == 17; else return pn == 9 || pn >= 14; }
    static __device__ __forceinline__ int vrow0(int pn) { if constexpr (LAYER == 0) return pn < 16 ? (pn - 12) * 256 : 1024; else return pn == 9 ? 0 : 256 + (pn - 14) * 256; }
    __device__ __forceinline__ void operator()(const f32x4 (&acc)[2][2][4][2], const Unit& u, int wr, int wc, int fr, int fq) const {
        const int tt = u.pm % 17, pn = u.pn; const bool latent = tt < 16;
        if (swapped(pn)) {
            bf16_t* vp = VTp + (size_t)(vrow0(pn) + wr * 64 + fr) * MROWS + (size_t)u.pm * BM + wc * 32 + 8 * fq;
#pragma unroll
            for (int ai = 0; ai < 2; ++ai)
#pragma unroll
                for (int m = 0; m < 4; ++m) { bf16_t* rowp = vp + (size_t)(ai * HALF + m * 16) * MROWS;
#pragma unroll
                    for (int bj = 0; bj < 2; ++bj) { const f32x4 v0 = acc[ai][bj][m][0] * asc, v1 = acc[ai][bj][m][1] * asc;
                        u32x4 w; w.x = cvt_pk_bf16(v0[0], v0[1]); w.y = cvt_pk_bf16(v0[2], v0[3]); w.z = cvt_pk_bf16(v1[0], v1[1]); w.w = cvt_pk_bf16(v1[2], v1[3]);
                        *(u32x4*)(rowp + bj * HALF) = w; } }
            return;
        }
        int kind0, kind1; bool norm = false;
        if constexpr (LAYER == 0) { const int k = (pn < 4 || (pn >= 8 && pn < 12)) ? 1 : ((pn >= 4 && pn < 8) || pn == 16) ? 2 : 0; kind0 = kind1 = k; norm = (k == 2); }
        else { kind0 = kind1 = (pn < 4 || pn == 8) ? 2 : 0; }
        const int row0 = u.pm * BM + wr * 64 + fr, col0 = pn * BM + wc * 32 + 8 * fq, ch = wc * 32 + 8 * fq;
        if (norm) {
#pragma unroll
            for (int ai = 0; ai < 2; ++ai)
#pragma unroll
                for (int m = 0; m < 4; ++m)
#pragma unroll
                    for (int bj = 0; bj < 2; ++bj) { const f32x4 a = acc[ai][bj][m][0], b = acc[ai][bj][m][1];
                        float q = (a[0] * a[0] + a[1] * a[1]) + (a[2] * a[2] + a[3] * a[3]) + (b[0] * b[0] + b[1] * b[1]) + (b[2] * b[2] + b[3] * b[3]);
                        q += __shfl_xor(q, 16); q += __shfl_xor(q, 32);
                        if (fq == 0) scr[((ai * HALF + wr * 64 + m * 16 + fr) * 2 + bj) * 4 + wc] = q; }
            asm volatile("s_waitcnt lgkmcnt(0)" ::: "memory"); __builtin_amdgcn_s_barrier(); asm volatile("" ::: "memory");
        }
        f32x4 g0 = {1.f, 1.f, 1.f, 1.f}, g1 = g0;
        if (norm) { const LAS float* gl = scr + 2048 + ((pn == 16) ? 128 : 0) + ch; g0 = *(const LAS f32x4*)gl; g1 = *(const LAS f32x4*)(gl + 4); }
        const int kmax = kind0 > kind1 ? kind0 : kind1;
        const int npair = (kmax == 1) ? 16 : 32, p0 = (kmax == 1) ? ((ch & 63) >> 1) : (ch >> 1), q0 = p0 & (npair - 1); const bool use_row = p0 < npair;
        f32x4 frq;
#pragma unroll
        for (int i = 0; i < 4; ++i) frq[i] = __builtin_amdgcn_exp2f(-(float)(q0 + i) * (13.287712379549449f / (float)npair)) * 0.15915494309189535f;
#pragma unroll
        for (int ai = 0; ai < 2; ++ai)
#pragma unroll
            for (int m = 0; m < 4; ++m) { const int r = ai * HALF + wr * 64 + m * 16 + fr, t = tt * 256 + r;
                bf16_t* rowp = O + (size_t)(row0 + ai * HALF + m * 16) * PROJ + col0;
                f32x4 cs = {1.f, 1.f, 1.f, 1.f}, sn = {0.f, 0.f, 0.f, 0.f};
                if (latent && kmax != 0) { const float pos = (float)(use_row ? (t >> 6) : (t & 63));
#pragma unroll
                    for (int i = 0; i < 4; ++i) { const float x = pos * frq[i]; cs[i] = __builtin_amdgcn_cosf(x); sn[i] = __builtin_amdgcn_sinf(x); } }
#pragma unroll
                for (int bj = 0; bj < 2; ++bj) { f32x4 v0 = acc[ai][bj][m][0] * asc, v1 = acc[ai][bj][m][1] * asc; const int kind = bj ? kind1 : kind0;
                    if (norm) { const f32x4 p = *(const LAS f32x4*)(scr + ((ai * HALF + wr * 64 + m * 16 + fr) * 2 + bj) * 4);
                        const float rsv = 1.0f / sqrtf(((p[0] + p[1]) + (p[2] + p[3])) * (1.0f / 128.0f) + EPS); v0 = v0 * rsv * g0; v1 = v1 * rsv * g1; }
                    if (latent && kind != 0) {
                        const f32x4 a = v0, b = v1;
                        v0[0] = a[0] * cs[0] - a[1] * sn[0]; v0[1] = a[0] * sn[0] + a[1] * cs[0]; v0[2] = a[2] * cs[1] - a[3] * sn[1]; v0[3] = a[2] * sn[1] + a[3] * cs[1];
                        v1[0] = b[0] * cs[2] - b[1] * sn[2]; v1[1] = b[0] * sn[2] + b[1] * cs[2]; v1[2] = b[2] * cs[3] - b[3] * sn[3]; v1[3] = b[2] * sn[3] + b[3] * cs[3]; }
                    if constexpr (LAYER == 0 && PRESCALE) { const float qs = pn < 4 ? A_SCALE * LOG2E : (pn < 8 ? ATT_SCALE * LOG2E : 1.0f); v0 = v0 * qs; v1 = v1 * qs; }
                    if constexpr (LAYER == 1 && PRESCALE && L1PRE) { const float qs = pn < (ATT_DMA ? 8 : 4) ? ATT_SCALE * LOG2E : 1.0f; v0 = v0 * qs; v1 = v1 * qs; }
                    u32x4 w; w.x = cvt_pk_bf16(v0[0], v0[1]); w.y = cvt_pk_bf16(v0[2], v0[3]); w.z = cvt_pk_bf16(v1[0], v1[1]); w.w = cvt_pk_bf16(v1[2], v1[3]);
                    *(u32x4*)(rowp + bj * HALF) = w; } }
    }
};
struct EpiSwiGLU {
    static constexpr bool PERM = true;
    bf16_t* O; int ldc; int npn;
    __device__ __forceinline__ void operator()(const f32x4 (&acc)[2][2][4][2], const Unit& u, int wr, int wc, int fr, int fq) const {
        const int row0 = u.pm * BM + wr * 64 + fr, col0 = (u.pn % npn) * HALF + wc * 32 + 8 * fq;
#pragma unroll
        for (int ai = 0; ai < 2; ++ai)
#pragma unroll
            for (int m = 0; m < 4; ++m) { bf16_t* rowp = O + (size_t)(row0 + ai * HALF + m * 16) * ldc + col0;
                const f32x4 g0 = acc[ai][0][m][0], g1 = acc[ai][0][m][1], u0 = acc[ai][1][m][0], u1 = acc[ai][1][m][1];
                u32x4 w;
                w.x = cvt_pk_bf16(fast_silu(g0[0]) * u0[0], fast_silu(g0[1]) * u0[1]); w.y = cvt_pk_bf16(fast_silu(g0[2]) * u0[2], fast_silu(g0[3]) * u0[3]);
                w.z = cvt_pk_bf16(fast_silu(g1[0]) * u1[0], fast_silu(g1[1]) * u1[1]); w.w = cvt_pk_bf16(fast_silu(g1[2]) * u1[2], fast_silu(g1[3]) * u1[3]);
                *(u32x4*)rowp = w; }
    }
};
struct EpiSwiGLU8 {
    static constexpr bool PERM = true;
    unsigned char* O; int ldc; int npn; float si, so;
    __device__ __forceinline__ f32x2 two(f32x2 ag, f32x2 au, float kneg, float c0) const {
        const f32x2 t = ag * kneg; f32x2 e; e.x = __builtin_amdgcn_exp2f(t.x); e.y = __builtin_amdgcn_exp2f(t.y);
        const f32x2 d = e * c0 + c0; f32x2 r; r.x = __builtin_amdgcn_rcpf(d.x); r.y = __builtin_amdgcn_rcpf(d.y);
        return (ag * au) * r; }
    __device__ __forceinline__ void operator()(const f32x4 (&acc)[2][2][4][2], const Unit& u, int wr, int wc, int fr, int fq) const {
        const int row0 = u.pm * BM + wr * 64 + fr, col0 = (u.pn % npn) * HALF + wc * 32 + 8 * fq;
        const float kneg = -si * LOG2E, c0 = 1.0f / (si * so);
#pragma unroll
        for (int ai = 0; ai < 2; ++ai)
#pragma unroll
            for (int m = 0; m < 4; ++m) { unsigned char* rowp = O + (size_t)(row0 + ai * HALF + m * 16) * ldc + col0;
                const f32x4 g0 = acc[ai][0][m][0], g1 = acc[ai][0][m][1], u0 = acc[ai][1][m][0], u1 = acc[ai][1][m][1];
                u32x2 w;
                const f32x2 a = two((f32x2){g0[0], g0[1]}, (f32x2){u0[0], u0[1]}, kneg, c0), b = two((f32x2){g0[2], g0[3]}, (f32x2){u0[2], u0[3]}, kneg, c0);
                const f32x2 c = two((f32x2){g1[0], g1[1]}, (f32x2){u1[0], u1[1]}, kneg, c0), d = two((f32x2){g1[2], g1[3]}, (f32x2){u1[2], u1[3]}, kneg, c0);
                w.x = pk4_fp8(a.x, a.y, b.x, b.y); w.y = pk4_fp8(c.x, c.y, d.x, d.y);
                *(u32x2*)rowp = w; }
    }
};
struct EpiResid {
    static constexpr bool PERM = false;
    const float* x_in; const float* ctx_in; float* XR; const float* mods; int gate_chunk; int from_input; float* slab; float asc;
    __device__ __forceinline__ void operator()(const f32x4 (&acc)[2][2][4][2], const Unit& u, int wr, int wc, int fr, int fq) const {
        const int b = u.pm / 17, tt = u.pm % 17;
        float* outp = XR + (size_t)u.pm * BM * DM;
        const float* basep = from_input ? (tt < 16 ? x_in + ((size_t)b * SEQ + (size_t)tt * 256) * DM : ctx_in + (size_t)b * NCTX * DM) : outp;
        const float* gate = mods + (size_t)(tt < 16 ? b : 4) * 12288 + gate_chunk * DM;
        const int col0 = u.pn * BM + wc * 32 + 4 * fq;
        f32x4 gv[2][2];
#pragma unroll
        for (int bj = 0; bj < 2; ++bj)
#pragma unroll
            for (int n = 0; n < 2; ++n) gv[bj][n] = *(const f32x4*)(gate + col0 + bj * HALF + n * 16) * asc;
        if (u.flag) {
            float* sp = slab + ((size_t)(u.flag - 1) * (NB * NCTX) + (size_t)b * NCTX) * DM;
#pragma unroll
            for (int ai = 0; ai < 2; ++ai)
#pragma unroll
                for (int m = 0; m < 4; ++m) { const size_t off = (size_t)(ai * HALF + wr * 64 + m * 16 + fr) * DM + col0;
#pragma unroll
                    for (int bj = 0; bj < 2; ++bj)
#pragma unroll
                        for (int n = 0; n < 2; ++n) *(f32x4*)(sp + off + bj * HALF + n * 16) = gv[bj][n] * acc[ai][bj][m][n]; }
            return;
        }
#pragma unroll
        for (int ai = 0; ai < 2; ++ai)
#pragma unroll
            for (int m = 0; m < 4; ++m) { const size_t off = (size_t)(ai * HALF + wr * 64 + m * 16 + fr) * DM + col0;
#pragma unroll
                for (int bj = 0; bj < 2; ++bj)
#pragma unroll
                    for (int n = 0; n < 2; ++n) { const f32x4 bs = *(const f32x4*)(basep + off + bj * HALF + n * 16);
                        *(f32x4*)(outp + off + bj * HALF + n * 16) = bs + gv[bj][n] * acc[ai][bj][m][n]; }
                if (m & 1) asm volatile("" ::: "memory"); }
    }
};

template <class Epi, class Sched, bool FP8 = false, bool ALIGN_EPI = true, bool SP2 = true, bool VT = false>
__device__ __forceinline__ void gemm_phase(LAS unsigned char* lds, const Gemm g, const Sched& S, const Epi& E) {
    const int tid = fresh_tid(), wid = __builtin_amdgcn_readfirstlane(tid >> 6), lane = tid & 63, wr = wid >> 2, wc = wid & 3, fr = lane & 15, fq = lane >> 4;
    const int K = g.K;
    unsigned voffA[2], voffB[2];
#pragma unroll
    for (int i = 0; i < 2; ++i) { int R, C; stage_rc(tid * 16 + i * 8192, R, C); const int Rb = Epi::PERM ? ((R & ~31) + perm32(R & 31)) : R;
        voffA[i] = (unsigned)(R * K + C) * 2u; voffB[i] = (unsigned)(Rb * K + C) * 2u; }
    const size_t kstep = (size_t)(BK * 2);
    const size_t hstep = (size_t)HALF * K * 2;
    const size_t tstep = 2 * hstep;
    const unsigned ldsw = (unsigned)wid * 1024u;
    const int aoff = FP8 ? lds_byte(wr * 64 + fr, fq * 16) : lds_byte(wr * 64 + fr, fq * 8), boff = FP8 ? lds_byte(wc * 32 + fr, fq * 16) : lds_byte(wc * 32 + fr, fq * 8);
#define PG8_SA(b, h) (((b) * 2 + (h)) * HTB)
#define PG8_SB(b, h) ((4 + (b) * 2 + (h)) * HTB)
#define PG8_STAGE(bufoff, gbase, voff) do { _Pragma("unroll") for (int _i = 0; _i < 2; ++_i) \
        __builtin_amdgcn_global_load_lds((const unsigned*)((const char*)(gbase) + (voff)[_i]), (LAS unsigned*)(lds + (bufoff) + ldsw + _i * 8192), 16, 0, 0); } while (0)
#define PG8_LD16(p) (*(const LAS i32x4_t*)(p))
#define PG8_LDA(dst, b, h) do { if constexpr (FP8) { _Pragma("unroll") for (int m = 0; m < 4; ++m) { const LAS unsigned char* _p = lds + PG8_SA(b, h) + aoff + m * 2048; \
            dst##8[m] = __builtin_shufflevector(PG8_LD16(_p), PG8_LD16(_p + 16), 0, 1, 2, 3, 4, 5, 6, 7); } } else { \
        _Pragma("unroll") for (int m = 0; m < 4; ++m) _Pragma("unroll") for (int k = 0; k < 2; ++k) dst[m][k] = *(const LAS bf16x8*)(lds + PG8_SA(b, h) + aoff + m * 2048 + k * 1024); } } while (0)
#define PG8_LDB(dst, b, h) do { if constexpr (FP8) { _Pragma("unroll") for (int n = 0; n < 2; ++n) { const LAS unsigned char* _p = lds + PG8_SB(b, h) + boff + n * 2048; \
            dst##8[n] = __builtin_shufflevector(PG8_LD16(_p), PG8_LD16(_p + 16), 0, 1, 2, 3, 4, 5, 6, 7); } } else { \
        _Pragma("unroll") for (int n = 0; n < 2; ++n) _Pragma("unroll") for (int k = 0; k < 2; ++k) dst[n][k] = *(const LAS bf16x8*)(lds + PG8_SB(b, h) + boff + n * 2048 + k * 1024); } } while (0)
#define PG8_MMA(ai, bj, At, Bt) do { __builtin_amdgcn_s_setprio(1); _Pragma("unroll") for (int m = 0; m < 4; ++m) _Pragma("unroll") for (int n = 0; n < 2; ++n) { if constexpr (FP8) \
        asm volatile("v_mfma_f32_16x16x128_f8f6f4 %0, %1, %2, %0" : "+v"(acc[ai][bj][m][n]) : "v"(Bt##8[n]), "v"(At##8[m])); else { _Pragma("unroll") for (int k = 0; k < 2; ++k) \
        acc[ai][bj][m][n] = __builtin_amdgcn_mfma_f32_16x16x32_bf16(Bt[n][k], At[m][k], acc[ai][bj][m][n], 0, 0, 0); } } __builtin_amdgcn_s_setprio(0); } while (0)
#define PG8_WAIT_V(n) asm volatile("s_waitcnt vmcnt(" #n ")" ::: "memory")
#define PG8_WAIT_L(n) asm volatile("s_waitcnt lgkmcnt(" #n ")" ::: "memory")
#define PG8_BAR __builtin_amdgcn_s_barrier()
#define PG8_SCHED __builtin_amdgcn_sched_barrier(0)
    Unit cur, nxt; int ui = 0;
    if (!S.next(0, cur)) return;
    f32x4 acc[2][2][4][2];
#pragma unroll
    for (int a = 0; a < 2; ++a)
#pragma unroll
        for (int b = 0; b < 2; ++b)
#pragma unroll
            for (int m = 0; m < 4; ++m)
#pragma unroll
                for (int n = 0; n < 2; ++n) acc[a][b][m][n] = (f32x4){0.f, 0.f, 0.f, 0.f};
    bf16x8 At[4][2], B0[2][2], B1[2][2]; i32x8 At8[4], B08[2], B18[2];
    auto opA = [&](const Unit& u) -> const char* { if constexpr (VT) { if (Epi::swapped(u.pn)) return (const char*)g.Bt + (size_t)u.pn * tstep + u.kofs; } return (const char*)g.A + (size_t)u.pm * tstep + u.kofs; };
    auto opB = [&](const Unit& u) -> const char* { if constexpr (VT) { if (Epi::swapped(u.pn)) return (const char*)g.A + (size_t)u.pm * tstep + u.kofs; } return (const char*)g.Bt + (size_t)u.pn * tstep + u.kofs; };
    const char* cA = opA(cur); const char* cB = opB(cur);
    S.a_ready(cur);
    if constexpr (SP2) {
        PG8_STAGE(PG8_SB(0, 0), cB, voffB); PG8_STAGE(PG8_SB(0, 1), cB + hstep, voffB); PG8_STAGE(PG8_SA(0, 0), cA, voffA); PG8_STAGE(PG8_SA(0, 1), cA + hstep, voffA);
        if (wr == 1) PG8_BAR;
        PG8_WAIT_V(2); PG8_BAR;
        PG8_STAGE(PG8_SB(1, 0), cB + kstep, voffB); PG8_STAGE(PG8_SA(1, 0), cA + kstep, voffA); PG8_STAGE(PG8_SB(1, 1), cB + hstep + kstep, voffB);
        PG8_WAIT_V(6); PG8_BAR;
    } else {
        PG8_STAGE(PG8_SB(0, 0), cB, voffB); PG8_STAGE(PG8_SA(0, 0), cA, voffA); PG8_STAGE(PG8_SB(0, 1), cB + hstep, voffB); PG8_STAGE(PG8_SA(0, 1), cA + hstep, voffA);
        if (wr == 1) PG8_BAR;
        PG8_WAIT_V(4); PG8_BAR;
        PG8_STAGE(PG8_SB(1, 0), cB + kstep, voffB); PG8_STAGE(PG8_SA(1, 0), cA + kstep, voffA); PG8_STAGE(PG8_SB(1, 1), cB + hstep + kstep, voffB);
        PG8_WAIT_V(6); PG8_BAR;
    }
    for (;;) {
        const bool has_next = S.next(ui + 1, nxt);
        const char* nA = has_next ? opA(nxt) : cA; const char* nB = has_next ? opB(nxt) : cB;
        const int nt = cur.nt;
        for (int t = 0; t < nt; t += 2) {
            const bool last = (t == nt - 2);
            const char* a1 = cA + (size_t)(t + 1) * kstep;
            const char* a2 = last ? nA : cA + (size_t)(t + 2) * kstep; const char* b2 = last ? nB : cB + (size_t)(t + 2) * kstep;
            const char* a3 = a2 + kstep; const char* b3 = b2 + kstep;
            if (last && has_next) S.a_ready(nxt);
            if constexpr (SP2) {
            PG8_LDB(B0, 0, 0); PG8_LDB(B1, 0, 1); PG8_SCHED; PG8_LDA(At, 0, 0); PG8_STAGE(PG8_SA(1, 1), a1 + hstep, voffA);
            PG8_WAIT_V(8); PG8_WAIT_L(0); PG8_BAR; PG8_MMA(0, 0, At, B0); PG8_MMA(0, 1, At, B1); PG8_BAR; PG8_SCHED;
            PG8_LDA(At, 0, 1); PG8_STAGE(PG8_SB(0, 0), b2, voffB); PG8_STAGE(PG8_SB(0, 1), b2 + hstep, voffB); PG8_STAGE(PG8_SA(0, 0), a2, voffA);
            PG8_WAIT_V(8); PG8_WAIT_L(0); PG8_BAR; PG8_MMA(1, 0, At, B0); PG8_MMA(1, 1, At, B1); PG8_BAR; PG8_SCHED;
            PG8_LDB(B0, 1, 0); PG8_LDB(B1, 1, 1); PG8_SCHED; PG8_LDA(At, 1, 0); PG8_STAGE(PG8_SA(0, 1), a2 + hstep, voffA);
            PG8_WAIT_V(8); PG8_WAIT_L(0); PG8_BAR; PG8_MMA(0, 0, At, B0); PG8_MMA(0, 1, At, B1); PG8_BAR; PG8_SCHED;
            PG8_LDA(At, 1, 1); PG8_STAGE(PG8_SB(1, 0), b3, voffB); PG8_STAGE(PG8_SB(1, 1), b3 + hstep, voffB); PG8_STAGE(PG8_SA(1, 0), a3, voffA);
            PG8_WAIT_V(8); PG8_WAIT_L(0); PG8_BAR; PG8_MMA(1, 0, At, B0); PG8_MMA(1, 1, At, B1); PG8_BAR; PG8_SCHED;
            } else {
            PG8_LDB(B0, 0, 0); PG8_SCHED; PG8_LDA(At, 0, 0); PG8_STAGE(PG8_SA(1, 1), a1 + hstep, voffA);
            PG8_WAIT_L(8); PG8_BAR; PG8_WAIT_L(0); PG8_MMA(0, 0, At, B0); PG8_BAR; PG8_SCHED;
            PG8_LDB(B1, 0, 1); PG8_STAGE(PG8_SB(0, 0), b2, voffB);
            PG8_BAR; PG8_WAIT_L(0); PG8_MMA(0, 1, At, B1); PG8_BAR;
            PG8_LDA(At, 0, 1); PG8_STAGE(PG8_SA(0, 0), a2, voffA);
            PG8_BAR; PG8_WAIT_L(0); PG8_MMA(1, 0, At, B0); PG8_BAR; PG8_SCHED;
            PG8_STAGE(PG8_SB(0, 1), b2 + hstep, voffB);
            PG8_WAIT_V(6); PG8_BAR; PG8_MMA(1, 1, At, B1); PG8_BAR;
            PG8_LDB(B0, 1, 0); PG8_SCHED; PG8_LDA(At, 1, 0); PG8_STAGE(PG8_SA(0, 1), a2 + hstep, voffA);
            PG8_WAIT_L(8); PG8_BAR; PG8_WAIT_L(0); PG8_MMA(0, 0, At, B0); PG8_BAR; PG8_SCHED;
            PG8_LDB(B1, 1, 1); PG8_STAGE(PG8_SB(1, 0), b3, voffB);
            PG8_BAR; PG8_WAIT_L(0); PG8_MMA(0, 1, At, B1); PG8_BAR;
            PG8_LDA(At, 1, 1); PG8_STAGE(PG8_SA(1, 0), a3, voffA);
            PG8_BAR; PG8_WAIT_L(0); PG8_MMA(1, 0, At, B0); PG8_BAR; PG8_SCHED;
            PG8_STAGE(PG8_SB(1, 1), b3 + hstep, voffB);
            PG8_WAIT_V(6); PG8_BAR; PG8_MMA(1, 1, At, B1); PG8_BAR;
            }
        }
        if constexpr (ALIGN_EPI) { if (wr == 0) PG8_BAR; }
        if constexpr (FP8) asm volatile("s_nop 15\n\ts_nop 15" ::: "memory");
        E(acc, cur, wr, wc, fr, fq); S.done(cur);
        if (!has_next) break;
#pragma unroll
        for (int a = 0; a < 2; ++a)
#pragma unroll
            for (int b = 0; b < 2; ++b)
#pragma unroll
                for (int m = 0; m < 4; ++m)
#pragma unroll
                    for (int n = 0; n < 2; ++n) acc[a][b][m][n] = (f32x4){0.f, 0.f, 0.f, 0.f};
        cur = nxt; cA = nA; cB = nB; ++ui;
        if constexpr (ALIGN_EPI) { if (wr == 1) PG8_BAR; }
    }
    PG8_WAIT_V(0);
    if constexpr (!ALIGN_EPI) { if (wr == 0) PG8_BAR; }
    PG8_BAR;
#undef PG8_SA
#undef PG8_SB
#undef PG8_STAGE
#undef PG8_LDA
#undef PG8_LDB
#undef PG8_MMA
#undef PG8_LD16
#undef PG8_WAIT_V
#undef PG8_WAIT_L
#undef PG8_BAR
#undef PG8_SCHED
}
}

namespace att {
constexpr int D = 128, NW = 8, QBLK = 32, KVBLK = 64;
constexpr int LDQK = PROJ, LDO = DM;
constexpr float THR = 8.f;
#ifndef DIFF_SD
#define DIFF_SD 2
#endif
#ifndef STD_SD
#define STD_SD 1
#endif
constexpr int SHM_V = KVBLK * D * 2, SHM_K = KVBLK * D * 2;
constexpr int OFF_WS = 2 * SHM_V + 2 * SHM_K, OFF_STASH = OFF_WS + NW * 64 * 4, OFF_BIAS = OFF_STASH + 65536, ATT_LDS = OFF_BIAS + 2048;
static_assert(ATT_LDS <= MISC_OFF, "attention LDS");
#define KSWZ(row, colB) ((row) * 256 + ((colB) ^ (((row) & 7) << 4)))
#define SBAR() __builtin_amdgcn_sched_barrier(0)
__device__ __forceinline__ int crow(int r, int hi) { return (r & 3) + 8 * (r >> 2) + 4 * hi; }
struct TileMap { int NC, cbase, lbase, NT; __device__ __forceinline__ int krow(int j) const { return j < NC ? cbase + 64 * j : lbase + 64 * (j - NC); } };
struct MaskInfo { int q0, r0, lo; };

template <int MODE>
__device__ __forceinline__ void apply_mask(f32x16& p0, f32x16& p1, int j, const TileMap& tm, const MaskInfo& mi, int wid, int r32, int hi, const float* btab) {
    if constexpr (MODE == 1) {
        if (j >= tm.NC) {
            const int kp0 = tm.lbase + 64 * (j - tm.NC), qw = mi.q0 + wid * 32;
            if (kp0 - (qw + 31) < -128 || kp0 + 63 - qw > 128) {
                const int dq = kp0 - (qw + r32) + 4 * hi;
#pragma unroll
                for (int r = 0; r < 16; ++r) { const int d = dq + (r & 3) + 8 * (r >> 2);
                    if (d > 128 || d < -128) p0[r] = -1e30f;
                    if (d + 32 > 128 || d + 32 < -128) p1[r] = -1e30f; }
            }
        }
    } else if constexpr (MODE == 2) {
        if (j >= tm.NC) {
            const int kr = mi.lo + (j - tm.NC), rq = mi.r0 + (wid >> 1);
            int rs = rq - 4; rs = rs < 0 ? 0 : (rs > 56 ? 56 : rs);
            if (kr >= rs && kr < rs + 8) {
                const int cq = (wid & 1) * 32 + r32; int cs = cq - 8; cs = cs < 0 ? 0 : (cs > 48 ? 48 : cs);
                const float* bt = btab + (kr - rq + 7) * 31 + (4 * hi - cq + 15);
                const int cb = 4 * hi - cs;
#pragma unroll
                for (int r = 0; r < 16; ++r) { const int ko = (r & 3) + 8 * (r >> 2);
                    p0[r] = ((unsigned)(ko + cb) < 16u) ? p0[r] + bt[ko] : -1e30f;
                    if ((r & 7) == 7) SBAR(); }
#pragma unroll
                for (int r = 0; r < 16; ++r) { const int ko = (r & 3) + 8 * (r >> 2);
                    p1[r] = ((unsigned)(ko + 32 + cb) < 16u) ? p1[r] + bt[ko + 32] : -1e30f;
                    if ((r & 7) == 7) SBAR(); }
            } else {
#pragma unroll
                for (int r = 0; r < 16; ++r) { p0[r] = -1e30f; p1[r] = -1e30f; }
            }
        }
    }
}
__device__ __forceinline__ void partialSM(f32x16& p0, f32x16& p1, float& m_reg, float& mn, float& alpha, const float C, const float thr_raw) {
    float pmax = p0[0];
#pragma unroll
    for (int r = 1; r < 16; ++r) pmax = fmaxf(pmax, p0[r]);
#pragma unroll
    for (int r = 0; r < 16; ++r) pmax = fmaxf(pmax, p1[r]);
    { auto rr = __builtin_amdgcn_permlane32_swap(__float_as_uint(pmax), __float_as_uint(pmax), false, false);
      pmax = fmaxf(__uint_as_float(rr[0]), __uint_as_float(rr[1])); }
    if (__builtin_expect(__all(pmax - m_reg <= thr_raw), 1)) { mn = m_reg; alpha = 1.f; }
    else { mn = fmaxf(m_reg, pmax); alpha = __builtin_amdgcn_exp2f((m_reg - mn) * C); m_reg = mn; }
    const float mnC = -mn * C;
#pragma unroll
    for (int r = 0; r < 16; ++r) p0[r] = fmaf(p0[r], C, mnC);
#pragma unroll
    for (int r = 0; r < 16; ++r) p1[r] = fmaf(p1[r], C, mnC);
#pragma unroll
    for (int r = 0; r < 16; ++r) p0[r] = __builtin_amdgcn_exp2f(p0[r]);
}
__device__ __forceinline__ void finishSM(f32x16& p0, f32x16& p1, float alpha, float& l_reg, bf16x8& pa0, bf16x8& pa1, bf16x8& pa2, bf16x8& pa3) {
#pragma unroll
    for (int r = 0; r < 16; ++r) p1[r] = __builtin_amdgcn_exp2f(p1[r]);
    float ps = 0;
#pragma unroll
    for (int r = 0; r < 16; ++r) ps += p0[r];
#pragma unroll
    for (int r = 0; r < 16; ++r) ps += p1[r];
    { auto rr = __builtin_amdgcn_permlane32_swap(__float_as_uint(ps), __float_as_uint(ps), false, false);
      ps = __uint_as_float(rr[0]) + __uint_as_float(rr[1]); }
    l_reg = l_reg * alpha + ps;
#define PK4(P, BASE, OUT) do { unsigned a0 = cvt_pk_bf16(P[BASE + 0], P[BASE + 1]), a1 = cvt_pk_bf16(P[BASE + 2], P[BASE + 3]);   \
    unsigned b0 = cvt_pk_bf16(P[BASE + 4], P[BASE + 5]), b1 = cvt_pk_bf16(P[BASE + 6], P[BASE + 7]);                              \
    auto r0 = __builtin_amdgcn_permlane32_swap(a0, b0, false, false); auto r1 = __builtin_amdgcn_permlane32_swap(a1, b1, false, false); \
    u32x4 w = {r0[0], r1[0], r0[1], r1[1]}; OUT = *reinterpret_cast<bf16x8*>(&w); } while (0)
    PK4(p0, 0, pa0); PK4(p0, 8, pa1); PK4(p1, 0, pa2); PK4(p1, 8, pa3);
#undef PK4
}
template <int DLO, int DHI, bool QLDS, bool PREQ = false>
__device__ __forceinline__ void qkt(f32x16& p0, f32x16& p1, const char* Ks, const bf16x8* qr, const char* qlds, int r32, int hi, const f32x16& cinit = f32x16{}) {
#pragma unroll
    for (int d0 = DLO; d0 < DHI; ++d0) { const int cb = (d0 * 16 + hi * 8) * 2;
        bf16x8 q; if constexpr (QLDS) q = *(const volatile LAS bf16x8*)((const LAS char*)qlds + d0 * 8192); else q = qr[d0];
        const bf16x8 b0 = *reinterpret_cast<const bf16x8*>(Ks + KSWZ(r32, cb));
        const bf16x8 b1 = *reinterpret_cast<const bf16x8*>(Ks + KSWZ(32 + r32, cb));
        if (d0 == DLO) {
            if constexpr (PRESCALE && (!QLDS || (L1PRE && PREQ))) {
                asm("v_mfma_f32_32x32x16_bf16 %0, %1, %2, %3" : "=&v"(p0) : "v"(b0), "v"(q), "v"(cinit));
                asm("v_mfma_f32_32x32x16_bf16 %0, %1, %2, %3" : "=&v"(p1) : "v"(b1), "v"(q), "v"(cinit)); }
            else { p0 = __builtin_amdgcn_mfma_f32_32x32x16_bf16(b0, q, cinit, 0, 0, 0); p1 = __builtin_amdgcn_mfma_f32_32x32x16_bf16(b1, q, cinit, 0, 0, 0); } }
        else { p0 = __builtin_amdgcn_mfma_f32_32x32x16_bf16(b0, q, p0, 0, 0, 0); p1 = __builtin_amdgcn_mfma_f32_32x32x16_bf16(b1, q, p1, 0, 0, 0); } }
}
constexpr float THR_L2 = THR * LOG2E;
__device__ __forceinline__ void presm_decide(f32x16& p0, f32x16& p1, float pmax, float& m_hat, float& alpha, f32x16& negm, bool first) {
    { auto rr = __builtin_amdgcn_permlane32_swap(__float_as_uint(pmax), __float_as_uint(pmax), false, false);
      pmax = fmaxf(__uint_as_float(rr[0]), __uint_as_float(rr[1])); }
    if (!first && __builtin_expect(__all(pmax <= THR_L2), 1)) { alpha = 1.f; }
    else { const float dl = first ? pmax : fmaxf(pmax, 0.f); m_hat += dl; alpha = first ? 1.f : __builtin_amdgcn_exp2f(-dl);
#pragma unroll
        for (int r = 0; r < 16; ++r) { p0[r] -= dl; p1[r] -= dl; }
#pragma unroll
        for (int r = 0; r < 16; ++r) negm[r] = -m_hat; }
}
struct VB { int a0, a1, a2, a3; };
__device__ __forceinline__ VB v_rd_base(int vlds, int r32, int hi) { const int sw = (r32 >> 1) & 7, b = vlds + r32 * 128;
    return VB{b + (((0 + hi) ^ sw) << 4), b + (((2 + hi) ^ sw) << 4), b + (((4 + hi) ^ sw) << 4), b + (((6 + hi) ^ sw) << 4)}; }
template <int OFF> __device__ __forceinline__ bf16x8 v_read(int a) {
    pg8::i32x4_t r; asm volatile("ds_read_b128 %0, %1 offset:%2" : "=&v"(r) : "v"(a), "i"(OFF) : "memory"); return __builtin_bit_cast(bf16x8, r);
}
template <int D0, int VOFF> __device__ __forceinline__ void pv_one(f32x16& od, const VB& vb, bf16x8 pa0, bf16x8 pa1, bf16x8 pa2, bf16x8 pa3) {
    const bf16x8 v0 = v_read<VOFF + D0 * 4096>(vb.a0), v1 = v_read<VOFF + D0 * 4096>(vb.a1), v2 = v_read<VOFF + D0 * 4096>(vb.a2), v3 = v_read<VOFF + D0 * 4096>(vb.a3);
    asm volatile("s_waitcnt lgkmcnt(0)" ::: "memory"); SBAR();
    od = __builtin_amdgcn_mfma_f32_32x32x16_bf16(pa0, v0, od, 0, 0, 0);
    od = __builtin_amdgcn_mfma_f32_32x32x16_bf16(pa1, v1, od, 0, 0, 0);
    od = __builtin_amdgcn_mfma_f32_32x32x16_bf16(pa2, v2, od, 0, 0, 0);
    od = __builtin_amdgcn_mfma_f32_32x32x16_bf16(pa3, v3, od, 0, 0, 0);
}
template <int VOFF> __device__ __forceinline__ void pv_d0(f32x16* o, const VB& vb, bf16x8 pa0, bf16x8 pa1, bf16x8 pa2, bf16x8 pa3) {
    pv_one<0, VOFF>(o[0], vb, pa0, pa1, pa2, pa3); pv_one<1, VOFF>(o[1], vb, pa0, pa1, pa2, pa3); pv_one<2, VOFF>(o[2], vb, pa0, pa1, pa2, pa3); pv_one<3, VOFF>(o[3], vb, pa0, pa1, pa2, pa3);
}
template <int MODE, bool PRE, int VOFF>
__device__ __forceinline__ void pv_sm(f32x16* o, const VB& vb, bf16x8 pa0, bf16x8 pa1, bf16x8 pa2, bf16x8 pa3, f32x16& p0, f32x16& p1, float& m_reg, float& mn, float& alpha, const float C, const float thr_raw,
                                      int j, const TileMap& tm, const MaskInfo& mi, int wid, int r32, int hi, const float* btab, f32x16* negm = nullptr) {
    if constexpr (PRE) {
        pv_one<0, VOFF>(o[0], vb, pa0, pa1, pa2, pa3);
        apply_mask<MODE>(p0, p1, j, tm, mi, wid, r32, hi, btab);
        float pmax = p0[0];
#pragma unroll
        for (int r = 1; r < 16; ++r) pmax = fmaxf(pmax, p0[r]);
        pv_one<1, VOFF>(o[1], vb, pa0, pa1, pa2, pa3);
#pragma unroll
        for (int r = 0; r < 16; ++r) pmax = fmaxf(pmax, p1[r]);
        pv_one<2, VOFF>(o[2], vb, pa0, pa1, pa2, pa3);
        presm_decide(p0, p1, pmax, m_reg, alpha, *negm, false);
        pv_one<3, VOFF>(o[3], vb, pa0, pa1, pa2, pa3);
#pragma unroll
        for (int r = 0; r < 16; ++r) p0[r] = __builtin_amdgcn_exp2f(p0[r]);
        return;
    }
    pv_one<0, VOFF>(o[0], vb, pa0, pa1, pa2, pa3);
    apply_mask<MODE>(p0, p1, j, tm, mi, wid, r32, hi, btab);
    float pmax = p0[0];
#pragma unroll
    for (int r = 1; r < 16; ++r) pmax = fmaxf(pmax, p0[r]);
    pv_one<1, VOFF>(o[1], vb, pa0, pa1, pa2, pa3);
#pragma unroll
    for (int r = 0; r < 16; ++r) pmax = fmaxf(pmax, p1[r]);
    { auto rr = __builtin_amdgcn_permlane32_swap(__float_as_uint(pmax), __float_as_uint(pmax), false, false);
      pmax = fmaxf(__uint_as_float(rr[0]), __uint_as_float(rr[1])); }
    if (__builtin_expect(__all(pmax - m_reg <= thr_raw), 1)) { mn = m_reg; alpha = 1.f; }
    else { mn = fmaxf(m_reg, pmax); alpha = __builtin_amdgcn_exp2f((m_reg - mn) * C); m_reg = mn; }
    const float mnC = -mn * C;
    pv_one<2, VOFF>(o[2], vb, pa0, pa1, pa2, pa3);
#pragma unroll
    for (int r = 0; r < 16; ++r) p0[r] = fmaf(p0[r], C, mnC);
#pragma unroll
    for (int r = 0; r < 16; ++r) p1[r] = fmaf(p1[r], C, mnC);
    pv_one<3, VOFF>(o[3], vb, pa0, pa1, pa2, pa3);
#pragma unroll
    for (int r = 0; r < 16; ++r) p0[r] = __builtin_amdgcn_exp2f(p0[r]);
}

template <int MODE, bool PRE>
__device__ __forceinline__ void sm_alone(f32x16& p0, f32x16& p1, float& m_reg, float& mn, float& alpha, const float C, const float thr_raw,
                                         int j, const TileMap& tm, const MaskInfo& mi, int wid, int r32, int hi, const float* btab, f32x16& negm) {
    apply_mask<MODE>(p0, p1, j, tm, mi, wid, r32, hi, btab);
    if constexpr (PRE) { float pmax = p0[0];
#pragma unroll
        for (int r = 1; r < 16; ++r) pmax = fmaxf(pmax, p0[r]);
#pragma unroll
        for (int r = 0; r < 16; ++r) pmax = fmaxf(pmax, p1[r]);
        presm_decide(p0, p1, pmax, m_reg, alpha, negm, false);
#pragma unroll
        for (int r = 0; r < 16; ++r) p0[r] = __builtin_amdgcn_exp2f(p0[r]); }
    else partialSM(p0, p1, m_reg, mn, alpha, C, thr_raw);
}
template <int MODE, int DLO, int DHI, bool QLDS>
__device__ __forceinline__ void attn_core_dma(const bf16_t* __restrict__ Qb, const bf16_t* __restrict__ Kh, const bf16_t* __restrict__ Vh, const TileMap tm, const MaskInfo mi,
                                              const float C, const float thr_raw, char* lds, f32x16 (&o)[4], float& l_out, float& m_out) {
    const int tid = fresh_tid(), wid = tid >> 6, lane = tid & 63, r32 = lane & 31, hi = lane >> 5;
    const int widu = __builtin_amdgcn_readfirstlane(wid);
    char* V_lds = lds; char* K_lds = lds + 2 * SHM_V;
    float* ws = (float*)(lds + OFF_WS) + wid * 64; float* al_l = ws + 32;
    const float* btab = (const float*)(lds + OFF_BIAS);
    constexpr bool PRE = (PRESCALE != 0) && (MODE == 0 || L1PRE);
    float m_reg = PRE ? 0.f : -1e30f, l_reg = 0; f32x16 negm = f32x16{};
#pragma unroll
    for (int d = 0; d < 4; ++d) o[d] = f32x16{};
    bf16x8 qr[8];
    const unsigned qoff = (unsigned)((wid * QBLK + r32) * LDQK + hi * 8);
#pragma unroll
    for (int d0 = 0; d0 < 8; ++d0) { if (d0 >= DLO && d0 < DHI) qr[d0] = *reinterpret_cast<const bf16x8*>(Qb + qoff + d0 * 16); else qr[d0] = bf16x8{}; }
    const char* qlds = lds + OFF_STASH + tid * 16;
    if constexpr (QLDS) {
#pragma unroll
        for (int d0 = DLO; d0 < DHI; ++d0) *(bf16x8*)(lds + OFF_STASH + tid * 16 + d0 * 8192) = qr[d0];
        asm volatile("s_waitcnt lgkmcnt(0)" ::: "memory");
    }
    unsigned kso[2], vso[2];
#pragma unroll
    for (int i = 0; i < 2; ++i) { const int row = (i * 8 + wid) * 4 + (lane >> 4), col = ((lane & 15) ^ (row & 7)) * 8; kso[i] = (unsigned)(row * LDQK + col) * 2u;
        const int d = (i * 8 + wid) * 8 + (lane >> 3), c = (lane & 7) ^ ((d >> 1) & 7);
        vso[i] = (unsigned)(d * MROWS + c * 8) * 2u; }
    LAS unsigned char* Vd = (LAS unsigned char*)V_lds + widu * 1024; LAS unsigned char* Kd = (LAS unsigned char*)K_lds + widu * 1024;
    const VB vb0 = v_rd_base((int)(uintptr_t)V_lds, r32, hi);
#define DMAK(b, k0) do { const char* _g = (const char*)(Kh + (size_t)(k0) * LDQK); _Pragma("unroll") for (int _i = 0; _i < 2; ++_i) \
        __builtin_amdgcn_global_load_lds((const unsigned*)(_g + kso[_i]), (LAS unsigned*)(Kd + (b) * SHM_K + _i * 8192), 16, 0, 0); } while (0)
#define DMAV(b, k0) do { const char* _g = (const char*)(Vh + (size_t)(k0)); _Pragma("unroll") for (int _i = 0; _i < 2; ++_i) \
        __builtin_amdgcn_global_load_lds((const unsigned*)(_g + vso[_i]), (LAS unsigned*)(Vd + (b) * SHM_V + _i * 8192), 16, 0, 0); } while (0)
#define LANDED() do { asm volatile("s_waitcnt vmcnt(0)" ::: "memory"); __builtin_amdgcn_s_barrier(); asm volatile("" ::: "memory"); } while (0)
#define RESC(a) do { if (__any((a) < 1.f)) { if (hi == 0) al_l[r32] = (a); asm volatile("s_waitcnt lgkmcnt(0)" ::: "memory"); \
    _Pragma("unroll") for (int d = 0; d < 4; ++d) _Pragma("unroll") for (int r = 0; r < 16; ++r) o[d][r] *= al_l[crow(r, hi)]; } } while (0)
    f32x16 pA0, pA1, pB0, pB1; float mnA, mnB, alA, alB; bf16x8 pa0, pa1, pa2, pa3; const int NT = tm.NT;
    DMAK(0, tm.krow(0)); DMAV(0, tm.krow(0)); DMAK(1, tm.krow(1)); LANDED();
    qkt<DLO, DHI, QLDS, PRE>(pA0, pA1, K_lds, qr, qlds, r32, hi, negm); apply_mask<MODE>(pA0, pA1, 0, tm, mi, wid, r32, hi, btab);
    if constexpr (PRE) { float pmax = pA0[0];
#pragma unroll
        for (int r = 1; r < 16; ++r) pmax = fmaxf(pmax, pA0[r]);
#pragma unroll
        for (int r = 0; r < 16; ++r) pmax = fmaxf(pmax, pA1[r]);
        presm_decide(pA0, pA1, pmax, m_reg, alA, negm, true);
#pragma unroll
        for (int r = 0; r < 16; ++r) pA0[r] = __builtin_amdgcn_exp2f(pA0[r]); }
    else partialSM(pA0, pA1, m_reg, mnA, alA, C, thr_raw);
    asm volatile("s_waitcnt lgkmcnt(0)" ::: "memory"); __builtin_amdgcn_s_barrier(); asm volatile("" ::: "memory");
    auto ACT = [&](int j) -> bool {
        if constexpr (MODE == 0 || !TSKIP) return true;
        else { if (j < tm.NC) return true;
            if constexpr (MODE == 1) { const int kp0 = tm.lbase + 64 * (j - tm.NC), qw = mi.q0 + widu * 32; return !(kp0 + 63 - qw < -128 || kp0 - (qw + 31) > 128); }
            else { const int kr = mi.lo + (j - tm.NC), rq = mi.r0 + (widu >> 1); int rs = rq - 4; rs = rs < 0 ? 0 : (rs > 56 ? 56 : rs); return kr >= rs && kr < rs + 8; } } };
#define STEPX(PC0, PC1, ALC, MNC, PP0, PP1, ALP, KOFF, VOFF, JC, LIVE) do { \
        if (LIVE) { SBAR(); qkt<DLO, DHI, QLDS, PRE>(PC0, PC1, K_lds + (KOFF), qr, qlds, r32, hi, negm); \
            finishSM(PP0, PP1, ALP, l_reg, pa0, pa1, pa2, pa3); SBAR(); \
            pv_sm<MODE, PRE, VOFF>(o, vb0, pa0, pa1, pa2, pa3, PC0, PC1, m_reg, MNC, ALC, C, thr_raw, JC, tm, mi, wid, r32, hi, btab, &negm); \
            RESC(ALC); } \
        else { _Pragma("unroll") for (int r_ = 0; r_ < 16; ++r_) { PC0[r_] = 0.f; PC1[r_] = -1e30f; } ALC = 1.f; } } while (0)
    bool aA = true, aB;
    for (int j = 1; j + 1 < NT; j += 2) {
        DMAK(0, tm.krow(j + 1)); DMAV(1, tm.krow(j)); aB = ACT(j);
        STEPX(pB0, pB1, alB, mnB, pA0, pA1, alA, SHM_K, 0, j, (aA || aB));
        LANDED();
        DMAK(1, tm.krow(j + 2)); DMAV(0, tm.krow(j + 1)); aA = ACT(j + 1);
        STEPX(pA0, pA1, alA, mnA, pB0, pB1, alB, 0, SHM_V, j + 1, (aB || aA));
        LANDED();
    }
    DMAV(1, tm.krow(NT - 1)); aB = ACT(NT - 1);
    STEPX(pB0, pB1, alB, mnB, pA0, pA1, alA, SHM_K, 0, NT - 1, (aA || aB));
    LANDED();
    if (aB) { finishSM(pB0, pB1, alB, l_reg, pa0, pa1, pa2, pa3); SBAR();
        pv_d0<SHM_V>(o, vb0, pa0, pa1, pa2, pa3); }
    l_out = l_reg; m_out = m_reg;
#undef DMAK
#undef DMAV
#undef LANDED
#undef RESC
#undef STEPX
}
__device__ __forceinline__ void normalise(f32x16 (&o)[4], float l_reg, char* lds) {
    const int tid = fresh_tid(), wid = tid >> 6, lane = tid & 63, r32 = lane & 31, hi = lane >> 5;
    float* li_l = (float*)(lds + OFF_WS) + wid * 64;
    if (hi == 0) li_l[r32] = l_reg; asm volatile("s_waitcnt lgkmcnt(0)" ::: "memory");
#pragma unroll
    for (int r = 0; r < 16; ++r) { const float rl = __builtin_amdgcn_rcpf(li_l[crow(r, hi)]);
#pragma unroll
        for (int d0 = 0; d0 < 4; ++d0) o[d0][r] *= rl; }
    asm volatile("s_waitcnt lgkmcnt(0)" ::: "memory");
}
__device__ __forceinline__ void store_o(const f32x16 (&o)[4], bf16_t* Ob) {
    const int tid = fresh_tid(), wid = tid >> 6, lane = tid & 63, r32 = lane & 31, hi = lane >> 5;
    __hip_bfloat16* Ow = (__hip_bfloat16*)Ob + (long)(wid * QBLK) * LDO;
#pragma unroll
    for (int r = 0; r < 16; ++r) { const int orow = crow(r, hi);
#pragma unroll
        for (int d0 = 0; d0 < 4; ++d0) Ow[(long)orow * LDO + d0 * 32 + r32] = __float2bfloat16(o[d0][r]); }
}
__device__ __forceinline__ void store_o8(const f32x16 (&o)[4], unsigned char* Ob8) {
    const int tid = fresh_tid(), wid = tid >> 6, lane = tid & 63, r32 = lane & 31, hi = lane >> 5;
    unsigned char* Ow = Ob8 + (long)(wid * QBLK) * LDO;
#pragma unroll
    for (int r = 0; r < 16; r += 2) { const int orow = crow(r, hi);
#pragma unroll
        for (int d0 = 0; d0 < 4; ++d0) { const int w = __builtin_amdgcn_cvt_pk_fp8_f32(clamp8(o[d0][r] * S_A8), clamp8(o[d0][r + 1] * S_A8), 0, false);
            Ow[(long)orow * LDO + d0 * 32 + r32] = (unsigned char)(w & 0xff); Ow[(long)(orow + 1) * LDO + d0 * 32 + r32] = (unsigned char)((w >> 8) & 0xff); } }
}
template <int MODE>
__device__ __forceinline__ void unit_std(const bf16_t* Qb, const bf16_t* Kh, const bf16_t* Vh, const TileMap tm, const MaskInfo mi, float sink, bf16_t* Ob, char* lds) {
    f32x16 o[4]; float l, m;
    const float C = ATT_SCALE * LOG2E;
    attn_core_dma<MODE, 0, 8, (MODE != 0)>(Qb, Kh, Vh, tm, mi, C, THR / ATT_SCALE, lds, o, l, m);
    if constexpr (MODE == 1) l += __builtin_amdgcn_exp2f(sink * LOG2E - ((PRESCALE && L1PRE) ? m : m * C));
    normalise(o, l, lds);
    if constexpr (MODE != 0 && L1ATT_FP8) store_o8(o, (unsigned char*)Ob); else store_o(o, Ob);
    __syncthreads();
}
__device__ __forceinline__ void unit_diff(const bf16_t* Qb, const bf16_t* Kh, const bf16_t* Vh, const TileMap tm, float lam, const float* subln_g, bf16_t* Ob, char* lds) {
    const int tid = fresh_tid(), lane = tid & 63, r32 = lane & 31;
    f32x16 o[4]; float l, m; const MaskInfo mi{0, 0, 0};
    const float C = A_SCALE * LOG2E;
    unsigned* stash = (unsigned*)(lds + OFF_STASH);
    attn_core_dma<0, 0, 4, false>(Qb, Kh, Vh, tm, mi, C, THR / A_SCALE, lds, o, l, m);
    normalise(o, l, lds);
#pragma unroll
    for (int d0 = 0; d0 < 4; ++d0)
#pragma unroll
        for (int r = 0; r < 16; r += 2) stash[(d0 * 8 + (r >> 1)) * 512 + tid] = cvt_pk_bf16(o[d0][r], o[d0][r + 1]);
    __syncthreads();
    attn_core_dma<0, 4, 8, false>(Qb, Kh, Vh, tm, mi, C, THR / A_SCALE, lds, o, l, m);
    normalise(o, l, lds);
    float ss[16];
#pragma unroll
    for (int r = 0; r < 16; ++r) ss[r] = 0.f;
#pragma unroll
    for (int d0 = 0; d0 < 4; ++d0)
#pragma unroll
        for (int r = 0; r < 16; r += 2) { const unsigned w = stash[(d0 * 8 + (r >> 1)) * 512 + tid];
            const float a = bf_lo(w) - lam * o[d0][r], b = bf_hi(w) - lam * o[d0][r + 1];
            o[d0][r] = a; o[d0][r + 1] = b; ss[r] += a * a; ss[r + 1] += b * b; }
#pragma unroll
    for (int r = 0; r < 16; ++r) {
#pragma unroll
        for (int x = 1; x < 32; x <<= 1) ss[r] += __shfl_xor(ss[r], x);
        ss[r] = (1.0f - LAMBDA_INIT) / sqrtf(ss[r] * (1.0f / 128.0f) + EPS); }
    float gg[4];
#pragma unroll
    for (int d0 = 0; d0 < 4; ++d0) gg[d0] = subln_g[d0 * 32 + r32];
#pragma unroll
    for (int d0 = 0; d0 < 4; ++d0)
#pragma unroll
        for (int r = 0; r < 16; ++r) o[d0][r] *= ss[r] * gg[d0];
    store_o(o, Ob);
    __syncthreads();
}
#undef SBAR
}

#define XB_TMO      128
#define XB_XCNT(j)  (256  + 64 * (j))
#define XB_XSUB(j)  (1280 + 64 * (j))
#define XB_XGEN(j)  (2304 + 64 * (j))
#define XB_TOP      3328
#define XB_TOPGEN   3392
#define XCD_BAR_WORDS 3456
#define XB_SPIN_CAP (1u << 22)
__device__ __forceinline__ unsigned xb_ld(unsigned* p)              { return __hip_atomic_load(p, __ATOMIC_RELAXED, __HIP_MEMORY_SCOPE_AGENT); }
__device__ __forceinline__ unsigned xb_add(unsigned* p, unsigned v) { return __hip_atomic_fetch_add(p, v, __ATOMIC_RELAXED, __HIP_MEMORY_SCOPE_AGENT); }
__device__ __forceinline__ unsigned xb_xcc_id() { return (unsigned)__builtin_amdgcn_s_getreg((3 << 11) | 20) & 0xFu; }
#define XB_SPIN(cond, bar) do { unsigned _sp = 0; while (cond) { __builtin_amdgcn_s_sleep(1); \
    if ((++_sp & 255u) == 0u) { if (xb_ld(&(bar)[XB_TMO])) break; if (_sp > XB_SPIN_CAP) { atomicAdd(&(bar)[XB_TMO], 1u); break; } } } } while (0)
struct XcdBarrier { unsigned* bar; unsigned x; volatile LAS unsigned* st; };
__device__ __forceinline__ XcdBarrier xcd_barrier_post(unsigned* bar, volatile LAS unsigned* st) {
    XcdBarrier b; b.bar = bar; b.x = xb_xcc_id(); b.st = st;
    if (threadIdx.x == 0) (void)xb_add(&bar[XB_XCNT(b.x)], 1u);
    return b;
}
__device__ __forceinline__ void xcd_barrier_complete(unsigned* bar, unsigned x, unsigned& nloc, unsigned& nx) {
    const unsigned G = gridDim.x * gridDim.y * gridDim.z;
    unsigned sum, cnt, mine, sp = 0u;
    for (;;) {
        sum = 0u; cnt = 0u; mine = 0u;
#pragma unroll
        for (unsigned j = 0; j < 16; ++j) { const unsigned c = xb_ld(&bar[XB_XCNT(j)]); sum += c; cnt += (c > 0u) ? 1u : 0u; mine = (j == x) ? c : mine; }
        if (sum == G) break;
        __builtin_amdgcn_s_sleep(1);
        if ((++sp & 255u) == 0u) { if (xb_ld(&bar[XB_TMO])) break; if (sp > XB_SPIN_CAP) { atomicAdd(&bar[XB_TMO], 1u); break; } }
    }
    nloc = mine > 0u ? mine : 1u; nx = cnt > 0u ? cnt : 1u;
}
__device__ __forceinline__ void xcd_barrier(const XcdBarrier& b) {
    asm volatile("s_waitcnt vmcnt(0)" ::: "memory");
    __syncthreads();
    if (threadIdx.x == 0) {
        unsigned* bar = b.bar;
        __builtin_amdgcn_s_waitcnt(0);
        unsigned nloc = b.st[0], nx = b.st[1];
        if (nloc == 0u) { xcd_barrier_complete(bar, b.x, nloc, nx); b.st[0] = nloc; b.st[1] = nx; }
        const unsigned old = xb_add(&bar[XB_XSUB(b.x)], 1u);
        const unsigned gen = old / nloc;
        if (old + 1u == (gen + 1u) * nloc) {
            __builtin_amdgcn_fence(__ATOMIC_RELEASE, "agent");
            asm volatile("s_waitcnt vmcnt(0)" ::: "memory");
            const unsigned og = xb_add(&bar[XB_TOP], 1u);
            const unsigned tg = og / nx;
            if (og + 1u == (tg + 1u) * nx) xb_add(&bar[XB_TOPGEN], 1u);
            else XB_SPIN(xb_ld(&bar[XB_TOPGEN]) == tg, bar);
            __builtin_amdgcn_fence(__ATOMIC_ACQUIRE, "agent");
            xb_add(&bar[XB_XGEN(b.x)], 1u);
            asm volatile("s_waitcnt vmcnt(0)" ::: "memory");
        } else {
            XB_SPIN(xb_ld(&bar[XB_XGEN(b.x)]) == gen, bar);
            __builtin_amdgcn_fence(__ATOMIC_ACQUIRE, "agent");
            asm volatile("s_waitcnt vmcnt(0)" ::: "memory");
        }
    }
    __syncthreads();
}

struct Args { const float* in[33]; float* out; unsigned char* ws; int ph_lo, ph_hi; };
struct Frame {
    LAS unsigned char* lds; int vcu, G;
};

__device__ __forceinline__ void transpose_item(const float* W, int ldw, int K, bf16_t* WT, int k0, int n0, long dst_row0, LAS float* scr, int lane) {
    { float tv[32]; const float* wp = W + (size_t)(k0 + (lane >> 5)) * ldw + n0 + (lane & 31);
#pragma unroll
      for (int i = 0; i < 32; ++i) tv[i] = wp[(size_t)(2 * i) * ldw];
#pragma unroll
      for (int i = 0; i < 32; ++i) scr[(2 * i + (lane >> 5)) * 33 + (lane & 31)] = tv[i]; }
    LDS_WAIT(); asm volatile("" ::: "memory");
    const int c = lane & 7;
#pragma unroll
    for (int j = 0; j < 4; ++j) { const int n = (lane >> 3) + 8 * j; const LAS float* s = scr + (8 * c) * 33 + n;
        u32x4 o; o.x = cvt_pk_bf16(s[0 * 33], s[1 * 33]); o.y = cvt_pk_bf16(s[2 * 33], s[3 * 33]); o.z = cvt_pk_bf16(s[4 * 33], s[5 * 33]); o.w = cvt_pk_bf16(s[6 * 33], s[7 * 33]);
        *(GAS u32x4*)(WT + (size_t)(dst_row0 + n) * K + k0 + 8 * c) = o; }
    LDS_WAIT(); asm volatile("" ::: "memory");
}
__device__ __forceinline__ void transpose_item8(const float* W, int ldw, int K, unsigned char* WT, int k0, int n0, long dst_row0, LAS float* scr, int lane, float scale) {
#pragma unroll
    for (int hb = 0; hb < 2; ++hb) { float tv[32]; const float* wp = W + (size_t)(k0 + 64 * hb + (lane >> 5)) * ldw + n0 + (lane & 31);
#pragma unroll
        for (int i = 0; i < 32; ++i) tv[i] = wp[(size_t)(2 * i) * ldw];
#pragma unroll
        for (int i = 0; i < 32; ++i) { const int kk = 64 * hb + 2 * i + (lane >> 5); scr[kk * 32 + (((lane & 31) + 8 * (kk >> 4)) & 31)] = tv[i]; } }
    LDS_WAIT(); asm volatile("" ::: "memory");
    const int c = lane & 7;
#pragma unroll
    for (int j = 0; j < 4; ++j) { const int n = (lane >> 3) + 8 * j; const LAS float* s = scr + (16 * c) * 32 + ((n + 8 * c) & 31);
        u32x4 o;
        o.x = pk4_fp8(s[0 * 32] * scale, s[1 * 32] * scale, s[2 * 32] * scale, s[3 * 32] * scale); o.y = pk4_fp8(s[4 * 32] * scale, s[5 * 32] * scale, s[6 * 32] * scale, s[7 * 32] * scale);
        o.z = pk4_fp8(s[8 * 32] * scale, s[9 * 32] * scale, s[10 * 32] * scale, s[11 * 32] * scale); o.w = pk4_fp8(s[12 * 32] * scale, s[13 * 32] * scale, s[14 * 32] * scale, s[15 * 32] * scale);
        *(GAS u32x4*)(WT + (size_t)(dst_row0 + n) * K + k0 + 16 * c) = o; }
    LDS_WAIT(); asm volatile("" ::: "memory");
}
__device__ __forceinline__ void tr_plain8(const float* W, int K, int N, unsigned char* WT, long row_off, LAS float* scr, int item, int lane) {
    const int nblk = N / 32, kb = item / nblk, nb = item % nblk;
    transpose_item8(W, N, K, WT, 128 * kb, 32 * nb, row_off + 32 * nb, scr, lane, S_W8);
}
__device__ __forceinline__ void tr_gu8(const float* W, int K, int N, unsigned char* WT, long row_off, int up, LAS float* scr, int item, int lane) {
    const int nblk = N / 32, kb = item / nblk, nb = item % nblk, n0 = 32 * nb;
    transpose_item8(W, N, K, WT, 128 * kb, n0, row_off + (long)(n0 >> 7) * 256 + (n0 & 127) + up * 128, scr, lane, S_W8);
}
__device__ __forceinline__ void tr_plain(const float* W, int K, int N, bf16_t* WT, long row_off, LAS float* scr, int item, int lane) {
    const int nblk = N / 32, kb = item / nblk, nb = item % nblk;
    transpose_item(W, N, K, WT, 64 * kb, 32 * nb, row_off + 32 * nb, scr, lane);
}
__device__ __forceinline__ void tr_gu(const float* W, int K, int N, bf16_t* WT, long row_off, int up, LAS float* scr, int item, int lane) {
    const int nblk = N / 32, kb = item / nblk, nb = item % nblk, n0 = 32 * nb;
    transpose_item(W, N, K, WT, 64 * kb, n0, row_off + (long)(n0 >> 7) * 256 + (n0 & 127) + up * 128, scr, lane);
}

template <bool OUT8 = false>
__device__ __forceinline__ void mod_row(const float* xrow, const float* g, const float* sh, const float* sc, bf16_t* orow, int lane, f32x4 (&v)[8], const float* xs = nullptr, size_t xs_stride = 0, int nxs = 0, float* xout = nullptr) {
    const f32x4* xr = (const f32x4*)xrow + lane;
    float s = 0.f;
#pragma unroll
    for (int j = 0; j < 8; ++j) { v[j] = xr[64 * j];
        if (xs) {
#pragma unroll
            for (int p = 0; p < 8; ++p) if (p < nxs) v[j] += ((const f32x4*)(xs + p * xs_stride))[64 * j + lane];
            if (xout) ((f32x4*)xout)[64 * j + lane] = v[j]; }
        s += (v[j].x * v[j].x + v[j].y * v[j].y) + (v[j].z * v[j].z + v[j].w * v[j].w); }
    const float rstd = 1.0f / sqrtf(wave_sum(s) * (1.0f / DM) + EPS);
    u32x2* o8 = (u32x2*)orow + lane;
#pragma unroll
    for (int j = 0; j < 8; ++j) { const f32x4 gg = ((const f32x4*)g)[64 * j + lane], ss = ((const f32x4*)sc)[64 * j + lane], hh = ((const f32x4*)sh)[64 * j + lane];
        v[j] = v[j] * rstd * gg * (ss + 1.0f) + hh;
        if constexpr (OUT8) ((unsigned*)orow)[64 * j + lane] = pk4_fp8(v[j].x * S_H8, v[j].y * S_H8, v[j].z * S_H8, v[j].w * S_H8);
        else { u32x2 w; w.x = cvt_pk_bf16(v[j].x, v[j].y); w.y = cvt_pk_bf16(v[j].z, v[j].w); o8[64 * j] = w; } }
}
__device__ __forceinline__ const float* in_row(const float* x, const float* ctx, int row) {
    const int b = row / RPB, t = row % RPB;
    return t < SEQ ? x + ((size_t)b * SEQ + t) * DM : ctx + ((size_t)b * NCTX + (t - SEQ)) * DM;
}

__device__ __forceinline__ void rope8(float (&f)[8], const float* cs, const float* sn) {
    const f32x4 c = *(const f32x4*)cs, s = *(const f32x4*)sn;
#pragma unroll
    for (int p = 0; p < 4; ++p) { const float x0 = f[2 * p], x1 = f[2 * p + 1]; f[2 * p] = x0 * c[p] - x1 * s[p]; f[2 * p + 1] = x0 * s[p] + x1 * c[p]; }
}
__device__ __forceinline__ void unpack8(const u32x4 w, float (&f)[8]) { f[0] = bf_lo(w.x); f[1] = bf_hi(w.x); f[2] = bf_lo(w.y); f[3] = bf_hi(w.y); f[4] = bf_lo(w.z); f[5] = bf_hi(w.z); f[6] = bf_lo(w.w); f[7] = bf_hi(w.w); }
__device__ __forceinline__ u32x4 pack8(const float (&f)[8]) { u32x4 w; w.x = cvt_pk_bf16(f[0], f[1]); w.y = cvt_pk_bf16(f[2], f[3]); w.z = cvt_pk_bf16(f[4], f[5]); w.w = cvt_pk_bf16(f[6], f[7]); return w; }
template <bool NORM, int ROPE_DIM>
__device__ __forceinline__ void fix_span(bf16_t* rowp, int col0, int nvec, const float* g, const float* cosT, const float* sinT, int lane) {
    for (int v = lane; v < nvec; v += 64) {
        const int e0 = v * 8;
        u32x4 w = *(u32x4*)(rowp + col0 + e0); float f[8]; unpack8(w, f);
        if constexpr (NORM) {
            float s = 0.f;
#pragma unroll
            for (int i = 0; i < 8; ++i) s += f[i] * f[i];
            s += __shfl_xor(s, 1); s += __shfl_xor(s, 2); s += __shfl_xor(s, 4); s += __shfl_xor(s, 8);
            const float rstd = 1.0f / sqrtf(s * (1.0f / 128.0f) + EPS);
            const f32x4 g0 = *(const f32x4*)(g + (e0 & 127)), g1 = *(const f32x4*)(g + (e0 & 127) + 4);
#pragma unroll
            for (int i = 0; i < 4; ++i) { f[i] = f[i] * rstd * g0[i]; f[4 + i] = f[4 + i] * rstd * g1[i]; }
        }
        if constexpr (ROPE_DIM == 64) { const int p0 = (e0 & 63) >> 1; rope8(f, cosT + p0, sinT + p0); }
        if constexpr (ROPE_DIM == 128) { const int p0 = (e0 & 127) >> 1; rope8(f, cosT + p0, sinT + p0); }
        *(u32x4*)(rowp + col0 + e0) = pack8(f);
    }
}

__global__ void __launch_bounds__(512, 2) hybrid_fwd(Args args) {
    extern __shared__ __attribute__((aligned(16))) unsigned char lds[];
    Frame F;
    F.lds = (LAS unsigned char*)lds;
    F.G = gridDim.x; { const int bx = blockIdx.x; F.vcu = (F.G % 8 == 0) ? (bx % 8) * (F.G / 8) + bx / 8 : bx; }
    volatile LAS unsigned* MISC = (volatile LAS unsigned*)(F.lds + MISC_OFF);
    unsigned char* ws = args.ws;
    gu32* ctl = (gu32*)(ws + WS_CTL);
    for (int u = threadIdx.x; u < 64; u += 512) MISC[u] = 0u;
    __syncthreads();
    XcdBarrier bar; bar.bar = (unsigned*)(ctl + CW_BAR); bar.x = 0; bar.st = nullptr;
#if !MK_PER_PHASE
    bar = xcd_barrier_post((unsigned*)(ctl + CW_BAR), MISC + 8);
#define GRID_BAR() xcd_barrier(bar)
#else
#define GRID_BAR() do { } while (0)
#endif
    const int lo = args.ph_lo, hi = args.ph_hi;
#ifndef PH_MASK
#define PH_MASK 0xFFFFFu
#endif
#define IN(k) ((((PH_MASK) >> (k)) & 1u) && lo <= (k) && (k) < hi)
#ifndef DBL_MASK
#define DBL_MASK 0u
#endif
#define NREP(k) ((((DBL_MASK) >> (k)) & 1u) ? 2 : 1)
#define SEAM(k) do { if (IN(k) && IN((k) + 1)) GRID_BAR(); } while (0)

#define MODS ((float*)(ws + WS_MODS))
#define ADAP ((float*)(ws + WS_ADAP))
#define cosA ((float*)(ws + WS_ROPE))
#define sinA (cosA + 4096 * 32)
#define cosB (cosA + 2 * 4096 * 32)
#define sinB (cosA + 2 * 4096 * 32 + 4096 * 64)
#define ROUTE ((int*)(ws + WS_ROUTE))
#define GATES ((float*)(ws + WS_GATES))
#define SLOT ((int*)(ws + WS_SLOT))
#define CNT ((int*)(ws + WS_CNT))
#define TILEE ((int*)(ws + WS_TILEE))
#define W_IN0 ((bf16_t*)(ws + WS_WIN0))
#define W_OUT0 ((bf16_t*)(ws + WS_WOUT0))
#define W_GU0 ((bf16_t*)(ws + WS_WGU0))
#define W_DN0 ((bf16_t*)(ws + WS_WDN0))
#define W_IN1 ((bf16_t*)(ws + WS_WIN1))
#define W_OUT1 ((bf16_t*)(ws + WS_WOUT1))
#define W_GU1 ((bf16_t*)(ws + WS_WGU1))
#define W_DN1 ((bf16_t*)(ws + WS_WDN1))
#define XR ((float*)(ws + WS_XR))
#define H ((bf16_t*)(ws + WS_H))
#define AO ((bf16_t*)(ws + WS_AO))
#define Y ((bf16_t*)(ws + WS_Y))
#define QKV ((bf16_t*)(ws + WS_QKV))
#define XG ((bf16_t*)(ws + WS_XG))
#define MID ((bf16_t*)(ws + WS_MID))
#define MODS1 (MODS + 5 * 12288)
#define SLAB0 ((float*)(ws + WS_SLAB0))
#define SLAB1 ((float*)(ws + WS_SLAB1))
#define SLABW ((float*)(ws + WS_SLABW))
#define VTB ((bf16_t*)(ws + WS_VT))
#define x_in (args.in[0])
#define c_in (args.in[1])
#define ctx_in (args.in[2])
#define cctx_in (args.in[3])
    const int NGW = F.G * 8;
#define PH_LOCALS const int tid = fresh_tid(), lane = tid & 63, wave = __builtin_amdgcn_readfirstlane(tid >> 6), gw = F.vcu * 8 + wave; (void)tid; (void)lane; (void)wave; (void)gw

    if (IN(0)) for (int rep_ = 0; rep_ < NREP(0); ++rep_) {
        PH_LOCALS;
        LAS float* scr = (LAS float*)(F.lds + wave * 16384);
        LAS float* sil = (LAS float*)(F.lds + 98304);
        __syncthreads();
        for (int i = tid; i < 5 * DM; i += 512) { const float v = (i < 4 * DM) ? c_in[i] : cctx_in[i - 4 * DM]; sil[i] = v / (1.0f + __expf(-v)); }
        __syncthreads();
        for (int it = gw; it < 2 * 48 * 32; it += NGW) {
            const int l = it / (48 * 32), r = it % (48 * 32), cg = r / 32, kc = r % 32;
            const float* W = args.in[l ? 22 : 6] + (size_t)(kc * 64) * 12288 + cg * 256 + lane * 4;
            f32x4 a[5];
#pragma unroll
            for (int b = 0; b < 5; ++b) a[b] = (f32x4){0.f, 0.f, 0.f, 0.f};
#pragma unroll 8
            for (int k = 0; k < 64; ++k) { const f32x4 w = *(const f32x4*)(W + (size_t)k * 12288);
#pragma unroll
                for (int b = 0; b < 5; ++b) a[b] += w * sil[b * DM + kc * 64 + k]; }
#pragma unroll
            for (int b = 0; b < 5; ++b) *(f32x4*)(ADAP + ((size_t)(l * 32 + kc) * 5 + b) * 12288 + cg * 256 + lane * 4) = a[b];
        }
        __syncthreads();
        {
            constexpr int I_IN = (DM / 64) * (PROJ / 32), I_OUT = (DM / 64) * (DM / 32);
            constexpr int I_GU = (FFN0_FP8 == 2) ? (DM / 128) * (DFF / 32) : (DM / 64) * (DFF / 32), I_DN = (FFN0_FP8 >= 1) ? (DFF / 128) * (DM / 32) : (DFF / 64) * (DM / 32);
            constexpr int I_EGU = (DM / 128) * (DEX / 32), I_EDN = (DEX / 128) * (DM / 32);
            constexpr int I_IN8 = (DM / 128) * (PROJ / 32), I_OUT8 = (DM / 128) * (DM / 32);
            constexpr int NIT = I_IN + (L1ATT_FP8 ? I_IN8 : I_IN) + I_OUT + (L1ATT_FP8 ? I_OUT8 : I_OUT) + 2 * I_GU + I_DN;
            for (int it = gw; it < NIT; it += NGW) {
                int r = it;
                if (r < I_IN) { tr_plain(args.in[8], DM, PROJ, W_IN0, 0, scr, r, lane); continue; } r -= I_IN;
#if L1ATT_FP8
                if (r < I_IN8) { tr_plain8(args.in[24], DM, PROJ, (unsigned char*)W_IN1, 0, scr, r, lane); continue; } r -= I_IN8;
#else
                if (r < I_IN) { tr_plain(args.in[24], DM, PROJ, W_IN1, 0, scr, r, lane); continue; } r -= I_IN;
#endif
                if (r < I_OUT) { tr_plain(args.in[9], DM, DM, W_OUT0, 0, scr, r, lane); continue; } r -= I_OUT;
#if L1ATT_FP8
                if (r < I_OUT8) { tr_plain8(args.in[25], DM, DM, (unsigned char*)W_OUT1, 0, scr, r, lane); continue; } r -= I_OUT8;
#else
                if (r < I_OUT) { tr_plain(args.in[25], DM, DM, W_OUT1, 0, scr, r, lane); continue; } r -= I_OUT;
#endif
#if FFN0_FP8 == 2
                if (r < I_GU) { tr_gu8(args.in[17], DM, DFF, (unsigned char*)W_GU0, 0, 0, scr, r, lane); continue; } r -= I_GU;
                if (r < I_GU) { tr_gu8(args.in[18], DM, DFF, (unsigned char*)W_GU0, 0, 1, scr, r, lane); continue; } r -= I_GU;
#else
                if (r < I_GU) { tr_gu(args.in[17], DM, DFF, W_GU0, 0, 0, scr, r, lane); continue; } r -= I_GU;
                if (r < I_GU) { tr_gu(args.in[18], DM, DFF, W_GU0, 0, 1, scr, r, lane); continue; } r -= I_GU;
#endif
#if FFN0_FP8 >= 1
                if (r < I_DN) { tr_plain8(args.in[19], DFF, DM, (unsigned char*)W_DN0, 0, scr, r, lane); continue; } r -= I_DN;
#else
                if (r < I_DN) { tr_plain(args.in[19], DFF, DM, W_DN0, 0, scr, r, lane); continue; } r -= I_DN;
#endif
            }
            constexpr int NITX = NE * (2 * I_EGU + I_EDN);
            const float* wp; int ldw; unsigned char* wt; int Kb;
#define XDECODE(IT, WP, LDW, WT, KB) do { int r_ = (IT); const int e_ = r_ / (2 * I_EGU + I_EDN); r_ -= e_ * (2 * I_EGU + I_EDN); \
                if (r_ < 2 * I_EGU) { const int up_ = r_ >= I_EGU; r_ -= up_ * I_EGU; const int nblk_ = DEX / 32, kb_ = r_ / nblk_, n0_ = 32 * (r_ % nblk_); \
                    WP = args.in[29 + up_] + (size_t)e_ * DM * DEX + (size_t)(128 * kb_ + (lane >> 5)) * DEX + n0_ + (lane & 31); LDW = DEX; KB = DM; \
                    WT = (unsigned char*)W_GU1 + ((size_t)e_ * 2 * DEX + (size_t)(n0_ >> 7) * 256 + (n0_ & 127) + up_ * 128) * DM + 128 * kb_; } \
                else { r_ -= 2 * I_EGU; const int nblk_ = DM / 32, kb_ = r_ / nblk_, n0_ = 32 * (r_ % nblk_); \
                    WP = args.in[31] + (size_t)e_ * DEX * DM + (size_t)(128 * kb_ + (lane >> 5)) * DM + n0_ + (lane & 31); LDW = DM; KB = DEX; \
                    WT = (unsigned char*)W_DN1 + ((size_t)e_ * DM + n0_) * DEX + 128 * kb_; } } while (0)
#define XLOAD(T, WP, LDW, HB) do { _Pragma("unroll") for (int i_ = 0; i_ < 32; ++i_) T[i_] = (WP)[(size_t)(64 * (HB) + 2 * i_) * (LDW)]; } while (0)
#define XWRITE(T, HB) do { _Pragma("unroll") for (int i_ = 0; i_ < 32; ++i_) { const int kk_ = 64 * (HB) + 2 * i_ + (lane >> 5); scr[kk_ * 32 + (((lane & 31) + 8 * (kk_ >> 4)) & 31)] = T[i_]; } } while (0)
            float ta[32], tb[32];
            int itx = gw;
            if (itx < NITX) { XDECODE(itx, wp, ldw, wt, Kb); XLOAD(ta, wp, ldw, 0); }
            while (itx < NITX) {
                XLOAD(tb, wp, ldw, 1);
                XWRITE(ta, 0);
                unsigned char* wt_c = wt; const int Kb_c = Kb;
                const int nxt = itx + NGW;
                if (nxt < NITX) { XDECODE(nxt, wp, ldw, wt, Kb); XLOAD(ta, wp, ldw, 0); }
                XWRITE(tb, 1);
                LDS_WAIT(); asm volatile("" ::: "memory");
                { const int c = lane & 7;
#pragma unroll
                  for (int j = 0; j < 4; ++j) { const int n = (lane >> 3) + 8 * j; const LAS float* sp = scr + (16 * c) * 32 + ((n + 8 * c) & 31);
                      u32x4 o;
                      o.x = pk4_fp8(sp[0 * 32] * S_W8, sp[1 * 32] * S_W8, sp[2 * 32] * S_W8, sp[3 * 32] * S_W8); o.y = pk4_fp8(sp[4 * 32] * S_W8, sp[5 * 32] * S_W8, sp[6 * 32] * S_W8, sp[7 * 32] * S_W8);
                      o.z = pk4_fp8(sp[8 * 32] * S_W8, sp[9 * 32] * S_W8, sp[10 * 32] * S_W8, sp[11 * 32] * S_W8); o.w = pk4_fp8(sp[12 * 32] * S_W8, sp[13 * 32] * S_W8, sp[14 * 32] * S_W8, sp[15 * 32] * S_W8);
                      *(GAS u32x4*)(wt_c + (size_t)n * Kb_c + 16 * c) = o; } }
                LDS_WAIT(); asm volatile("" ::: "memory");
                itx = nxt;
            }
#undef XDECODE
#undef XLOAD
#undef XWRITE
        }
    }
    SEAM(0);
    if (IN(1)) for (int rep_ = 0; rep_ < NREP(1); ++rep_) {
        PH_LOCALS;
        for (int i = blockIdx.x * 512 + tid; i < 2 * 5 * 12288; i += F.G * 512) {
            const int l = i / (5 * 12288), r = i % (5 * 12288), b = r / 12288, j = r % 12288;
            float s = args.in[l ? 23 : 7][j];
            for (int kc = 0; kc < 32; ++kc) s += ADAP[((size_t)(l * 32 + kc) * 5 + b) * 12288 + j];
            MODS[i] = s;
        }
        if (blockIdx.x == 0 && wave == 0) {
            const float a = wave_sum(args.in[10][lane] * args.in[11][lane]), b = wave_sum(args.in[12][lane] * args.in[13][lane]);
            if (lane == 0) MODS[2 * 5 * 12288] = expf(a) - expf(b) + LAMBDA_INIT;
        }
    }
    SEAM(1);
    if (IN(2)) for (int rep_ = 0; rep_ < NREP(2); ++rep_) {
        PH_LOCALS;
        for (int row = gw; row < MROWS; row += NGW) {
            const int b = row / RPB, t = row % RPB; const float* md = MODS + (size_t)(t < SEQ ? b : 4) * 12288;
            f32x4 v[8]; mod_row(in_row(x_in, ctx_in, row), args.in[4], md + 0 * DM, md + 1 * DM, H + (size_t)row * DM, lane, v);
        }
    }
    SEAM(2);
    if (IN(3)) for (int rep_ = 0; rep_ < NREP(3); ++rep_) {
        PH_LOCALS;
        pg8::Gemm g{H, W_IN0, DM}; pg8::Order<pg8::MapId> S; S.init(MROWS / 256, PROJ / 256, F.G, (int)blockIdx.x, pg8::MapId{}, DM / 64);
        { LAS float* gl = (LAS float*)(F.lds + RING_BYTES) + 2048; if (tid < 256) gl[tid] = tid < 128 ? args.in[15][tid] : args.in[16][tid - 128]; __syncthreads(); }
        pg8::EpiQKV<0> E{QKV, cosA, sinA, cosB, sinB, args.in[15], args.in[16], (LAS float*)(F.lds + RING_BYTES), 1.0f, VTB};
        pg8::gemm_phase<pg8::EpiQKV<0>, pg8::Order<pg8::MapId>, false, true, true, true>(F.lds, g, S, E);
    }
    SEAM(3);
    if (IN(5)) for (int rep_ = 0; rep_ < NREP(5); ++rep_) {
        PH_LOCALS;
        const float lam = MODS[2 * 5 * 12288];
        for (int k = F.vcu; k < 256; k += F.G) {
            for (int i = 0; i < 3; ++i) {
                int b, h, qt;
                if (i < 2) { const int u = 2 * k + i; b = u >> 7; h = (u >> 4) & 7; qt = u & 15; } else { if (k >= 32) break; b = k >> 3; h = k & 7; qt = 16; }
                const size_t rb = (size_t)b * RPB;
                const att::TileMap tm = (qt < 16) ? att::TileMap{0, 0, 0, 68} : att::TileMap{0, 0, SEQ, 4};
#ifndef NO_DIFF
                att::unit_diff(QKV + (rb + qt * 256) * PROJ + h * 128, QKV + rb * PROJ + 2048 + h * 128, VTB + (size_t)(h * 128) * MROWS + rb, tm, lam, args.in[14],
                               AO + (rb + qt * 256) * DM + h * 128, (char*)lds);
#endif
            }
            for (int i = 0; i < 3; ++i) {
                int b, h, qt;
                if (i < 2) { const int u = 2 * k + i; b = u >> 7; h = (u >> 4) & 7; qt = u & 15; } else { if (k < 32 || k >= 64) break; b = (k - 32) >> 3; h = k & 7; qt = 16; }
                const size_t rb = (size_t)b * RPB; const int kv = h >> 2;
                const att::TileMap tm = (qt < 16) ? att::TileMap{0, 0, 0, 68} : att::TileMap{0, 0, SEQ, 4};
#ifndef NO_STD0
                att::unit_std<0>(QKV + (rb + qt * 256) * PROJ + 1024 + h * 128, QKV + rb * PROJ + 4096 + kv * 128, VTB + (size_t)(1024 + kv * 128) * MROWS + rb, tm, att::MaskInfo{0, 0, 0}, 0.f,
                                 AO + (rb + qt * 256) * DM + 1024 + h * 128, (char*)lds);
#endif
            }
        }
    }
    SEAM(5);
    if (IN(6)) for (int rep_ = 0; rep_ < NREP(6); ++rep_) {
        PH_LOCALS;
        pg8::Gemm g{AO, W_OUT0, DM}; pg8::Order<pg8::MapL0Split> S; S.init(NTOK / 256, DM / 256, F.G, (int)blockIdx.x, pg8::MapL0Split{}, DM / 64, 4, 8);
        pg8::EpiResid E{x_in, ctx_in, XR, MODS, 2, 1, SLABW, 1.0f};
        pg8::gemm_phase<pg8::EpiResid, pg8::Order<pg8::MapL0Split>>(F.lds, g, S, E);
    }
    SEAM(6);
    if (IN(7)) for (int rep_ = 0; rep_ < NREP(7); ++rep_) {
        PH_LOCALS;
        for (int row = gw; row < MROWS; row += NGW) {
            const int b = row / RPB, t = row % RPB; const float* md = MODS + (size_t)(t < SEQ ? b : 4) * 12288;
#if FFN0_FP8 == 2
            f32x4 v[8]; mod_row<true>(t < SEQ ? XR + (size_t)row * DM : in_row(x_in, ctx_in, row), args.in[5], md + 3 * DM, md + 4 * DM, (bf16_t*)((unsigned char*)H + (size_t)row * DM), lane, v,
                                      t < SEQ ? nullptr : SLABW + ((size_t)b * NCTX + (t - SEQ)) * DM, (size_t)NB * NCTX * DM, 8, XR + (size_t)row * DM);
#else
            f32x4 v[8]; mod_row(t < SEQ ? XR + (size_t)row * DM : in_row(x_in, ctx_in, row), args.in[5], md + 3 * DM, md + 4 * DM, H + (size_t)row * DM, lane, v,
                                t < SEQ ? nullptr : SLABW + ((size_t)b * NCTX + (t - SEQ)) * DM, (size_t)NB * NCTX * DM, 8, XR + (size_t)row * DM);
#endif
        }
    }
    SEAM(7);
    if (IN(8)) for (int rep_ = 0; rep_ < NREP(8); ++rep_) {
        PH_LOCALS;
#if FFN0_FP8 == 2
        pg8::Gemm g{H, W_GU0, DM / 2}; pg8::Order<pg8::MapId> S; S.init(MROWS / 256, 2 * DFF / 256, F.G, (int)blockIdx.x, pg8::MapId{}, DM / 128);
        pg8::EpiSwiGLU8 E{(unsigned char*)MID, DFF, 2 * DFF / 256, 1.0f / (S_H8 * S_W8), S_M8 / (S_H8 * S_W8)};
        pg8::gemm_phase<pg8::EpiSwiGLU8, pg8::Order<pg8::MapId>, true>(F.lds, g, S, E);
#elif FFN0_FP8 == 1
        pg8::Gemm g{H, W_GU0, DM}; pg8::Order<pg8::MapId> S; S.init(MROWS / 256, 2 * DFF / 256, F.G, (int)blockIdx.x, pg8::MapId{}, DM / 64);
        pg8::EpiSwiGLU8 E{(unsigned char*)MID, DFF, 2 * DFF / 256, 1.0f, S_M8};
        pg8::gemm_phase(F.lds, g, S, E);
#else
        pg8::Gemm g{H, W_GU0, DM}; pg8::Order<pg8::MapId> S; S.init(MROWS / 256, 2 * DFF / 256, F.G, (int)blockIdx.x, pg8::MapId{}, DM / 64);
        pg8::EpiSwiGLU E{MID, DFF, 2 * DFF / 256};
        pg8::gemm_phase(F.lds, g, S, E);
#endif
    }
    SEAM(8);
    if (IN(9)) for (int rep_ = 0; rep_ < NREP(9); ++rep_) {
        PH_LOCALS;
#if FFN0_FP8 >= 1
        pg8::Gemm g{MID, W_DN0, DFF / 2}; pg8::Order<pg8::MapL0Split> S; S.init(NTOK / 256, DM / 256, F.G, (int)blockIdx.x, pg8::MapL0Split{}, DFF / 128, 4, NS0);
        pg8::EpiResid E{x_in, ctx_in, XR, MODS, 5, 0, SLAB0, 1.0f / (S_M8 * S_W8)};
        pg8::gemm_phase<pg8::EpiResid, pg8::Order<pg8::MapL0Split>, true>(F.lds, g, S, E);
#else
        pg8::Gemm g{MID, W_DN0, DFF}; pg8::Order<pg8::MapL0Split> S; S.init(NTOK / 256, DM / 256, F.G, (int)blockIdx.x, pg8::MapL0Split{}, DFF / 64, 4, NS0);
        pg8::EpiResid E{x_in, ctx_in, XR, MODS, 5, 0, SLAB0, 1.0f};
        pg8::gemm_phase(F.lds, g, S, E);
#endif
    }
    SEAM(9);
    if (IN(10)) for (int rep_ = 0; rep_ < NREP(10); ++rep_) {
        PH_LOCALS;
        for (int row = gw; row < MROWS; row += NGW) {
            const int b = row / RPB, t = row % RPB; const float* md = MODS1 + (size_t)(t < SEQ ? b : 4) * 12288;
#if L1ATT_FP8
            f32x4 v[8]; mod_row<true>(XR + (size_t)row * DM, args.in[20], md + 0 * DM, md + 1 * DM, (bf16_t*)((unsigned char*)H + (size_t)row * DM), lane, v, t < SEQ ? nullptr : SLAB0 + ((size_t)b * NCTX + (t - SEQ)) * DM, (size_t)NB * NCTX * DM, NS0);
#else
            f32x4 v[8]; mod_row(XR + (size_t)row * DM, args.in[20], md + 0 * DM, md + 1 * DM, H + (size_t)row * DM, lane, v, t < SEQ ? nullptr : SLAB0 + ((size_t)b * NCTX + (t - SEQ)) * DM, (size_t)NB * NCTX * DM, NS0);
#endif
        }
    }
    SEAM(10);
    if (IN(11)) for (int rep_ = 0; rep_ < NREP(11); ++rep_) {
        PH_LOCALS;
        pg8::Gemm g{H, W_IN1, L1ATT_FP8 ? DM / 2 : DM}; pg8::Order<pg8::MapId> S; S.init(MROWS / 256, PROJ / 256, F.G, (int)blockIdx.x, pg8::MapId{}, L1ATT_FP8 ? DM / 128 : DM / 64);
#if L1ATT_FP8
        pg8::EpiQKV<1> E{QKV, cosA, sinA, cosB, sinB, nullptr, nullptr, (LAS float*)(F.lds + RING_BYTES), 1.0f / (S_H8 * S_W8), VTB};
        pg8::gemm_phase<pg8::EpiQKV<1>, pg8::Order<pg8::MapId>, true, true, true, true>(F.lds, g, S, E);
#else
        pg8::EpiQKV<1> E{QKV, cosA, sinA, cosB, sinB, nullptr, nullptr, (LAS float*)(F.lds + RING_BYTES), 1.0f, VTB};
        pg8::gemm_phase<pg8::EpiQKV<1>, pg8::Order<pg8::MapId>, false, true, true, true>(F.lds, g, S, E);
#endif
    }
    SEAM(11);
    if (IN(13)) for (int rep_ = 0; rep_ < NREP(13); ++rep_) {
        PH_LOCALS;
        float* btab = (float*)(lds + att::OFF_BIAS);
        for (int k = F.vcu; k < 256; k += F.G) {
            for (int i = 0; i < 2; ++i) {
                const int u = 2 * k + i, b = u >> 7, h = (u >> 4) & 7, qt = u & 15, kv = h >> 2; const size_t rb = (size_t)b * RPB;
                const int q0 = qt * 256, ks = (q0 - 128) < 0 ? 0 : (q0 - 128), ke = (q0 + 384) > SEQ ? SEQ : (q0 + 384);
                const att::TileMap tm{4, SEQ, ks, 4 + (ke - ks) / 64};
#ifndef NO_WIN
                att::unit_std<1>(QKV + (rb + q0) * PROJ + h * 128, QKV + rb * PROJ + 2048 + kv * 128, VTB + (size_t)(kv * 128) * MROWS + rb, tm, att::MaskInfo{q0, 0, 0}, args.in[26][h],
                                 L1ATT_FP8 ? (bf16_t*)((unsigned char*)AO + (rb + q0) * DM + h * 128) : AO + (rb + q0) * DM + h * 128, (char*)lds);
#endif
            }
            for (int i = 0; i < 2; ++i) {
                const int u = 2 * k + i, b = u >> 7, h = (u >> 4) & 7, qt = u & 15; const size_t rb = (size_t)b * RPB;
                const int r0 = qt * 4; int lo_ = r0 - 4; lo_ = lo_ < 0 ? 0 : (lo_ > 52 ? 52 : lo_);
                for (int j = tid; j < 15 * 31; j += 512) btab[j] = args.in[27][h * 465 + j] * ((PRESCALE && L1PRE && ATT_DMA) ? LOG2E : (1.0f / ATT_SCALE));
                __syncthreads();
                const att::TileMap tm{4, SEQ, lo_ * 64, 16};
#ifndef NO_NA
                att::unit_std<2>(QKV + (rb + qt * 256) * PROJ + 1024 + h * 128, QKV + rb * PROJ + 2560 + h * 128, VTB + (size_t)(256 + h * 128) * MROWS + rb, tm, att::MaskInfo{0, r0, lo_}, 0.f,
                                 L1ATT_FP8 ? (bf16_t*)((unsigned char*)AO + (rb + qt * 256) * DM + 1024 + h * 128) : AO + (rb + qt * 256) * DM + 1024 + h * 128, (char*)lds);
#endif
            }
        }
    }
    SEAM(13);
    if (IN(14)) for (int rep_ = 0; rep_ < NREP(14); ++rep_) {
        PH_LOCALS;
#if L1ATT_FP8
        pg8::Gemm g{AO, W_OUT1, DM / 2}; pg8::Order<pg8::MapLatent> S; S.init(NTOK / 256, DM / 256, F.G, (int)blockIdx.x, pg8::MapLatent{}, DM / 128);
        pg8::EpiResid E{x_in, ctx_in, XR, MODS1, 2, 0, nullptr, 1.0f / (S_A8 * S_W8)};
        pg8::gemm_phase<pg8::EpiResid, pg8::Order<pg8::MapLatent>, true>(F.lds, g, S, E);
#else
        pg8::Gemm g{AO, W_OUT1, DM}; pg8::Order<pg8::MapLatent> S; S.init(NTOK / 256, DM / 256, F.G, (int)blockIdx.x, pg8::MapLatent{}, DM / 64);
        pg8::EpiResid E{x_in, ctx_in, XR, MODS1, 2, 0, nullptr, 1.0f};
        pg8::gemm_phase(F.lds, g, S, E);
#endif
    }
    SEAM(14);
    if (IN(15)) for (int rep_ = 0; rep_ < NREP(15); ++rep_) {
        PH_LOCALS;
        LAS float* wt = (LAS float*)F.lds;
        LAS int* ce = (LAS int*)(F.lds + 65536);
        for (int i = tid; i < DM * NE; i += 512) { const int kk = i >> 3, e = i & 7; wt[e * DM + kk] = args.in[28][i]; }
        __syncthreads();
        for (int chunk = blockIdx.x; chunk < NTOK / 64; chunk += F.G) {
            for (int i = 0; i < 8; ++i) {
                const int tl = wave * 8 + i, n = chunk * 64 + tl, b = n >> 12, t = n & 4095, row = b * RPB + t;
                const float* md = MODS1 + (size_t)b * 12288;
                f32x4 v[8]; mod_row<true>(XR + (size_t)row * DM, args.in[21], md + 3 * DM, md + 4 * DM, (bf16_t*)((unsigned char*)H + (size_t)row * DM), lane, v);
                float lg[8];
#pragma unroll
                for (int e = 0; e < 8; ++e) { float s = 0.f;
#pragma unroll
                    for (int j = 0; j < 8; ++j) { const f32x4 w = *(const LAS f32x4*)(wt + e * DM + 256 * j + 4 * lane); s += (v[j].x * w.x + v[j].y * w.y) + (v[j].z * w.z + v[j].w * w.w); }
                    lg[e] = wave_sum(s); }
                int e0 = 0; float l0 = lg[0];
#pragma unroll
                for (int e = 1; e < 8; ++e) if (lg[e] > l0) { l0 = lg[e]; e0 = e; }
                int e1 = -1; float l1 = -3.4e38f;
#pragma unroll
                for (int e = 0; e < 8; ++e) if (e != e0 && lg[e] > l1) { l1 = lg[e]; e1 = e; }
                if (lane == 0) { ce[tl * 2] = e0; ce[tl * 2 + 1] = e1; const float g1 = 1.0f / (1.0f + expf(l0 - l1)); GATES[n * 2] = 1.0f - g1; GATES[n * 2 + 1] = g1; }
            }
            __syncthreads();
            if (wave == 0) {
                const int e0 = ce[lane * 2], e1 = ce[lane * 2 + 1]; int rk0 = 0, rk1 = 0;
                const unsigned long long below = (1ull << lane) - 1ull;
#pragma unroll
                for (int e = 0; e < 8; ++e) {
                    const unsigned long long m0 = __ballot(e0 == e), m1 = __ballot(e1 == e);
                    const int c0 = __popcll(m0);
                    if (e0 == e) rk0 = __popcll(m0 & below);
                    if (e1 == e) rk1 = c0 + __popcll(m1 & below);
                    if (lane == 0) CNT[chunk * 8 + e] = c0 + __popcll(m1);
                }
                const int n = chunk * 64 + lane;
                ROUTE[n * 4 + 0] = e0; ROUTE[n * 4 + 1] = e1; ROUTE[n * 4 + 2] = rk0; ROUTE[n * 4 + 3] = rk1;
            }
            __syncthreads();
        }
    }
    SEAM(15);
    if (IN(16)) for (int rep_ = 0; rep_ < NREP(16); ++rep_) {
        PH_LOCALS;
        LAS int* tot = (LAS int*)F.lds; LAS int* pre = tot + 8; LAS int* base = tot + 16;
        for (int chunk = blockIdx.x; chunk < NTOK / 64; chunk += F.G) {
            { const int e = wave; int a = 0, p = 0;
#pragma unroll
              for (int i = 0; i < 4; ++i) { const int c = 4 * lane + i; const int v = CNT[c * 8 + e]; a += v; p += (c < chunk) ? v : 0; }
              a = (int)wave_sum((float)a); p = (int)wave_sum((float)p);
              if (lane == 0) { tot[e] = a; pre[e] = p; } }
            __syncthreads();
            if (tid == 0) { int s = 0; for (int e = 0; e < 8; ++e) { base[e] = s; s += (tot[e] + 255) / 256 * 256; } base[8] = s; }
            __syncthreads();
            if (chunk == 0 && tid < CAP_TILES + 1) {
                const int ntile = base[8] / 256;
                if (tid == CAP_TILES) TILEE[CAP_TILES] = ntile;
                else { int e = 0; for (int q = 1; q < 8; ++q) if (tid * 256 >= base[q]) e = q; TILEE[tid] = e; }
            }
            for (int i = 0; i < 8; ++i) {
                const int tl = wave * 8 + i, n = chunk * 64 + tl, b = n >> 12, t = n & 4095, row = b * RPB + t;
                const int e0 = ROUTE[n * 4 + 0], e1 = ROUTE[n * 4 + 1], rk0 = ROUTE[n * 4 + 2], rk1 = ROUTE[n * 4 + 3];
                const int s0 = base[e0] + pre[e0] + rk0, s1 = base[e1] + pre[e1] + rk1;
                if (lane == 0) { SLOT[n * 2] = s0; SLOT[n * 2 + 1] = s1; }
                const u32x4* src = (const u32x4*)((const unsigned char*)H + (size_t)row * DM) + lane;
                u32x4* d0 = (u32x4*)((unsigned char*)XG + (size_t)s0 * DM) + lane; u32x4* d1 = (u32x4*)((unsigned char*)XG + (size_t)s1 * DM) + lane;
#pragma unroll
                for (int j = 0; j < 2; ++j) { const u32x4 w = src[64 * j]; d0[64 * j] = w; d1[64 * j] = w; }
            }
            __syncthreads();
        }
    }
    SEAM(16);
    if (IN(17)) for (int rep_ = 0; rep_ < NREP(17); ++rep_) {
        PH_LOCALS;
        const int ntile = TILEE[CAP_TILES];
        pg8::Gemm g{XG, W_GU1, DM / 2}; pg8::Order<pg8::MapMoe> S; S.init(ntile, 2 * DEX / 256, F.G, (int)blockIdx.x, pg8::MapMoe{TILEE, 2 * DEX / 256}, DM / 128);
        pg8::EpiSwiGLU8 E{(unsigned char*)MID, DEX, 2 * DEX / 256, 1.0f / (S_H8 * S_W8), S_M8 / (S_H8 * S_W8)};
        pg8::gemm_phase<pg8::EpiSwiGLU8, pg8::Order<pg8::MapMoe>, true>(F.lds, g, S, E);
    }
    SEAM(17);
    if (IN(18)) for (int rep_ = 0; rep_ < NREP(18); ++rep_) {
        PH_LOCALS;
        const int ntile = TILEE[CAP_TILES];
        pg8::Gemm g{MID, W_DN1, DEX / 2}; pg8::Order<pg8::MapMoe> S; S.init(ntile < 128 ? ntile : 128, DM / 256, F.G, (int)blockIdx.x, pg8::MapMoe{TILEE, DM / 256}, DEX / 128, ntile < 128 ? 0 : ntile - 128, 4);
        pg8::EpiBf16 E{Y, DM, DM / 256, 1.0f / (S_M8 * S_W8), SLAB1};
        pg8::gemm_phase<pg8::EpiBf16, pg8::Order<pg8::MapMoe>, true>(F.lds, g, S, E);
    }
    SEAM(18);
    if (IN(19)) for (int rep_ = 0; rep_ < NREP(19); ++rep_) {
        PH_LOCALS;
        for (int n = gw; n < NTOK; n += NGW) {
            const int b = n >> 12, t = n & 4095, row = b * RPB + t;
            const int s0 = SLOT[n * 2], s1 = SLOT[n * 2 + 1]; const float g0 = GATES[n * 2], g1 = GATES[n * 2 + 1];
            const float* gt = MODS1 + (size_t)b * 12288 + 5 * DM;
            const f32x4* xr = (const f32x4*)(XR + (size_t)row * DM) + lane;
            f32x4 v[8]; float s = 0.f;
#pragma unroll
            for (int j = 0; j < 8; ++j) { f32x4 ya, yb;
                if (s0 < 128 * 256) { const u32x2 a = ((const u32x2*)(Y + (size_t)s0 * DM))[64 * j + lane]; ya = (f32x4){bf_lo(a.x), bf_hi(a.x), bf_lo(a.y), bf_hi(a.y)}; }
                else { ya = (f32x4){0.f, 0.f, 0.f, 0.f};
#pragma unroll
                    for (int p = 0; p < 4; ++p) ya += ((const f32x4*)(SLAB1 + ((size_t)p * (7 * 256) + (s0 - 128 * 256)) * DM))[64 * j + lane]; }
                if (s1 < 128 * 256) { const u32x2 a = ((const u32x2*)(Y + (size_t)s1 * DM))[64 * j + lane]; yb = (f32x4){bf_lo(a.x), bf_hi(a.x), bf_lo(a.y), bf_hi(a.y)}; }
                else { yb = (f32x4){0.f, 0.f, 0.f, 0.f};
#pragma unroll
                    for (int p = 0; p < 4; ++p) yb += ((const f32x4*)(SLAB1 + ((size_t)p * (7 * 256) + (s1 - 128 * 256)) * DM))[64 * j + lane]; }
                const f32x4 gg = ((const f32x4*)gt)[64 * j + lane];
                v[j] = xr[64 * j] + gg * (ya * g0 + yb * g1); s += (v[j].x * v[j].x + v[j].y * v[j].y) + (v[j].z * v[j].z + v[j].w * v[j].w); }
            const float rstd = 1.0f / sqrtf(wave_sum(s) * (1.0f / DM) + EPS);
            f32x4* op = (f32x4*)(args.out + (size_t)n * DM) + lane;
#pragma unroll
            for (int j = 0; j < 8; ++j) op[64 * j] = v[j] * rstd * ((const f32x4*)args.in[32])[64 * j + lane];
        }
    }
#undef IN
#undef SEAM
}

constexpr int N_PHASES = 20;
extern "C" void kernel_launch(void* const* d_in, const int* in_sizes, int n_in, void* d_out, int out_size, void* d_ws, size_t ws_size, hipStream_t stream) {
    static int grid = 0;
    if (grid == 0) {
        if (n_in != 33 || ws_size < WS_END) { fprintf(stderr, "kernel_launch: need 33 inputs and %zu bytes of workspace; got %d, %zu\n", (size_t)WS_END, n_in, ws_size); grid = -1; return; }
        int dev = 0, cus = 0, per_cu = 0;
        if (hipGetDevice(&dev) != hipSuccess || hipDeviceGetAttribute(&cus, hipDeviceAttributeMultiprocessorCount, dev) != hipSuccess) { grid = -1; return; }
        if (hipFuncSetAttribute((const void*)hybrid_fwd, hipFuncAttributeMaxDynamicSharedMemorySize, LDS_BYTES) != hipSuccess) { fprintf(stderr, "kernel_launch: hipFuncSetAttribute failed\n"); grid = -1; return; }
        if (hipOccupancyMaxActiveBlocksPerMultiprocessor(&per_cu, (const void*)hybrid_fwd, 512, LDS_BYTES) != hipSuccess || per_cu < 1)
            fprintf(stderr, "kernel_launch: occupancy query reports %d workgroups per CU\n", per_cu);
        (void)hipGetLastError();
        grid = cus;
    }
    if (grid < 0) return;
    (void)hipMemsetAsync((char*)d_ws + WS_CTL, 0, CTL_ZERO_BYTES, stream);
    Args a{};
    for (int i = 0; i < 33; ++i) a.in[i] = (const float*)d_in[i];
    a.out = (float*)d_out; a.ws = (unsigned char*)d_ws;
#if MK_PER_PHASE
    for (int p = 0; p < N_PHASES; ++p) { a.ph_lo = p; a.ph_hi = p + 1; hipLaunchKernelGGL(hybrid_fwd, dim3(grid), dim3(512), LDS_BYTES, stream, a); }
#else
    a.ph_lo = 0; a.ph_hi = N_PHASES;
    hipLaunchKernelGGL(hybrid_fwd, dim3(grid), dim3(512), LDS_BYTES, stream, a);
#endif
    const hipError_t le = hipPeekAtLastError();
    if (le != hipSuccess) fprintf(stderr, "kernel_launch: launch failed: %s\n", hipGetErrorName(le));
}
```
